# Optimizing an MI355X kernel written in HIP

```python
import jax, jax.numpy as jnp
from jax import lax
import numpy as np

D_MODEL = 1024
BATCH = 2
SEQ = 8192
DEPTH = 2
DEC_BATCH = 32
DEC_SEQ = 8
PAST_LEN = 8192
PAGE_SIZE = 128

N_SB_LAYERS = (DEPTH + 1) // 2
N_RET_LAYERS = DEPTH // 2
H_A = 8
HD_A = 64
W_A = H_A * HD_A
SB_BIAS_INIT = -6.0
H_B = 4
DK_B = 128
DV_B = 128
F_B = H_B * DK_B
W_B = H_B * DV_B
H_C = 4
DK_C = 256
DV_C = 512
QK_C = H_C * DK_C
W_C = H_C * DV_C

W_EVEN_IN = 4 * W_A + 2 * F_B + 2 * W_B
W_EVEN_MIX = W_A + W_B
W_ODD_IN = 2 * QK_C + 2 * W_C
SPLITS_EVEN = (W_A, 2 * W_A, 3 * W_A, 4 * W_A, 4 * W_A + F_B, 4 * W_A + 2 * F_B, 4 * W_A + 2 * F_B + W_B)
SPLITS_ODD = (QK_C, 2 * QK_C, 2 * QK_C + W_C)

Q_BLOCK = 128
HGRN_CHUNK = 64
RET_CHUNK = 128
ROPE_BASE = 10000.0
NORM_EPS = 1e-6

kernel_name = 'stickbreak_hgrn2_retention_decoder_step'


def rms_norm(x, g=None):
    xf = x.astype(jnp.float32)
    y = xf * lax.rsqrt(jnp.mean(xf * xf, axis=-1, keepdims=True) + NORM_EPS)
    if g is not None:
        y = y * g.astype(jnp.float32)
    return y.astype(x.dtype)


def rotary(x, pos):
    half = x.shape[-1] // 2
    inv = 1.0 / (ROPE_BASE ** jnp.linspace(0.0, 1.0, half, dtype=jnp.float32))
    ang = pos[:, None] * inv[None, :]
    cos = jnp.cos(ang)[None, :, None, :]
    sin = jnp.sin(ang)[None, :, None, :]
    xf = x.astype(jnp.float32)
    x1, x2 = xf[..., :half], xf[..., half:]
    return jnp.concatenate([x1 * cos - x2 * sin, x2 * cos + x1 * sin], axis=-1)


def to_chunks(a, chunk):
    b, t, h, d = a.shape
    return a.reshape(b, t // chunk, chunk, h, d).transpose(1, 0, 3, 2, 4)


def from_chunks(a):
    n, b, h, c, d = a.shape
    return a.transpose(1, 0, 3, 2, 4).reshape(b, n * c, h, d)


def sb_attend(q, k, v, qpos, kpos, bias):
    scale = q.shape[-1] ** -0.5
    z = jnp.einsum('bqhd,bkhd->bhqk', q.astype(jnp.float32), k.astype(jnp.float32)) * scale
    z = z + bias.astype(jnp.float32)[None, :, None, None]
    mask = (kpos[None, :] < qpos[:, None])[None, None]
    log_keep = jnp.where(mask, jax.nn.log_sigmoid(-z), 0.0)
    log_between = lax.cumsum(log_keep, axis=3, reverse=True) - log_keep
    w = jnp.where(mask, jnp.exp(jax.nn.log_sigmoid(z) + log_between), 0.0)
    return jnp.einsum('bhqk,bkhd->bqhd', w, v.astype(jnp.float32))


def sb_prompt(q, k, v, bias):
    b, t, h, d = q.shape
    nb = t // Q_BLOCK
    q_blocks = q.reshape(b, nb, Q_BLOCK, h, d).transpose(1, 0, 2, 3, 4)
    kpos = jnp.arange(t)
    qpos_blocks = kpos.reshape(nb, Q_BLOCK)
    o = lax.map(lambda a: sb_attend(a[0], k, v, a[1], kpos, bias), (q_blocks, qpos_blocks))
    return o.transpose(1, 0, 2, 3, 4).reshape(b, t, h, d)


def gla_chunk_scan(q, k, v, log_f, s0, chunk):
    mask = jnp.tril(jnp.ones((chunk, chunk), dtype=bool))[None, None, :, :, None]

    def step(S, inp):
        qc, kc, vc, gc = inp
        bcum = jnp.cumsum(gc, axis=2)
        o_inter = jnp.einsum('bhtk,bhkv->bhtv', qc * jnp.exp(bcum), S)
        diff = bcum[:, :, :, None, :] - bcum[:, :, None, :, :]
        decay = jnp.exp(jnp.where(mask, diff, -jnp.inf))
        scores = jnp.einsum('bhtk,bhsk,bhtsk->bhts', qc, kc, decay)
        o_intra = jnp.einsum('bhts,bhsv->bhtv', scores, vc)
        blast = bcum[:, :, -1, :]
        S_new = jnp.exp(blast)[..., None] * S + jnp.einsum('bhsk,bhsv->bhkv', kc * jnp.exp(blast[:, :, None, :] - bcum), vc)
        return S_new, o_inter + o_intra

    S_fin, o = lax.scan(step, s0, (to_chunks(q, chunk), to_chunks(k, chunk), to_chunks(v, chunk), to_chunks(log_f, chunk)))
    return from_chunks(o), S_fin


def retention_chunk_scan(q, k, v, log_gamma, s0, chunk):
    idx = jnp.arange(chunk, dtype=jnp.float32)
    rel = idx[:, None] - idx[None, :]
    causal = rel >= 0
    intra_decay = jnp.exp(jnp.where(causal[None], rel[None] * log_gamma[:, None, None], -jnp.inf))
    q_decay = jnp.exp((idx[None, :] + 1.0) * log_gamma[:, None])[None, :, :, None]
    k_decay = jnp.exp((chunk - 1.0 - idx[None, :]) * log_gamma[:, None])[None, :, :, None]
    chunk_decay = jnp.exp(chunk * log_gamma)[None, :, None, None]

    def step(S, inp):
        qc, kc, vc = inp
        o_inter = jnp.einsum('bhtk,bhkv->bhtv', qc, S) * q_decay
        scores = jnp.einsum('bhtk,bhsk->bhts', qc, kc) * intra_decay[None]
        o_intra = jnp.einsum('bhts,bhsv->bhtv', scores, vc)
        S_new = chunk_decay * S + jnp.einsum('bhsk,bhsv->bhkv', kc * k_decay, vc)
        return S_new, o_inter + o_intra

    S_fin, o = lax.scan(step, s0, (to_chunks(q, chunk), to_chunks(k, chunk), to_chunks(v, chunk)))
    return from_chunks(o), S_fin


def even_mixer(h, w_in, w_out, qg, kg, sbb, lb, og, s0, past_k, past_v, chunk):
    f32 = jnp.float32
    b, t, _ = h.shape
    qa, ka, va, ga, qb, fb, ib, gb = jnp.split(h @ w_in, SPLITS_EVEN, axis=-1)
    qa = rms_norm(qa.reshape(b, t, H_A, HD_A), qg)
    ka = rms_norm(ka.reshape(b, t, H_A, HD_A), kg)
    va = va.reshape(b, t, H_A, HD_A)
    if past_k is None:
        oa = sb_prompt(qa, ka, va, sbb)
    else:
        p = past_k.shape[1]
        keys = jnp.concatenate([past_k, ka.astype(past_k.dtype)], axis=1)
        vals = jnp.concatenate([past_v, va.astype(past_v.dtype)], axis=1)
        oa = sb_attend(qa, keys, vals, p + jnp.arange(t), jnp.arange(p + t), sbb)
    fb32 = fb.astype(f32).reshape(b, t, H_B, DK_B)
    lb = lb.reshape(H_B, DK_B)
    log_f = jnp.log(lb + (1.0 - lb) * jax.nn.sigmoid(fb32))
    k_b = (1.0 - lb) * jax.nn.sigmoid(-fb32)
    q_b = jax.nn.silu(qb.astype(f32)).reshape(b, t, H_B, DK_B)
    v_b = ib.astype(f32).reshape(b, t, H_B, DV_B)
    ob, s_new = gla_chunk_scan(q_b, k_b, v_b, log_f, s0, chunk)
    ob = rms_norm(ob, og)
    mix = jnp.concatenate([oa.reshape(b, t, W_A) * jax.nn.silu(ga.astype(f32)),
                           ob.reshape(b, t, W_B) * jax.nn.silu(gb.astype(f32))], axis=-1)
    return mix.astype(h.dtype) @ w_out, ka, va, s_new


def odd_mixer(h, pos, w_in, w_out, s0, chunk):
    f32 = jnp.float32
    b, t, _ = h.shape
    q, k, v, g = jnp.split(h @ w_in, SPLITS_ODD, axis=-1)
    q = rotary(q.reshape(b, t, H_C, DK_C), pos)
    k = rotary(k.reshape(b, t, H_C, DK_C), pos) * (DK_C ** -0.5)
    v = v.astype(f32).reshape(b, t, H_C, DV_C)
    log_gamma = jnp.log1p(-jnp.exp2(-5.0 - jnp.arange(H_C, dtype=f32)))
    o, s_new = retention_chunk_scan(q, k, v, log_gamma, s0, chunk)
    o = rms_norm(o).reshape(b, t, W_C) * jax.nn.silu(g.astype(f32))
    return o.astype(h.dtype) @ w_out, s_new


def setup_inputs(seed: int = 0) -> dict:
    key = jax.random.key(seed)
    ks = jax.random.split(key, 17)
    f32 = jnp.float32
    n_pages = PAST_LEN // PAGE_SIZE
    n_used = DEC_BATCH * n_pages
    n_pool = (5 * n_used + 3) // 4
    nrm = jax.random.normal
    x_prompt = nrm(ks[0], (BATCH, SEQ, D_MODEL), f32)
    x_sample = nrm(ks[1], (DEC_BATCH, DEC_SEQ, D_MODEL), f32)
    cache_k = nrm(ks[2], (N_SB_LAYERS, n_pool, PAGE_SIZE, H_A, HD_A), f32)
    cache_v = nrm(ks[3], (N_SB_LAYERS, n_pool, PAGE_SIZE, H_A, HD_A), f32)
    page_table = jax.random.permutation(ks[4], n_pool)[:n_used].reshape(DEC_BATCH, n_pages).astype(jnp.int32)
    state_hgrn = 0.5 * nrm(ks[5], (N_SB_LAYERS, DEC_BATCH, H_B, DK_B, DV_B), f32)
    state_ret = 0.5 * nrm(ks[6], (N_RET_LAYERS, DEC_BATCH, H_C, DK_C, DV_C), f32)
    norm_g = 1.0 + 0.1 * nrm(ks[7], (DEPTH, D_MODEL), f32)
    w_in_even = nrm(ks[8], (N_SB_LAYERS, D_MODEL, W_EVEN_IN), f32) * D_MODEL ** -0.5
    w_out_even = nrm(ks[9], (N_SB_LAYERS, W_EVEN_MIX, D_MODEL), f32) * W_EVEN_MIX ** -0.5
    q_norm_g = 1.0 + 0.1 * nrm(ks[10], (N_SB_LAYERS, HD_A), f32)
    k_norm_g = 1.0 + 0.1 * nrm(ks[11], (N_SB_LAYERS, HD_A), f32)
    sb_logit_bias = SB_BIAS_INIT + 0.1 * nrm(ks[16], (N_SB_LAYERS, H_A), f32)
    hgrn_lower_bounds = 0.5 * nrm(ks[12], (N_SB_LAYERS + 1, F_B), f32)
    hgrn_out_norm_g = 1.0 + 0.1 * nrm(ks[13], (N_SB_LAYERS, DV_B), f32)
    w_in_odd = nrm(ks[14], (N_RET_LAYERS, D_MODEL, W_ODD_IN), f32) * D_MODEL ** -0.5
    w_out_odd = nrm(ks[15], (N_RET_LAYERS, W_C, D_MODEL), f32) * W_C ** -0.5
    return {'x_prompt': x_prompt, 'x_sample': x_sample, 'cache_k': cache_k, 'cache_v': cache_v,
            'page_table': page_table, 'state_hgrn': state_hgrn, 'state_ret': state_ret,
            'norm_g': norm_g, 'w_in_even': w_in_even, 'w_out_even': w_out_even,
            'q_norm_g': q_norm_g, 'k_norm_g': k_norm_g, 'sb_logit_bias': sb_logit_bias,
            'hgrn_lower_bounds': hgrn_lower_bounds,
            'hgrn_out_norm_g': hgrn_out_norm_g, 'w_in_odd': w_in_odd, 'w_out_odd': w_out_odd}


def reference(x_prompt, x_sample, cache_k, cache_v, page_table, state_hgrn, state_ret, norm_g,
              w_in_even, w_out_even, q_norm_g, k_norm_g, sb_logit_bias, hgrn_lower_bounds,
              hgrn_out_norm_g, w_in_odd, w_out_odd):
    f32 = jnp.float32
    bp, tp, _ = x_prompt.shape
    bs, ts, _ = x_sample.shape
    past_len = page_table.shape[1] * cache_k.shape[2]
    pos_p = jnp.arange(tp, dtype=f32)
    pos_s = past_len + jnp.arange(ts, dtype=f32)
    lower_bounds = jnp.cumsum(jax.nn.softmax(hgrn_lower_bounds.astype(f32), axis=0), axis=0)
    yp, ys = x_prompt, x_sample
    k_p, v_p, k_s, v_s, hg_p, hg_s, rt_p, rt_s = [], [], [], [], [], [], [], []
    for layer in range(DEPTH):
        e = layer // 2
        hp = rms_norm(yp, norm_g[layer])
        hs = rms_norm(ys, norm_g[layer])
        if layer % 2 == 0:
            wts = (w_in_even[e], w_out_even[e], q_norm_g[e], k_norm_g[e], sb_logit_bias[e],
                   lower_bounds[e], hgrn_out_norm_g[e])
            past_k = jnp.take(cache_k[e], page_table, axis=0).reshape(bs, past_len, H_A, HD_A)
            past_v = jnp.take(cache_v[e], page_table, axis=0).reshape(bs, past_len, H_A, HD_A)
            s0p = jnp.zeros((bp, H_B, DK_B, DV_B), f32)
            op, kn, vn, sn = even_mixer(hp, *wts, s0p, None, None, HGRN_CHUNK)
            os_, kn2, vn2, sn2 = even_mixer(hs, *wts, state_hgrn[e].astype(f32), past_k, past_v, ts)
            k_p.append(kn.astype(cache_k.dtype)); v_p.append(vn.astype(cache_v.dtype))
            k_s.append(kn2.astype(cache_k.dtype)); v_s.append(vn2.astype(cache_v.dtype))
            hg_p.append(sn.astype(state_hgrn.dtype)); hg_s.append(sn2.astype(state_hgrn.dtype))
        else:
            s0p = jnp.zeros((bp, H_C, DK_C, DV_C), f32)
            op, sn = odd_mixer(hp, pos_p, w_in_odd[e], w_out_odd[e], s0p, RET_CHUNK)
            os_, sn2 = odd_mixer(hs, pos_s, w_in_odd[e], w_out_odd[e], state_ret[e].astype(f32), ts)
            rt_p.append(sn.astype(state_ret.dtype)); rt_s.append(sn2.astype(state_ret.dtype))
        yp = yp + op
        ys = ys + os_
    return (yp, ys, jnp.stack(k_p), jnp.stack(v_p), jnp.stack(k_s), jnp.stack(v_s),
            jnp.stack(hg_p), jnp.stack(hg_s), jnp.stack(rt_p), jnp.stack(rt_s))
```

```cpp
#include <hip/hip_runtime.h>
#include <cstdio>
#include <cstdint>

constexpr int DM = 1024, TP = 8192, NBP = 2, MP = NBP * TP;
constexpr int NSQ = 32, TSQ = 8, MSM = NSQ * TSQ;
constexpr int MT = MP + MSM;
constexpr int PAST = 8192, PAGE = 128, NPG = PAST / PAGE;
constexpr int HA = 8, HDA = 64, WA = 512, HB = 4, DKB = 128, DVB = 128, HC = 4, DKC = 256, DVC = 512, WC = 2048;
constexpr int N1 = 4096, N3 = 6144;
constexpr float EPS = 1e-6f;
constexpr float LOG2E = 1.4426950408889634f;
constexpr size_t OY_P = 0, OY_S = 16777216, OK_P = 17039360, OV_P = 25427968, OK_S = 33816576, OV_S = 33947648,
                 OHG_P = 34078720, OHG_S = 34209792, ORT_P = 36306944, ORT_S = 37355520, OUT_TOTAL = 54132736;
#define MK_N_LAUNCHES 12
namespace pg8 {
#define PG8_LAS __attribute__((address_space(3)))
typedef unsigned short bf16_t;
typedef short bf16x8 __attribute__((ext_vector_type(8)));
typedef float f32x4 __attribute__((ext_vector_type(4)));
typedef unsigned u32x4 __attribute__((ext_vector_type(4)));
constexpr int BM = 256, BK = 64, HALF = 128, HTB = HALF * BK * 2  , STAGE_BYTES = 8 * HTB, NXCD = 8, WGM = 8;

__host__ __device__ __forceinline__ int lds_byte(int r, int c) { const int st = (r >> 4) * 2 + (c >> 5), rr = r & 15, cc = c & 31, ob = rr * 64 + cc * 2; return st * 1024 + (ob ^ (((ob >> 9) & 1) << 5)); }
__host__ __device__ __forceinline__ void stage_rc(int b, int& R, int& C) { const int st = b / 1024, sb = b % 1024, swz = sb ^ (((sb >> 9) & 1) << 5); R = (st >> 1) * 16 + swz / 64; C = (st & 1) * 32 + (swz % 64) / 2; }
__host__ __device__ __forceinline__ int perm32(int rho) { const int n = rho >> 4, i = rho & 15; return 8 * (i >> 2) + 4 * n + (i & 3); }

struct Unit { int pm, pn; };
struct Gemm { const bf16_t* A; const bf16_t* Bt; int M, N, K; };

struct StaticOrder {
    int nM, nN, nwg, G, c;
    __host__ __device__ void init(int M, int N, int G_, int c_) { nM = M / BM; nN = N / BM; nwg = nM * nN; G = G_; c = c_; }
    __host__ __device__ bool next(int i, Unit& u) const {
        const long L = (long)i * G + c; if (L >= nwg) return false;
        int wgid = (int)L; { const int q = nwg / NXCD, r = nwg % NXCD, xcd = wgid % NXCD, off = wgid / NXCD; wgid = (xcd < r ? xcd * (q + 1) : r * (q + 1) + (xcd - r) * q) + off; }
        const int nig = WGM * nN, gid = wgid / nig, fm = gid * WGM, gsz = (nM - fm) < WGM ? (nM - fm) : WGM;
        u.pm = fm + ((wgid % nig) % gsz); u.pn = (wgid % nig) / gsz; return true;
    }
    __device__ __forceinline__ void a_ready(const Unit&) const {}
    __device__ __forceinline__ void done(const Unit&) const {}
};
__device__ __forceinline__ unsigned cvt_pk_bf16(float lo, float hi) { unsigned r; asm volatile("v_cvt_pk_bf16_f32 %0, %1, %2" : "=v"(r) : "v"(lo), "v"(hi)); return r; }
typedef float f32x2 __attribute__((ext_vector_type(2)));
template <class Epi, class Sched, bool ALIGN_EPI = false, bool SP2 = false>
__device__ __forceinline__ void gemm_phase(PG8_LAS unsigned char* lds, const Gemm g, const Sched& S, const Epi& E) {
    const int tid = threadIdx.x, wid = __builtin_amdgcn_readfirstlane(tid >> 6), lane = tid & 63, wr = wid >> 2, wc = wid & 3, fr = lane & 15, fq = lane >> 4;
    const int K = g.K, nt = K / BK;
    unsigned voffA[2], voffB[2];
#pragma unroll
    for (int i = 0; i < 2; ++i) { int R, C; stage_rc(tid * 16 + i * 8192, R, C); const int Rb = Epi::PERM ? ((R & ~31) + perm32(R & 31)) : R;
        voffA[i] = (unsigned)(R * K + C) * 2u; voffB[i] = (unsigned)(Rb * K + C) * 2u; }
    const size_t kstep = (size_t)(BK * 2);
    const size_t hstep = (size_t)HALF * K * 2;
    const size_t tstep = 2 * hstep;
    const unsigned ldsw = (unsigned)wid * 1024u;
    const int aoff = lds_byte(wr * 64 + fr, fq * 8), boff = lds_byte(wc * 32 + fr, fq * 8);
#define PG8_SA(b, h) (((b) * 2 + (h)) * HTB)
#define PG8_SB(b, h) ((4 + (b) * 2 + (h)) * HTB)
#define PG8_STAGE(bufoff, gbase, voff) do { _Pragma("unroll") for (int _i = 0; _i < 2; ++_i) \
        __builtin_amdgcn_global_load_lds((const unsigned*)((const char*)(gbase) + (voff)[_i]), (PG8_LAS unsigned*)(lds + (bufoff) + ldsw + _i * 8192), 16, 0, 0); } while (0)
#define PG8_LDA(dst, b, h) do { _Pragma("unroll") for (int m = 0; m < 4; ++m) _Pragma("unroll") for (int k = 0; k < 2; ++k) dst[m][k] = *(const PG8_LAS bf16x8*)(lds + PG8_SA(b, h) + aoff + m * 2048 + k * 1024); } while (0)
#define PG8_LDB(dst, b, h) do { _Pragma("unroll") for (int n = 0; n < 2; ++n) _Pragma("unroll") for (int k = 0; k < 2; ++k) dst[n][k] = *(const PG8_LAS bf16x8*)(lds + PG8_SB(b, h) + boff + n * 2048 + k * 1024); } while (0)
#define PG8_MMA(ai, bj, At, Bt) do { __builtin_amdgcn_s_setprio(1); _Pragma("unroll") for (int m = 0; m < 4; ++m) _Pragma("unroll") for (int n = 0; n < 2; ++n) _Pragma("unroll") for (int k = 0; k < 2; ++k) \
        acc[ai][bj][m][n] = __builtin_amdgcn_mfma_f32_16x16x32_bf16(Bt[n][k], At[m][k], acc[ai][bj][m][n], 0, 0, 0); __builtin_amdgcn_s_setprio(0); } while (0)
#define PG8_WAIT_V(n) asm volatile("s_waitcnt vmcnt(" #n ")" ::: "memory")
#define PG8_WAIT_L(n) asm volatile("s_waitcnt lgkmcnt(" #n ")" ::: "memory")
#define PG8_BAR __builtin_amdgcn_s_barrier()
#define PG8_SCHED __builtin_amdgcn_sched_barrier(0)
    Unit cur, nxt; int ui = 0;
    if (!S.next(0, cur)) return;
    f32x4 acc[2][2][4][2];
#pragma unroll
    for (int a = 0; a < 2; ++a)
#pragma unroll
        for (int b = 0; b < 2; ++b)
#pragma unroll
            for (int m = 0; m < 4; ++m)
#pragma unroll
                for (int n = 0; n < 2; ++n) acc[a][b][m][n] = (f32x4){0.f, 0.f, 0.f, 0.f};
    bf16x8 At[4][2], B0[2][2], B1[2][2];
    const char* cA = (const char*)g.A + (size_t)cur.pm * tstep; const char* cB = (const char*)g.Bt + (size_t)cur.pn * tstep;
    S.a_ready(cur);
    if constexpr (SP2) {
        PG8_STAGE(PG8_SB(0, 0), cB, voffB); PG8_STAGE(PG8_SB(0, 1), cB + hstep, voffB); PG8_STAGE(PG8_SA(0, 0), cA, voffA); PG8_STAGE(PG8_SA(0, 1), cA + hstep, voffA);
        if (wr == 1) PG8_BAR;
        PG8_WAIT_V(2); PG8_BAR;
        PG8_STAGE(PG8_SB(1, 0), cB + kstep, voffB); PG8_STAGE(PG8_SA(1, 0), cA + kstep, voffA); PG8_STAGE(PG8_SB(1, 1), cB + hstep + kstep, voffB);
        PG8_WAIT_V(6); PG8_BAR;
    } else {
        PG8_STAGE(PG8_SB(0, 0), cB, voffB); PG8_STAGE(PG8_SA(0, 0), cA, voffA); PG8_STAGE(PG8_SB(0, 1), cB + hstep, voffB); PG8_STAGE(PG8_SA(0, 1), cA + hstep, voffA);
        if (wr == 1) PG8_BAR;
        PG8_WAIT_V(4); PG8_BAR;
        PG8_STAGE(PG8_SB(1, 0), cB + kstep, voffB); PG8_STAGE(PG8_SA(1, 0), cA + kstep, voffA); PG8_STAGE(PG8_SB(1, 1), cB + hstep + kstep, voffB);
        PG8_WAIT_V(6); PG8_BAR;
    }
    for (;;) {
        const bool has_next = S.next(ui + 1, nxt);
        const char* nA = has_next ? (const char*)g.A + (size_t)nxt.pm * tstep : cA; const char* nB = has_next ? (const char*)g.Bt + (size_t)nxt.pn * tstep : cB;
        for (int t = 0; t < nt; t += 2) {
            const bool last = (t == nt - 2);
            const char* a1 = cA + (size_t)(t + 1) * kstep;
            const char* a2 = last ? nA : cA + (size_t)(t + 2) * kstep; const char* b2 = last ? nB : cB + (size_t)(t + 2) * kstep;
            const char* a3 = a2 + kstep; const char* b3 = b2 + kstep;
            if (last && has_next) S.a_ready(nxt);
            if constexpr (SP2) {
            PG8_LDB(B0, 0, 0); PG8_LDB(B1, 0, 1); PG8_SCHED; PG8_LDA(At, 0, 0); PG8_STAGE(PG8_SA(1, 1), a1 + hstep, voffA);
            PG8_WAIT_V(8); PG8_WAIT_L(0); PG8_BAR; PG8_MMA(0, 0, At, B0); PG8_MMA(0, 1, At, B1); PG8_BAR; PG8_SCHED;
            PG8_LDA(At, 0, 1); PG8_STAGE(PG8_SB(0, 0), b2, voffB); PG8_STAGE(PG8_SB(0, 1), b2 + hstep, voffB); PG8_STAGE(PG8_SA(0, 0), a2, voffA);
            PG8_WAIT_V(8); PG8_WAIT_L(0); PG8_BAR; PG8_MMA(1, 0, At, B0); PG8_MMA(1, 1, At, B1); PG8_BAR; PG8_SCHED;
            PG8_LDB(B0, 1, 0); PG8_LDB(B1, 1, 1); PG8_SCHED; PG8_LDA(At, 1, 0); PG8_STAGE(PG8_SA(0, 1), a2 + hstep, voffA);
            PG8_WAIT_V(8); PG8_WAIT_L(0); PG8_BAR; PG8_MMA(0, 0, At, B0); PG8_MMA(0, 1, At, B1); PG8_BAR; PG8_SCHED;
            PG8_LDA(At, 1, 1); PG8_STAGE(PG8_SB(1, 0), b3, voffB); PG8_STAGE(PG8_SB(1, 1), b3 + hstep, voffB); PG8_STAGE(PG8_SA(1, 0), a3, voffA);
            PG8_WAIT_V(8); PG8_WAIT_L(0); PG8_BAR; PG8_MMA(1, 0, At, B0); PG8_MMA(1, 1, At, B1); PG8_BAR; PG8_SCHED;
            } else {
            PG8_LDB(B0, 0, 0); PG8_SCHED; PG8_LDA(At, 0, 0); PG8_STAGE(PG8_SA(1, 1), a1 + hstep, voffA);
            PG8_WAIT_L(8); PG8_BAR; PG8_WAIT_L(0); PG8_MMA(0, 0, At, B0); PG8_BAR; PG8_SCHED;
            PG8_LDB(B1, 0, 1); PG8_STAGE(PG8_SB(0, 0), b2, voffB);
            PG8_BAR; PG8_WAIT_L(0); PG8_MMA(0, 1, At, B1); PG8_BAR;
            PG8_LDA(At, 0, 1); PG8_STAGE(PG8_SA(0, 0), a2, voffA);
            PG8_BAR; PG8_WAIT_L(0); PG8_MMA(1, 0, At, B0); PG8_BAR; PG8_SCHED;
            PG8_STAGE(PG8_SB(0, 1), b2 + hstep, voffB);
            PG8_WAIT_V(6); PG8_BAR; PG8_MMA(1, 1, At, B1); PG8_BAR;
            PG8_LDB(B0, 1, 0); PG8_SCHED; PG8_LDA(At, 1, 0); PG8_STAGE(PG8_SA(0, 1), a2 + hstep, voffA);
            PG8_WAIT_L(8); PG8_BAR; PG8_WAIT_L(0); PG8_MMA(0, 0, At, B0); PG8_BAR; PG8_SCHED;
            PG8_LDB(B1, 1, 1); PG8_STAGE(PG8_SB(1, 0), b3, voffB);
            PG8_BAR; PG8_WAIT_L(0); PG8_MMA(0, 1, At, B1); PG8_BAR;
            PG8_LDA(At, 1, 1); PG8_STAGE(PG8_SA(1, 0), a3, voffA);
            PG8_BAR; PG8_WAIT_L(0); PG8_MMA(1, 0, At, B0); PG8_BAR; PG8_SCHED;
            PG8_STAGE(PG8_SB(1, 1), b3 + hstep, voffB);
            PG8_WAIT_V(6); PG8_BAR; PG8_MMA(1, 1, At, B1); PG8_BAR;
            }
        }
        if constexpr (ALIGN_EPI) { if (wr == 0) PG8_BAR; }
        if constexpr (!Epi::AFTER_DRAIN) { E(acc, cur, wr, wc, fr, fq); S.done(cur); }
        if (!has_next) break;
#pragma unroll
        for (int a = 0; a < 2; ++a)
#pragma unroll
            for (int b = 0; b < 2; ++b)
#pragma unroll
                for (int m = 0; m < 4; ++m)
#pragma unroll
                    for (int n = 0; n < 2; ++n) acc[a][b][m][n] = (f32x4){0.f, 0.f, 0.f, 0.f};
        cur = nxt; cA = nA; cB = nB; ++ui;
        if constexpr (ALIGN_EPI) { if (wr == 1) PG8_BAR; }
    }
    PG8_WAIT_V(0);
    if constexpr (!ALIGN_EPI) { if (wr == 0) PG8_BAR; }
    PG8_BAR;
    if constexpr (Epi::AFTER_DRAIN) { E.fused(acc, cur, wr, wc, fr, fq, lds, wid, lane); S.done(cur); }
#undef PG8_SA
#undef PG8_SB
#undef PG8_STAGE
#undef PG8_LDA
#undef PG8_LDB
#undef PG8_MMA
#undef PG8_WAIT_V
#undef PG8_WAIT_L
#undef PG8_BAR
#undef PG8_SCHED
}
__device__ __forceinline__ float silu_f(float x) { return x / (1.f + __expf(-x)); }
__device__ __forceinline__ float sigm_f(float x) { return 1.f / (1.f + __expf(-x)); }
__device__ __forceinline__ u32x4 pack8(const f32x4 a, const f32x4 b) { u32x4 w; w.x = cvt_pk_bf16(a[0], a[1]); w.y = cvt_pk_bf16(a[2], a[3]); w.z = cvt_pk_bf16(b[0], b[1]); w.w = cvt_pk_bf16(b[2], b[3]); return w; }
__device__ __forceinline__ unsigned short bf1(float f) { return (unsigned short)(cvt_pk_bf16(f, 0.f) & 0xffffu); }

struct EpiEven {
    static constexpr bool PERM = true, AFTER_DRAIN = false;
    bf16_t *QA, *KA, *VAT, *GA, *QB, *KB, *VB, *GB; float* LOGF; float* out;
    const float *qg, *kg, *hlb; float qscale; int MTOT, MPR; size_t okp, oks, ovp, ovs;
    __device__ __forceinline__ void operator()(const f32x4 (&acc)[2][2][4][2], const Unit& u, int wr, int wc, int fr, int fq) const {
        const int typ = u.pn >> 1;
        const int c0 = (u.pn & 1) * 256 + wc * 64 + fq * 8;
        const int d0 = fq * 8;
#pragma unroll
        for (int ai = 0; ai < 2; ++ai)
#pragma unroll
            for (int m = 0; m < 4; ++m) {
                const int row = u.pm * BM + ai * HALF + wr * 64 + m * 16 + fr;
                f32x4 v[2][2];
#pragma unroll
                for (int bj = 0; bj < 2; ++bj)
#pragma unroll
                    for (int n = 0; n < 2; ++n) v[bj][n] = acc[ai][bj][m][n];
                if (typ <= 1) {
                    float ss = 0.f;
#pragma unroll
                    for (int bj = 0; bj < 2; ++bj)
#pragma unroll
                        for (int n = 0; n < 2; ++n) ss += (v[bj][n][0] * v[bj][n][0] + v[bj][n][1] * v[bj][n][1]) + (v[bj][n][2] * v[bj][n][2] + v[bj][n][3] * v[bj][n][3]);
                    ss += __shfl_xor(ss, 16); ss += __shfl_xor(ss, 32);
                    const float rstd = __builtin_amdgcn_rsqf(ss * (1.f / 64.f) + 1e-6f) * (typ == 0 ? qscale : 1.f);
                    const float* g = (typ == 0) ? qg : kg;
#pragma unroll
                    for (int bj = 0; bj < 2; ++bj) {
#pragma unroll
                        for (int n = 0; n < 2; ++n) { const f32x4 gv = *(const f32x4*)(g + d0 + 32 * bj + 4 * n); v[bj][n] = v[bj][n] * gv * rstd; }
                        const int c = c0 + 32 * bj;
                        if (typ == 0) *(u32x4*)(QA + (size_t)row * 512 + c) = pack8(v[bj][0], v[bj][1]);
                        else {
                            *(u32x4*)(KA + (size_t)row * 512 + c) = pack8(v[bj][0], v[bj][1]);
                            float* ko = out + (row < MPR ? okp + (size_t)row * 512 : oks + (size_t)(row - MPR) * 512) + c;
                            *(f32x4*)ko = v[bj][0]; *(f32x4*)(ko + 4) = v[bj][1];
                        }
                    }
                } else if (typ == 2) {
#pragma unroll
                    for (int bj = 0; bj < 2; ++bj) {
                        const int c = c0 + 32 * bj;
                        float* vo = out + (row < MPR ? ovp + (size_t)row * 512 : ovs + (size_t)(row - MPR) * 512) + c;
                        *(f32x4*)vo = v[bj][0]; *(f32x4*)(vo + 4) = v[bj][1];
#pragma unroll
                        for (int n = 0; n < 2; ++n)
#pragma unroll
                            for (int e = 0; e < 4; ++e) VAT[(size_t)(c + 4 * n + e) * MTOT + row] = bf1(v[bj][n][e]);
                    }
                } else if (typ == 5) {
#pragma unroll
                    for (int bj = 0; bj < 2; ++bj) {
                        const int c = c0 + 32 * bj;
                        f32x4 lf[2], kk[2];
#pragma unroll
                        for (int n = 0; n < 2; ++n)
#pragma unroll
                            for (int e = 0; e < 4; ++e) {
                                const int cc = c + 4 * n + e;
                                const float lb = 1.f / (1.f + __expf(hlb[512 + cc] - hlb[cc]));
                                const float sg = sigm_f(v[bj][n][e]);
                                lf[n][e] = __logf(lb + (1.f - lb) * sg);
                                kk[n][e] = (1.f - lb) * (1.f - sg);
                            }
                        *(f32x4*)(LOGF + (size_t)row * 512 + c) = lf[0]; *(f32x4*)(LOGF + (size_t)row * 512 + c + 4) = lf[1];
                        *(u32x4*)(KB + (size_t)row * 512 + c) = pack8(kk[0], kk[1]);
                    }
                } else {
                    bf16_t* dst = (typ == 3) ? GA : (typ == 4) ? QB : (typ == 6) ? VB : GB;
#pragma unroll
                    for (int bj = 0; bj < 2; ++bj) {
                        if (typ != 6) {
#pragma unroll
                            for (int n = 0; n < 2; ++n)
#pragma unroll
                                for (int e = 0; e < 4; ++e) v[bj][n][e] = silu_f(v[bj][n][e]);
                        }
                        *(u32x4*)(dst + (size_t)row * 512 + c0 + 32 * bj) = pack8(v[bj][0], v[bj][1]);
                    }
                }
            }
    }
};

struct EpiRes {
    static constexpr bool PERM = false, AFTER_DRAIN = false;
    const float *r0, *r1; float *o0, *o1; int MPR, ldc;
    __device__ __forceinline__ void operator()(const f32x4 (&acc)[2][2][4][2], const Unit& u, int wr, int wc, int fr, int fq) const {
        const int row0 = u.pm * BM + wr * 64 + fr, col0 = u.pn * BM + wc * 32 + 4 * fq;
#pragma unroll
        for (int ai = 0; ai < 2; ++ai)
#pragma unroll
            for (int m = 0; m < 4; ++m) {
                const int row = row0 + ai * HALF + m * 16;
                const float* rp = (row < MPR) ? r0 + (size_t)row * ldc : r1 + (size_t)(row - MPR) * ldc;
                float* op = (row < MPR) ? o0 + (size_t)row * ldc : o1 + (size_t)(row - MPR) * ldc;
#pragma unroll
                for (int bj = 0; bj < 2; ++bj)
#pragma unroll
                    for (int n = 0; n < 2; ++n) { const int c = col0 + bj * HALF + n * 16; *(f32x4*)(op + c) = acc[ai][bj][m][n] + *(const f32x4*)(rp + c); }
            }
    }
};

struct EpiOdd {
    static constexpr bool PERM = true, AFTER_DRAIN = false;
    bf16_t *QC, *KC, *VC, *GC; const float *rcos, *rsin; int MPR;
    __device__ __forceinline__ void operator()(const f32x4 (&acc)[2][2][4][2], const Unit& u, int wr, int wc, int fr, int fq) const {
        const int j0 = wc * 32 + fq * 8;
#pragma unroll
        for (int ai = 0; ai < 2; ++ai)
#pragma unroll
            for (int m = 0; m < 4; ++m) {
                const int row = u.pm * BM + ai * HALF + wr * 64 + m * 16 + fr;
                if (u.pn < 8) {
                    const int pos = (row < MPR) ? (row & (TP - 1)) : (PAST + ((row - MPR) & 7));
                    const float sc = (u.pn < 4) ? 1.f : 0.0625f;
                    f32x4 o1[2], o2[2];
#pragma unroll
                    for (int n = 0; n < 2; ++n) {
                        const f32x4 c = *(const f32x4*)(rcos + (size_t)pos * 128 + j0 + 4 * n), s = *(const f32x4*)(rsin + (size_t)pos * 128 + j0 + 4 * n);
                        const f32x4 x1 = acc[ai][0][m][n], x2 = acc[ai][1][m][n];
                        o1[n] = (x1 * c - x2 * s) * sc; o2[n] = (x2 * c + x1 * s) * sc;
                    }
                    bf16_t* dst = ((u.pn < 4) ? QC : KC) + (size_t)row * 1024 + (u.pn & 3) * 256 + j0;
                    *(u32x4*)dst = pack8(o1[0], o1[1]); *(u32x4*)(dst + 128) = pack8(o2[0], o2[1]);
                } else {
                    const bool isg = u.pn >= 16;
                    bf16_t* dst = (isg ? GC : VC) + (size_t)row * 2048 + ((u.pn - 8) & 7) * 256 + j0;
#pragma unroll
                    for (int bj = 0; bj < 2; ++bj) {
                        f32x4 a = acc[ai][bj][m][0], b = acc[ai][bj][m][1];
                        if (isg) {
#pragma unroll
                            for (int e = 0; e < 4; ++e) { a[e] = silu_f(a[e]); b[e] = silu_f(b[e]); }
                        }
                        *(u32x4*)(dst + 128 * bj) = pack8(a, b);
                    }
                }
            }
    }
};
}
#define GAS __attribute__((address_space(1)))
#define LAS __attribute__((address_space(3)))
typedef unsigned short bf16;
typedef unsigned v4u __attribute__((ext_vector_type(4)));
typedef float f32x4 __attribute__((ext_vector_type(4)));
typedef short bf16x8 __attribute__((ext_vector_type(8)));
typedef GAS unsigned gu32;
typedef GAS unsigned long long gu64;
#define RLX_AGENT __ATOMIC_RELAXED, __HIP_MEMORY_SCOPE_AGENT
#define LDS_WAIT() asm volatile("s_waitcnt lgkmcnt(0)" ::: "memory")
#define VM_WAIT() asm volatile("s_waitcnt vmcnt(0)" ::: "memory")
__device__ __forceinline__ unsigned long long rt() { return __builtin_amdgcn_s_memrealtime(); }
__device__ __forceinline__ unsigned f2bf(float f) { unsigned u = __builtin_bit_cast(unsigned, f); return (u + 0x7fffu + ((u >> 16) & 1u)) >> 16; }
__device__ __forceinline__ unsigned pk2(float lo, float hi) { return f2bf(lo) | (f2bf(hi) << 16); }
#define XB_TMO      128
#define XB_XCNT(j)  (256  + 64 * (j))
#define XB_XSUB(j)  (1280 + 64 * (j))
#define XB_XGEN(j)  (2304 + 64 * (j))
#define XB_TOP      3328
#define XB_TOPGEN   3392
#define XCD_BAR_WORDS 3456
#define XB_SPIN_CAP (1u << 18)

__device__ __forceinline__ unsigned xb_ld(unsigned* p)              { return __hip_atomic_load(p, __ATOMIC_RELAXED, __HIP_MEMORY_SCOPE_AGENT); }
__device__ __forceinline__ unsigned xb_add(unsigned* p, unsigned v) { return __hip_atomic_fetch_add(p, v, __ATOMIC_RELAXED, __HIP_MEMORY_SCOPE_AGENT); }
__device__ __forceinline__ unsigned xb_xcc_id() { return (unsigned)__builtin_amdgcn_s_getreg((3 << 11) | 20) & 0xFu; }
#define XB_SPIN(cond, bar) do { unsigned _sp = 0; while (cond) { __builtin_amdgcn_s_sleep(1); \
    if ((++_sp & 255u) == 0u) { if (xb_ld(&(bar)[XB_TMO])) break; if (_sp > XB_SPIN_CAP) { atomicAdd(&(bar)[XB_TMO], 1u); break; } } } } while (0)

struct XcdBarrier {
    unsigned* bar; unsigned x;
    volatile LAS unsigned* st;
};

__device__ __forceinline__ XcdBarrier xcd_barrier_post(unsigned* bar, volatile LAS unsigned* st) {
    XcdBarrier b; b.bar = bar; b.x = xb_xcc_id(); b.st = st;
    if (threadIdx.x == 0) (void)xb_add(&bar[XB_XCNT(b.x)], 1u);
    return b;
}
__device__ __forceinline__ void xcd_barrier_complete(unsigned* bar, unsigned x, unsigned& nloc, unsigned& nx) {
    const unsigned G = gridDim.x * gridDim.y * gridDim.z;
    unsigned sum, cnt, mine, sp = 0u;
    for (;;) {
        sum = 0u; cnt = 0u; mine = 0u;
#pragma unroll
        for (unsigned j = 0; j < 16; ++j) { const unsigned c = xb_ld(&bar[XB_XCNT(j)]); sum += c; cnt += (c > 0u) ? 1u : 0u; mine = (j == x) ? c : mine; }
        if (sum == G) break;
        __builtin_amdgcn_s_sleep(1);
        if ((++sp & 255u) == 0u) { if (xb_ld(&bar[XB_TMO])) break; if (sp > XB_SPIN_CAP) { atomicAdd(&bar[XB_TMO], 1u); break; } }
    }
    nloc = mine > 0u ? mine : 1u; nx = cnt > 0u ? cnt : 1u;
}

__device__ __forceinline__ void xcd_barrier(const XcdBarrier& b) {
    asm volatile("s_waitcnt vmcnt(0)" ::: "memory");
    __syncthreads();
    if (threadIdx.x == 0) {
        unsigned* bar = b.bar;
        __builtin_amdgcn_s_waitcnt(0);
        unsigned nloc = b.st[0], nx = b.st[1];
        if (nloc == 0u) { xcd_barrier_complete(bar, b.x, nloc, nx); b.st[0] = nloc; b.st[1] = nx; }
        const unsigned old = xb_add(&bar[XB_XSUB(b.x)], 1u);
        const unsigned gen = old / nloc;
        if (old + 1u == (gen + 1u) * nloc) {
            __builtin_amdgcn_fence(__ATOMIC_RELEASE, "agent");
            asm volatile("s_waitcnt vmcnt(0)" ::: "memory");
            const unsigned og = xb_add(&bar[XB_TOP], 1u);
            const unsigned tg = og / nx;
            if (og + 1u == (tg + 1u) * nx) xb_add(&bar[XB_TOPGEN], 1u);
            else XB_SPIN(xb_ld(&bar[XB_TOPGEN]) == tg, bar);
            __builtin_amdgcn_fence(__ATOMIC_ACQUIRE, "agent");
            xb_add(&bar[XB_XGEN(b.x)], 1u);
            asm volatile("s_waitcnt vmcnt(0)" ::: "memory");
        } else {
            XB_SPIN(xb_ld(&bar[XB_XGEN(b.x)]) == gen, bar);
            __builtin_amdgcn_fence(__ATOMIC_ACQUIRE, "agent");
            asm volatile("s_waitcnt vmcnt(0)" ::: "memory");
        }
    }
    __syncthreads();
}
constexpr size_t MiB = 1u << 20;
constexpr size_t WS_CTL = 0, CTL_ZERO_BYTES = 1 * MiB;
constexpr size_t WS_W1T = 2 * MiB;
constexpr size_t WS_W2T = 10 * MiB;
constexpr size_t WS_W3T = 12 * MiB;
constexpr size_t WS_W4T = 24 * MiB;
constexpr size_t WS_RCOS = 28 * MiB, WS_RSIN = 33 * MiB;
constexpr size_t SZ_H = (size_t)MT * 1024 * 2;
constexpr size_t SZ_S = (size_t)MT * 512 * 2;
constexpr size_t WS_H = 40 * MiB;
constexpr size_t WS_QA = WS_H + 33 * MiB, WS_KA = WS_QA + 17 * MiB, WS_VAT = WS_KA + 17 * MiB, WS_GA = WS_VAT + 17 * MiB;
constexpr size_t WS_QB = WS_GA + 17 * MiB, WS_KB = WS_QB + 17 * MiB, WS_VB = WS_KB + 17 * MiB, WS_GB = WS_VB + 17 * MiB;
constexpr size_t WS_LOGF = WS_GB + 17 * MiB;
constexpr size_t WS_OB = WS_LOGF + 33 * MiB;
constexpr size_t WS_MIX = WS_OB + 33 * MiB;
constexpr size_t WS_Y1 = WS_MIX + 33 * MiB;
constexpr size_t WS_QC = WS_Y1 + 65 * MiB, WS_KC = WS_QC + 33 * MiB;
constexpr size_t WS_VC = WS_KC + 33 * MiB, WS_GC = WS_VC + 65 * MiB;
constexpr size_t WS_OC = WS_GC + 65 * MiB;
constexpr size_t WS_MIX2 = WS_OC + 130 * MiB;
constexpr size_t WS_END = WS_MIX2 + 65 * MiB;
static_assert(SZ_H <= 33 * MiB && SZ_S <= 17 * MiB && (size_t)MT * 2048 * 4 <= 130 * MiB, "ws map");

constexpr int CW_TMO = 0, CW_CODE = 1, CW_BAR = 4096;

constexpr int RING_OFF = 0, RING_BYTES = 131072;
constexpr int LDSCTL_OFF = RING_BYTES, MISC_OFF = LDSCTL_OFF + 320;
constexpr int LDS_BYTES = 147456;
constexpr int NWAVES = 8;

typedef float f32x16 __attribute__((ext_vector_type(16)));
__device__ __forceinline__ float bf2f(bf16 b) { return __builtin_bit_cast(float, (unsigned)b << 16); }
__device__ __forceinline__ float bflo(unsigned w) { return __builtin_bit_cast(float, w << 16); }
__device__ __forceinline__ float bfhi(unsigned w) { return __builtin_bit_cast(float, w & 0xffff0000u); }
__device__ __forceinline__ int crow(int r, int hi) { return (r & 3) + 8 * (r >> 2) + 4 * hi; }
__device__ __forceinline__ float wave_sum(float v) {
#pragma unroll
    for (int o = 1; o < 64; o <<= 1) v += __shfl_xor(v, o);
    return v;
}

struct Frame {
    LAS unsigned char* lds;
    volatile LAS unsigned* MISC;
    gu32* ctl;
    int tid, lane, wave, G, bid;
    const float *xp, *xs, *ck, *cv, *st_h, *st_r, *ng, *w1, *w2, *qg, *kg, *sbb, *hlb, *og, *w3, *w4; const int* pt;
    float* out;
    bf16 *W1T, *W2T, *W3T, *W4T, *H, *QA, *KA, *VAT, *GA, *QB, *KB, *VB, *GB, *MIX, *QC, *KC, *VC, *GC, *MIX2;
    float *RCOS, *RSIN, *LOGF, *OB, *Y1, *OC;
};

template <bool HP>
__device__ __forceinline__ void p0_transpose_item(const float* W, int K, int N, bf16* WT, LAS float* scr, int item, int lane) {
    const int nblk = N / 32, kb = item / nblk, nb = item % nblk, k0 = 64 * kb, n0 = 32 * nb;
#pragma unroll 8
    for (int i = 0; i < 32; ++i) { const int kk = 2 * i + (lane >> 5); scr[kk * 33 + (lane & 31)] = W[(size_t)(k0 + kk) * N + n0 + (lane & 31)]; }
    LDS_WAIT(); asm volatile("" ::: "memory");
    const int c = lane & 7;
#pragma unroll
    for (int j = 0; j < 4; ++j) { const int n = (lane >> 3) + 8 * j; const LAS float* s = scr + (8 * c) * 33 + n;
        v4u o; o.x = pk2(s[0 * 33], s[1 * 33]); o.y = pk2(s[2 * 33], s[3 * 33]); o.z = pk2(s[4 * 33], s[5 * 33]); o.w = pk2(s[6 * 33], s[7 * 33]);
        int ca = n0 + n;
        if (HP) ca = (ca & ~255) | (((ca >> 5) & 1) << 7) | (((ca >> 6) & 3) << 5) | (ca & 31);
        *(GAS v4u*)(WT + (size_t)ca * K + k0 + 8 * c) = o; }
    LDS_WAIT(); asm volatile("" ::: "memory");
}
__device__ __forceinline__ void rms_row_to_bf16(int lane, const float* xrow, const float* g, bf16* orow) {
    const GAS f32x4* xr = (const GAS f32x4*)xrow + lane;
    f32x4 v[4]; float s2 = 0.f;
#pragma unroll
    for (int j = 0; j < 4; ++j) { v[j] = xr[64 * j]; s2 += (v[j].x * v[j].x + v[j].y * v[j].y) + (v[j].z * v[j].z + v[j].w * v[j].w); }
    const float rstd = 1.f / sqrtf(wave_sum(s2) * (1.f / 1024.f) + EPS);
    GAS unsigned long long* o8 = (GAS unsigned long long*)orow + lane;
#pragma unroll
    for (int j = 0; j < 4; ++j) { const f32x4 gv = *((const GAS f32x4*)g + lane + 64 * j);
        o8[64 * j] = (unsigned long long)pk2(v[j].x * rstd * gv.x, v[j].y * rstd * gv.y) | ((unsigned long long)pk2(v[j].z * rstd * gv.z, v[j].w * rstd * gv.w) << 32); }
}
__device__ __forceinline__ void sincos_acc(float a, float& s, float& c) {
    const double x = (double)a;
    const double kd = __builtin_rint(x * 0.63661977236758134308);
    const double r = (x - kd * 1.57079632673412561417e+00) - kd * 6.07710050650619224932e-11;
    const double r2 = r * r;
    const double sp = r * (1.0 + r2 * (-1.66666666666666324348e-01 + r2 * (8.33333333332248946124e-03 + r2 * (-1.98412698298579493134e-04 + r2 * (2.75573137070700676789e-06 + r2 * (-2.50507602534068634195e-08 + r2 * 1.58969099521155010221e-10))))));
    const double cp = 1.0 + r2 * (-0.5 + r2 * (4.16666666666666019037e-02 + r2 * (-1.38888888888741095749e-03 + r2 * (2.48015872894767294178e-05 + r2 * (-2.75573143513906633035e-07 + r2 * (2.08757232129817482790e-09 + r2 * -1.13596475577881948265e-11))))));
    const int q = (int)((long long)kd & 3);
    const double sv = (q & 1) ? cp : sp, cv = (q & 1) ? sp : cp;
    s = (float)((q & 2) ? -sv : sv);
    c = (float)(((q + 1) & 2) ? -cv : cv);
}
__device__ __forceinline__ void p0_prologue(Frame& F) {
    LAS float* scr = (LAS float*)(F.lds + RING_OFF + F.wave * 16384);
    const int gw = F.bid * NWAVES + F.wave, NGW = F.G * NWAVES;
    constexpr int I1 = (1024 / 64) * (N1 / 32), I2 = (1024 / 64) * (1024 / 32), I3 = (1024 / 64) * (N3 / 32), I4 = (2048 / 64) * (1024 / 32);
    for (int it = gw; it < I1 + I2 + I3 + I4; it += NGW) {
        int r = it;
        if (r < I1) { p0_transpose_item<true>(F.w1, 1024, N1, F.W1T, scr, r, F.lane); continue; } r -= I1;
        if (r < I2) { p0_transpose_item<false>(F.w2, 1024, 1024, F.W2T, scr, r, F.lane); continue; } r -= I2;
        if (r < I3) { p0_transpose_item<false>(F.w3, 1024, N3, F.W3T, scr, r, F.lane); continue; } r -= I3;
        p0_transpose_item<false>(F.w4, 2048, 1024, F.W4T, scr, r, F.lane);
    }
    for (int m = gw; m < MT; m += NGW) rms_row_to_bf16(F.lane, (m < MP) ? F.xp + (size_t)m * DM : F.xs + (size_t)(m - MP) * DM, F.ng, F.H + (size_t)m * DM);
    for (int e = F.bid * (NWAVES * 64) + F.tid; e < (PAST + TSQ) * 128; e += F.G * NWAVES * 64) {
        const int pos = e >> 7, i = e & 127;
        const float lin = (float)i / 127.0f;
        const float inv = (float)(1.0 / exp2((double)lin * 13.287712379549449));
        const float ang = (float)pos * inv;
        float s, c; sincos_acc(ang, s, c);
        F.RCOS[e] = c; F.RSIN[e] = s;
    }
}

__device__ __forceinline__ void sb_tile(f32x16& p0, f32x16& p1, float& carry, int hi, int kb0, int qpos, bool need_mask, v4u (&pw)[4]) {
#pragma unroll
    for (int r = 0; r < 16; ++r) {
        float b0 = __builtin_amdgcn_rcpf(1.f + __builtin_amdgcn_exp2f(p0[r]));
        float b1 = __builtin_amdgcn_rcpf(1.f + __builtin_amdgcn_exp2f(p1[r]));
        if (need_mask) { if (kb0 + r >= qpos) b0 = 0.f; if (kb0 + 32 + r >= qpos) b1 = 0.f; }
        p0[r] = b0; p1[r] = b1;
    }
    float s0 = 1.f, s1 = 1.f;
#pragma unroll
    for (int r = 15; r >= 0; --r) {
        const float b0 = p0[r], b1 = p1[r];
        p0[r] = b0 * s0; p1[r] = b1 * s1;
        s0 = __builtin_fmaf(-s0, b0, s0); s1 = __builtin_fmaf(-s1, b1, s1);
    }
    const float t0 = __shfl_xor(s0, 32), t1 = __shfl_xor(s1, 32);
    const float pre1 = hi ? carry : carry * t1;
    const float pre0 = hi ? carry * s1 * t1 : carry * t1 * s1 * t0;
    carry = carry * ((s0 * s1) * (t0 * t1));
#pragma unroll
    for (int r = 0; r < 16; ++r) { p0[r] *= pre0; p1[r] *= pre1; }
    pw[0] = (v4u){pg8::cvt_pk_bf16(p0[0], p0[1]), pg8::cvt_pk_bf16(p0[2], p0[3]), pg8::cvt_pk_bf16(p0[4], p0[5]), pg8::cvt_pk_bf16(p0[6], p0[7])};
    pw[1] = (v4u){pg8::cvt_pk_bf16(p0[8], p0[9]), pg8::cvt_pk_bf16(p0[10], p0[11]), pg8::cvt_pk_bf16(p0[12], p0[13]), pg8::cvt_pk_bf16(p0[14], p0[15])};
    pw[2] = (v4u){pg8::cvt_pk_bf16(p1[0], p1[1]), pg8::cvt_pk_bf16(p1[2], p1[3]), pg8::cvt_pk_bf16(p1[4], p1[5]), pg8::cvt_pk_bf16(p1[6], p1[7])};
    pw[3] = (v4u){pg8::cvt_pk_bf16(p1[8], p1[9]), pg8::cvt_pk_bf16(p1[10], p1[11]), pg8::cvt_pk_bf16(p1[12], p1[13]), pg8::cvt_pk_bf16(p1[14], p1[15])};
}
#define MFMA32(a, b, c) __builtin_amdgcn_mfma_f32_32x32x16_bf16((a), (b), (c), 0, 0, 0)
__device__ __forceinline__ f32x16 splat16(float v) { f32x16 r;
#pragma unroll
    for (int i = 0; i < 16; ++i) r[i] = v; return r; }

__device__ __forceinline__ void attn_prompt_unit(Frame& F, int b, int h, int qb) {
    const int lane = F.lane, r32 = lane & 31, hi = lane >> 5, wid = F.wave;
    const int rowbase = b * TP, q0 = qb * 256 + 32 * wid, qpos = q0 + r32;
    const float cinit = -F.sbb[h] * LOG2E;
    bf16x8 qr[4];
#pragma unroll
    for (int d0 = 0; d0 < 4; ++d0) qr[d0] = *(const bf16x8*)(F.QA + (size_t)(rowbase + qpos) * 512 + h * 64 + d0 * 16 + hi * 8);
    f32x16 o0 = splat16(0.f), o1 = splat16(0.f); float carry = 1.f;
    const int pi = 16 * ((r32 >> 2) & 1) + 4 * (r32 >> 3) + (r32 & 3);
    const bf16* kp = F.KA + (size_t)(rowbase + pi) * 512 + h * 64 + hi * 8;
    const bf16* vp = F.VAT + (size_t)(h * 64 + r32) * MT + rowbase + 16 * hi;
    for (int t = (q0 + 30) >> 6; t >= 0; --t) {
        const int kbase = 64 * t;
        f32x16 p0 = splat16(cinit), p1 = splat16(cinit);
#pragma unroll
        for (int d0 = 0; d0 < 4; ++d0) {
            const bf16x8 k0 = *(const bf16x8*)(kp + (size_t)kbase * 512 + d0 * 16), k1 = *(const bf16x8*)(kp + (size_t)(kbase + 32) * 512 + d0 * 16);
            p0 = MFMA32(k0, qr[d0], p0); p1 = MFMA32(k1, qr[d0], p1);
        }
        v4u pw[4];
        sb_tile(p0, p1, carry, hi, kbase + 16 * hi, qpos, kbase + 63 >= q0, pw);
#pragma unroll
        for (int ks = 0; ks < 4; ++ks) {
            const int ko = kbase + (ks >> 1) * 32 + (ks & 1) * 8;
            const bf16x8 v0 = *(const bf16x8*)(vp + ko), v1 = *(const bf16x8*)(vp + (size_t)32 * MT + ko);
            o0 = MFMA32(__builtin_bit_cast(bf16x8, pw[ks]), v0, o0); o1 = MFMA32(__builtin_bit_cast(bf16x8, pw[ks]), v1, o1);
        }
    }
#pragma unroll
    for (int r = 0; r < 16; ++r) {
        const size_t row = (size_t)rowbase + q0 + crow(r, hi);
        F.MIX[row * 1024 + h * 64 + r32] = pg8::bf1(o0[r] * bf2f(F.GA[row * 512 + h * 64 + r32]));
        F.MIX[row * 1024 + h * 64 + 32 + r32] = pg8::bf1(o1[r] * bf2f(F.GA[row * 512 + h * 64 + 32 + r32]));
    }
}

__device__ __forceinline__ bf16x8 cvt8(const f32x4 a, const f32x4 b) { return __builtin_bit_cast(bf16x8, pg8::pack8(a, b)); }
__device__ __forceinline__ void attn_decode_unit(Frame& F, int s, int h) {
    const int lane = F.lane, r32 = lane & 31, hi = lane >> 5, wid = F.wave;
    const int qpos = PAST + r32;
    const float cinit = -F.sbb[h] * LOG2E;
    const int qrow = MP + s * 8 + (r32 & 7);
    bf16x8 qr[4];
#pragma unroll
    for (int d0 = 0; d0 < 4; ++d0) qr[d0] = *(const bf16x8*)(F.QA + (size_t)qrow * 512 + h * 64 + d0 * 16 + hi * 8);
    f32x16 o0 = splat16(0.f), o1 = splat16(0.f); float carry = 1.f;
    const int pi = 16 * ((r32 >> 2) & 1) + 4 * (r32 >> 3) + (r32 & 3);
    const int* ptab = F.pt + s * NPG;
    if (wid == 7) {
        f32x16 p0 = splat16(cinit), p1 = splat16(cinit);
        const bf16* kp = F.KA + (size_t)(MP + s * 8 + (pi & 7)) * 512 + h * 64 + hi * 8;
#pragma unroll
        for (int d0 = 0; d0 < 4; ++d0) { const bf16x8 k0 = *(const bf16x8*)(kp + d0 * 16); p0 = MFMA32(k0, qr[d0], p0); p1 = MFMA32(k0, qr[d0], p1); }
        v4u pw[4];
        sb_tile(p0, p1, carry, hi, PAST + 16 * hi, qpos, true, pw);
        const bf16* vp = F.VAT + (size_t)(h * 64 + r32) * MT + MP + s * 8;
        const bf16x8 v0 = *(const bf16x8*)vp, v1 = *(const bf16x8*)(vp + (size_t)32 * MT);
#pragma unroll
        for (int ks = 0; ks < 4; ++ks) { o0 = MFMA32(__builtin_bit_cast(bf16x8, pw[ks]), v0, o0); o1 = MFMA32(__builtin_bit_cast(bf16x8, pw[ks]), v1, o1); }
    }
    for (int t = 15; t >= 0; --t) {
        const int kbase = 1024 * wid + 64 * t;
        const int page = ptab[kbase >> 7];
        const float* kpg = F.ck + ((size_t)page * PAGE + (kbase & 127)) * 512 + h * 64;
        const float* vpg = F.cv + ((size_t)page * PAGE + (kbase & 127)) * 512 + h * 64;
        f32x16 p0 = splat16(cinit), p1 = splat16(cinit);
#pragma unroll
        for (int d0 = 0; d0 < 4; ++d0) {
            const float* a0 = kpg + (size_t)pi * 512 + d0 * 16 + hi * 8; const float* a1 = a0 + (size_t)32 * 512;
            const bf16x8 k0 = cvt8(*(const f32x4*)a0, *(const f32x4*)(a0 + 4)), k1 = cvt8(*(const f32x4*)a1, *(const f32x4*)(a1 + 4));
            p0 = MFMA32(k0, qr[d0], p0); p1 = MFMA32(k1, qr[d0], p1);
        }
        v4u pw[4];
        sb_tile(p0, p1, carry, hi, kbase + 16 * hi, qpos, false, pw);
#pragma unroll
        for (int ks = 0; ks < 4; ++ks) {
            const float* vb = vpg + (size_t)((ks >> 1) * 32 + (ks & 1) * 8 + 16 * hi) * 512 + r32;
            f32x4 a, b2, c, d2;
#pragma unroll
            for (int j = 0; j < 4; ++j) { a[j] = vb[(size_t)j * 512]; b2[j] = vb[(size_t)(j + 4) * 512]; c[j] = vb[(size_t)j * 512 + 32]; d2[j] = vb[(size_t)(j + 4) * 512 + 32]; }
            o0 = MFMA32(__builtin_bit_cast(bf16x8, pw[ks]), cvt8(a, b2), o0); o1 = MFMA32(__builtin_bit_cast(bf16x8, pw[ks]), cvt8(c, d2), o1);
        }
    }
    LAS float* ob = (LAS float*)(F.lds + RING_OFF);
    LAS float* cb = ob + 8 * 8 * 64;
#pragma unroll
    for (int r = 0; r < 4; ++r) { const int q = r + 4 * hi; ob[(wid * 8 + q) * 64 + r32] = o0[r]; ob[(wid * 8 + q) * 64 + 32 + r32] = o1[r]; }
    if (lane < 8) cb[wid * 8 + lane] = carry;
    __syncthreads();
    {
        const int q = F.tid >> 6, d = F.tid & 63; float acc = 0.f, pref = 1.f;
#pragma unroll
        for (int w = 7; w >= 0; --w) { acc += pref * ob[(w * 8 + q) * 64 + d]; pref *= cb[w * 8 + q]; }
        const size_t row = (size_t)MP + s * 8 + q;
        F.MIX[row * 1024 + h * 64 + d] = pg8::bf1(acc * bf2f(F.GA[row * 512 + h * 64 + d]));
    }
    __syncthreads();
}

__device__ __forceinline__ void hgrn_seq_unit(Frame& F, int stream, int h, int slice) {
    const int lane = F.lane, c = lane >> 5, kg = lane & 31, col = slice * 16 + 2 * F.wave + c;
    const bool prm = stream < NBP; const int T = prm ? TP : TSQ; const size_t row0 = prm ? (size_t)stream * TP : (size_t)MP + (size_t)(stream - NBP) * TSQ;
    float S[4];
    if (prm) { S[0] = S[1] = S[2] = S[3] = 0.f; }
    else { const float* s0 = F.st_h + (((size_t)(stream - NBP) * HB + h) * DKB + 4 * kg) * DVB + col;
#pragma unroll
        for (int i = 0; i < 4; ++i) S[i] = s0[(size_t)i * DVB]; }
    const size_t cb = (size_t)h * 128 + 4 * kg;
#pragma unroll 4
    for (int t = 0; t < T; ++t) {
        const size_t row = row0 + t;
        const f32x4 lf = *(const f32x4*)(F.LOGF + row * 512 + cb);
        const uint2 kk = *(const uint2*)(F.KB + row * 512 + cb), qq = *(const uint2*)(F.QB + row * 512 + cb);
        const float v = bf2f(F.VB[row * 512 + h * 128 + col]);
        S[0] = __expf(lf[0]) * S[0] + bflo(kk.x) * v; S[1] = __expf(lf[1]) * S[1] + bfhi(kk.x) * v;
        S[2] = __expf(lf[2]) * S[2] + bflo(kk.y) * v; S[3] = __expf(lf[3]) * S[3] + bfhi(kk.y) * v;
        float o = (bflo(qq.x) * S[0] + bfhi(qq.x) * S[1]) + (bflo(qq.y) * S[2] + bfhi(qq.y) * S[3]);
#pragma unroll
        for (int m = 1; m < 32; m <<= 1) o += __shfl_xor(o, m);
        if (kg == 0) F.OB[row * 512 + h * 128 + col] = o;
    }
    float* so = F.out + (prm ? OHG_P + (((size_t)stream * HB + h) * DKB + 4 * kg) * DVB : OHG_S + (((size_t)(stream - NBP) * HB + h) * DKB + 4 * kg) * DVB) + col;
#pragma unroll
    for (int i = 0; i < 4; ++i) so[(size_t)i * DVB] = S[i];
}
__device__ __forceinline__ void ret_seq_unit(Frame& F, int stream, int h, int slice) {
    const int lane = F.lane, c = lane >> 5, kg = lane & 31, col = slice * 16 + 2 * F.wave + c;
    const bool prm = stream < NBP; const int T = prm ? TP : TSQ; const size_t row0 = prm ? (size_t)stream * TP : (size_t)MP + (size_t)(stream - NBP) * TSQ;
    const float gamma = 1.f - __builtin_exp2f(-5.f - (float)h);
    float S[8];
    if (prm) {
#pragma unroll
        for (int i = 0; i < 8; ++i) S[i] = 0.f; }
    else { const float* s0 = F.st_r + (((size_t)(stream - NBP) * HC + h) * DKC + 8 * kg) * DVC + col;
#pragma unroll
        for (int i = 0; i < 8; ++i) S[i] = s0[(size_t)i * DVC]; }
    const size_t cb = (size_t)h * 256 + 8 * kg;
#pragma unroll 4
    for (int t = 0; t < T; ++t) {
        const size_t row = row0 + t;
        const v4u kk = *(const v4u*)(F.KC + row * 1024 + cb), qq = *(const v4u*)(F.QC + row * 1024 + cb);
        const float v = bf2f(F.VC[row * 2048 + h * 512 + col]);
        float o = 0.f;
#pragma unroll
        for (int i = 0; i < 4; ++i) {
            S[2 * i] = gamma * S[2 * i] + bflo(kk[i]) * v; S[2 * i + 1] = gamma * S[2 * i + 1] + bfhi(kk[i]) * v;
            o += bflo(qq[i]) * S[2 * i] + bfhi(qq[i]) * S[2 * i + 1];
        }
#pragma unroll
        for (int m = 1; m < 32; m <<= 1) o += __shfl_xor(o, m);
        if (kg == 0) F.OC[row * 2048 + h * 512 + col] = o;
    }
    float* so = F.out + (prm ? ORT_P + (((size_t)stream * HC + h) * DKC + 8 * kg) * DVC : ORT_S + (((size_t)(stream - NBP) * HC + h) * DKC + 8 * kg) * DVC) + col;
#pragma unroll
    for (int i = 0; i < 8; ++i) so[(size_t)i * DVC] = S[i];
}
__device__ __forceinline__ void hgrn_norm_row(Frame& F, int row) {
    const int lane = F.lane, c = lane * 8;
    const f32x4 a = *(const f32x4*)(F.OB + (size_t)row * 512 + c), b = *(const f32x4*)(F.OB + (size_t)row * 512 + c + 4);
    float ss = (a[0] * a[0] + a[1] * a[1]) + (a[2] * a[2] + a[3] * a[3]) + (b[0] * b[0] + b[1] * b[1]) + (b[2] * b[2] + b[3] * b[3]);
#pragma unroll
    for (int m = 1; m < 16; m <<= 1) ss += __shfl_xor(ss, m);
    const float rstd = 1.f / sqrtf(ss * (1.f / 128.f) + EPS);
    const f32x4 g0 = *(const f32x4*)(F.og + (c & 127)), g1 = *(const f32x4*)(F.og + (c & 127) + 4);
    const v4u gt = *(const v4u*)(F.GB + (size_t)row * 512 + c);
    f32x4 x, y;
    x[0] = a[0] * rstd * g0[0] * bflo(gt[0]); x[1] = a[1] * rstd * g0[1] * bfhi(gt[0]); x[2] = a[2] * rstd * g0[2] * bflo(gt[1]); x[3] = a[3] * rstd * g0[3] * bfhi(gt[1]);
    y[0] = b[0] * rstd * g1[0] * bflo(gt[2]); y[1] = b[1] * rstd * g1[1] * bfhi(gt[2]); y[2] = b[2] * rstd * g1[2] * bflo(gt[3]); y[3] = b[3] * rstd * g1[3] * bfhi(gt[3]);
    *(pg8::u32x4*)(F.MIX + (size_t)row * 1024 + 512 + c) = pg8::pack8(x, y);
}
__device__ __forceinline__ void ret_norm_item(Frame& F, int item) {
    const int row = item >> 2, h = item & 3, lane = F.lane, c = h * 512 + lane * 8;
    const f32x4 a = *(const f32x4*)(F.OC + (size_t)row * 2048 + c), b = *(const f32x4*)(F.OC + (size_t)row * 2048 + c + 4);
    const float ss = wave_sum((a[0] * a[0] + a[1] * a[1]) + (a[2] * a[2] + a[3] * a[3]) + (b[0] * b[0] + b[1] * b[1]) + (b[2] * b[2] + b[3] * b[3]));
    const float rstd = 1.f / sqrtf(ss * (1.f / 512.f) + EPS);
    const v4u gt = *(const v4u*)(F.GC + (size_t)row * 2048 + c);
    f32x4 x, y;
    x[0] = a[0] * rstd * bflo(gt[0]); x[1] = a[1] * rstd * bfhi(gt[0]); x[2] = a[2] * rstd * bflo(gt[1]); x[3] = a[3] * rstd * bfhi(gt[1]);
    y[0] = b[0] * rstd * bflo(gt[2]); y[1] = b[1] * rstd * bfhi(gt[2]); y[2] = b[2] * rstd * bflo(gt[3]); y[3] = b[3] * rstd * bfhi(gt[3]);
    *(pg8::u32x4*)(F.MIX2 + (size_t)row * 2048 + c) = pg8::pack8(x, y);
}

#ifndef MK_N_LAUNCHES
#define MK_N_LAUNCHES 1
#endif
constexpr int NPH = 12;
constexpr int N_LAUNCHES = MK_N_LAUNCHES;
struct Args { const void* in[17]; float* out; unsigned char* ws; int ph_lo, ph_hi, li, pad; };
__global__ void __launch_bounds__(NWAVES * 64, 2) mk_fwd(Args args) {
    extern __shared__ __attribute__((aligned(16))) unsigned char lds[];
    Frame F;
    F.lds = (LAS unsigned char*)lds;
    F.MISC = (volatile LAS unsigned*)(F.lds + MISC_OFF);
    F.tid = threadIdx.x; F.lane = F.tid & 63; F.wave = __builtin_amdgcn_readfirstlane(F.tid >> 6);
    F.G = gridDim.x; F.bid = blockIdx.x;
    unsigned char* ws = args.ws;
    F.ctl = (gu32*)(ws + WS_CTL);
    F.xp = (const float*)args.in[0]; F.xs = (const float*)args.in[1]; F.ck = (const float*)args.in[2]; F.cv = (const float*)args.in[3]; F.pt = (const int*)args.in[4];
    F.st_h = (const float*)args.in[5]; F.st_r = (const float*)args.in[6]; F.ng = (const float*)args.in[7]; F.w1 = (const float*)args.in[8]; F.w2 = (const float*)args.in[9];
    F.qg = (const float*)args.in[10]; F.kg = (const float*)args.in[11]; F.sbb = (const float*)args.in[12]; F.hlb = (const float*)args.in[13]; F.og = (const float*)args.in[14];
    F.w3 = (const float*)args.in[15]; F.w4 = (const float*)args.in[16]; F.out = args.out;
    F.W1T = (bf16*)(ws + WS_W1T); F.W2T = (bf16*)(ws + WS_W2T); F.W3T = (bf16*)(ws + WS_W3T); F.W4T = (bf16*)(ws + WS_W4T);
    F.RCOS = (float*)(ws + WS_RCOS); F.RSIN = (float*)(ws + WS_RSIN);
    F.H = (bf16*)(ws + WS_H); F.QA = (bf16*)(ws + WS_QA); F.KA = (bf16*)(ws + WS_KA); F.VAT = (bf16*)(ws + WS_VAT); F.GA = (bf16*)(ws + WS_GA);
    F.QB = (bf16*)(ws + WS_QB); F.KB = (bf16*)(ws + WS_KB); F.VB = (bf16*)(ws + WS_VB); F.GB = (bf16*)(ws + WS_GB);
    F.LOGF = (float*)(ws + WS_LOGF); F.OB = (float*)(ws + WS_OB); F.MIX = (bf16*)(ws + WS_MIX); F.Y1 = (float*)(ws + WS_Y1);
    F.QC = (bf16*)(ws + WS_QC); F.KC = (bf16*)(ws + WS_KC); F.VC = (bf16*)(ws + WS_VC); F.GC = (bf16*)(ws + WS_GC); F.OC = (float*)(ws + WS_OC); F.MIX2 = (bf16*)(ws + WS_MIX2);
    for (int u = F.tid; u < (LDS_BYTES - LDSCTL_OFF) / 4; u += NWAVES * 64) ((LAS unsigned*)(F.lds + LDSCTL_OFF))[u] = 0u;
    __syncthreads();
    XcdBarrier bar; bar.bar = (unsigned*)(F.ctl + CW_BAR); bar.x = 0; bar.st = nullptr;
    if (N_LAUNCHES == 1) bar = xcd_barrier_post((unsigned*)(F.ctl + CW_BAR), F.MISC + 8);
#define GRID_BAR() do { if (N_LAUNCHES == 1) xcd_barrier(bar); } while (0)
    const int lo = args.ph_lo, hi = args.ph_hi;
#define IN(k) (lo <= (k) && (k) < hi)
    const int gw = F.bid * NWAVES + F.wave, NGW = F.G * NWAVES;

    if (IN(0)) { p0_prologue(F); GRID_BAR(); }
    if (IN(1)) {
        pg8::Gemm g{F.H, F.W1T, MT, N1, 1024}; pg8::StaticOrder S; S.init(MT, N1, F.G, F.bid);
        pg8::EpiEven E{F.QA, F.KA, F.VAT, F.GA, F.QB, F.KB, F.VB, F.GB, F.LOGF, F.out, F.qg, F.kg, F.hlb, -0.125f * LOG2E, MT, MP, OK_P, OK_S, OV_P, OV_S};
        pg8::gemm_phase<pg8::EpiEven, pg8::StaticOrder, true, true>(F.lds + RING_OFF, g, S, E);
        GRID_BAR();
    }
    if (IN(2)) {
        for (int u = F.bid; u < NBP * HA * 32; u += F.G) { const int qb = 31 - (u >> 4), bh = u & 15; attn_prompt_unit(F, bh >> 3, bh & 7, qb); }
        GRID_BAR();
    }
    if (IN(3)) {
        for (int u = F.bid; u < NSQ * HA; u += F.G) attn_decode_unit(F, u >> 3, u & 7);
        GRID_BAR();
    }
    if (IN(4)) {
        for (int u = F.bid; u < (NBP + NSQ) * HB * 8; u += F.G) { const int slice = u & 7, sh = u >> 3; hgrn_seq_unit(F, sh >> 2, sh & 3, slice); }
        GRID_BAR();
    }
    if (IN(5)) { for (int m = gw; m < MT; m += NGW) hgrn_norm_row(F, m); GRID_BAR(); }
    if (IN(6)) {
        pg8::Gemm g{F.MIX, F.W2T, MT, 1024, 1024}; pg8::StaticOrder S; S.init(MT, 1024, F.G, F.bid);
        pg8::EpiRes E{F.xp, F.xs, F.Y1, F.Y1 + (size_t)MP * 1024, MP, 1024};
        pg8::gemm_phase<pg8::EpiRes, pg8::StaticOrder, true, true>(F.lds + RING_OFF, g, S, E);
        GRID_BAR();
    }
    if (IN(7)) { for (int m = gw; m < MT; m += NGW) rms_row_to_bf16(F.lane, F.Y1 + (size_t)m * DM, F.ng + 1024, F.H + (size_t)m * DM); GRID_BAR(); }
    if (IN(8)) {
        pg8::Gemm g{F.H, F.W3T, MT, N3, 1024}; pg8::StaticOrder S; S.init(MT, N3, F.G, F.bid);
        pg8::EpiOdd E{F.QC, F.KC, F.VC, F.GC, F.RCOS, F.RSIN, MP};
        pg8::gemm_phase<pg8::EpiOdd, pg8::StaticOrder, true, true>(F.lds + RING_OFF, g, S, E);
        GRID_BAR();
    }
    if (IN(9)) {
        for (int u = F.bid; u < (NBP + NSQ) * HC * 32; u += F.G) { const int slice = u & 31, sh = u >> 5; ret_seq_unit(F, sh >> 2, sh & 3, slice); }
        GRID_BAR();
    }
    if (IN(10)) { for (int it = gw; it < MT * 4; it += NGW) ret_norm_item(F, it); GRID_BAR(); }
    if (IN(11)) {
        pg8::Gemm g{F.MIX2, F.W4T, MT, 1024, 2048}; pg8::StaticOrder S; S.init(MT, 1024, F.G, F.bid);
        pg8::EpiRes E{F.Y1, F.Y1 + (size_t)MP * 1024, F.out + OY_P, F.out + OY_S, MP, 1024};
        pg8::gemm_phase<pg8::EpiRes, pg8::StaticOrder, true, true>(F.lds + RING_OFF, g, S, E);
    }
#undef IN
}

extern "C" void kernel_launch(void* const* d_in, const int* in_sizes, int n_in, void* d_out, int out_size, void* d_ws, size_t ws_size, hipStream_t stream) {
    static int grid = 0;
    if (grid == 0) {
        if (n_in != 17 || (size_t)out_size != OUT_TOTAL || ws_size < WS_END) { fprintf(stderr, "kernel_launch: unexpected shapes: n_in %d out %d ws %zu (need %zu)\n", n_in, out_size, ws_size, (size_t)WS_END); grid = -1; return; }
        int dev = 0, cus = 0, per_cu = 0;
        if (hipGetDevice(&dev) != hipSuccess || hipDeviceGetAttribute(&cus, hipDeviceAttributeMultiprocessorCount, dev) != hipSuccess) { grid = -1; return; }
        if (hipFuncSetAttribute((const void*)mk_fwd, hipFuncAttributeMaxDynamicSharedMemorySize, LDS_BYTES) != hipSuccess) { fprintf(stderr, "kernel_launch: hipFuncSetAttribute failed\n"); grid = -1; return; }
        if (hipOccupancyMaxActiveBlocksPerMultiprocessor(&per_cu, (const void*)mk_fwd, NWAVES * 64, LDS_BYTES) != hipSuccess || per_cu < 1) { fprintf(stderr, "kernel_launch: occupancy query says %d\n", per_cu); }
        (void)hipGetLastError();
        grid = cus;
    }
    if (grid < 0) return;
    if (hipMemsetAsync((char*)d_ws + WS_CTL, 0, CTL_ZERO_BYTES, stream) != hipSuccess) return;
    Args a{};
    for (int i = 0; i < 17; ++i) a.in[i] = d_in[i];
    a.out = (float*)d_out; a.ws = (unsigned char*)d_ws;
    for (int li = 0; li < N_LAUNCHES; ++li) {
        a.ph_lo = (N_LAUNCHES == 1) ? 0 : li; a.ph_hi = (N_LAUNCHES == 1) ? NPH : li + 1; a.li = li;
        hipLaunchKernelGGL(mk_fwd, dim3(grid), dim3(NWAVES * 64), LDS_BYTES, stream, a);
        if (hipPeekAtLastError() != hipSuccess) break;
    }
}
```

```cpp
#include <hip/hip_runtime.h>
#include <cstdio>
#include <cstdint>

constexpr int DM = 1024, TP = 8192, NBP = 2, MP = NBP * TP;
constexpr int NSQ = 32, TSQ = 8, MSM = NSQ * TSQ;
constexpr int MT = MP + MSM;
constexpr int PAST = 8192, PAGE = 128, NPG = PAST / PAGE;
constexpr int HA = 8, HDA = 64, WA = 512, HB = 4, DKB = 128, DVB = 128, HC = 4, DKC = 256, DVC = 512, WC = 2048;
constexpr int N1 = 4096, N3 = 6144;
constexpr float EPS = 1e-6f;
constexpr float LOG2E = 1.4426950408889634f;
constexpr size_t OY_P = 0, OY_S = 16777216, OK_P = 17039360, OV_P = 25427968, OK_S = 33816576, OV_S = 33947648,
                 OHG_P = 34078720, OHG_S = 34209792, ORT_P = 36306944, ORT_S = 37355520, OUT_TOTAL = 54132736;
#define MK_N_LAUNCHES 1
namespace pg8 {
#define PG8_LAS __attribute__((address_space(3)))
typedef unsigned short bf16_t;
typedef short bf16x8 __attribute__((ext_vector_type(8)));
typedef float f32x4 __attribute__((ext_vector_type(4)));
typedef unsigned u32x4 __attribute__((ext_vector_type(4)));
constexpr int BM = 256, BK = 64, HALF = 128, HTB = HALF * BK * 2  , STAGE_BYTES = 8 * HTB, NXCD = 8, WGM = 8;

__host__ __device__ __forceinline__ int lds_byte(int r, int c) { const int st = (r >> 4) * 2 + (c >> 5), rr = r & 15, cc = c & 31, ob = rr * 64 + cc * 2; return st * 1024 + (ob ^ (((ob >> 9) & 1) << 5)); }
__host__ __device__ __forceinline__ void stage_rc(int b, int& R, int& C) { const int st = b / 1024, sb = b % 1024, swz = sb ^ (((sb >> 9) & 1) << 5); R = (st >> 1) * 16 + swz / 64; C = (st & 1) * 32 + (swz % 64) / 2; }
__host__ __device__ __forceinline__ int perm32(int rho) { const int n = rho >> 4, i = rho & 15; return 8 * (i >> 2) + 4 * n + (i & 3); }

struct Unit { int pm, pn, kind, aux; };
struct Gemm { int K, lda, ldb; };

struct StaticOrder {
    int nM, nN, nwg, G, c;
    __host__ __device__ void init(int M, int N, int G_, int c_) { nM = M / BM; nN = N / BM; nwg = nM * nN; G = G_; c = c_; }
    __host__ __device__ bool next(int i, Unit& u) const {
        const long L = (long)i * G + c; if (L >= nwg) return false;
        int wgid = (int)L; { const int q = nwg / NXCD, r = nwg % NXCD, xcd = wgid % NXCD, off = wgid / NXCD; wgid = (xcd < r ? xcd * (q + 1) : r * (q + 1) + (xcd - r) * q) + off; }
        const int nig = WGM * nN, gid = wgid / nig, fm = gid * WGM, gsz = (nM - fm) < WGM ? (nM - fm) : WGM;
        u.pm = fm + ((wgid % nig) % gsz); u.pn = (wgid % nig) / gsz; return true;
    }
    __device__ __forceinline__ void a_ready(const Unit&) const {}
    __device__ __forceinline__ void done(const Unit&) const {}
};
typedef float f32x2_t __attribute__((ext_vector_type(2))); typedef __bf16 bf16x2_t __attribute__((ext_vector_type(2)));
__device__ __forceinline__ unsigned cvt_pk_bf16(float lo, float hi) { f32x2_t v = {lo, hi}; bf16x2_t b = __builtin_convertvector(v, bf16x2_t); return __builtin_bit_cast(unsigned, b); }
typedef float f32x2 __attribute__((ext_vector_type(2)));
template <class Epi, class Sched, bool ALIGN_EPI = false, bool SP2 = false>
__device__ __forceinline__ void gemm_phase(PG8_LAS unsigned char* lds, const Gemm g, const Sched& S, const Epi& E) {
    const int tid = threadIdx.x, wid = __builtin_amdgcn_readfirstlane(tid >> 6), lane = tid & 63, wr = wid >> 2, wc = wid & 3, fr = lane & 15, fq = lane >> 4;
    const int K = g.K, nt = K / BK;
    unsigned voffA[2], voffB[2];
#pragma unroll
    for (int i = 0; i < 2; ++i) { int R, C; stage_rc(tid * 16 + i * 8192, R, C); const int Rb = Epi::PERM ? ((R & ~31) + perm32(R & 31)) : R;
        voffA[i] = (unsigned)(R * g.lda + C) * 2u; voffB[i] = (unsigned)(Rb * g.ldb + C) * 2u; }
    const size_t kstep = (size_t)(BK * 2);
    const size_t hstepA = (size_t)HALF * g.lda * 2, hstepB = (size_t)HALF * g.ldb * 2;
    const unsigned ldsw = (unsigned)wid * 1024u;
    const int aoff = lds_byte(wr * 64 + fr, fq * 8), boff = lds_byte(wc * 32 + fr, fq * 8);
#define PG8_SA(b, h) (((b) * 2 + (h)) * HTB)
#define PG8_SB(b, h) ((4 + (b) * 2 + (h)) * HTB)
#define PG8_STAGE(bufoff, gbase, voff) do { _Pragma("unroll") for (int _i = 0; _i < 2; ++_i) \
        __builtin_amdgcn_global_load_lds((const unsigned*)((const char*)(gbase) + (voff)[_i]), (PG8_LAS unsigned*)(lds + (bufoff) + ldsw + _i * 8192), 16, 0, 0); } while (0)
#define PG8_LDA(dst, b, h) do { _Pragma("unroll") for (int m = 0; m < 4; ++m) _Pragma("unroll") for (int k = 0; k < 2; ++k) dst[m][k] = *(const PG8_LAS bf16x8*)(lds + PG8_SA(b, h) + aoff + m * 2048 + k * 1024); } while (0)
#define PG8_LDB(dst, b, h) do { _Pragma("unroll") for (int n = 0; n < 2; ++n) _Pragma("unroll") for (int k = 0; k < 2; ++k) dst[n][k] = *(const PG8_LAS bf16x8*)(lds + PG8_SB(b, h) + boff + n * 2048 + k * 1024); } while (0)
#define PG8_MMA(ai, bj, At, Bt) do { __builtin_amdgcn_s_setprio(1); _Pragma("unroll") for (int m = 0; m < 4; ++m) _Pragma("unroll") for (int n = 0; n < 2; ++n) _Pragma("unroll") for (int k = 0; k < 2; ++k) \
        acc[ai][bj][m][n] = __builtin_amdgcn_mfma_f32_16x16x32_bf16(Bt[n][k], At[m][k], acc[ai][bj][m][n], 0, 0, 0); __builtin_amdgcn_s_setprio(0); } while (0)
#define PG8_WAIT_V(n) asm volatile("s_waitcnt vmcnt(" #n ")" ::: "memory")
#define PG8_WAIT_L(n) asm volatile("s_waitcnt lgkmcnt(" #n ")" ::: "memory")
#define PG8_BAR __builtin_amdgcn_s_barrier()
#define PG8_SCHED __builtin_amdgcn_sched_barrier(0)
    Unit cur, nxt; int ui = 0;
    if (!S.next(0, cur)) return;
    f32x4 acc[2][2][4][2];
#pragma unroll
    for (int a = 0; a < 2; ++a)
#pragma unroll
        for (int b = 0; b < 2; ++b)
#pragma unroll
            for (int m = 0; m < 4; ++m)
#pragma unroll
                for (int n = 0; n < 2; ++n) acc[a][b][m][n] = (f32x4){0.f, 0.f, 0.f, 0.f};
    bf16x8 At[4][2], B0[2][2], B1[2][2];
    const char* cA = S.a_base(cur); const char* cB = S.b_base(cur);
    S.a_ready(cur);
    if constexpr (SP2) {
        PG8_STAGE(PG8_SB(0, 0), cB, voffB); PG8_STAGE(PG8_SB(0, 1), cB + hstepB, voffB); PG8_STAGE(PG8_SA(0, 0), cA, voffA); PG8_STAGE(PG8_SA(0, 1), cA + hstepA, voffA);
        if (wr == 1) PG8_BAR;
        PG8_WAIT_V(2); PG8_BAR;
        PG8_STAGE(PG8_SB(1, 0), cB + kstep, voffB); PG8_STAGE(PG8_SA(1, 0), cA + kstep, voffA); PG8_STAGE(PG8_SB(1, 1), cB + hstepB + kstep, voffB);
        PG8_WAIT_V(6); PG8_BAR;
    } else {
        PG8_STAGE(PG8_SB(0, 0), cB, voffB); PG8_STAGE(PG8_SA(0, 0), cA, voffA); PG8_STAGE(PG8_SB(0, 1), cB + hstepB, voffB); PG8_STAGE(PG8_SA(0, 1), cA + hstepA, voffA);
        if (wr == 1) PG8_BAR;
        PG8_WAIT_V(4); PG8_BAR;
        PG8_STAGE(PG8_SB(1, 0), cB + kstep, voffB); PG8_STAGE(PG8_SA(1, 0), cA + kstep, voffA); PG8_STAGE(PG8_SB(1, 1), cB + hstepB + kstep, voffB);
        PG8_WAIT_V(6); PG8_BAR;
    }
    for (;;) {
        const bool has_next = S.next(ui + 1, nxt);
        const char* nA = has_next ? S.a_base(nxt) : cA; const char* nB = has_next ? S.b_base(nxt) : cB;
#pragma unroll 1
        for (int t = 0; t < nt; t += 2) {
            if constexpr (Epi::KHOOK) { if (t != 0 && (t & 7) == 0) E.khook(acc, cur, t >> 3, wr, fr); }
            const bool last = (t == nt - 2);
            const char* a1 = cA + (size_t)(t + 1) * kstep;
            const char* a2 = last ? nA : cA + (size_t)(t + 2) * kstep; const char* b2 = last ? nB : cB + (size_t)(t + 2) * kstep;
            const char* a3 = a2 + kstep; const char* b3 = b2 + kstep;
            if (last && has_next) S.a_ready(nxt);
            if constexpr (SP2) {
            PG8_LDB(B0, 0, 0); PG8_LDB(B1, 0, 1); PG8_SCHED; PG8_LDA(At, 0, 0); PG8_STAGE(PG8_SA(1, 1), a1 + hstepA, voffA);
            PG8_WAIT_V(8); PG8_WAIT_L(0); PG8_BAR; PG8_MMA(0, 0, At, B0); PG8_MMA(0, 1, At, B1); PG8_BAR; PG8_SCHED;
            PG8_LDA(At, 0, 1); PG8_STAGE(PG8_SB(0, 0), b2, voffB); PG8_STAGE(PG8_SB(0, 1), b2 + hstepB, voffB); PG8_STAGE(PG8_SA(0, 0), a2, voffA);
            PG8_WAIT_V(8); PG8_WAIT_L(0); PG8_BAR; PG8_MMA(1, 0, At, B0); PG8_MMA(1, 1, At, B1); PG8_BAR; PG8_SCHED;
            PG8_LDB(B0, 1, 0); PG8_LDB(B1, 1, 1); PG8_SCHED; PG8_LDA(At, 1, 0); PG8_STAGE(PG8_SA(0, 1), a2 + hstepA, voffA);
            PG8_WAIT_V(8); PG8_WAIT_L(0); PG8_BAR; PG8_MMA(0, 0, At, B0); PG8_MMA(0, 1, At, B1); PG8_BAR; PG8_SCHED;
            PG8_LDA(At, 1, 1); PG8_STAGE(PG8_SB(1, 0), b3, voffB); PG8_STAGE(PG8_SB(1, 1), b3 + hstepB, voffB); PG8_STAGE(PG8_SA(1, 0), a3, voffA);
            PG8_WAIT_V(8); PG8_WAIT_L(0); PG8_BAR; PG8_MMA(1, 0, At, B0); PG8_MMA(1, 1, At, B1); PG8_BAR; PG8_SCHED;
            } else {
            PG8_LDB(B0, 0, 0); PG8_SCHED; PG8_LDA(At, 0, 0); PG8_STAGE(PG8_SA(1, 1), a1 + hstepA, voffA);
            PG8_WAIT_L(8); PG8_BAR; PG8_WAIT_L(0); PG8_MMA(0, 0, At, B0); PG8_BAR; PG8_SCHED;
            PG8_LDB(B1, 0, 1); PG8_STAGE(PG8_SB(0, 0), b2, voffB);
            PG8_BAR; PG8_WAIT_L(0); PG8_MMA(0, 1, At, B1); PG8_BAR;
            PG8_LDA(At, 0, 1); PG8_STAGE(PG8_SA(0, 0), a2, voffA);
            PG8_BAR; PG8_WAIT_L(0); PG8_MMA(1, 0, At, B0); PG8_BAR; PG8_SCHED;
            PG8_STAGE(PG8_SB(0, 1), b2 + hstepB, voffB);
            PG8_WAIT_V(6); PG8_BAR; PG8_MMA(1, 1, At, B1); PG8_BAR;
            PG8_LDB(B0, 1, 0); PG8_SCHED; PG8_LDA(At, 1, 0); PG8_STAGE(PG8_SA(0, 1), a2 + hstepA, voffA);
            PG8_WAIT_L(8); PG8_BAR; PG8_WAIT_L(0); PG8_MMA(0, 0, At, B0); PG8_BAR; PG8_SCHED;
            PG8_LDB(B1, 1, 1); PG8_STAGE(PG8_SB(1, 0), b3, voffB);
            PG8_BAR; PG8_WAIT_L(0); PG8_MMA(0, 1, At, B1); PG8_BAR;
            PG8_LDA(At, 1, 1); PG8_STAGE(PG8_SA(1, 0), a3, voffA);
            PG8_BAR; PG8_WAIT_L(0); PG8_MMA(1, 0, At, B0); PG8_BAR; PG8_SCHED;
            PG8_STAGE(PG8_SB(1, 1), b3 + hstepB, voffB);
            PG8_WAIT_V(6); PG8_BAR; PG8_MMA(1, 1, At, B1); PG8_BAR;
            }
        }
        if constexpr (ALIGN_EPI) { if (wr == 0) PG8_BAR; }
        if constexpr (!Epi::AFTER_DRAIN) { E(acc, cur, wr, wc, fr, fq); S.done(cur); }
        if (!has_next) break;
#pragma unroll
        for (int a = 0; a < 2; ++a)
#pragma unroll
            for (int b = 0; b < 2; ++b)
#pragma unroll
                for (int m = 0; m < 4; ++m)
#pragma unroll
                    for (int n = 0; n < 2; ++n) acc[a][b][m][n] = (f32x4){0.f, 0.f, 0.f, 0.f};
        cur = nxt; cA = nA; cB = nB; ++ui;
        if constexpr (ALIGN_EPI) { if (wr == 1) PG8_BAR; }
    }
    PG8_WAIT_V(0);
    if constexpr (!ALIGN_EPI) { if (wr == 0) PG8_BAR; }
    PG8_BAR;
    if constexpr (Epi::AFTER_DRAIN) { E.fused(acc, cur, wr, wc, fr, fq, lds, wid, lane); S.done(cur); }
#undef PG8_SA
#undef PG8_SB
#undef PG8_STAGE
#undef PG8_LDA
#undef PG8_LDB
#undef PG8_MMA
#undef PG8_WAIT_V
#undef PG8_WAIT_L
#undef PG8_BAR
#undef PG8_SCHED
}
__device__ __forceinline__ float silu_f(float x) { return x * __builtin_amdgcn_rcpf(1.f + __builtin_amdgcn_exp2f(-1.4426950408889634f * x)); }
__device__ __forceinline__ float sigm_f(float x) { return __builtin_amdgcn_rcpf(1.f + __builtin_amdgcn_exp2f(-1.4426950408889634f * x)); }
__device__ __forceinline__ u32x4 pack8(const f32x4 a, const f32x4 b) { u32x4 w; w.x = cvt_pk_bf16(a[0], a[1]); w.y = cvt_pk_bf16(a[2], a[3]); w.z = cvt_pk_bf16(b[0], b[1]); w.w = cvt_pk_bf16(b[2], b[3]); return w; }
__device__ __forceinline__ unsigned short bf1(float f) { return (unsigned short)(cvt_pk_bf16(f, 0.f) & 0xffffu); }

struct EpiEven {
    static constexpr bool PERM = true, AFTER_DRAIN = false, KHOOK = false;
    bf16_t *QA, *KA, *VAT, *GA, *QB, *KB, *VB, *GB; float* LOGF; float* out;
    const float *qg, *kg, *hlb; float qscale; int MTOT, MPR; size_t okp, oks, ovp, ovs;
    __device__ __forceinline__ void operator()(const f32x4 (&acc)[2][2][4][2], const Unit& u, int wr, int wc, int fr, int fq) const {
        const int typ = u.pn >> 1;
        int rb = u.pm * BM + wr * 64 + fr; asm volatile("" : "+v"(rb));
        const int c0 = (u.pn & 1) * 256 + wc * 64 + fq * 8;
        const int d0 = fq * 8;
#pragma unroll
        for (int ai = 0; ai < 2; ++ai)
#pragma unroll
            for (int m = 0; m < 4; ++m) {
                const int row = rb + ai * HALF + m * 16;
                f32x4 v[2][2];
#pragma unroll
                for (int bj = 0; bj < 2; ++bj)
#pragma unroll
                    for (int n = 0; n < 2; ++n) v[bj][n] = acc[ai][bj][m][n];
                if (typ <= 1) {
                    float ss = 0.f;
#pragma unroll
                    for (int bj = 0; bj < 2; ++bj)
#pragma unroll
                        for (int n = 0; n < 2; ++n) ss += (v[bj][n][0] * v[bj][n][0] + v[bj][n][1] * v[bj][n][1]) + (v[bj][n][2] * v[bj][n][2] + v[bj][n][3] * v[bj][n][3]);
                    ss += __shfl_xor(ss, 16); ss += __shfl_xor(ss, 32);
                    const float rstd = __builtin_amdgcn_rsqf(ss * (1.f / 64.f) + 1e-6f) * (typ == 0 ? qscale : 1.f);
                    const float* g = (typ == 0) ? qg : kg;
#pragma unroll
                    for (int bj = 0; bj < 2; ++bj) {
#pragma unroll
                        for (int n = 0; n < 2; ++n) { const f32x4 gv = *(const f32x4*)(g + d0 + 32 * bj + 4 * n); v[bj][n] = v[bj][n] * gv * rstd; }
                        const int c = c0 + 32 * bj;
                        if (typ == 0) *(u32x4*)(QA + (size_t)row * 512 + c) = pack8(v[bj][0], v[bj][1]);
                        else {
                            *(u32x4*)(KA + (size_t)row * 512 + c) = pack8(v[bj][0], v[bj][1]);
                            float* ko = out + (row < MPR ? okp + (size_t)row * 512 : oks + (size_t)(row - MPR) * 512) + c;
                            *(f32x4*)ko = v[bj][0]; *(f32x4*)(ko + 4) = v[bj][1];
                        }
                    }
                } else if (typ == 2) {
#pragma unroll
                    for (int bj = 0; bj < 2; ++bj) {
                        const int c = c0 + 32 * bj;
                        float* vo = out + (row < MPR ? ovp + (size_t)row * 512 : ovs + (size_t)(row - MPR) * 512) + c;
                        *(f32x4*)vo = v[bj][0]; *(f32x4*)(vo + 4) = v[bj][1];
                        *(u32x4*)(VAT + (size_t)row * 512 + c) = pack8(v[bj][0], v[bj][1]);
                    }
                } else if (typ == 5) {
#pragma unroll
                    for (int bj = 0; bj < 2; ++bj) {
                        const int c = c0 + 32 * bj;
                        f32x4 lf[2], kk[2];
#pragma unroll
                        for (int n = 0; n < 2; ++n)
#pragma unroll
                            for (int e = 0; e < 4; ++e) {
                                const int cc = c + 4 * n + e;
                                const float lb = __builtin_amdgcn_rcpf(1.f + __expf(hlb[512 + cc] - hlb[cc]));
                                const float sg = sigm_f(v[bj][n][e]);
                                lf[n][e] = __logf(lb + (1.f - lb) * sg);
                                kk[n][e] = (1.f - lb) * (1.f - sg);
                            }
                        *(f32x4*)(LOGF + (size_t)row * 512 + c) = lf[0]; *(f32x4*)(LOGF + (size_t)row * 512 + c + 4) = lf[1];
                        *(u32x4*)(KB + (size_t)row * 512 + c) = pack8(kk[0], kk[1]);
                    }
                } else {
                    bf16_t* dst = (typ == 3) ? GA : (typ == 4) ? QB : (typ == 6) ? VB : GB;
#pragma unroll
                    for (int bj = 0; bj < 2; ++bj) {
                        if (typ != 6) {
#pragma unroll
                            for (int n = 0; n < 2; ++n)
#pragma unroll
                                for (int e = 0; e < 4; ++e) v[bj][n][e] = silu_f(v[bj][n][e]);
                        }
                        *(u32x4*)(dst + (size_t)row * 512 + c0 + 32 * bj) = pack8(v[bj][0], v[bj][1]);
                    }
                }
            }
    }
};


struct EpiY1 {
    static constexpr bool PERM = false, AFTER_DRAIN = false, KHOOK = false;
    const float* x; bf16_t* Y1; bf16_t* H; const float* g1; float* SS1;
    __device__ __forceinline__ void operator()(const f32x4 (&acc)[2][2][4][2], const Unit& u, int wr, int wc, int fr, int fq) const {
        int row0 = u.pm * BM + wr * 64 + fr; asm volatile("" : "+v"(row0));
        const int col0 = u.pn * BM + wc * 32 + 4 * fq;
#pragma unroll
        for (int ai = 0; ai < 2; ++ai)
#pragma unroll
            for (int m = 0; m < 4; ++m) {
                const int row = row0 + ai * HALF + m * 16; float ss = 0.f;
#pragma unroll
                for (int bj = 0; bj < 2; ++bj)
#pragma unroll
                    for (int n = 0; n < 2; ++n) { const int c = col0 + bj * HALF + n * 16;
                        const f32x4 y = acc[ai][bj][m][n] + *(const f32x4*)(x + (size_t)row * 1024 + c);
                        *(unsigned long long*)(Y1 + (size_t)row * 1024 + c) = (unsigned long long)cvt_pk_bf16(y[0], y[1]) | ((unsigned long long)cvt_pk_bf16(y[2], y[3]) << 32);
                        ss += (y[0] * y[0] + y[1] * y[1]) + (y[2] * y[2] + y[3] * y[3]);
                        const f32x4 h = y * *(const f32x4*)(g1 + c);
                        *(unsigned long long*)(H + (size_t)row * 1024 + c) = (unsigned long long)cvt_pk_bf16(h[0], h[1]) | ((unsigned long long)cvt_pk_bf16(h[2], h[3]) << 32); }
                ss += __shfl_xor(ss, 16); ss += __shfl_xor(ss, 32);
                if (fq == 0) atomicAdd(SS1 + row, ss);
            }
    }
};


__device__ __forceinline__ float lg2gamma(int h) { return __builtin_amdgcn_logf(1.f - __builtin_amdgcn_exp2f(-5.f - (float)h)); }

template <int KIND> struct EpiOdd3 {
    static constexpr bool PERM = true, AFTER_DRAIN = false, KHOOK = false;
    bf16_t *AQ, *KCH, *KCT, *BV, *GC, *QC, *KC, *VC; const float *rcos, *rsin, *rcosT, *rsinT; int MPR; const float* SS1;
    __device__ __forceinline__ void operator()(const f32x4 (&acc)[2][2][4][2], const Unit& u, int wr, int wc, int fr, int fq) const {

        if (KIND == 0) {
            const int j0 = wc * 32 + fq * 8;
            int rb = u.pm * BM + wr * 64 + fr; asm volatile("" : "+v"(rb));
#pragma unroll
            for (int ai = 0; ai < 2; ++ai)
#pragma unroll
                for (int m = 0; m < 4; ++m) {
                    const int row = rb + ai * HALF + m * 16;
                    const float rs = __builtin_amdgcn_rsqf(SS1[row] * (1.f / 1024.f) + 1e-6f);
                    if (u.pn < 8) {
                        const int pos = row & (TP - 1), h = u.pn & 3, tl = row & 255;
                        const float sc = rs * ((u.pn < 4) ? __builtin_amdgcn_exp2f((float)tl * lg2gamma(h)) : 0.0625f * __builtin_amdgcn_exp2f(-(float)tl * lg2gamma(h)));
                        f32x4 o1[2], o2[2];
#pragma unroll
                        for (int n = 0; n < 2; ++n) {
                            const f32x4 c = *(const f32x4*)(rcos + (size_t)pos * 128 + j0 + 4 * n), s = *(const f32x4*)(rsin + (size_t)pos * 128 + j0 + 4 * n);
                            const f32x4 x1 = acc[ai][0][m][n], x2 = acc[ai][1][m][n];
                            o1[n] = (x1 * c - x2 * s) * sc; o2[n] = (x2 * c + x1 * s) * sc;
                        }
                        bf16_t* dst = (u.pn < 4) ? AQ + (size_t)row * 2048 + h * 512 + 256 + j0 : KCH + (size_t)row * 1024 + h * 256 + j0;
                        *(u32x4*)dst = pack8(o1[0], o1[1]); *(u32x4*)(dst + 128) = pack8(o2[0], o2[1]);
                        if (u.pn >= 4) {
                            bf16_t* kt = KCT + ((size_t)(((row >> 13) * 4 + h) * 32 + ((row >> 8) & 31)) * 256 + j0) * 256 + tl;
#pragma unroll
                            for (int n = 0; n < 2; ++n)
#pragma unroll
                                for (int e = 0; e < 4; ++e) { kt[(size_t)(4 * n + e) * 256] = bf1(o1[n][e]); kt[(size_t)(128 + 4 * n + e) * 256] = bf1(o2[n][e]); }
                        }
                        asm volatile("" ::: "memory");
                    } else {
                        bf16_t* dst = GC + (size_t)row * 2048 + (u.pn - 8) * 256 + j0;
#pragma unroll
                        for (int bj = 0; bj < 2; ++bj) {
                            f32x4 a = acc[ai][bj][m][0] * rs, b = acc[ai][bj][m][1] * rs;
#pragma unroll
                            for (int e = 0; e < 4; ++e) { a[e] = silu_f(a[e]); b[e] = silu_f(b[e]); }
                            *(u32x4*)(dst + 128 * bj) = pack8(a, b);
                        }
                    }
                }
            return;
        }
        int fro = fr; asm volatile("" : "+v"(fro));
        if (u.pm < 4) {
            const int h = u.pm; const float lg = lg2gamma(h);
            int lt = wc * 32 + fq * 8; asm volatile("" : "+v"(lt));
            const float ginv = __builtin_amdgcn_exp2f(-lg), g128 = __builtin_amdgcn_exp2f(-128.f * lg);
            float scv[2][8]; scv[0][0] = 0.0625f * __builtin_amdgcn_exp2f(-(float)lt * lg);
#pragma unroll
            for (int i = 1; i < 8; ++i) scv[0][i] = scv[0][i - 1] * ginv;
#pragma unroll
            for (int i = 0; i < 8; ++i) scv[1][i] = scv[0][i] * g128;
#pragma unroll
            for (int m = 0; m < 4; ++m) {
                const int j = wr * 64 + m * 16 + fro;
#pragma unroll
                for (int bj = 0; bj < 2; ++bj) {
                    const int tl0 = bj * HALF + lt, tok0 = u.pn * BM + tl0, pos0 = tok0 & (TP - 1);
                    f32x4 o1[2], o2[2];
#pragma unroll
                    for (int n = 0; n < 2; ++n) {
                        const f32x4 c = *(const f32x4*)(rcosT + (size_t)j * 8200 + pos0 + 4 * n), s = *(const f32x4*)(rsinT + (size_t)j * 8200 + pos0 + 4 * n);
                        const f32x4 x1 = acc[0][bj][m][n], x2 = acc[1][bj][m][n], q2 = *(const f32x4*)(SS1 + tok0 + 4 * n);
#pragma unroll
                        for (int e = 0; e < 4; ++e) {
                            const float sc = scv[bj][4 * n + e] * __builtin_amdgcn_rsqf(q2[e] * (1.f / 1024.f) + 1e-6f);
                            o1[n][e] = (x1[e] * c[e] - x2[e] * s[e]) * sc; o2[n][e] = (x2[e] * c[e] + x1[e] * s[e]) * sc;
                        }
                    }
                    { const int b = tok0 >> 13, c = (tok0 >> 8) & 31; bf16_t* kc = KCT + ((size_t)((b * 4 + h) * 32 + c) * 256 + j) * 256 + (tok0 & 255);
                      *(u32x4*)kc = pack8(o1[0], o1[1]); *(u32x4*)(kc + 128 * 256) = pack8(o2[0], o2[1]); }
                    asm volatile("" ::: "memory");
                }
            }
        } else {
#pragma unroll
            for (int ai = 0; ai < 2; ++ai)
#pragma unroll
                for (int m = 0; m < 4; ++m) {
                    const int vf = (u.pm - 4) * BM + ai * HALF + wr * 64 + m * 16 + fro, h = vf >> 9, dv = vf & 511;
#pragma unroll
                    for (int bj = 0; bj < 2; ++bj) {
                        const int tok0 = u.pn * BM + bj * HALF + wc * 32 + fq * 8, b = tok0 >> 13, c = (tok0 >> 8) & 31, sl = tok0 & 255;
                        f32x4 r0 = *(const f32x4*)(SS1 + tok0), r1 = *(const f32x4*)(SS1 + tok0 + 4);
#pragma unroll
                        for (int e = 0; e < 4; ++e) { r0[e] = __builtin_amdgcn_rsqf(r0[e] * (1.f / 1024.f) + 1e-6f); r1[e] = __builtin_amdgcn_rsqf(r1[e] * (1.f / 1024.f) + 1e-6f); }
                        *(u32x4*)(BV + ((size_t)((b * 4 + h) * 32 + c) * 512 + dv) * 512 + sl) = pack8(acc[ai][bj][m][0] * r0, acc[ai][bj][m][1] * r1);
                    }
                }
        }
    }
};
template <int KIND> struct Sched3 {
    StaticOrder so; const char *H, *W3T; int G, c;
    __device__ __forceinline__ void init(const void* H_, const void* W3T_, int G_, int c_) { H = (const char*)H_; W3T = (const char*)W3T_; G = G_; c = c_; so.init(16384, 4096, G_, c_); }
    __device__ __forceinline__ bool next(int i, Unit& u) const {
        const int L = i * G + c; u.aux = 0; u.kind = KIND;
        if (KIND == 0) return so.next(i, u);
        if (KIND == 1) { if (L >= 512) return false; u.pm = 4 + (L & 7); u.pn = L >> 3; return true; }
        if (L >= 24) return false; u.pm = 64; u.pn = L; return true;
    }
    __device__ __forceinline__ const char* a_base(const Unit& u) const { return (KIND == 1) ? W3T + (size_t)(1024 + 256 * u.pm) * 2048 : H + (size_t)u.pm * 256 * 2048; }
    __device__ __forceinline__ const char* b_base(const Unit& u) const {
        if (KIND == 1) return H + (size_t)u.pn * 256 * 2048;
        const int r0 = (KIND == 0 && u.pn >= 8) ? 4096 + 256 * (u.pn - 8) : 256 * u.pn;
        return W3T + (size_t)r0 * 2048; }
    __device__ __forceinline__ void a_ready(const Unit&) const {}
    __device__ __forceinline__ void done(const Unit&) const {}
};
struct SchedPlain {
    StaticOrder so; const char *A, *Bt; size_t ta, tb;
    __device__ __forceinline__ void init(const void* A_, const void* Bt_, int M, int N, int K, int G, int c) { A = (const char*)A_; Bt = (const char*)Bt_; ta = (size_t)256 * K * 2; tb = ta; so.init(M, N, G, c); }
    __device__ __forceinline__ bool next(int i, Unit& u) const { u.kind = 0; u.aux = 0; return so.next(i, u); }
    __device__ __forceinline__ const char* a_base(const Unit& u) const { return A + (size_t)u.pm * ta; }
    __device__ __forceinline__ const char* b_base(const Unit& u) const { return Bt + (size_t)u.pn * tb; }
    __device__ __forceinline__ void a_ready(const Unit&) const {}
    __device__ __forceinline__ void done(const Unit&) const {}
};
struct SchedRet {
    const char *Ab, *Bb; int G, c, mode;
    __device__ __forceinline__ bool next(int i, Unit& u) const {
        const int L = i * G + c, n = (mode == 1) ? 256 : 512; if (L >= n) return false;
        int bc, half; if (mode == 1) { bc = L; half = 0; } else { bc = L >> 1; half = L & 1; }
        u.pm = bc; u.pn = half; u.kind = 0; u.aux = (bc >> 7) * TP + (bc & 31) * 256; return true;
    }
    __device__ __forceinline__ const char* a_base(const Unit& u) const {
        if (mode == 0) return Ab + ((size_t)u.pm * 512 + u.pn * 256) * 512 * 2;
        const int h = (u.pm >> 5) & 3;
        return Ab + ((size_t)u.aux * 2048 + h * 512 + (mode == 1 ? 256 : 0)) * 2; }
    __device__ __forceinline__ const char* b_base(const Unit& u) const {
        const int h = (u.pm >> 5) & 3;
        if (mode == 0) return Bb + (size_t)u.pm * 256 * 256 * 2;
        if (mode == 1) return Bb + ((size_t)u.aux * 1024 + h * 256) * 2;
        return Bb + ((size_t)u.pm * 512 + u.pn * 256) * 512 * 2; }
    __device__ __forceinline__ void a_ready(const Unit&) const {}
    __device__ __forceinline__ void done(const Unit&) const {}
};
struct EpiRetA {
    static constexpr bool PERM = true, AFTER_DRAIN = false, KHOOK = false;
    bf16_t* DST;
    __device__ __forceinline__ void operator()(const f32x4 (&acc)[2][2][4][2], const Unit& u, int wr, int wc, int fr, int fq) const {
        bf16_t* base = DST + ((size_t)u.pm * 512 + u.pn * 256) * 256;
        int rb = wr * 64 + fr; asm volatile("" : "+v"(rb));
#pragma unroll
        for (int ai = 0; ai < 2; ++ai)
#pragma unroll
            for (int m = 0; m < 4; ++m) { bf16_t* rp = base + (size_t)(ai * HALF + m * 16 + rb) * 256 + wc * 32 + 8 * fq;
#pragma unroll
                for (int bj = 0; bj < 2; ++bj) *(u32x4*)(rp + bj * HALF) = pack8(acc[ai][bj][m][0], acc[ai][bj][m][1]); }
    }
};
struct EpiRetP {
    static constexpr bool PERM = true, AFTER_DRAIN = false, KHOOK = false;
    bf16_t* AQ;
    __device__ __forceinline__ void operator()(const f32x4 (&acc)[2][2][4][2], const Unit& u, int wr, int wc, int fr, int fq) const {
        const int h = (u.pm >> 5) & 3;
        int rb = wr * 64 + fr; asm volatile("" : "+v"(rb));
#pragma unroll
        for (int ai = 0; ai < 2; ++ai)
#pragma unroll
            for (int m = 0; m < 4; ++m) { const int t = ai * HALF + m * 16 + rb;
#pragma unroll
                for (int bj = 0; bj < 2; ++bj) { const int s0 = bj * HALF + wc * 32 + fq * 8; f32x4 a = acc[ai][bj][m][0], b = acc[ai][bj][m][1];
#pragma unroll
                    for (int e = 0; e < 4; ++e) { if (s0 + e > t) a[e] = 0.f; if (s0 + 4 + e > t) b[e] = 0.f; }
                    *(u32x4*)(AQ + (size_t)(u.aux + t) * 2048 + h * 512 + s0) = pack8(a, b); } }
    }
};
struct EpiRetO {
    static constexpr bool PERM = true, AFTER_DRAIN = false, KHOOK = false;
    const bf16_t* GC; bf16_t* MIX2; float* SS;
    __device__ __forceinline__ void operator()(const f32x4 (&acc)[2][2][4][2], const Unit& u, int wr, int wc, int fr, int fq) const {
        const int h = (u.pm >> 5) & 3;
        int rb = u.aux + wr * 64 + fr; asm volatile("" : "+v"(rb));
#pragma unroll
        for (int ai = 0; ai < 2; ++ai)
#pragma unroll
            for (int m = 0; m < 4; ++m) { const size_t row = (size_t)(rb + ai * HALF + m * 16); float ss = 0.f;
#pragma unroll
                for (int bj = 0; bj < 2; ++bj) { const int col = h * 512 + u.pn * 256 + bj * HALF + wc * 32 + fq * 8; f32x4 a = acc[ai][bj][m][0], b = acc[ai][bj][m][1];
                    ss += (a[0] * a[0] + a[1] * a[1]) + (a[2] * a[2] + a[3] * a[3]) + (b[0] * b[0] + b[1] * b[1]) + (b[2] * b[2] + b[3] * b[3]);
                    const u32x4 g = *(const u32x4*)(GC + row * 2048 + col);
                    a[0] *= __builtin_bit_cast(float, g.x << 16); a[1] *= __builtin_bit_cast(float, g.x & 0xffff0000u); a[2] *= __builtin_bit_cast(float, g.y << 16); a[3] *= __builtin_bit_cast(float, g.y & 0xffff0000u);
                    b[0] *= __builtin_bit_cast(float, g.z << 16); b[1] *= __builtin_bit_cast(float, g.z & 0xffff0000u); b[2] *= __builtin_bit_cast(float, g.w << 16); b[3] *= __builtin_bit_cast(float, g.w & 0xffff0000u);
                    *(u32x4*)(MIX2 + row * 2048 + col) = pack8(a, b); }
                ss += __shfl_xor(ss, 16); ss += __shfl_xor(ss, 32);
                if (fq == 0) atomicAdd(SS + row * 4 + h, ss); }
    }
};

struct SchedSplit {
    const char *A, *Bt; int nN, nP, G, c; size_t lda2, ldb2;
    __device__ __forceinline__ bool next(int i, Unit& u) const { const int L = i * G + c; if (L >= nN * nP) return false; u.pn = L / nP; u.aux = L % nP; u.pm = 0; u.kind = 0; return true; }
    __device__ __forceinline__ const char* a_base(const Unit& u) const { return A + (size_t)u.aux * 512; }
    __device__ __forceinline__ const char* b_base(const Unit& u) const { return Bt + (size_t)u.pn * 256 * ldb2 + (size_t)u.aux * 512; }
    __device__ __forceinline__ void a_ready(const Unit&) const {}
    __device__ __forceinline__ void done(const Unit&) const {}
};
struct EpiSlab {
    static constexpr bool PERM = true, AFTER_DRAIN = false, KHOOK = false;
    bf16_t* slab; int ncols;
    __device__ __forceinline__ void operator()(const f32x4 (&acc)[2][2][4][2], const Unit& u, int wr, int wc, int fr, int fq) const {
        int rb = wr * 64 + fr; asm volatile("" : "+v"(rb));
        bf16_t* base = slab + (size_t)u.aux * 256 * ncols + u.pn * BM + wc * 32 + 8 * fq;
#pragma unroll
        for (int ai = 0; ai < 2; ++ai)
#pragma unroll
            for (int m = 0; m < 4; ++m) { bf16_t* rp = base + (size_t)(rb + ai * HALF + m * 16) * ncols;
#pragma unroll
                for (int bj = 0; bj < 2; ++bj) *(u32x4*)(rp + bj * HALF) = pack8(acc[ai][bj][m][0], acc[ai][bj][m][1]); }
    }
};
struct EpiOut {
    static constexpr bool PERM = false, AFTER_DRAIN = false, KHOOK = true;
    const bf16_t* Y1; float* out; const float* SS;
    __device__ __forceinline__ float rstd(int row, int h) const { return __builtin_amdgcn_rsqf(SS[(size_t)row * 4 + h] * (1.f / 512.f) + 1e-6f); }
    __device__ __forceinline__ void khook(f32x4 (&acc)[2][2][4][2], const Unit& u, int hb, int wr, int fr) const {
        int rb = u.pm * BM + wr * 64 + fr; asm volatile("" : "+v"(rb));
#pragma unroll
        for (int ai = 0; ai < 2; ++ai)
#pragma unroll
            for (int m = 0; m < 4; ++m) { const int row = rb + ai * HALF + m * 16; const float ratio = rstd(row, hb - 1) * __builtin_amdgcn_rcpf(rstd(row, hb));
#pragma unroll
                for (int bj = 0; bj < 2; ++bj)
#pragma unroll
                    for (int n = 0; n < 2; ++n) acc[ai][bj][m][n] = acc[ai][bj][m][n] * ratio; }
    }
    __device__ __forceinline__ void operator()(const f32x4 (&acc)[2][2][4][2], const Unit& u, int wr, int wc, int fr, int fq) const {
        int row0 = u.pm * BM + wr * 64 + fr; asm volatile("" : "+v"(row0));
        const int col0 = u.pn * BM + wc * 32 + 4 * fq;
#pragma unroll
        for (int ai = 0; ai < 2; ++ai)
#pragma unroll
            for (int m = 0; m < 4; ++m) { const int row = row0 + ai * HALF + m * 16; const float r3 = rstd(row, 3);
#pragma unroll
                for (int bj = 0; bj < 2; ++bj)
#pragma unroll
                    for (int n = 0; n < 2; ++n) { const int c = col0 + bj * HALF + n * 16; const unsigned long long yq = *(const unsigned long long*)(Y1 + (size_t)row * 1024 + c);
                        const f32x4 yv = {__builtin_bit_cast(float, (unsigned)yq << 16), __builtin_bit_cast(float, (unsigned)yq & 0xffff0000u), __builtin_bit_cast(float, (unsigned)(yq >> 32) << 16), __builtin_bit_cast(float, (unsigned)(yq >> 32) & 0xffff0000u)};
                        *(f32x4*)(out + (size_t)row * 1024 + c) = acc[ai][bj][m][n] * r3 + yv; } }
    }
};
}
#define GAS __attribute__((address_space(1)))
#define LAS __attribute__((address_space(3)))
typedef unsigned short bf16;
typedef unsigned v4u __attribute__((ext_vector_type(4)));
typedef float f32x4 __attribute__((ext_vector_type(4)));
typedef short bf16x8 __attribute__((ext_vector_type(8)));
typedef GAS unsigned gu32;
typedef GAS unsigned long long gu64;
#define RLX_AGENT __ATOMIC_RELAXED, __HIP_MEMORY_SCOPE_AGENT
#define LDS_WAIT() asm volatile("s_waitcnt lgkmcnt(0)" ::: "memory")
#define VM_WAIT() asm volatile("s_waitcnt vmcnt(0)" ::: "memory")
__device__ __forceinline__ unsigned long long rt() { return __builtin_amdgcn_s_memrealtime(); }
__device__ __forceinline__ unsigned f2bf(float f) { unsigned u = __builtin_bit_cast(unsigned, f); return (u + 0x7fffu + ((u >> 16) & 1u)) >> 16; }
__device__ __forceinline__ unsigned pk2(float lo, float hi) { return f2bf(lo) | (f2bf(hi) << 16); }
#define XB_TMO      128
#define XB_XCNT(j)  (256  + 64 * (j))
#define XB_XSUB(j)  (1280 + 64 * (j))
#define XB_XGEN(j)  (2304 + 64 * (j))
#define XB_TOP      3328
#define XB_TOPGEN   3392
#define XCD_BAR_WORDS 3456
#define XB_SPIN_CAP (1u << 18)

__device__ __forceinline__ unsigned xb_ld(unsigned* p)              { return __hip_atomic_load(p, __ATOMIC_RELAXED, __HIP_MEMORY_SCOPE_AGENT); }
__device__ __forceinline__ unsigned xb_add(unsigned* p, unsigned v) { return __hip_atomic_fetch_add(p, v, __ATOMIC_RELAXED, __HIP_MEMORY_SCOPE_AGENT); }
__device__ __forceinline__ unsigned xb_xcc_id() { return (unsigned)__builtin_amdgcn_s_getreg((3 << 11) | 20) & 0xFu; }
#define XB_SPIN(cond, bar) do { unsigned _sp = 0; while (cond) { __builtin_amdgcn_s_sleep(1); \
    if ((++_sp & 255u) == 0u) { if (xb_ld(&(bar)[XB_TMO])) break; if (_sp > XB_SPIN_CAP) { atomicAdd(&(bar)[XB_TMO], 1u); break; } } } } while (0)

struct XcdBarrier {
    unsigned* bar; unsigned x;
    volatile LAS unsigned* st;
};

__device__ __forceinline__ XcdBarrier xcd_barrier_post(unsigned* bar, volatile LAS unsigned* st) {
    XcdBarrier b; b.bar = bar; b.x = xb_xcc_id(); b.st = st;
    if (threadIdx.x == 0) (void)xb_add(&bar[XB_XCNT(b.x)], 1u);
    return b;
}
__device__ __forceinline__ void xcd_barrier_complete(unsigned* bar, unsigned x, unsigned& nloc, unsigned& nx) {
    const unsigned G = gridDim.x * gridDim.y * gridDim.z;
    unsigned sum, cnt, mine, sp = 0u;
    for (;;) {
        sum = 0u; cnt = 0u; mine = 0u;
#pragma unroll
        for (unsigned j = 0; j < 16; ++j) { const unsigned c = xb_ld(&bar[XB_XCNT(j)]); sum += c; cnt += (c > 0u) ? 1u : 0u; mine = (j == x) ? c : mine; }
        if (sum == G) break;
        __builtin_amdgcn_s_sleep(1);
        if ((++sp & 255u) == 0u) { if (xb_ld(&bar[XB_TMO])) break; if (sp > XB_SPIN_CAP) { atomicAdd(&bar[XB_TMO], 1u); break; } }
    }
    nloc = mine > 0u ? mine : 1u; nx = cnt > 0u ? cnt : 1u;
}

__device__ __forceinline__ void xcd_barrier(const XcdBarrier& b) {
    asm volatile("s_waitcnt vmcnt(0)" ::: "memory");
    __syncthreads();
    if (threadIdx.x == 0) {
        unsigned* bar = b.bar;
        __builtin_amdgcn_s_waitcnt(0);
        unsigned nloc = b.st[0], nx = b.st[1];
        if (nloc == 0u) { xcd_barrier_complete(bar, b.x, nloc, nx); b.st[0] = nloc; b.st[1] = nx; }
        const unsigned old = xb_add(&bar[XB_XSUB(b.x)], 1u);
        const unsigned gen = old / nloc;
        if (old + 1u == (gen + 1u) * nloc) {
            __builtin_amdgcn_fence(__ATOMIC_RELEASE, "agent");
            asm volatile("s_waitcnt vmcnt(0)" ::: "memory");
            const unsigned og = xb_add(&bar[XB_TOP], 1u);
            const unsigned tg = og / nx;
            if (og + 1u == (tg + 1u) * nx) xb_add(&bar[XB_TOPGEN], 1u);
            else XB_SPIN(xb_ld(&bar[XB_TOPGEN]) == tg, bar);
            __builtin_amdgcn_fence(__ATOMIC_ACQUIRE, "agent");
            xb_add(&bar[XB_XGEN(b.x)], 1u);
            asm volatile("s_waitcnt vmcnt(0)" ::: "memory");
        } else {
            XB_SPIN(xb_ld(&bar[XB_XGEN(b.x)]) == gen, bar);
            __builtin_amdgcn_fence(__ATOMIC_ACQUIRE, "agent");
            asm volatile("s_waitcnt vmcnt(0)" ::: "memory");
        }
    }
    __syncthreads();
}
constexpr size_t MiB = 1u << 20;
constexpr size_t WS_CTL = 0, CTL_ZERO_BYTES = 1 * MiB;
constexpr size_t WS_W1T = 2 * MiB;
constexpr size_t WS_W2T = 10 * MiB;
constexpr size_t WS_W3T = 12 * MiB;
constexpr size_t WS_W4T = 24 * MiB;
constexpr size_t WS_RCOS = 28 * MiB, WS_RSIN = 33 * MiB;
constexpr size_t SZ_H = (size_t)MT * 1024 * 2;
constexpr size_t SZ_S = (size_t)MT * 512 * 2;
constexpr size_t WS_H = 40 * MiB;
constexpr size_t WS_QA = WS_H + 33 * MiB, WS_KA = WS_QA + 17 * MiB, WS_VAT = WS_KA + 17 * MiB, WS_GA = WS_VAT + 17 * MiB;
constexpr size_t WS_QB = WS_GA + 17 * MiB, WS_KB = WS_QB + 17 * MiB, WS_VB = WS_KB + 17 * MiB, WS_GB = WS_VB + 17 * MiB;
constexpr size_t WS_LOGF = WS_GB + 17 * MiB;
constexpr size_t WS_OB = WS_LOGF + 33 * MiB;
constexpr size_t WS_MIX = WS_OB + 33 * MiB;
constexpr size_t WS_Y1 = WS_MIX + 33 * MiB;
constexpr size_t WS_QC = WS_Y1 + 65 * MiB, WS_KC = WS_QC + 33 * MiB;
constexpr size_t WS_VC = WS_KC + 33 * MiB, WS_GC = WS_VC + 65 * MiB;
constexpr size_t WS_OC = WS_GC + 65 * MiB;
constexpr size_t WS_MIX2 = WS_OC + 130 * MiB;
constexpr size_t WS_AQ = WS_MIX2 + 65 * MiB;
constexpr size_t WS_KCH = WS_AQ + 64 * MiB;
constexpr size_t WS_KCT = WS_KCH + 32 * MiB;
constexpr size_t WS_BV = WS_KCT + 32 * MiB;
constexpr size_t WS_DST = WS_BV + 128 * MiB;
constexpr size_t WS_RCOST = WS_DST + 128 * MiB, WS_RSINT = WS_RCOST + 5 * MiB;
constexpr size_t WS_DSH = WS_RSINT + 5 * MiB;
constexpr size_t WS_SST = WS_DSH + 16 * MiB;
constexpr size_t WS_DD = WS_SST + 16 * MiB;
constexpr size_t WS_SLAB = WS_DD + 1 * MiB;
constexpr size_t WS_SLAB4 = WS_SLAB + 24 * MiB;
constexpr size_t WS_END = WS_SLAB4 + 8 * MiB;
constexpr size_t CTL_SS = 65536;
constexpr size_t CTL_SS1 = CTL_SS + (size_t)MP * 16;
constexpr size_t CTL_SSS = CTL_SS1 + (size_t)MT * 4;
static_assert(CTL_SSS + 4096 <= CTL_ZERO_BYTES, "SS / SS1 / SSS inside the zeroed region");
static_assert(SZ_H <= 33 * MiB && SZ_S <= 17 * MiB && (size_t)MT * 2048 * 4 <= 130 * MiB, "ws map");

constexpr int CW_TMO = 0, CW_CODE = 1, CW_BAR = 4096;

constexpr int RING_OFF = 0, RING_BYTES = 131072;
constexpr int LDSCTL_OFF = RING_BYTES, MISC_OFF = LDSCTL_OFF + 320;
constexpr int LDS_BYTES = 147456;
constexpr int NWAVES = 8;

typedef float f32x16 __attribute__((ext_vector_type(16)));
__device__ __forceinline__ float bf2f(bf16 b) { return __builtin_bit_cast(float, (unsigned)b << 16); }
__device__ __forceinline__ float bflo(unsigned w) { return __builtin_bit_cast(float, w << 16); }
__device__ __forceinline__ float bfhi(unsigned w) { return __builtin_bit_cast(float, w & 0xffff0000u); }
__device__ __forceinline__ int crow(int r, int hi) { return (r & 3) + 8 * (r >> 2) + 4 * hi; }
__device__ __forceinline__ float wave_sum(float v) {
#pragma unroll
    for (int o = 1; o < 64; o <<= 1) v += __shfl_xor(v, o);
    return v;
}

struct Frame {
    LAS unsigned char* lds;
    volatile LAS unsigned* MISC;
    gu32* ctl;
    int tid, lane, wave, G, bid;
    const float *xp, *xs, *ck, *cv, *st_h, *st_r, *ng, *w1, *w2, *qg, *kg, *sbb, *hlb, *og, *w3, *w4; const int* pt;
    float* out;
    unsigned char* ws;
    __device__ __forceinline__ float* SSS() const { return (float*)(ws + WS_CTL + CTL_SSS); }
    __device__ __forceinline__ float* SS1() const { return (float*)(ws + WS_CTL + CTL_SS1); }
    __device__ __forceinline__ bf16* SLAB() const { return (bf16*)(ws + WS_SLAB); }
    __device__ __forceinline__ bf16* Y1B() const { return (bf16*)(ws + WS_OB); }
    __device__ __forceinline__ bf16* SLAB4() const { return (bf16*)(ws + WS_SLAB4); }
    __device__ __forceinline__ bf16* W1T() const { return (bf16*)(ws + WS_W1T); }
    __device__ __forceinline__ bf16* W2T() const { return (bf16*)(ws + WS_W2T); }
    __device__ __forceinline__ bf16* W3T() const { return (bf16*)(ws + WS_W3T); }
    __device__ __forceinline__ bf16* W4T() const { return (bf16*)(ws + WS_W4T); }
    __device__ __forceinline__ bf16* H() const { return (bf16*)(ws + WS_H); }
    __device__ __forceinline__ bf16* QA() const { return (bf16*)(ws + WS_QA); }
    __device__ __forceinline__ bf16* KA() const { return (bf16*)(ws + WS_KA); }
    __device__ __forceinline__ bf16* VAT() const { return (bf16*)(ws + WS_VAT); }
    __device__ __forceinline__ bf16* VA() const { return (bf16*)(ws + WS_VAT); }
    __device__ __forceinline__ bf16* GA() const { return (bf16*)(ws + WS_GA); }
    __device__ __forceinline__ bf16* QB() const { return (bf16*)(ws + WS_QB); }
    __device__ __forceinline__ bf16* KB() const { return (bf16*)(ws + WS_KB); }
    __device__ __forceinline__ bf16* VB() const { return (bf16*)(ws + WS_VB); }
    __device__ __forceinline__ bf16* GB() const { return (bf16*)(ws + WS_GB); }
    __device__ __forceinline__ bf16* MIX() const { return (bf16*)(ws + WS_MIX); }
    __device__ __forceinline__ bf16* QC() const { return (bf16*)(ws + WS_QC); }
    __device__ __forceinline__ bf16* KC() const { return (bf16*)(ws + WS_KC); }
    __device__ __forceinline__ bf16* VC() const { return (bf16*)(ws + WS_VC); }
    __device__ __forceinline__ bf16* GC() const { return (bf16*)(ws + WS_GC); }
    __device__ __forceinline__ bf16* MIX2() const { return (bf16*)(ws + WS_MIX2); }
    __device__ __forceinline__ float* RCOS() const { return (float*)(ws + WS_RCOS); }
    __device__ __forceinline__ float* RSIN() const { return (float*)(ws + WS_RSIN); }
    __device__ __forceinline__ float* LOGF() const { return (float*)(ws + WS_LOGF); }
    __device__ __forceinline__ float* OB() const { return (float*)(ws + WS_OB); }
    __device__ __forceinline__ float* Y1() const { return (float*)(ws + WS_Y1); }
    __device__ __forceinline__ float* OC() const { return (float*)(ws + WS_OC); }
    __device__ __forceinline__ bf16* AQ() const { return (bf16*)(ws + WS_AQ); }
    __device__ __forceinline__ bf16* KCH() const { return (bf16*)(ws + WS_KCH); }
    __device__ __forceinline__ bf16* KCT() const { return (bf16*)(ws + WS_KCT); }
    __device__ __forceinline__ bf16* BV() const { return (bf16*)(ws + WS_BV); }
    __device__ __forceinline__ float* DST() const { return (float*)(ws + WS_DST); }
    __device__ __forceinline__ float* RCOST() const { return (float*)(ws + WS_RCOST); }
    __device__ __forceinline__ float* RSINT() const { return (float*)(ws + WS_RSINT); }
    __device__ __forceinline__ float* SS() const { return (float*)(ws + WS_CTL + CTL_SS); }
    __device__ __forceinline__ float* DSH() const { return (float*)(ws + WS_DSH); }
    __device__ __forceinline__ float* SST() const { return (float*)(ws + WS_SST); }
    __device__ __forceinline__ float* DD() const { return (float*)(ws + WS_DD); }
};

template <bool HP>
__device__ __forceinline__ void p0_transpose_item(const float* W, int K, int N, bf16* WT, LAS float* scr, int item, int lane) {
    const int nblk = N / 32, kb = item / nblk, nb = item % nblk, k0 = 64 * kb, n0 = 32 * nb;
#pragma unroll 8
    for (int i = 0; i < 32; ++i) { const int kk = 2 * i + (lane >> 5); scr[kk * 33 + (lane & 31)] = W[(size_t)(k0 + kk) * N + n0 + (lane & 31)]; }
    LDS_WAIT(); asm volatile("" ::: "memory");
    const int c = lane & 7;
#pragma unroll
    for (int j = 0; j < 4; ++j) { const int n = (lane >> 3) + 8 * j; const LAS float* s = scr + (8 * c) * 33 + n;
        v4u o; o.x = pk2(s[0 * 33], s[1 * 33]); o.y = pk2(s[2 * 33], s[3 * 33]); o.z = pk2(s[4 * 33], s[5 * 33]); o.w = pk2(s[6 * 33], s[7 * 33]);
        int ca = n0 + n;
        if (HP) ca = (ca & ~255) | (((ca >> 5) & 1) << 7) | (((ca >> 6) & 3) << 5) | (ca & 31);
        *(GAS v4u*)(WT + (size_t)ca * K + k0 + 8 * c) = o; }
    LDS_WAIT(); asm volatile("" ::: "memory");
}
__device__ __forceinline__ void rms_row_to_bf16(int lane, const float* xrow, const float* g, bf16* orow) {
    const GAS f32x4* xr = (const GAS f32x4*)xrow + lane;
    f32x4 v[4]; float s2 = 0.f;
#pragma unroll
    for (int j = 0; j < 4; ++j) { v[j] = xr[64 * j]; s2 += (v[j].x * v[j].x + v[j].y * v[j].y) + (v[j].z * v[j].z + v[j].w * v[j].w); }
    const float rstd = 1.f / sqrtf(wave_sum(s2) * (1.f / 1024.f) + EPS);
    GAS unsigned long long* o8 = (GAS unsigned long long*)orow + lane;
#pragma unroll
    for (int j = 0; j < 4; ++j) { const f32x4 gv = *((const GAS f32x4*)g + lane + 64 * j);
        o8[64 * j] = (unsigned long long)pk2(v[j].x * rstd * gv.x, v[j].y * rstd * gv.y) | ((unsigned long long)pk2(v[j].z * rstd * gv.z, v[j].w * rstd * gv.w) << 32); }
}
__device__ __forceinline__ void sincos_acc(float a, float& s, float& c) {
    const double x = (double)a;
    const double kd = __builtin_rint(x * 0.63661977236758134308);
    const double r = (x - kd * 1.57079632673412561417e+00) - kd * 6.07710050650619224932e-11;
    const double r2 = r * r;
    const double sp = r * (1.0 + r2 * (-1.66666666666666324348e-01 + r2 * (8.33333333332248946124e-03 + r2 * (-1.98412698298579493134e-04 + r2 * (2.75573137070700676789e-06 + r2 * (-2.50507602534068634195e-08 + r2 * 1.58969099521155010221e-10))))));
    const double cp = 1.0 + r2 * (-0.5 + r2 * (4.16666666666666019037e-02 + r2 * (-1.38888888888741095749e-03 + r2 * (2.48015872894767294178e-05 + r2 * (-2.75573143513906633035e-07 + r2 * (2.08757232129817482790e-09 + r2 * -1.13596475577881948265e-11))))));
    const int q = (int)((long long)kd & 3);
    const double sv = (q & 1) ? cp : sp, cv = (q & 1) ? sp : cp;
    s = (float)((q & 2) ? -sv : sv);
    c = (float)(((q + 1) & 2) ? -cv : cv);
}
__device__ __forceinline__ void p0_prologue(Frame& F) {
    LAS float* scr = (LAS float*)(F.lds + RING_OFF + F.wave * 16384);
    const int gw = F.bid * NWAVES + F.wave, NGW = F.G * NWAVES;
    constexpr int I1 = (1024 / 64) * (N1 / 32), I2 = (1024 / 64) * (1024 / 32), I3 = (1024 / 64) * (N3 / 32), I4 = (2048 / 64) * (1024 / 32);
    for (int it = gw; it < I1 + I2 + I3 + I4; it += NGW) {
        int r = it;
        if (r < I1) { p0_transpose_item<true>(F.w1, 1024, N1, F.W1T(), scr, r, F.lane); continue; } r -= I1;
        if (r < I2) { p0_transpose_item<false>(F.w2, 1024, 1024, F.W2T(), scr, r, F.lane); continue; } r -= I2;
        if (r < I3) { p0_transpose_item<false>(F.w3, 1024, N3, F.W3T(), scr, r, F.lane); continue; } r -= I3;
        p0_transpose_item<false>(F.w4, 2048, 1024, F.W4T(), scr, r, F.lane);
    }
    for (int m = gw; m < MT; m += NGW) rms_row_to_bf16(F.lane, (m < MP) ? F.xp + (size_t)m * DM : F.xs + (size_t)(m - MP) * DM, F.ng, F.H() + (size_t)m * DM);
    const int ri = F.tid & 127;
    const float rinv = (float)(1.0 / exp2((double)((float)ri / 127.0f) * 13.287712379549449));
    for (int e = F.bid * (NWAVES * 64) + F.tid; e < (PAST + TSQ) * 128; e += F.G * NWAVES * 64) {
        const int pos = e >> 7, i = ri;
        const float inv = rinv;
        const float ang = (float)pos * inv;
        float s, c; sincos_acc(ang, s, c);
        F.RCOS()[e] = c; F.RSIN()[e] = s; F.RCOST()[(size_t)i * 8200 + pos] = c; F.RSINT()[(size_t)i * 8200 + pos] = s;
    }
}

__device__ __forceinline__ void sb_tile(f32x16& p0, f32x16& p1, float& carry, int hi, int kb0, int qpos, bool need_mask, v4u (&pw)[4]) {
#pragma unroll
    for (int r = 0; r < 16; ++r) {
        float b0 = __builtin_amdgcn_rcpf(1.f + __builtin_amdgcn_exp2f(p0[r]));
        float b1 = __builtin_amdgcn_rcpf(1.f + __builtin_amdgcn_exp2f(p1[r]));
        if (need_mask) { if (kb0 + r >= qpos) b0 = 0.f; if (kb0 + 32 + r >= qpos) b1 = 0.f; }
        p0[r] = b0; p1[r] = b1;
    }
    float s0 = 1.f, s1 = 1.f;
#pragma unroll
    for (int r = 15; r >= 0; --r) {
        const float b0 = p0[r], b1 = p1[r];
        p0[r] = b0 * s0; p1[r] = b1 * s1;
        s0 = __builtin_fmaf(-s0, b0, s0); s1 = __builtin_fmaf(-s1, b1, s1);
    }
    float t0, t1;
    {
      auto a = __builtin_amdgcn_permlane32_swap(__float_as_uint(s0), __float_as_uint(s0), false, false);
      auto b = __builtin_amdgcn_permlane32_swap(__float_as_uint(s1), __float_as_uint(s1), false, false);
      t0 = hi ? __uint_as_float(a[0]) : __uint_as_float(a[1]); t1 = hi ? __uint_as_float(b[0]) : __uint_as_float(b[1]); }
    const float pre1 = hi ? carry : carry * t1;
    const float pre0 = hi ? carry * s1 * t1 : carry * t1 * s1 * t0;
    carry = carry * ((s0 * s1) * (t0 * t1));
#pragma unroll
    for (int r = 0; r < 16; ++r) { p0[r] *= pre0; p1[r] *= pre1; }
    pw[0] = (v4u){pg8::cvt_pk_bf16(p0[0], p0[1]), pg8::cvt_pk_bf16(p0[2], p0[3]), pg8::cvt_pk_bf16(p0[4], p0[5]), pg8::cvt_pk_bf16(p0[6], p0[7])};
    pw[1] = (v4u){pg8::cvt_pk_bf16(p0[8], p0[9]), pg8::cvt_pk_bf16(p0[10], p0[11]), pg8::cvt_pk_bf16(p0[12], p0[13]), pg8::cvt_pk_bf16(p0[14], p0[15])};
    pw[2] = (v4u){pg8::cvt_pk_bf16(p1[0], p1[1]), pg8::cvt_pk_bf16(p1[2], p1[3]), pg8::cvt_pk_bf16(p1[4], p1[5]), pg8::cvt_pk_bf16(p1[6], p1[7])};
    pw[3] = (v4u){pg8::cvt_pk_bf16(p1[8], p1[9]), pg8::cvt_pk_bf16(p1[10], p1[11]), pg8::cvt_pk_bf16(p1[12], p1[13]), pg8::cvt_pk_bf16(p1[14], p1[15])};
}
typedef float f32x2v __attribute__((ext_vector_type(2)));
__device__ __forceinline__ void sb_tile2(f32x16& p0, f32x16& p1, float& carry, int hi, int kb0, int qpos, bool need_mask, v4u (&pw)[4]) {
#pragma unroll
    for (int r = 0; r < 16; ++r) { p0[r] = __builtin_amdgcn_exp2f(p0[r]); p1[r] = __builtin_amdgcn_exp2f(p1[r]); }
#define SB_INV4(P, j0) do { const f32x2v ea_ = {P[2 * (j0)], P[2 * (j0) + 1]}, eb_ = {P[2 * (j0) + 2], P[2 * (j0) + 3]}, ec_ = {P[2 * (j0) + 4], P[2 * (j0) + 5]}, ed_ = {P[2 * (j0) + 6], P[2 * (j0) + 7]}; \
        const f32x2v b_ = eb_ + (f32x2v){1.f, 1.f}; const f32x2v ab_ = ea_ * b_ + b_, abc_ = ab_ * ec_ + ab_, abcd_ = abc_ * ed_ + abc_; \
        f32x2v R_ = {__builtin_amdgcn_rcpf(abcd_.x), __builtin_amdgcn_rcpf(abcd_.y)}; \
        const f32x2v id_ = R_ * abc_; R_ = R_ * ed_ + R_; const f32x2v ic_ = R_ * ab_; R_ = R_ * ec_ + R_; const f32x2v ib_ = R_ * ea_ + R_, ia_ = R_ * b_; \
        P[2 * (j0)] = ia_.x; P[2 * (j0) + 1] = ia_.y; P[2 * (j0) + 2] = ib_.x; P[2 * (j0) + 3] = ib_.y; P[2 * (j0) + 4] = ic_.x; P[2 * (j0) + 5] = ic_.y; P[2 * (j0) + 6] = id_.x; P[2 * (j0) + 7] = id_.y; } while (0)
    SB_INV4(p0, 0); SB_INV4(p1, 0); SB_INV4(p0, 4); SB_INV4(p1, 4);
#undef SB_INV4
    if (need_mask) {
        asm volatile("" ::: "memory");
#pragma unroll
        for (int r = 0; r < 16; ++r) { const int kk = kb0 + 8 * (1 - (r & 1)) + (r >> 1); if (kk >= qpos) p0[r] = 0.f; if (kk + 32 >= qpos) p1[r] = 0.f; }
    }
    f32x2v s0 = {1.f, 1.f}, s1 = {1.f, 1.f};
#pragma unroll
    for (int k = 7; k >= 0; --k) {
        const f32x2v b0 = {p0[2 * k], p0[2 * k + 1]}, b1 = {p1[2 * k], p1[2 * k + 1]};
        const f32x2v w0 = b0 * s0, w1 = b1 * s1;
        s0 = s0 - s0 * b0; s1 = s1 - s1 * b1;
        p0[2 * k] = w0.x; p0[2 * k + 1] = w0.y; p1[2 * k] = w1.x; p1[2 * k + 1] = w1.y;
    }
    const float a0 = s0.x * s0.y, a1 = s1.x * s1.y;
    float t0, t1;
    { auto a = __builtin_amdgcn_permlane32_swap(__float_as_uint(a0), __float_as_uint(a0), false, false);
      auto b = __builtin_amdgcn_permlane32_swap(__float_as_uint(a1), __float_as_uint(a1), false, false);
      t0 = hi ? __uint_as_float(a[0]) : __uint_as_float(a[1]); t1 = hi ? __uint_as_float(b[0]) : __uint_as_float(b[1]); }
    const float pre1 = hi ? carry : carry * t1;
    const float pre0 = hi ? carry * a1 * t1 : carry * t1 * a1 * t0;
    carry = carry * ((a0 * a1) * (t0 * t1));
    const f32x2v q0 = {pre0, pre0 * s0.x}, q1 = {pre1, pre1 * s1.x};
#pragma unroll
    for (int k = 0; k < 8; ++k) { const f32x2v w0 = (f32x2v){p0[2 * k], p0[2 * k + 1]} * q0, w1 = (f32x2v){p1[2 * k], p1[2 * k + 1]} * q1;
        p0[2 * k] = w0.x; p0[2 * k + 1] = w0.y; p1[2 * k] = w1.x; p1[2 * k + 1] = w1.y; }
    pw[0] = (v4u){pg8::cvt_pk_bf16(p0[1], p0[3]), pg8::cvt_pk_bf16(p0[5], p0[7]), pg8::cvt_pk_bf16(p0[9], p0[11]), pg8::cvt_pk_bf16(p0[13], p0[15])};
    pw[1] = (v4u){pg8::cvt_pk_bf16(p0[0], p0[2]), pg8::cvt_pk_bf16(p0[4], p0[6]), pg8::cvt_pk_bf16(p0[8], p0[10]), pg8::cvt_pk_bf16(p0[12], p0[14])};
    pw[2] = (v4u){pg8::cvt_pk_bf16(p1[1], p1[3]), pg8::cvt_pk_bf16(p1[5], p1[7]), pg8::cvt_pk_bf16(p1[9], p1[11]), pg8::cvt_pk_bf16(p1[13], p1[15])};
    pw[3] = (v4u){pg8::cvt_pk_bf16(p1[0], p1[2]), pg8::cvt_pk_bf16(p1[4], p1[6]), pg8::cvt_pk_bf16(p1[8], p1[10]), pg8::cvt_pk_bf16(p1[12], p1[14])};
}
#define MFMA32(a, b, c) __builtin_amdgcn_mfma_f32_32x32x16_bf16((a), (b), (c), 0, 0, 0)
__device__ __forceinline__ f32x16 splat16(float v) { f32x16 r;
#pragma unroll
    for (int i = 0; i < 16; ++i) r[i] = v; return r; }

__device__ __forceinline__ bf16x8 cvt8(const f32x4 a, const f32x4 b) { return __builtin_bit_cast(bf16x8, pg8::pack8(a, b)); }

__device__ __forceinline__ void ret_passB(Frame& F) {
    for (int e = F.bid * (NWAVES * 64) + F.tid; e < 8 * 512 * 32; e += F.G * NWAVES * 64) {
        const int bh = e >> 14, dv = (e >> 5) & 511, dk8 = (e & 31) * 8, h = bh & 3;
        const float lg = pg8::lg2gamma(h), g1 = 1.f - __builtin_amdgcn_exp2f(-5.f - (float)h), g255 = __builtin_amdgcn_exp2f(255.f * lg), g256 = __builtin_amdgcn_exp2f(256.f * lg);
        f32x4 S0 = {0.f, 0.f, 0.f, 0.f}, S1 = {0.f, 0.f, 0.f, 0.f};
        for (int c0 = 0; c0 < 32; c0 += 16) {
            v4u dq[16];
#pragma unroll
            for (int j = 0; j < 16; ++j) dq[j] = *(const v4u*)((const bf16*)F.DST() + ((size_t)(bh * 32 + c0 + j) * 512 + dv) * 256 + dk8);
#pragma unroll
            for (int j = 0; j < 16; ++j) { const size_t ro = (size_t)(bh * 32 + c0 + j) * 512 + dv;
                const f32x4 d0 = {bflo(dq[j][0]), bfhi(dq[j][0]), bflo(dq[j][1]), bfhi(dq[j][1])}, d1 = {bflo(dq[j][2]), bfhi(dq[j][2]), bflo(dq[j][3]), bfhi(dq[j][3])};
                *(pg8::u32x4*)(F.BV() + ro * 512 + 256 + dk8) = pg8::pack8(S0 * g1, S1 * g1);
                S0 = S0 * g256 + d0 * g255; S1 = S1 * g256 + d1 * g255; }
        }
        float* so = F.out + ORT_P + ((size_t)bh * 256 + dk8) * 512 + dv;
#pragma unroll
        for (int i = 0; i < 4; ++i) { so[(size_t)i * 512] = S0[i]; so[(size_t)(i + 4) * 512] = S1[i]; }
    }
}

typedef unsigned u32x2 __attribute__((ext_vector_type(2)));
constexpr int HQ_STR = 136, HT_STR = 72;
constexpr int H_QT = 0, H_KH = 17408, H_KHT = 34816, H_VT = 53248, H_PP = 71680, H_CS = 80896, H_RR = 82944, H_A63 = 83456, H_C63 = 83968, H_SSQ = 84480;
#define MFMA16(a, b, c) __builtin_amdgcn_mfma_f32_16x16x32_bf16((a), (b), (c), 0, 0, 0)
__device__ __forceinline__ void hgrn_passB(Frame& F) {
    const int vb = (F.bid + F.G / 2) % F.G;
    for (int e = vb * (NWAVES * 64) + F.tid; e < 8 * 128 * 32; e += F.G * NWAVES * 64) {
        const int bh = e >> 12, dk = (e >> 5) & 127, dv4 = (e & 31) * 4;
        f32x4 S = {0.f, 0.f, 0.f, 0.f};
        for (int s0 = 0; s0 < 32; s0 += 16) {
            f32x4 dv[16]; float dd[16];
#pragma unroll
            for (int j = 0; j < 16; ++j) { dv[j] = *(const f32x4*)(F.DSH() + ((size_t)(bh * 32 + s0 + j) * 128 + dk) * 128 + dv4); dd[j] = F.DD()[(size_t)(bh * 32 + s0 + j) * 128 + dk]; }
#pragma unroll
            for (int j = 0; j < 16; ++j) { *(f32x4*)(F.SST() + ((size_t)(bh * 32 + s0 + j) * 128 + dk) * 128 + dv4) = S; S = S * __expf(dd[j]) + dv[j]; }
        }
        *(f32x4*)(F.out + OHG_P + ((size_t)bh * 128 + dk) * 128 + dv4) = S;
    }
}

__device__ __forceinline__ void ret_sample_unit(Frame& F, int s, int h, int vhalf) {
    const int tid = F.tid, v = tid & 255, kh = tid >> 8, col = vhalf * 256 + v;
    LAS float* QL = (LAS float*)(F.lds + RING_OFF);
    LAS float* KL = QL + 8 * 256;
    LAS float* OP = KL + 8 * 256;
    const size_t row0 = (size_t)MP + s * 8;
    for (int e = tid; e < 8 * 256; e += NWAVES * 64) { const int t = e >> 8, kk = e & 255;
        QL[e] = bf2f(F.QC()[(row0 + t) * 1024 + h * 256 + kk]); KL[e] = bf2f(F.KC()[(row0 + t) * 1024 + h * 256 + kk]); }
    float vt[8];
#pragma unroll
    for (int t = 0; t < 8; ++t) vt[t] = bf2f(F.VC()[(row0 + t) * 2048 + h * 512 + col]);
    const float gamma = 1.f - __builtin_amdgcn_exp2f(-5.f - (float)h);
    float S[128];
    const float* s0 = F.st_r + (((size_t)s * HC + h) * DKC + kh * 128) * DVC + col;
#pragma unroll
    for (int i = 0; i < 128; ++i) S[i] = s0[(size_t)i * DVC];
    __syncthreads();
    float o[8];
#pragma unroll
    for (int t = 0; t < 8; ++t) {
        float acc = 0.f;
#pragma unroll
        for (int i4 = 0; i4 < 32; ++i4) {
            const f32x4 kq = *(const LAS f32x4*)(KL + t * 256 + kh * 128 + 4 * i4), qq = *(const LAS f32x4*)(QL + t * 256 + kh * 128 + 4 * i4);
#pragma unroll
            for (int j = 0; j < 4; ++j) { S[4 * i4 + j] = gamma * S[4 * i4 + j] + kq[j] * vt[t]; acc += qq[j] * S[4 * i4 + j]; }
        }
        o[t] = acc;
    }
#pragma unroll
    for (int t = 0; t < 8; ++t) OP[(kh * 8 + t) * 256 + v] = o[t];
    float* so = F.out + ORT_S + (((size_t)s * HC + h) * DKC + kh * 128) * DVC + col;
#pragma unroll
    for (int i = 0; i < 128; ++i) so[(size_t)i * DVC] = S[i];
    __syncthreads();
    for (int e = tid; e < 8 * 256; e += NWAVES * 64) {
        const int t = e >> 8, vv = e & 255; const float ov = OP[e] + OP[8 * 256 + e];
        const size_t gi = (row0 + t) * 2048 + h * 512 + vhalf * 256 + vv;
        F.MIX2()[gi] = pg8::bf1(ov * bf2f(F.GC()[gi]));
        const float sq = wave_sum(ov * ov);
        if (F.lane == 0) atomicAdd(F.SSS() + (s * 8 + t) * 4 + h, sq);
    }
    __syncthreads();
}
__device__ __forceinline__ void hgrn_sample_unit(Frame& F, int s, int h) {
    const int tid = F.tid, v = tid & 127, kq = tid >> 7;
    LAS float* FL = (LAS float*)(F.lds + RING_OFF);
    LAS float* KL = FL + 8 * 128; LAS float* QL = KL + 8 * 128; LAS float* OP = QL + 8 * 128;
    const size_t row0 = (size_t)MP + s * 8;
    for (int e = tid; e < 8 * 128; e += NWAVES * 64) { const int t = e >> 7, kk = e & 127; const size_t gi = (row0 + t) * 512 + h * 128 + kk;
        FL[e] = __expf(F.LOGF()[gi]); KL[e] = bf2f(F.KB()[gi]); QL[e] = bf2f(F.QB()[gi]); }
    float vt[8];
#pragma unroll
    for (int t = 0; t < 8; ++t) vt[t] = bf2f(F.VB()[(row0 + t) * 512 + h * 128 + v]);
    float S[32];
    const float* s0 = F.st_h + (((size_t)s * HB + h) * DKB + kq * 32) * DVB + v;
#pragma unroll
    for (int i = 0; i < 32; ++i) S[i] = s0[(size_t)i * DVB];
    __syncthreads();
#pragma unroll
    for (int t = 0; t < 8; ++t) {
        float acc = 0.f;
#pragma unroll
        for (int i4 = 0; i4 < 8; ++i4) {
            const f32x4 ff = *(const LAS f32x4*)(FL + t * 128 + kq * 32 + 4 * i4), kk = *(const LAS f32x4*)(KL + t * 128 + kq * 32 + 4 * i4), qq = *(const LAS f32x4*)(QL + t * 128 + kq * 32 + 4 * i4);
#pragma unroll
            for (int j = 0; j < 4; ++j) { S[4 * i4 + j] = ff[j] * S[4 * i4 + j] + kk[j] * vt[t]; acc += qq[j] * S[4 * i4 + j]; }
        }
        OP[(kq * 8 + t) * 128 + v] = acc;
    }
    float* so = F.out + OHG_S + (((size_t)s * HB + h) * DKB + kq * 32) * DVB + v;
#pragma unroll
    for (int i = 0; i < 32; ++i) so[(size_t)i * DVB] = S[i];
    __syncthreads();
    {
        const int t = F.wave, c0 = 2 * F.lane;
        float a = 0.f, b = 0.f;
#pragma unroll
        for (int q4 = 0; q4 < 4; ++q4) { a += OP[(q4 * 8 + t) * 128 + c0]; b += OP[(q4 * 8 + t) * 128 + c0 + 1]; }
        const float rstd = 1.f / sqrtf(wave_sum(a * a + b * b) * (1.f / 128.f) + EPS);
        const size_t row = row0 + t;
        const unsigned gt = *(const unsigned*)(F.GB() + row * 512 + h * 128 + c0);
        *(unsigned*)(F.MIX() + row * 1024 + 512 + h * 128 + c0) = pg8::cvt_pk_bf16(a * rstd * F.og[c0] * bflo(gt), b * rstd * F.og[c0 + 1] * bfhi(gt));
    }
    __syncthreads();
}

constexpr int AT_K = 0, AT_V = 24576, AT_O = 49152, AT_SLOT = 8192;
__device__ __forceinline__ void glds16(const void* gsrc, unsigned lds_dst) { unsigned keep;
    asm volatile("s_mov_b32 %0, m0\n\ts_mov_b32 m0, %2\n\ts_nop 0\n\tglobal_load_lds_dwordx4 %1, off\n\ts_mov_b32 m0, %0" : "=&s"(keep) : "v"(gsrc), "s"(lds_dst) : "memory"); }
typedef short v4i16_t __attribute__((ext_vector_type(4)));
__device__ __forceinline__ v4i16_t vtr(const LAS unsigned char* p) { return __builtin_amdgcn_ds_read_tr16_b64_v4i16((LAS v4i16_t*)p); }

__device__ __forceinline__ void bf8_add(const bf16* p, f32x4& a, f32x4& b) { const v4u w = *(const v4u*)p; a[0] += bflo(w[0]); a[1] += bfhi(w[0]); a[2] += bflo(w[1]); a[3] += bfhi(w[1]); b[0] += bflo(w[2]); b[1] += bfhi(w[2]); b[2] += bflo(w[3]); b[3] += bfhi(w[3]); }
__device__ __forceinline__ void slab_sum8(const bf16* slab, int nparts, size_t pstride, size_t off, f32x4& a, f32x4& b) {
    a = (f32x4){0.f, 0.f, 0.f, 0.f}; b = a;
    for (int p = 0; p < nparts; ++p) bf8_add(slab + p * pstride + off, a, b);
}
__device__ __forceinline__ void pp1_item(Frame& F, int item) {
    const int r = item >> 3, gi = item & 7, lane = F.lane, c = lane * 8, a0 = gi * 512 + c;
    const int g0 = (a0 & ~255) | (((a0 >> 5) & 1) << 7) | (((a0 >> 6) & 3) << 5) | (a0 & 31);
    f32x4 x, y; slab_sum8(F.SLAB(), 4, (size_t)256 * N1, (size_t)r * N1 + g0, x, y);
    const size_t row = (size_t)MP + r;
    if (gi <= 1) {
        float ss = (x[0] * x[0] + x[1] * x[1]) + (x[2] * x[2] + x[3] * x[3]) + (y[0] * y[0] + y[1] * y[1]) + (y[2] * y[2] + y[3] * y[3]);
        ss += __shfl_xor(ss, 1); ss += __shfl_xor(ss, 2); ss += __shfl_xor(ss, 4);
        const float rstd = __builtin_amdgcn_rsqf(ss * (1.f / 64.f) + EPS) * (gi == 0 ? -0.125f * LOG2E : 1.f);
        const float* g = (gi == 0 ? F.qg : F.kg) + (c & 63);
        x = x * *(const f32x4*)g * rstd; y = y * *(const f32x4*)(g + 4) * rstd;
        if (gi == 0) *(pg8::u32x4*)(F.QA() + row * 512 + c) = pg8::pack8(x, y);
        else { *(pg8::u32x4*)(F.KA() + row * 512 + c) = pg8::pack8(x, y); float* ko = F.out + OK_S + (size_t)r * 512 + c; *(f32x4*)ko = x; *(f32x4*)(ko + 4) = y; }
    } else if (gi == 2) {
        *(pg8::u32x4*)(F.VA() + row * 512 + c) = pg8::pack8(x, y); float* vo = F.out + OV_S + (size_t)r * 512 + c; *(f32x4*)vo = x; *(f32x4*)(vo + 4) = y;
    } else if (gi == 5) {
        f32x4 lf0, lf1, k0, k1;
#pragma unroll
        for (int e = 0; e < 8; ++e) { const int cc = c + e; const float lb = __builtin_amdgcn_rcpf(1.f + __expf(F.hlb[512 + cc] - F.hlb[cc])); const float v = e < 4 ? x[e & 3] : y[e & 3];
            const float sg = pg8::sigm_f(v); const float lf = __logf(lb + (1.f - lb) * sg), kk = (1.f - lb) * (1.f - sg);
            if (e < 4) { lf0[e & 3] = lf; k0[e & 3] = kk; } else { lf1[e & 3] = lf; k1[e & 3] = kk; } }
        *(f32x4*)(F.LOGF() + row * 512 + c) = lf0; *(f32x4*)(F.LOGF() + row * 512 + c + 4) = lf1;
        *(pg8::u32x4*)(F.KB() + row * 512 + c) = pg8::pack8(k0, k1);
    } else {
        bf16* dst = (gi == 3) ? F.GA() : (gi == 4) ? F.QB() : (gi == 6) ? F.VB() : F.GB();
        if (gi != 6) {
#pragma unroll
            for (int e = 0; e < 4; ++e) { x[e] = pg8::silu_f(x[e]); y[e] = pg8::silu_f(y[e]); } }
        *(pg8::u32x4*)(dst + row * 512 + c) = pg8::pack8(x, y);
    }
}
__device__ __forceinline__ void pp2_row(Frame& F, int r) {
    const int lane = F.lane; f32x4 v[4]; float s2 = 0.f;
#pragma unroll
    for (int j = 0; j < 2; ++j) { const int c = 8 * lane + 512 * j; f32x4 a, b2; slab_sum8(F.SLAB(), 4, (size_t)256 * 1024, (size_t)r * 1024 + c, a, b2);
        a += *(const f32x4*)(F.xs + (size_t)r * DM + c); b2 += *(const f32x4*)(F.xs + (size_t)r * DM + c + 4);
        *(f32x4*)(F.Y1() + ((size_t)MP + r) * DM + c) = a; *(f32x4*)(F.Y1() + ((size_t)MP + r) * DM + c + 4) = b2;
        s2 += (a[0] * a[0] + a[1] * a[1]) + (a[2] * a[2] + a[3] * a[3]) + (b2[0] * b2[0] + b2[1] * b2[1]) + (b2[2] * b2[2] + b2[3] * b2[3]);
        v[2 * j] = a; v[2 * j + 1] = b2; }
    s2 = wave_sum(s2); if (lane == 0) F.SS1()[MP + r] = s2;
#pragma unroll
    for (int j = 0; j < 2; ++j) { const int c = 8 * lane + 512 * j; const f32x4 g0 = *(const f32x4*)(F.ng + 1024 + c), g1 = *(const f32x4*)(F.ng + 1024 + c + 4);
        *(pg8::u32x4*)(F.H() + ((size_t)MP + r) * DM + c) = pg8::pack8(v[2 * j] * g0, v[2 * j + 1] * g1); }
}
__device__ __forceinline__ void pp3_item(Frame& F, int item) {
    const int r = item / 24, pn = item % 24, lane = F.lane; const size_t row = (size_t)MP + r;
    if (lane >= 32) return;
    const size_t off = (size_t)r * N3 + pn * 256, ps = (size_t)256 * N3;
    const float rs = __builtin_amdgcn_rsqf(F.SS1()[MP + r] * (1.f / 1024.f) + EPS);
    if (pn < 8) {
        const int j = 8 * (lane & 15), up = lane >> 4;
        f32x4 x1a, x1b, x2a, x2b; slab_sum8(F.SLAB(), 4, ps, off + j, x1a, x1b); slab_sum8(F.SLAB(), 4, ps, off + 128 + j, x2a, x2b);
        const int pos = PAST + (r & 7);
        const f32x4 ca = *(const f32x4*)(F.RCOS() + (size_t)pos * 128 + j), cb = *(const f32x4*)(F.RCOS() + (size_t)pos * 128 + j + 4), sa = *(const f32x4*)(F.RSIN() + (size_t)pos * 128 + j), sb = *(const f32x4*)(F.RSIN() + (size_t)pos * 128 + j + 4);
        const float sc = rs * (pn < 4 ? 1.f : 0.0625f);
        const f32x4 oa = (up ? (x2a * ca + x1a * sa) : (x1a * ca - x2a * sa)) * sc, ob = (up ? (x2b * cb + x1b * sb) : (x1b * cb - x2b * sb)) * sc;
        *(pg8::u32x4*)((pn < 4 ? F.QC() : F.KC()) + row * 1024 + (pn & 3) * 256 + up * 128 + j) = pg8::pack8(oa, ob);
    } else {
        const int j = 8 * lane; f32x4 xa, xb; slab_sum8(F.SLAB(), 4, ps, off + j, xa, xb);
        xa = xa * rs; xb = xb * rs;
        const bool isg = pn >= 16;
        if (isg) {
#pragma unroll
            for (int e = 0; e < 4; ++e) { xa[e] = pg8::silu_f(xa[e]); xb[e] = pg8::silu_f(xb[e]); } }
        *(pg8::u32x4*)((isg ? F.GC() : F.VC()) + row * 2048 + ((pn - 8) & 7) * 256 + j) = pg8::pack8(xa, xb);
    }
}
__device__ __forceinline__ void pp4_row(Frame& F, int r) {
    float rs[4];
#pragma unroll
    for (int hh = 0; hh < 4; ++hh) rs[hh] = __builtin_amdgcn_rsqf(F.SSS()[r * 4 + hh] * (1.f / 512.f) + EPS);
#pragma unroll
    for (int j = 0; j < 2; ++j) { const int c = 8 * F.lane + 512 * j;
        f32x4 a = *(const f32x4*)(F.Y1() + ((size_t)MP + r) * DM + c), b2 = *(const f32x4*)(F.Y1() + ((size_t)MP + r) * DM + c + 4);
#pragma unroll
        for (int p = 0; p < 8; ++p) { f32x4 pa = {0.f, 0.f, 0.f, 0.f}, pb = pa; bf8_add(F.SLAB4() + ((size_t)p * 256 + r) * 1024 + c, pa, pb); a += pa * rs[p >> 1]; b2 += pb * rs[p >> 1]; }
        *(f32x4*)(F.out + OY_S + (size_t)r * DM + c) = a; *(f32x4*)(F.out + OY_S + (size_t)r * DM + c + 4) = b2; }
}

constexpr int G_QT = 0, G_KH = 17408, G_VV = 34816, G_PP = 52224, G_CS = 61440, G_RR = 69632, G_A63 = 70144, G_C63 = 70656, G_OST = 73728, OST_STR = 132;
__device__ __forceinline__ bf16x8 tr8(const LAS unsigned char* p, int rowbytes4) { const v4i16_t a = vtr(p), b = vtr(p + rowbytes4); return (bf16x8){a[0], a[1], a[2], a[3], b[0], b[1], b[2], b[3]}; }
#define LDS_BAR() asm volatile("s_waitcnt lgkmcnt(0)\n\ts_barrier" ::: "memory")
template <bool OUT>
__device__ __forceinline__ void hgrn_chunk_unit2(Frame& F, int bh, int sc) {
    const int tid = F.tid, lane = F.lane, w = F.wave, l15 = lane & 15, g = lane >> 4;
    const int b = bh >> 2, h = bh & 3, cg = tid & 31, tq = tid >> 5;
    LAS unsigned char* L = F.lds + RING_OFF;
    LAS bf16* QT = (LAS bf16*)(L + G_QT); LAS bf16* KH = (LAS bf16*)(L + G_KH); LAS bf16* VV = (LAS bf16*)(L + G_VV); LAS bf16* PP = (LAS bf16*)(L + G_PP);
    LAS float* CS = (LAS float*)(L + G_CS); LAS float* RR = (LAS float*)(L + G_RR); LAS float* A63 = (LAS float*)(L + G_A63); LAS float* C63 = (LAS float*)(L + G_C63); LAS float* OST = (LAS float*)(L + G_OST);
    f32x4 S[8];
    unsigned sbase = (unsigned)(((bh * 32 + sc) * 128 + 4 * g) * 128 + 16 * w + l15);
    asm volatile("" : "+v"(sbase));
#pragma unroll
    for (int i = 0; i < 8; ++i)
#pragma unroll
        for (int r = 0; r < 4; ++r) S[i][r] = OUT ? F.SST()[sbase + (unsigned)(16 * i + r) * 128u] : 0.f;
    f32x4 dsum = {0.f, 0.f, 0.f, 0.f};
    f32x4 lf[4]; u32x2 kq[4], qq[4], vq[4];
    unsigned e0 = (unsigned)((b * TP + sc * 256 + 4 * tq) * 512 + h * 128 + 4 * cg);
#define HG_LOAD(ch_) do { unsigned ee = e0 + (unsigned)(ch_) * 64u * 512u; asm volatile("" : "+v"(ee)); \
        _Pragma("unroll") for (int i = 0; i < 4; ++i) { lf[i] = *(const f32x4*)(F.LOGF() + ee + (unsigned)i * 512u); kq[i] = *(const u32x2*)(F.KB() + ee + (unsigned)i * 512u); \
            vq[i] = *(const u32x2*)(F.VB() + ee + (unsigned)i * 512u); if (OUT) qq[i] = *(const u32x2*)(F.QB() + ee + (unsigned)i * 512u); } } while (0)
    HG_LOAD(0);
    const LAS unsigned char* trK = (const LAS unsigned char*)KH + ((8 * g + (l15 >> 2)) * HQ_STR + (l15 & 3) * 4) * 2;
    const LAS unsigned char* trV = (const LAS unsigned char*)VV + ((8 * g + (l15 >> 2)) * HQ_STR + 16 * w + (l15 & 3) * 4) * 2;
    for (int ch = 0; ch < 4; ++ch) {
        f32x4 c[4]; c[0] = lf[0]; c[1] = c[0] + lf[1]; c[2] = c[1] + lf[2]; c[3] = c[2] + lf[3];
        *(LAS f32x4*)(CS + tq * 128 + 4 * cg) = c[3];
        LDS_BAR();
        f32x4 off = {0.f, 0.f, 0.f, 0.f}, run = {0.f, 0.f, 0.f, 0.f}, r = {0.f, 0.f, 0.f, 0.f};
#pragma unroll
        for (int q = 0; q < 16; ++q) { const f32x4 v = *(const LAS f32x4*)(CS + q * 128 + 4 * cg); if (q == 8) r = run; if (q < tq) off += v; run += v; }
        const f32x4 b63 = run;
#pragma unroll
        for (int i = 0; i < 4; ++i) {
            const int t = 4 * tq + i; const f32x4 bt = off + c[i];
            f32x4 kf = {bflo(kq[i].x), bfhi(kq[i].x), bflo(kq[i].y), bfhi(kq[i].y)};
#pragma unroll
            for (int e = 0; e < 4; ++e) kf[e] *= __expf(r[e] - bt[e]);
            *(LAS u32x2*)(KH + t * HQ_STR + 4 * cg) = (u32x2){pg8::cvt_pk_bf16(kf[0], kf[1]), pg8::cvt_pk_bf16(kf[2], kf[3])};
            *(LAS u32x2*)(VV + t * HQ_STR + 4 * cg) = vq[i];
            if (OUT) { f32x4 qf = {bflo(qq[i].x), bfhi(qq[i].x), bflo(qq[i].y), bfhi(qq[i].y)};
#pragma unroll
                for (int e = 0; e < 4; ++e) qf[e] *= __expf(bt[e] - r[e]);
                *(LAS u32x2*)(QT + t * HQ_STR + 4 * cg) = (u32x2){pg8::cvt_pk_bf16(qf[0], qf[1]), pg8::cvt_pk_bf16(qf[2], qf[3])}; }
        }
        if (tq == 0) { f32x4 er, ea, ec;
#pragma unroll
            for (int e = 0; e < 4; ++e) { er[e] = __expf(r[e]); ea[e] = __expf(b63[e]); ec[e] = __expf(b63[e] - r[e]); }
            *(LAS f32x4*)(RR + 4 * cg) = er; *(LAS f32x4*)(A63 + 4 * cg) = ea; *(LAS f32x4*)(C63 + 4 * cg) = ec; dsum += b63; }
        if (ch < 3) HG_LOAD(ch + 1);
        v4u gq0, gq1; unsigned rowe = 0;
        if (OUT) { rowe = (unsigned)(b * TP + sc * 256 + ch * 64 + (tid >> 3)); asm volatile("" : "+v"(rowe));
            gq0 = *(const v4u*)(F.GB() + rowe * 512u + h * 128 + (tid & 7) * 16); gq1 = *(const v4u*)(F.GB() + rowe * 512u + h * 128 + (tid & 7) * 16 + 8); }
        LDS_BAR();
        f32x4 o[4];
        bf16x8 vf[2];
#pragma unroll
        for (int kk = 0; kk < 2; ++kk) vf[kk] = tr8(trV + (32 * kk) * HQ_STR * 2, 4 * HQ_STR * 2);
        if (OUT) {
#pragma unroll
            for (int tt = 0; tt < 2; ++tt) {
                const int tile = 2 * w + tt, ti = tile >> 2, si = tile & 3;
                f32x4 p = {0.f, 0.f, 0.f, 0.f};
#pragma unroll
                for (int kk = 0; kk < 4; ++kk) {
                    const bf16x8 a = *(const LAS bf16x8*)(QT + (16 * ti + l15) * HQ_STR + 32 * kk + 8 * g), bb = *(const LAS bf16x8*)(KH + (16 * si + l15) * HQ_STR + 32 * kk + 8 * g);
                    p = MFMA16(a, bb, p);
                }
#pragma unroll
                for (int rr = 0; rr < 4; ++rr) { const int tl = 16 * ti + 4 * g + rr, sl = 16 * si + l15; PP[tl * HT_STR + sl] = pg8::bf1(sl <= tl ? p[rr] : 0.f); }
            }
            LDS_BAR();
#pragma unroll
            for (int ti = 0; ti < 4; ++ti) { o[ti] = (f32x4){0.f, 0.f, 0.f, 0.f};
#pragma unroll
                for (int kk = 0; kk < 2; ++kk) { const bf16x8 a = *(const LAS bf16x8*)(PP + (16 * ti + l15) * HT_STR + 32 * kk + 8 * g); o[ti] = MFMA16(a, vf[kk], o[ti]); } }
#pragma unroll
            for (int kk = 0; kk < 4; ++kk) {
                const f32x4 r0 = *(const LAS f32x4*)(RR + 32 * kk + 4 * g), r1 = *(const LAS f32x4*)(RR + 32 * kk + 16 + 4 * g);
                const bf16x8 sb = __builtin_bit_cast(bf16x8, pg8::pack8(S[2 * kk] * r0, S[2 * kk + 1] * r1));
#pragma unroll
                for (int ti = 0; ti < 4; ++ti) {
                    const u32x2 a0 = *(const LAS u32x2*)(QT + (16 * ti + l15) * HQ_STR + 32 * kk + 4 * g), a1 = *(const LAS u32x2*)(QT + (16 * ti + l15) * HQ_STR + 32 * kk + 16 + 4 * g);
                    const v4u av = {a0.x, a0.y, a1.x, a1.y};
                    o[ti] = MFMA16(__builtin_bit_cast(bf16x8, av), sb, o[ti]);
                }
            }
        }
#pragma unroll
        for (int i = 0; i < 8; ++i) {
            f32x4 U = {0.f, 0.f, 0.f, 0.f};
#pragma unroll
            for (int kk = 0; kk < 2; ++kk) { const bf16x8 a = tr8(trK + ((32 * kk) * HQ_STR + 16 * i) * 2, 4 * HQ_STR * 2); U = MFMA16(a, vf[kk], U); }
            const f32x4 a63 = *(const LAS f32x4*)(A63 + 16 * i + 4 * g), c63 = *(const LAS f32x4*)(C63 + 16 * i + 4 * g);
            S[i] = a63 * S[i] + c63 * U;
        }
        if (OUT) {
#pragma unroll
            for (int ti = 0; ti < 4; ++ti)
#pragma unroll
                for (int rr = 0; rr < 4; ++rr) OST[(16 * ti + 4 * g + rr) * OST_STR + 16 * w + l15] = o[ti][rr];
            LDS_BAR();
            const int t = tid >> 3, c16 = (tid & 7) * 16;
            f32x4 x[4]; float sq = 0.f;
#pragma unroll
            for (int j = 0; j < 4; ++j) { x[j] = *(const LAS f32x4*)(OST + t * OST_STR + c16 + 4 * j); sq += (x[j][0] * x[j][0] + x[j][1] * x[j][1]) + (x[j][2] * x[j][2] + x[j][3] * x[j][3]); }
            sq += __shfl_xor(sq, 1); sq += __shfl_xor(sq, 2); sq += __shfl_xor(sq, 4);
            const float rstd = __builtin_amdgcn_rsqf(sq * (1.f / 128.f) + EPS);
            const v4u g0 = gq0, g1 = gq1;
#pragma unroll
            for (int j = 0; j < 4; ++j) { const f32x4 gn = *(const f32x4*)(F.og + c16 + 4 * j); x[j] = x[j] * gn * rstd; }
            x[0][0] *= bflo(g0[0]); x[0][1] *= bfhi(g0[0]); x[0][2] *= bflo(g0[1]); x[0][3] *= bfhi(g0[1]); x[1][0] *= bflo(g0[2]); x[1][1] *= bfhi(g0[2]); x[1][2] *= bflo(g0[3]); x[1][3] *= bfhi(g0[3]);
            x[2][0] *= bflo(g1[0]); x[2][1] *= bfhi(g1[0]); x[2][2] *= bflo(g1[1]); x[2][3] *= bfhi(g1[1]); x[3][0] *= bflo(g1[2]); x[3][1] *= bfhi(g1[2]); x[3][2] *= bflo(g1[3]); x[3][3] *= bfhi(g1[3]);
            *(pg8::u32x4*)(F.MIX() + rowe * 1024u + 512u + h * 128 + c16) = pg8::pack8(x[0], x[1]);
            *(pg8::u32x4*)(F.MIX() + rowe * 1024u + 512u + h * 128 + c16 + 8) = pg8::pack8(x[2], x[3]);
        }
    }
#undef HG_LOAD
    if (!OUT) {
#pragma unroll
        for (int i = 0; i < 8; ++i)
#pragma unroll
            for (int r = 0; r < 4; ++r) F.DSH()[sbase + (unsigned)(16 * i + r) * 128u] = S[i][r];
        if (tq == 0) *(f32x4*)(F.DD() + (size_t)(bh * 32 + sc) * 128 + 4 * cg) = dsum;
    }
    __syncthreads();
}

typedef short s16x4 __attribute__((ext_vector_type(4)));

struct DecStage2 { f32x4 k[4]; f32x4 v[4]; };
constexpr int DW_T = 107008;
struct DecW { DecStage2 S; f32x4 o[4]; float carry; bf16x8 qb[2]; int i, last, w, s, h, pagev; LAS unsigned char* tb; u32x2 wpk; bool pend; };
__device__ __forceinline__ void decw_load(Frame& F, DecW& D, int l15, int g) {
    const int kb = 1024 * D.w + 1024 - 16 * D.i;
    const int page = __builtin_amdgcn_readlane(D.pagev, (kb >> 7) & 7);
    const unsigned sbase = (unsigned)__builtin_amdgcn_readfirstlane((int)((((unsigned)page * PAGE + (unsigned)(kb & 127)) * 512u + (unsigned)(D.h * 64)) * 4u));
    const __amdgpu_buffer_rsrc_t rk = __builtin_amdgcn_make_buffer_rsrc((void*)F.ck, 0, 0x7fffffff, 0x00020000), rv = __builtin_amdgcn_make_buffer_rsrc((void*)F.cv, 0, 0x7fffffff, 0x00020000);
    int vk = l15 * 2048 + 32 * g; asm volatile("" : "+v"(vk)); const int vv = vk - 16 * g;
#pragma unroll
    for (int ks = 0; ks < 2; ++ks) { D.S.k[2 * ks] = __builtin_bit_cast(f32x4, __builtin_amdgcn_raw_buffer_load_b128(rk, vk + 128 * ks, sbase, 0)); D.S.k[2 * ks + 1] = __builtin_bit_cast(f32x4, __builtin_amdgcn_raw_buffer_load_b128(rk, vk + 128 * ks + 16, sbase, 0)); }
#pragma unroll
    for (int j = 0; j < 4; ++j) D.S.v[j] = __builtin_bit_cast(f32x4, __builtin_amdgcn_raw_buffer_load_b128(rv, vv + 64 * j, sbase, 0));
}
__device__ __forceinline__ void decw_procA(DecW& D, bool newk, float cinit, int l15, int g) {
    f32x4 p = {cinit, cinit, cinit, cinit};
    p = MFMA16(cvt8(D.S.k[0], D.S.k[1]), D.qb[0], p); p = MFMA16(cvt8(D.S.k[2], D.S.k[3]), D.qb[1], p);
    float bt[4];
#pragma unroll
    for (int r = 0; r < 4; ++r) { bt[r] = __builtin_amdgcn_rcpf(1.f + __builtin_amdgcn_exp2f(p[r])); if (newk && (4 * g + r >= l15 || 4 * g + r >= 8)) bt[r] = 0.f; }
    float suf = 1.f, wl[4];
#pragma unroll
    for (int r = 3; r >= 0; --r) { wl[r] = bt[r] * suf; suf = __builtin_fmaf(-suf, bt[r], suf); }
    float t1, po;
    { auto a = __builtin_amdgcn_permlane16_swap(__float_as_uint(suf), __float_as_uint(suf), false, false); t1 = (g & 1) ? __uint_as_float(a[0]) : __uint_as_float(a[1]); }
    const float pp = suf * t1;
    { auto b = __builtin_amdgcn_permlane32_swap(__float_as_uint(pp), __float_as_uint(pp), false, false); po = (g & 2) ? __uint_as_float(b[0]) : __uint_as_float(b[1]); }
    const float pre = D.carry * ((g & 2) ? 1.f : po) * ((g & 1) ? 1.f : t1);
    D.carry = D.carry * pp * po;
    D.wpk = (u32x2){pg8::cvt_pk_bf16(wl[0] * pre, wl[1] * pre), pg8::cvt_pk_bf16(wl[2] * pre, wl[3] * pre)};
#pragma unroll
    for (int j = 0; j < 4; ++j) *(LAS u32x2*)(D.tb + j * 512 + l15 * 32 + g * 8) = (u32x2){pg8::cvt_pk_bf16(D.S.v[j][0], D.S.v[j][1]), pg8::cvt_pk_bf16(D.S.v[j][2], D.S.v[j][3])};
}
__device__ __forceinline__ void decw_procB(DecW& D, int l15, int g) {
    asm volatile("s_waitcnt lgkmcnt(0)" ::: "memory");
#pragma unroll
    for (int dt = 0; dt < 4; ++dt) { const v4i16_t vb = vtr(D.tb + dt * 512 + (4 * g + (l15 >> 2)) * 32 + (l15 & 3) * 8);
        D.o[dt] = __builtin_amdgcn_mfma_f32_16x16x16bf16_1k(__builtin_bit_cast(s16x4, D.wpk), vb, D.o[dt], 0, 0, 0); }
}
__device__ __forceinline__ void decw_proc(DecW& D, bool newk, float cinit, int l15, int g) { decw_procA(D, newk, cinit, l15, g); decw_procB(D, l15, g); }
__device__ __forceinline__ void attn_unit_dec(Frame& F, int b, int h, int qb, DecW& D) {
    const int lane = F.lane, r32 = lane & 31, hi = lane >> 5, wid = F.wave, l15 = lane & 15, g4 = lane >> 4;
    const int rowbase = b * TP, q0 = qb * 256 + 32 * wid, qpos = q0 + r32;
    const float cinit = -F.sbb[h] * LOG2E, dcinit = -F.sbb[D.h] * LOG2E;
    LAS unsigned char* L = F.lds + RING_OFF;
    const unsigned lds0 = (unsigned)(uintptr_t)L;
    bf16x8 qr[4];
#pragma unroll
    for (int d0 = 0; d0 < 4; ++d0) qr[d0] = *(const bf16x8*)(F.QA() + (size_t)(rowbase + qpos) * 512 + h * 64 + d0 * 16 + hi * 8);
    asm volatile("" :: "v"(qr[0]), "v"(qr[1]), "v"(qr[2]), "v"(qr[3]));
    const int NT = 4 * (qb + 1);
    const int rr_ = (lane & 3) + 4 * ((lane & 31) >> 3), pil = 16 * ((lane >> 2) & 1) + 8 * (1 - (rr_ & 1)) + (rr_ >> 1) + (lane & 32);
    const bf16* ksrc = F.KA() + (size_t)(rowbase + pil) * 512 + h * 64 + wid * 8;
    const bf16* vsrc = F.VA() + (size_t)(rowbase + 16 * (wid & 3) + (lane >> 2)) * 512 + h * 64 + (wid >> 2) * 32 + (lane & 3) * 8;
    const unsigned kdst = lds0 + AT_K + wid * 1024, vdst = lds0 + AT_V + wid * 1024;
#define AT_DMA(t, slot) do { glds16(ksrc + (size_t)(t) * 64 * 512, (unsigned)__builtin_amdgcn_readfirstlane(kdst + (slot))); glds16(vsrc + (size_t)(t) * 64 * 512, (unsigned)__builtin_amdgcn_readfirstlane(vdst + (slot))); } while (0)
    const LAS unsigned char* kfb = L + AT_K + hi * 1024 + r32 * 16;
    const LAS unsigned char* vfb = L + AT_V + ((lane >> 4) & 1) * 32 + (lane & 3) * 8 + ((lane & 15) >> 2) * 64 + hi * 1024;
    f32x16 o0 = splat16(0.f), o1 = splat16(0.f); float carry = 1.f;
    int s_cur = 0, s_nxt = AT_SLOT, s_fre = 2 * AT_SLOT;
    bool l1 = false, l2 = false;
    AT_DMA(NT - 1, 0); AT_DMA(NT - 2, AT_SLOT);
    if (wid >= 4) __builtin_amdgcn_s_setprio(1);
    for (int t = NT - 1; t >= 0; --t) {
        if (t == 0) asm volatile("s_waitcnt vmcnt(0) lgkmcnt(0)\n\ts_barrier" ::: "memory");
        else if (l1 || l2) asm volatile("s_waitcnt vmcnt(10) lgkmcnt(0)\n\ts_barrier" ::: "memory");
        else asm volatile("s_waitcnt vmcnt(2) lgkmcnt(0)\n\ts_barrier" ::: "memory");
        const bool dstep = ((t & 1) == (wid >> 2)) && (D.i <= D.last) && !D.pend;
        if (dstep) decw_procA(D, false, dcinit, l15, g4);
        else if (D.pend) { decw_procB(D, l15, g4); D.pend = false; }
        if (t >= 2) AT_DMA(t - 2, s_fre);
        l2 = l1; l1 = false;
        const int kbase = 64 * t;
        if (kbase <= q0 + 30) {
            f32x16 p0 = splat16(cinit), p1 = splat16(cinit);
#pragma unroll
            for (int d0 = 0; d0 < 4; ++d0) {
                const bf16x8 k0 = *(const LAS bf16x8*)(kfb + s_cur + d0 * 2048), k1 = *(const LAS bf16x8*)(kfb + s_cur + d0 * 2048 + 512);
                p0 = MFMA32(k0, qr[d0], p0); p1 = MFMA32(k1, qr[d0], p1);
            }
            v4u pw[4];
            sb_tile2(p0, p1, carry, hi, kbase + 16 * hi, qpos, kbase + 63 >= q0, pw);
#pragma unroll
            for (int ks = 0; ks < 4; ++ks) {
                const LAS unsigned char* vp = vfb + s_cur + (ks >> 1) * 2048 + (ks & 1) * 512;
                const v4i16_t a0 = vtr(vp), a1 = vtr(vp + 256), b0 = vtr(vp + 4096), b1 = vtr(vp + 4096 + 256);
                const bf16x8 v0 = {a0[0], a0[1], a0[2], a0[3], a1[0], a1[1], a1[2], a1[3]}, v1 = {b0[0], b0[1], b0[2], b0[3], b1[0], b1[1], b1[2], b1[3]};
                o0 = MFMA32(__builtin_bit_cast(bf16x8, pw[ks]), v0, o0); o1 = MFMA32(__builtin_bit_cast(bf16x8, pw[ks]), v1, o1);
            }
        }
        if (dstep) { D.pend = true; ++D.i; if (D.i <= D.last) { decw_load(F, D, l15, g4); l1 = true; } }
        const int tmp = s_fre; s_fre = s_cur; s_cur = s_nxt; s_nxt = tmp;
    }
    __builtin_amdgcn_s_setprio(0);
    LAS bf16* stg = (LAS bf16*)(L + AT_O) + wid * 2048;
#pragma unroll
    for (int r = 0; r < 16; ++r) { const int orow = crow(r, hi); stg[orow * 64 + r32] = pg8::bf1(o0[r]); stg[orow * 64 + 32 + r32] = pg8::bf1(o1[r]); }
    asm volatile("s_waitcnt lgkmcnt(0)" ::: "memory");
#pragma unroll
    for (int i = 0; i < 4; ++i) {
        const int row = i * 8 + (lane >> 3), ch = lane & 7; const size_t grow = (size_t)rowbase + q0 + row;
        const v4u ov = *(const LAS v4u*)(stg + row * 64 + ch * 8), gv = *(const v4u*)(F.GA() + grow * 512 + h * 64 + ch * 8);
        f32x4 x, y;
        x[0] = bflo(ov[0]) * bflo(gv[0]); x[1] = bfhi(ov[0]) * bfhi(gv[0]); x[2] = bflo(ov[1]) * bflo(gv[1]); x[3] = bfhi(ov[1]) * bfhi(gv[1]);
        y[0] = bflo(ov[2]) * bflo(gv[2]); y[1] = bfhi(ov[2]) * bfhi(gv[2]); y[2] = bflo(ov[3]) * bflo(gv[3]); y[3] = bfhi(ov[3]) * bfhi(gv[3]);
        *(pg8::u32x4*)(F.MIX() + grow * 1024 + h * 64 + ch * 8) = pg8::pack8(x, y);
    }
    asm volatile("s_waitcnt lgkmcnt(0)\n\ts_barrier" ::: "memory");
#undef AT_DMA
}
constexpr int DW_OB = 90112, DW_CB = 106496;
__device__ __forceinline__ void attn_pair_dec(Frame& F, int it) {
    const int lane = F.lane, l15 = lane & 15, g4 = lane >> 4, wid = F.wave;
    const int bh = it >> 4, x = it & 15;
    DecW D; D.s = it >> 3; D.h = it & 7; D.w = wid; D.carry = 1.f; D.i = 1; D.last = 64; D.pend = false;
    D.pagev = F.pt[D.s * NPG + 8 * wid + (lane & 7)];
    D.tb = F.lds + RING_OFF + DW_T + wid * 2048;
#pragma unroll
    for (int dt = 0; dt < 4; ++dt) D.o[dt] = (f32x4){0.f, 0.f, 0.f, 0.f};
#pragma unroll
    for (int ks = 0; ks < 2; ++ks) D.qb[ks] = *(const bf16x8*)(F.QA() + ((size_t)MP + D.s * 8 + (l15 & 7)) * 512 + D.h * 64 + 32 * ks + 8 * g4);
    const float dcinit = -F.sbb[D.h] * LOG2E;
    if (wid == 7) {
        const size_t row = (size_t)MP + D.s * 8;
        const bf16* kp = F.KA() + (row + (l15 & 7)) * 512 + D.h * 64 + 8 * g4;
#pragma unroll
        for (int ks = 0; ks < 2; ++ks) { const v4u w = *(const v4u*)(kp + 32 * ks);
            D.S.k[2 * ks] = (f32x4){bflo(w[0]), bfhi(w[0]), bflo(w[1]), bfhi(w[1])}; D.S.k[2 * ks + 1] = (f32x4){bflo(w[2]), bfhi(w[2]), bflo(w[3]), bfhi(w[3])}; }
        const bf16* vp = F.VA() + (row + (l15 & 7)) * 512 + D.h * 64 + 4 * g4;
#pragma unroll
        for (int j = 0; j < 4; ++j) { const u32x2 w = *(const u32x2*)(vp + 16 * j); D.S.v[j] = (f32x4){bflo(w.x), bfhi(w.x), bflo(w.y), bfhi(w.y)}; }
        decw_proc(D, true, dcinit, l15, g4);
    }
    decw_load(F, D, l15, g4);
    asm volatile("s_waitcnt vmcnt(0)" ::: "memory");
    attn_unit_dec(F, bh >> 3, bh & 7, 31 - x, D);
    attn_unit_dec(F, bh >> 3, bh & 7, x, D);
    if (D.pend) { decw_procB(D, l15, g4); D.pend = false; }
    while (D.i <= D.last) { decw_proc(D, false, dcinit, l15, g4); ++D.i; if (D.i <= D.last) decw_load(F, D, l15, g4); }
    LAS float* ob = (LAS float*)(F.lds + RING_OFF + DW_OB); LAS float* cb = (LAS float*)(F.lds + RING_OFF + DW_CB);
    if (g4 < 2) {
#pragma unroll
        for (int dt = 0; dt < 4; ++dt)
#pragma unroll
            for (int r = 0; r < 4; ++r) ob[(wid * 8 + 4 * g4 + r) * 64 + 16 * dt + l15] = D.o[dt][r];
        if (g4 == 0 && l15 < 8) cb[wid * 8 + l15] = D.carry;
    }
    __syncthreads();
    {
        const int q = F.tid >> 6, d = F.tid & 63; float acc = 0.f, pref = 1.f;
#pragma unroll
        for (int w = 7; w >= 0; --w) { acc += pref * ob[(w * 8 + q) * 64 + d]; pref *= cb[w * 8 + q]; }
        const size_t row = (size_t)MP + D.s * 8 + q;
        F.MIX()[row * 1024 + D.h * 64 + d] = pg8::bf1(acc * bf2f(F.GA()[row * 512 + D.h * 64 + d]));
    }
    __syncthreads();
}

#ifndef MK_N_LAUNCHES
#define MK_N_LAUNCHES 1
#endif
constexpr int NPH = 15;
constexpr int N_LAUNCHES = MK_N_LAUNCHES;
struct Args { const void* in[17]; float* out; unsigned char* ws; int ph_lo, ph_hi, li, pad; };
__global__ void __launch_bounds__(NWAVES * 64, 2) mk_fwd(Args args) {
    extern __shared__ __attribute__((aligned(16))) unsigned char lds[];
    Frame F;
    F.lds = (LAS unsigned char*)lds;
    F.MISC = (volatile LAS unsigned*)(F.lds + MISC_OFF);
    F.tid = threadIdx.x; F.lane = F.tid & 63; F.wave = __builtin_amdgcn_readfirstlane(F.tid >> 6);
    F.G = gridDim.x; F.bid = blockIdx.x;
    unsigned char* ws = args.ws;
    F.ctl = (gu32*)(ws + WS_CTL);
    F.xp = (const float*)args.in[0]; F.xs = (const float*)args.in[1]; F.ck = (const float*)args.in[2]; F.cv = (const float*)args.in[3]; F.pt = (const int*)args.in[4];
    F.st_h = (const float*)args.in[5]; F.st_r = (const float*)args.in[6]; F.ng = (const float*)args.in[7]; F.w1 = (const float*)args.in[8]; F.w2 = (const float*)args.in[9];
    F.qg = (const float*)args.in[10]; F.kg = (const float*)args.in[11]; F.sbb = (const float*)args.in[12]; F.hlb = (const float*)args.in[13]; F.og = (const float*)args.in[14];
    F.w3 = (const float*)args.in[15]; F.w4 = (const float*)args.in[16]; F.out = args.out;
    F.ws = ws;
    for (int u = F.tid; u < (LDS_BYTES - LDSCTL_OFF) / 4; u += NWAVES * 64) ((LAS unsigned*)(F.lds + LDSCTL_OFF))[u] = 0u;
    __syncthreads();
    XcdBarrier bar; bar.bar = (unsigned*)(F.ctl + CW_BAR); bar.x = 0; bar.st = nullptr;
    if (N_LAUNCHES == 1) bar = xcd_barrier_post((unsigned*)(F.ctl + CW_BAR), F.MISC + 8);
#define GRID_BAR() do { if (N_LAUNCHES == 1) xcd_barrier(bar); } while (0)
    const int lo = args.ph_lo, hi = args.ph_hi;
#define IN(k) (lo <= (k) && (k) < hi)
    const int gw = F.bid * NWAVES + F.wave, NGW = F.G * NWAVES;
    const int vcu_ = (F.G % 8 == 0) ? (F.bid % 8) * (F.G / 8) + F.bid / 8 : F.bid;

    if (IN(0)) { p0_prologue(F); GRID_BAR(); }
    if (IN(1)) {
        pg8::Gemm g{1024, 1024, 1024}; pg8::SchedPlain S; S.init(F.H(), F.W1T(), MP, N1, 1024, F.G, F.bid);
        pg8::EpiEven E{F.QA(), F.KA(), F.VAT(), F.GA(), F.QB(), F.KB(), F.VB(), F.GB(), F.LOGF(), F.out, F.qg, F.kg, F.hlb, -0.125f * LOG2E, MT, MP, OK_P, OK_S, OV_P, OV_S};
        pg8::gemm_phase<pg8::EpiEven, pg8::SchedPlain, true, true>(F.lds + RING_OFF, g, S, E);
        { pg8::Gemm gs{256, 1024, 1024}; pg8::SchedSplit Ss{(const char*)(F.H() + (size_t)MP * 1024), (const char*)F.W1T(), N1 / 256, 4, F.G, F.bid, 2048, 2048};
          pg8::EpiSlab Es{F.SLAB(), N1}; pg8::gemm_phase<pg8::EpiSlab, pg8::SchedSplit, true, true>(F.lds + RING_OFF, gs, Ss, Es); }
        GRID_BAR();
    }
    if (IN(2)) {
        for (int it = gw; it < MSM * 8; it += NGW) pp1_item(F, it);
        for (int u = F.bid; u < 8 * 32; u += F.G) hgrn_chunk_unit2<false>(F, u >> 5, u & 31);
        GRID_BAR();
    }
    if (IN(3)) {
        hgrn_passB(F);
        for (int u = F.bid; u < NSQ * HB; u += F.G) hgrn_sample_unit(F, u >> 2, u & 3);
        { const int vcu = (F.G % 8 == 0) ? (F.bid % 8) * (F.G / 8) + F.bid / 8 : F.bid;
          for (int it = vcu; it < 256; it += F.G) attn_pair_dec(F, it); }
        GRID_BAR();
    }
    if (IN(4)) {
        for (int u = F.bid; u < 8 * 32; u += F.G) hgrn_chunk_unit2<true>(F, u >> 5, u & 31);
        { pg8::Gemm gs{256, 1024, 1024}; pg8::SchedSplit Ss{(const char*)(F.MIX() + (size_t)MP * 1024), (const char*)F.W2T(), 4, 4, F.G, F.bid, 2048, 2048};
          pg8::EpiSlab Es{F.SLAB(), 1024}; pg8::gemm_phase<pg8::EpiSlab, pg8::SchedSplit, true, true>(F.lds + RING_OFF, gs, Ss, Es); }
        GRID_BAR();
    }
    if (IN(6)) {
        pg8::Gemm g{1024, 1024, 1024}; pg8::SchedPlain S; S.init(F.MIX(), F.W2T(), MP, 1024, 1024, F.G, F.bid);
        pg8::EpiY1 E{F.xp, F.Y1B(), F.H(), F.ng + 1024, F.SS1()};
        pg8::gemm_phase<pg8::EpiY1, pg8::SchedPlain, true, true>(F.lds + RING_OFF, g, S, E);
        for (int r = gw; r < MSM; r += NGW) pp2_row(F, r);
        GRID_BAR();
    }
    if (IN(8)) {
        pg8::Gemm g{1024, 1024, 1024};
        { pg8::Sched3<0> S; S.init(F.H(), F.W3T(), F.G, F.bid); pg8::EpiOdd3<0> E{F.AQ(), F.KCH(), F.KCT(), F.BV(), F.GC(), F.QC(), F.KC(), F.VC(), F.RCOS(), F.RSIN(), F.RCOST(), F.RSINT(), MP, F.SS1()};
          pg8::gemm_phase<pg8::EpiOdd3<0>, pg8::Sched3<0>, true, true>(F.lds + RING_OFF, g, S, E); }
        { pg8::Sched3<1> S; S.init(F.H(), F.W3T(), F.G, F.bid); pg8::EpiOdd3<1> E{F.AQ(), F.KCH(), F.KCT(), F.BV(), F.GC(), F.QC(), F.KC(), F.VC(), F.RCOS(), F.RSIN(), F.RCOST(), F.RSINT(), MP, F.SS1()};
          pg8::gemm_phase<pg8::EpiOdd3<1>, pg8::Sched3<1>, true, true>(F.lds + RING_OFF, g, S, E); }
        { pg8::Gemm gs{256, 1024, 1024}; pg8::SchedSplit Ss{(const char*)(F.H() + (size_t)MP * 1024), (const char*)F.W3T(), N3 / 256, 4, F.G, F.bid, 2048, 2048};
          pg8::EpiSlab Es{F.SLAB(), N3}; pg8::gemm_phase<pg8::EpiSlab, pg8::SchedSplit, true, true>(F.lds + RING_OFF, gs, Ss, Es); }
        GRID_BAR();
    }
    if (IN(9)) {
        { pg8::Gemm g{256, 512, 256}; pg8::SchedRet S{(const char*)F.BV(), (const char*)F.KCT(), F.G, vcu_, 0};
          pg8::EpiRetA E{(pg8::bf16_t*)F.DST()};
          pg8::gemm_phase<pg8::EpiRetA, pg8::SchedRet, true, true>(F.lds + RING_OFF, g, S, E); }
        { pg8::Gemm g{256, 2048, 1024}; pg8::SchedRet S{(const char*)F.AQ(), (const char*)F.KCH(), F.G, vcu_, 1};
          pg8::EpiRetP E{F.AQ()};
          pg8::gemm_phase<pg8::EpiRetP, pg8::SchedRet, true, true>(F.lds + RING_OFF, g, S, E); }
        for (int it = gw; it < MSM * 24; it += NGW) pp3_item(F, it);
        GRID_BAR();
    }
    if (IN(10)) {
        ret_passB(F);
        for (int u = F.bid; u < NSQ * HC * 2; u += F.G) ret_sample_unit(F, u >> 3, (u >> 1) & 3, u & 1);
        GRID_BAR();
    }
    if (IN(12)) {
        pg8::Gemm g{512, 2048, 512}; pg8::SchedRet S{(const char*)F.AQ(), (const char*)F.BV(), F.G, vcu_, 2};
        pg8::EpiRetO E{F.GC(), F.MIX2(), F.SS()};
        pg8::gemm_phase<pg8::EpiRetO, pg8::SchedRet, true, true>(F.lds + RING_OFF, g, S, E);
        { pg8::Gemm gs{256, 2048, 2048}; pg8::SchedSplit Ss{(const char*)(F.MIX2() + (size_t)MP * 2048), (const char*)F.W4T(), 4, 8, F.G, F.bid, 4096, 4096};
          pg8::EpiSlab Es{F.SLAB4(), 1024}; pg8::gemm_phase<pg8::EpiSlab, pg8::SchedSplit, true, true>(F.lds + RING_OFF, gs, Ss, Es); }
        GRID_BAR();
    }
    if (IN(14)) {
        pg8::Gemm g{2048, 2048, 2048}; pg8::SchedPlain S; S.init(F.MIX2(), F.W4T(), MP, 1024, 2048, F.G, F.bid);
        pg8::EpiOut E{F.Y1B(), F.out + OY_P, F.SS()};
        pg8::gemm_phase<pg8::EpiOut, pg8::SchedPlain, true, true>(F.lds + RING_OFF, g, S, E);
        for (int r = gw; r < MSM; r += NGW) pp4_row(F, r);
    }
#undef IN
}

extern "C" void kernel_launch(void* const* d_in, const int* in_sizes, int n_in, void* d_out, int out_size, void* d_ws, size_t ws_size, hipStream_t stream) {
    static int grid = 0;
    if (grid == 0) {
        if (n_in != 17 || (size_t)out_size != OUT_TOTAL || ws_size < WS_END) { fprintf(stderr, "kernel_launch: unexpected shapes: n_in %d out %d ws %zu (need %zu)\n", n_in, out_size, ws_size, (size_t)WS_END); grid = -1; return; }
        int dev = 0, cus = 0, per_cu = 0;
        if (hipGetDevice(&dev) != hipSuccess || hipDeviceGetAttribute(&cus, hipDeviceAttributeMultiprocessorCount, dev) != hipSuccess) { grid = -1; return; }
        if (hipFuncSetAttribute((const void*)mk_fwd, hipFuncAttributeMaxDynamicSharedMemorySize, LDS_BYTES) != hipSuccess) { fprintf(stderr, "kernel_launch: hipFuncSetAttribute failed\n"); grid = -1; return; }
        if (hipOccupancyMaxActiveBlocksPerMultiprocessor(&per_cu, (const void*)mk_fwd, NWAVES * 64, LDS_BYTES) != hipSuccess || per_cu < 1) { fprintf(stderr, "kernel_launch: occupancy query says %d\n", per_cu); }
        (void)hipGetLastError();
        grid = cus;
    }
    if (grid < 0) return;
    if (hipMemsetAsync((char*)d_ws + WS_CTL, 0, CTL_ZERO_BYTES, stream) != hipSuccess) return;
    Args a{};
    for (int i = 0; i < 17; ++i) a.in[i] = d_in[i];
    a.out = (float*)d_out; a.ws = (unsigned char*)d_ws;
    for (int li = 0; li < N_LAUNCHES; ++li) {
        a.ph_lo = (N_LAUNCHES == 1) ? 0 : li; a.ph_hi = (N_LAUNCHES == 1) ? NPH : li + 1; a.li = li;
        hipLaunchKernelGGL(mk_fwd, dim3(grid), dim3(NWAVES * 64), LDS_BYTES, stream, a);
        if (hipPeekAtLastError() != hipSuccess) break;
    }
}
```

```cpp
#include <hip/hip_runtime.h>
#include <cstdio>
#include <cstdint>

constexpr int DM = 1024, TP = 8192, NBP = 2, MP = NBP * TP;
constexpr int NSQ = 32, TSQ = 8, MSM = NSQ * TSQ;
constexpr int MT = MP + MSM;
constexpr int PAST = 8192, PAGE = 128, NPG = PAST / PAGE;
constexpr int HA = 8, HDA = 64, WA = 512, HB = 4, DKB = 128, DVB = 128, HC = 4, DKC = 256, DVC = 512, WC = 2048;
constexpr int N1 = 4096, N3 = 6144;
constexpr float EPS = 1e-6f;
constexpr float LOG2E = 1.4426950408889634f;
constexpr size_t OY_P = 0, OY_S = 16777216, OK_P = 17039360, OV_P = 25427968, OK_S = 33816576, OV_S = 33947648,
                 OHG_P = 34078720, OHG_S = 34209792, ORT_P = 36306944, ORT_S = 37355520, OUT_TOTAL = 54132736;
#define MK_N_LAUNCHES 1
namespace pg8 {
#define PG8_LAS __attribute__((address_space(3)))
typedef unsigned short bf16_t;
typedef short bf16x8 __attribute__((ext_vector_type(8)));
typedef float f32x4 __attribute__((ext_vector_type(4)));
typedef unsigned u32x4 __attribute__((ext_vector_type(4)));
constexpr int BM = 256, BK = 64, HALF = 128, HTB = HALF * BK * 2  , STAGE_BYTES = 8 * HTB, NXCD = 8, WGM = 8;

__host__ __device__ __forceinline__ int lds_byte(int r, int c) { const int st = (r >> 4) * 2 + (c >> 5), rr = r & 15, cc = c & 31, ob = rr * 64 + cc * 2; return st * 1024 + (ob ^ (((ob >> 9) & 1) << 5)); }
__host__ __device__ __forceinline__ void stage_rc(int b, int& R, int& C) { const int st = b / 1024, sb = b % 1024, swz = sb ^ (((sb >> 9) & 1) << 5); R = (st >> 1) * 16 + swz / 64; C = (st & 1) * 32 + (swz % 64) / 2; }
__host__ __device__ __forceinline__ int perm32(int rho) { const int n = rho >> 4, i = rho & 15; return 8 * (i >> 2) + 4 * n + (i & 3); }

struct Unit { int pm, pn, kind, aux; };
struct Gemm { int K, lda, ldb; };

struct StaticOrder {
    int nM, nN, nwg, G, c;
    __host__ __device__ void init(int M, int N, int G_, int c_) { nM = M / BM; nN = N / BM; nwg = nM * nN; G = G_; c = c_; }
    __host__ __device__ bool next(int i, Unit& u) const {
        const long L = (long)i * G + c; if (L >= nwg) return false;
        int wgid = (int)L; { const int q = nwg / NXCD, r = nwg % NXCD, xcd = wgid % NXCD, off = wgid / NXCD; wgid = (xcd < r ? xcd * (q + 1) : r * (q + 1) + (xcd - r) * q) + off; }
        const int nig = WGM * nN, gid = wgid / nig, fm = gid * WGM, gsz = (nM - fm) < WGM ? (nM - fm) : WGM;
        u.pm = fm + ((wgid % nig) % gsz); u.pn = (wgid % nig) / gsz; return true;
    }
    __device__ __forceinline__ void a_ready(const Unit&) const {}
    __device__ __forceinline__ void done(const Unit&) const {}
};
typedef float f32x2_t __attribute__((ext_vector_type(2))); typedef __bf16 bf16x2_t __attribute__((ext_vector_type(2)));
__device__ __forceinline__ unsigned cvt_pk_bf16(float lo, float hi) { f32x2_t v = {lo, hi}; bf16x2_t b = __builtin_convertvector(v, bf16x2_t); return __builtin_bit_cast(unsigned, b); }
typedef float f32x2 __attribute__((ext_vector_type(2)));
template <class Epi, class Sched, bool ALIGN_EPI = false, bool SP2 = false>
__device__ __forceinline__ void gemm_phase(PG8_LAS unsigned char* lds, const Gemm g, const Sched& S, const Epi& E) {
    const int tid = threadIdx.x, wid = __builtin_amdgcn_readfirstlane(tid >> 6), lane = tid & 63, wr = wid >> 2, wc = wid & 3, fr = lane & 15, fq = lane >> 4;
    const int K = g.K, nt = K / BK;
    unsigned voffA[2], voffB[2];
#pragma unroll
    for (int i = 0; i < 2; ++i) { int R, C; stage_rc(tid * 16 + i * 8192, R, C); const int Rb = Epi::PERM ? ((R & ~31) + perm32(R & 31)) : R;
        voffA[i] = (unsigned)(R * g.lda + C) * 2u; voffB[i] = (unsigned)(Rb * g.ldb + C) * 2u; }
    const size_t kstep = (size_t)(BK * 2);
    const size_t hstepA = (size_t)HALF * g.lda * 2, hstepB = (size_t)HALF * g.ldb * 2;
    const unsigned ldsw = (unsigned)wid * 1024u;
    const int aoff = lds_byte(wr * 64 + fr, fq * 8), boff = lds_byte(wc * 32 + fr, fq * 8);
#define PG8_SA(b, h) (((b) * 2 + (h)) * HTB)
#define PG8_SB(b, h) ((4 + (b) * 2 + (h)) * HTB)
#define PG8_STAGE(bufoff, gbase, voff) do { _Pragma("unroll") for (int _i = 0; _i < 2; ++_i) \
        __builtin_amdgcn_global_load_lds((const unsigned*)((const char*)(gbase) + (voff)[_i]), (PG8_LAS unsigned*)(lds + (bufoff) + ldsw + _i * 8192), 16, 0, 0); } while (0)
#define PG8_LDA(dst, b, h) do { _Pragma("unroll") for (int m = 0; m < 4; ++m) _Pragma("unroll") for (int k = 0; k < 2; ++k) dst[m][k] = *(const PG8_LAS bf16x8*)(lds + PG8_SA(b, h) + aoff + m * 2048 + k * 1024); } while (0)
#define PG8_LDB(dst, b, h) do { _Pragma("unroll") for (int n = 0; n < 2; ++n) _Pragma("unroll") for (int k = 0; k < 2; ++k) dst[n][k] = *(const PG8_LAS bf16x8*)(lds + PG8_SB(b, h) + boff + n * 2048 + k * 1024); } while (0)
#define PG8_MMA(ai, bj, At, Bt) do { __builtin_amdgcn_s_setprio(1); _Pragma("unroll") for (int m = 0; m < 4; ++m) _Pragma("unroll") for (int n = 0; n < 2; ++n) _Pragma("unroll") for (int k = 0; k < 2; ++k) \
        acc[ai][bj][m][n] = __builtin_amdgcn_mfma_f32_16x16x32_bf16(Bt[n][k], At[m][k], acc[ai][bj][m][n], 0, 0, 0); __builtin_amdgcn_s_setprio(0); } while (0)
#define PG8_WAIT_V(n) asm volatile("s_waitcnt vmcnt(" #n ")" ::: "memory")
#define PG8_WAIT_L(n) asm volatile("s_waitcnt lgkmcnt(" #n ")" ::: "memory")
#define PG8_BAR __builtin_amdgcn_s_barrier()
#define PG8_SCHED __builtin_amdgcn_sched_barrier(0)
    Unit cur, nxt; int ui = 0;
    if (!S.next(0, cur)) return;
    f32x4 acc[2][2][4][2];
#pragma unroll
    for (int a = 0; a < 2; ++a)
#pragma unroll
        for (int b = 0; b < 2; ++b)
#pragma unroll
            for (int m = 0; m < 4; ++m)
#pragma unroll
                for (int n = 0; n < 2; ++n) acc[a][b][m][n] = (f32x4){0.f, 0.f, 0.f, 0.f};
    bf16x8 At[4][2], B0[2][2], B1[2][2];
    const char* cA = S.a_base(cur); const char* cB = S.b_base(cur);
    S.a_ready(cur);
    if constexpr (SP2) {
        PG8_STAGE(PG8_SB(0, 0), cB, voffB); PG8_STAGE(PG8_SB(0, 1), cB + hstepB, voffB); PG8_STAGE(PG8_SA(0, 0), cA, voffA); PG8_STAGE(PG8_SA(0, 1), cA + hstepA, voffA);
        if (wr == 1) PG8_BAR;
        PG8_WAIT_V(2); PG8_BAR;
        PG8_STAGE(PG8_SB(1, 0), cB + kstep, voffB); PG8_STAGE(PG8_SA(1, 0), cA + kstep, voffA); PG8_STAGE(PG8_SB(1, 1), cB + hstepB + kstep, voffB);
        PG8_WAIT_V(6); PG8_BAR;
    } else {
        PG8_STAGE(PG8_SB(0, 0), cB, voffB); PG8_STAGE(PG8_SA(0, 0), cA, voffA); PG8_STAGE(PG8_SB(0, 1), cB + hstepB, voffB); PG8_STAGE(PG8_SA(0, 1), cA + hstepA, voffA);
        if (wr == 1) PG8_BAR;
        PG8_WAIT_V(4); PG8_BAR;
        PG8_STAGE(PG8_SB(1, 0), cB + kstep, voffB); PG8_STAGE(PG8_SA(1, 0), cA + kstep, voffA); PG8_STAGE(PG8_SB(1, 1), cB + hstepB + kstep, voffB);
        PG8_WAIT_V(6); PG8_BAR;
    }
    for (;;) {
        const bool has_next = S.next(ui + 1, nxt);
        const char* nA = has_next ? S.a_base(nxt) : cA; const char* nB = has_next ? S.b_base(nxt) : cB;
#pragma unroll 1
        for (int t = 0; t < nt; t += 2) {
            if constexpr (Epi::KHOOK) { if (t != 0 && (t & 7) == 0) E.khook(acc, cur, t >> 3, wr, fr); }
            const bool last = (t == nt - 2);
            const char* a1 = cA + (size_t)(t + 1) * kstep;
            const char* a2 = last ? nA : cA + (size_t)(t + 2) * kstep; const char* b2 = last ? nB : cB + (size_t)(t + 2) * kstep;
            const char* a3 = a2 + kstep; const char* b3 = b2 + kstep;
            if (last && has_next) S.a_ready(nxt);
            if constexpr (SP2) {
            PG8_LDB(B0, 0, 0); PG8_LDB(B1, 0, 1); PG8_SCHED; PG8_LDA(At, 0, 0); PG8_STAGE(PG8_SA(1, 1), a1 + hstepA, voffA);
            PG8_WAIT_V(8); PG8_WAIT_L(0); PG8_BAR; PG8_MMA(0, 0, At, B0); PG8_MMA(0, 1, At, B1); PG8_BAR; PG8_SCHED;
            PG8_LDA(At, 0, 1); PG8_STAGE(PG8_SB(0, 0), b2, voffB); PG8_STAGE(PG8_SB(0, 1), b2 + hstepB, voffB); PG8_STAGE(PG8_SA(0, 0), a2, voffA);
            PG8_WAIT_V(8); PG8_WAIT_L(0); PG8_BAR; PG8_MMA(1, 0, At, B0); PG8_MMA(1, 1, At, B1); PG8_BAR; PG8_SCHED;
            PG8_LDB(B0, 1, 0); PG8_LDB(B1, 1, 1); PG8_SCHED; PG8_LDA(At, 1, 0); PG8_STAGE(PG8_SA(0, 1), a2 + hstepA, voffA);
            PG8_WAIT_V(8); PG8_WAIT_L(0); PG8_BAR; PG8_MMA(0, 0, At, B0); PG8_MMA(0, 1, At, B1); PG8_BAR; PG8_SCHED;
            PG8_LDA(At, 1, 1); PG8_STAGE(PG8_SB(1, 0), b3, voffB); PG8_STAGE(PG8_SB(1, 1), b3 + hstepB, voffB); PG8_STAGE(PG8_SA(1, 0), a3, voffA);
            PG8_WAIT_V(8); PG8_WAIT_L(0); PG8_BAR; PG8_MMA(1, 0, At, B0); PG8_MMA(1, 1, At, B1); PG8_BAR; PG8_SCHED;
            } else {
            PG8_LDB(B0, 0, 0); PG8_SCHED; PG8_LDA(At, 0, 0); PG8_STAGE(PG8_SA(1, 1), a1 + hstepA, voffA);
            PG8_WAIT_L(8); PG8_BAR; PG8_WAIT_L(0); PG8_MMA(0, 0, At, B0); PG8_BAR; PG8_SCHED;
            PG8_LDB(B1, 0, 1); PG8_STAGE(PG8_SB(0, 0), b2, voffB);
            PG8_BAR; PG8_WAIT_L(0); PG8_MMA(0, 1, At, B1); PG8_BAR;
            PG8_LDA(At, 0, 1); PG8_STAGE(PG8_SA(0, 0), a2, voffA);
            PG8_BAR; PG8_WAIT_L(0); PG8_MMA(1, 0, At, B0); PG8_BAR; PG8_SCHED;
            PG8_STAGE(PG8_SB(0, 1), b2 + hstepB, voffB);
            PG8_WAIT_V(6); PG8_BAR; PG8_MMA(1, 1, At, B1); PG8_BAR;
            PG8_LDB(B0, 1, 0); PG8_SCHED; PG8_LDA(At, 1, 0); PG8_STAGE(PG8_SA(0, 1), a2 + hstepA, voffA);
            PG8_WAIT_L(8); PG8_BAR; PG8_WAIT_L(0); PG8_MMA(0, 0, At, B0); PG8_BAR; PG8_SCHED;
            PG8_LDB(B1, 1, 1); PG8_STAGE(PG8_SB(1, 0), b3, voffB);
            PG8_BAR; PG8_WAIT_L(0); PG8_MMA(0, 1, At, B1); PG8_BAR;
            PG8_LDA(At, 1, 1); PG8_STAGE(PG8_SA(1, 0), a3, voffA);
            PG8_BAR; PG8_WAIT_L(0); PG8_MMA(1, 0, At, B0); PG8_BAR; PG8_SCHED;
            PG8_STAGE(PG8_SB(1, 1), b3 + hstepB, voffB);
            PG8_WAIT_V(6); PG8_BAR; PG8_MMA(1, 1, At, B1); PG8_BAR;
            }
        }
        if constexpr (ALIGN_EPI) { if (wr == 0) PG8_BAR; }
        if constexpr (!Epi::AFTER_DRAIN) { E(acc, cur, wr, wc, fr, fq); S.done(cur); }
        if (!has_next) break;
#pragma unroll
        for (int a = 0; a < 2; ++a)
#pragma unroll
            for (int b = 0; b < 2; ++b)
#pragma unroll
                for (int m = 0; m < 4; ++m)
#pragma unroll
                    for (int n = 0; n < 2; ++n) acc[a][b][m][n] = (f32x4){0.f, 0.f, 0.f, 0.f};
        cur = nxt; cA = nA; cB = nB; ++ui;
        if constexpr (ALIGN_EPI) { if (wr == 1) PG8_BAR; }
    }
    PG8_WAIT_V(0);
    if constexpr (!ALIGN_EPI) { if (wr == 0) PG8_BAR; }
    PG8_BAR;
    if constexpr (Epi::AFTER_DRAIN) { E.fused(acc, cur, wr, wc, fr, fq, lds, wid, lane); S.done(cur); }
#undef PG8_SA
#undef PG8_SB
#undef PG8_STAGE
#undef PG8_LDA
#undef PG8_LDB
#undef PG8_MMA
#undef PG8_WAIT_V
#undef PG8_WAIT_L
#undef PG8_BAR
#undef PG8_SCHED
}
__device__ __forceinline__ float silu_f(float x) { return x * __builtin_amdgcn_rcpf(1.f + __builtin_amdgcn_exp2f(-1.4426950408889634f * x)); }
__device__ __forceinline__ float sigm_f(float x) { return __builtin_amdgcn_rcpf(1.f + __builtin_amdgcn_exp2f(-1.4426950408889634f * x)); }
__device__ __forceinline__ u32x4 pack8(const f32x4 a, const f32x4 b) { u32x4 w; w.x = cvt_pk_bf16(a[0], a[1]); w.y = cvt_pk_bf16(a[2], a[3]); w.z = cvt_pk_bf16(b[0], b[1]); w.w = cvt_pk_bf16(b[2], b[3]); return w; }
__device__ __forceinline__ unsigned short bf1(float f) { return (unsigned short)(cvt_pk_bf16(f, 0.f) & 0xffffu); }

struct EpiEven {
    static constexpr bool PERM = true, AFTER_DRAIN = false, KHOOK = false;
    bf16_t *QA, *KA, *VAT, *GA, *QB, *KB, *VB, *GB; float* LOGF; float* out;
    const float *qg, *kg, *hlb; float qscale; int MTOT, MPR; size_t okp, oks, ovp, ovs;
    __device__ __forceinline__ void operator()(const f32x4 (&acc)[2][2][4][2], const Unit& u, int wr, int wc, int fr, int fq) const {
        const int typ = u.pn >> 1;
        int rb = u.pm * BM + wr * 64 + fr; asm volatile("" : "+v"(rb));
        const int c0 = (u.pn & 1) * 256 + wc * 64 + fq * 8;
        const int d0 = fq * 8;
#pragma unroll
        for (int ai = 0; ai < 2; ++ai)
#pragma unroll
            for (int m = 0; m < 4; ++m) {
                const int row = rb + ai * HALF + m * 16;
                f32x4 v[2][2];
#pragma unroll
                for (int bj = 0; bj < 2; ++bj)
#pragma unroll
                    for (int n = 0; n < 2; ++n) v[bj][n] = acc[ai][bj][m][n];
                if (typ <= 1) {
                    float ss = 0.f;
#pragma unroll
                    for (int bj = 0; bj < 2; ++bj)
#pragma unroll
                        for (int n = 0; n < 2; ++n) ss += (v[bj][n][0] * v[bj][n][0] + v[bj][n][1] * v[bj][n][1]) + (v[bj][n][2] * v[bj][n][2] + v[bj][n][3] * v[bj][n][3]);
                    ss += __shfl_xor(ss, 16); ss += __shfl_xor(ss, 32);
                    const float rstd = __builtin_amdgcn_rsqf(ss * (1.f / 64.f) + 1e-6f) * (typ == 0 ? qscale : 1.f);
                    const float* g = (typ == 0) ? qg : kg;
#pragma unroll
                    for (int bj = 0; bj < 2; ++bj) {
#pragma unroll
                        for (int n = 0; n < 2; ++n) { const f32x4 gv = *(const f32x4*)(g + d0 + 32 * bj + 4 * n); v[bj][n] = v[bj][n] * gv * rstd; }
                        const int c = c0 + 32 * bj;
                        if (typ == 0) *(u32x4*)(QA + (size_t)row * 512 + c) = pack8(v[bj][0], v[bj][1]);
                        else {
                            *(u32x4*)(KA + (size_t)row * 512 + c) = pack8(v[bj][0], v[bj][1]);
                            float* ko = out + (row < MPR ? okp + (size_t)row * 512 : oks + (size_t)(row - MPR) * 512) + c;
                            *(f32x4*)ko = v[bj][0]; *(f32x4*)(ko + 4) = v[bj][1];
                        }
                    }
                } else if (typ == 2) {
#pragma unroll
                    for (int bj = 0; bj < 2; ++bj) {
                        const int c = c0 + 32 * bj;
                        float* vo = out + (row < MPR ? ovp + (size_t)row * 512 : ovs + (size_t)(row - MPR) * 512) + c;
                        *(f32x4*)vo = v[bj][0]; *(f32x4*)(vo + 4) = v[bj][1];
                        *(u32x4*)(VAT + (size_t)row * 512 + c) = pack8(v[bj][0], v[bj][1]);
                    }
                } else if (typ == 5) {
#pragma unroll
                    for (int bj = 0; bj < 2; ++bj) {
                        const int c = c0 + 32 * bj;
                        f32x4 lf[2], kk[2];
#pragma unroll
                        for (int n = 0; n < 2; ++n)
#pragma unroll
                            for (int e = 0; e < 4; ++e) {
                                const int cc = c + 4 * n + e;
                                const float lb = __builtin_amdgcn_rcpf(1.f + __expf(hlb[512 + cc] - hlb[cc]));
                                const float sg = sigm_f(v[bj][n][e]);
                                lf[n][e] = __logf(lb + (1.f - lb) * sg);
                                kk[n][e] = (1.f - lb) * (1.f - sg);
                            }
                        *(f32x4*)(LOGF + (size_t)row * 512 + c) = lf[0]; *(f32x4*)(LOGF + (size_t)row * 512 + c + 4) = lf[1];
                        *(u32x4*)(KB + (size_t)row * 512 + c) = pack8(kk[0], kk[1]);
                    }
                } else {
                    bf16_t* dst = (typ == 3) ? GA : (typ == 4) ? QB : (typ == 6) ? VB : GB;
#pragma unroll
                    for (int bj = 0; bj < 2; ++bj) {
                        if (typ != 6) {
#pragma unroll
                            for (int n = 0; n < 2; ++n)
#pragma unroll
                                for (int e = 0; e < 4; ++e) v[bj][n][e] = silu_f(v[bj][n][e]);
                        }
                        *(u32x4*)(dst + (size_t)row * 512 + c0 + 32 * bj) = pack8(v[bj][0], v[bj][1]);
                    }
                }
            }
    }
};


struct EpiY1 {
    static constexpr bool PERM = false, AFTER_DRAIN = false, KHOOK = false;
    const float* x; bf16_t* Y1; float* SS1;
    __device__ __forceinline__ void operator()(const f32x4 (&acc)[2][2][4][2], const Unit& u, int wr, int wc, int fr, int fq) const {
        int row0 = u.pm * BM + wr * 64 + fr; asm volatile("" : "+v"(row0));
        const int col0 = u.pn * BM + wc * 32 + 4 * fq;
#pragma unroll
        for (int ai = 0; ai < 2; ++ai)
#pragma unroll
            for (int m = 0; m < 4; ++m) {
                const int row = row0 + ai * HALF + m * 16; float ss = 0.f;
#pragma unroll
                for (int bj = 0; bj < 2; ++bj)
#pragma unroll
                    for (int n = 0; n < 2; ++n) { const int c = col0 + bj * HALF + n * 16;
                        const f32x4 y = acc[ai][bj][m][n] + *(const f32x4*)(x + (size_t)row * 1024 + c);
                        *(unsigned long long*)(Y1 + (size_t)row * 1024 + c) = (unsigned long long)cvt_pk_bf16(y[0], y[1]) | ((unsigned long long)cvt_pk_bf16(y[2], y[3]) << 32);
                        ss += (y[0] * y[0] + y[1] * y[1]) + (y[2] * y[2] + y[3] * y[3]); }
                ss += __shfl_xor(ss, 16); ss += __shfl_xor(ss, 32);
                if (fq == 0) atomicAdd(SS1 + row, ss);
            }
    }
};


__device__ __forceinline__ float lg2gamma(int h) { return __builtin_amdgcn_logf(1.f - __builtin_amdgcn_exp2f(-5.f - (float)h)); }

template <int KIND> struct EpiOdd3 {
    static constexpr bool PERM = true, AFTER_DRAIN = false, KHOOK = false;
    bf16_t *AQ, *KCH, *KCT, *BV, *GC, *QC, *KC, *VC; const float *rcos, *rsin, *rcosT, *rsinT; int MPR; const float* SS1;
    __device__ __forceinline__ void operator()(const f32x4 (&acc)[2][2][4][2], const Unit& u, int wr, int wc, int fr, int fq) const {

        if (KIND == 0) {
            const int j0 = wc * 32 + fq * 8;
            int rb = u.pm * BM + wr * 64 + fr; asm volatile("" : "+v"(rb));
#pragma unroll
            for (int ai = 0; ai < 2; ++ai)
#pragma unroll
                for (int m = 0; m < 4; ++m) {
                    const int row = rb + ai * HALF + m * 16;
                    const float rs = __builtin_amdgcn_rsqf(SS1[row] * (1.f / 1024.f) + 1e-6f);
                    if (u.pn < 8) {
                        const int pos = row & (TP - 1), h = u.pn & 3, tl = row & 255;
                        const float sc = rs * ((u.pn < 4) ? __builtin_amdgcn_exp2f((float)tl * lg2gamma(h)) : 0.0625f * __builtin_amdgcn_exp2f(-(float)tl * lg2gamma(h)));
                        f32x4 o1[2], o2[2];
#pragma unroll
                        for (int n = 0; n < 2; ++n) {
                            const f32x4 c = *(const f32x4*)(rcos + (size_t)pos * 128 + j0 + 4 * n), s = *(const f32x4*)(rsin + (size_t)pos * 128 + j0 + 4 * n);
                            const f32x4 x1 = acc[ai][0][m][n], x2 = acc[ai][1][m][n];
                            o1[n] = (x1 * c - x2 * s) * sc; o2[n] = (x2 * c + x1 * s) * sc;
                        }
                        bf16_t* dst = (u.pn < 4) ? AQ + (size_t)row * 2048 + h * 512 + 256 + j0 : KCH + (size_t)row * 1024 + h * 256 + j0;
                        *(u32x4*)dst = pack8(o1[0], o1[1]); *(u32x4*)(dst + 128) = pack8(o2[0], o2[1]);
                        if (u.pn >= 4) {
                            bf16_t* kt = KCT + ((size_t)(((row >> 13) * 4 + h) * 32 + ((row >> 8) & 31)) * 256 + j0) * 256 + tl;
#pragma unroll
                            for (int n = 0; n < 2; ++n)
#pragma unroll
                                for (int e = 0; e < 4; ++e) { kt[(size_t)(4 * n + e) * 256] = bf1(o1[n][e]); kt[(size_t)(128 + 4 * n + e) * 256] = bf1(o2[n][e]); }
                        }
                        asm volatile("" ::: "memory");
                    } else {
                        bf16_t* dst = GC + (size_t)row * 2048 + (u.pn - 8) * 256 + j0;
#pragma unroll
                        for (int bj = 0; bj < 2; ++bj) {
                            f32x4 a = acc[ai][bj][m][0] * rs, b = acc[ai][bj][m][1] * rs;
#pragma unroll
                            for (int e = 0; e < 4; ++e) { a[e] = silu_f(a[e]); b[e] = silu_f(b[e]); }
                            *(u32x4*)(dst + 128 * bj) = pack8(a, b);
                        }
                    }
                }
            return;
        }
        int fro = fr; asm volatile("" : "+v"(fro));
        if (u.pm < 4) {
            const int h = u.pm; const float lg = lg2gamma(h);
            int lt = wc * 32 + fq * 8; asm volatile("" : "+v"(lt));
            const float ginv = __builtin_amdgcn_exp2f(-lg), g128 = __builtin_amdgcn_exp2f(-128.f * lg);
            float scv[2][8]; scv[0][0] = 0.0625f * __builtin_amdgcn_exp2f(-(float)lt * lg);
#pragma unroll
            for (int i = 1; i < 8; ++i) scv[0][i] = scv[0][i - 1] * ginv;
#pragma unroll
            for (int i = 0; i < 8; ++i) scv[1][i] = scv[0][i] * g128;
#pragma unroll
            for (int m = 0; m < 4; ++m) {
                const int j = wr * 64 + m * 16 + fro;
#pragma unroll
                for (int bj = 0; bj < 2; ++bj) {
                    const int tl0 = bj * HALF + lt, tok0 = u.pn * BM + tl0, pos0 = tok0 & (TP - 1);
                    f32x4 o1[2], o2[2];
#pragma unroll
                    for (int n = 0; n < 2; ++n) {
                        const f32x4 c = *(const f32x4*)(rcosT + (size_t)j * 8200 + pos0 + 4 * n), s = *(const f32x4*)(rsinT + (size_t)j * 8200 + pos0 + 4 * n);
                        const f32x4 x1 = acc[0][bj][m][n], x2 = acc[1][bj][m][n], q2 = *(const f32x4*)(SS1 + tok0 + 4 * n);
#pragma unroll
                        for (int e = 0; e < 4; ++e) {
                            const float sc = scv[bj][4 * n + e] * __builtin_amdgcn_rsqf(q2[e] * (1.f / 1024.f) + 1e-6f);
                            o1[n][e] = (x1[e] * c[e] - x2[e] * s[e]) * sc; o2[n][e] = (x2[e] * c[e] + x1[e] * s[e]) * sc;
                        }
                    }
                    { const int b = tok0 >> 13, c = (tok0 >> 8) & 31; bf16_t* kc = KCT + ((size_t)((b * 4 + h) * 32 + c) * 256 + j) * 256 + (tok0 & 255);
                      *(u32x4*)kc = pack8(o1[0], o1[1]); *(u32x4*)(kc + 128 * 256) = pack8(o2[0], o2[1]); }
                    asm volatile("" ::: "memory");
                }
            }
        } else {
#pragma unroll
            for (int ai = 0; ai < 2; ++ai)
#pragma unroll
                for (int m = 0; m < 4; ++m) {
                    const int vf = (u.pm - 4) * BM + ai * HALF + wr * 64 + m * 16 + fro, h = vf >> 9, dv = vf & 511;
#pragma unroll
                    for (int bj = 0; bj < 2; ++bj) {
                        const int tok0 = u.pn * BM + bj * HALF + wc * 32 + fq * 8, b = tok0 >> 13, c = (tok0 >> 8) & 31, sl = tok0 & 255;
                        f32x4 r0 = *(const f32x4*)(SS1 + tok0), r1 = *(const f32x4*)(SS1 + tok0 + 4);
#pragma unroll
                        for (int e = 0; e < 4; ++e) { r0[e] = __builtin_amdgcn_rsqf(r0[e] * (1.f / 1024.f) + 1e-6f); r1[e] = __builtin_amdgcn_rsqf(r1[e] * (1.f / 1024.f) + 1e-6f); }
                        *(u32x4*)(BV + ((size_t)((b * 4 + h) * 32 + c) * 512 + dv) * 512 + sl) = pack8(acc[ai][bj][m][0] * r0, acc[ai][bj][m][1] * r1);
                    }
                }
        }
    }
};
template <int KIND> struct Sched3 {
    StaticOrder so; const char *H, *W3T; int G, c;
    __device__ __forceinline__ void init(const void* H_, const void* W3T_, int G_, int c_) { H = (const char*)H_; W3T = (const char*)W3T_; G = G_; c = c_; so.init(16384, 4096, G_, c_); }
    __device__ __forceinline__ bool next(int i, Unit& u) const {
        const int L = i * G + c; u.aux = 0; u.kind = KIND;
        if (KIND == 0) return so.next(i, u);
        if (KIND == 1) { if (L >= 512) return false; u.pm = 4 + (L & 7); u.pn = L >> 3; return true; }
        if (L >= 24) return false; u.pm = 64; u.pn = L; return true;
    }
    __device__ __forceinline__ const char* a_base(const Unit& u) const { return (KIND == 1) ? W3T + (size_t)(1024 + 256 * u.pm) * 2048 : H + (size_t)u.pm * 256 * 2048; }
    __device__ __forceinline__ const char* b_base(const Unit& u) const {
        if (KIND == 1) return H + (size_t)u.pn * 256 * 2048;
        const int r0 = (KIND == 0 && u.pn >= 8) ? 4096 + 256 * (u.pn - 8) : 256 * u.pn;
        return W3T + (size_t)r0 * 2048; }
    __device__ __forceinline__ void a_ready(const Unit&) const {}
    __device__ __forceinline__ void done(const Unit&) const {}
};
struct SchedPlain {
    StaticOrder so; const char *A, *Bt; size_t ta, tb;
    __device__ __forceinline__ void init(const void* A_, const void* Bt_, int M, int N, int K, int G, int c) { A = (const char*)A_; Bt = (const char*)Bt_; ta = (size_t)256 * K * 2; tb = ta; so.init(M, N, G, c); }
    __device__ __forceinline__ bool next(int i, Unit& u) const { u.kind = 0; u.aux = 0; return so.next(i, u); }
    __device__ __forceinline__ const char* a_base(const Unit& u) const { return A + (size_t)u.pm * ta; }
    __device__ __forceinline__ const char* b_base(const Unit& u) const { return Bt + (size_t)u.pn * tb; }
    __device__ __forceinline__ void a_ready(const Unit&) const {}
    __device__ __forceinline__ void done(const Unit&) const {}
};
struct SchedRet {
    const char *Ab, *Bb; int G, c, mode;
    __device__ __forceinline__ bool next(int i, Unit& u) const {
        const int L = i * G + c, n = (mode == 1) ? 256 : 512; if (L >= n) return false;
        int bc, half; if (mode == 1) { bc = L; half = 0; } else { bc = L >> 1; half = L & 1; }
        u.pm = bc; u.pn = half; u.kind = 0; u.aux = (bc >> 7) * TP + (bc & 31) * 256; return true;
    }
    __device__ __forceinline__ const char* a_base(const Unit& u) const {
        if (mode == 0) return Ab + ((size_t)u.pm * 512 + u.pn * 256) * 512 * 2;
        const int h = (u.pm >> 5) & 3;
        return Ab + ((size_t)u.aux * 2048 + h * 512 + (mode == 1 ? 256 : 0)) * 2; }
    __device__ __forceinline__ const char* b_base(const Unit& u) const {
        const int h = (u.pm >> 5) & 3;
        if (mode == 0) return Bb + (size_t)u.pm * 256 * 256 * 2;
        if (mode == 1) return Bb + ((size_t)u.aux * 1024 + h * 256) * 2;
        return Bb + ((size_t)u.pm * 512 + u.pn * 256) * 512 * 2; }
    __device__ __forceinline__ void a_ready(const Unit&) const {}
    __device__ __forceinline__ void done(const Unit&) const {}
};
struct EpiRetA {
    static constexpr bool PERM = true, AFTER_DRAIN = false, KHOOK = false;
    bf16_t* DST;
    __device__ __forceinline__ void operator()(const f32x4 (&acc)[2][2][4][2], const Unit& u, int wr, int wc, int fr, int fq) const {
        bf16_t* base = DST + ((size_t)u.pm * 512 + u.pn * 256) * 256;
        int rb = wr * 64 + fr; asm volatile("" : "+v"(rb));
#pragma unroll
        for (int ai = 0; ai < 2; ++ai)
#pragma unroll
            for (int m = 0; m < 4; ++m) { bf16_t* rp = base + (size_t)(ai * HALF + m * 16 + rb) * 256 + wc * 32 + 8 * fq;
#pragma unroll
                for (int bj = 0; bj < 2; ++bj) *(u32x4*)(rp + bj * HALF) = pack8(acc[ai][bj][m][0], acc[ai][bj][m][1]); }
    }
};
struct EpiRetP {
    static constexpr bool PERM = true, AFTER_DRAIN = false, KHOOK = false;
    bf16_t* AQ;
    __device__ __forceinline__ void operator()(const f32x4 (&acc)[2][2][4][2], const Unit& u, int wr, int wc, int fr, int fq) const {
        const int h = (u.pm >> 5) & 3;
        int rb = wr * 64 + fr; asm volatile("" : "+v"(rb));
#pragma unroll
        for (int ai = 0; ai < 2; ++ai)
#pragma unroll
            for (int m = 0; m < 4; ++m) { const int t = ai * HALF + m * 16 + rb;
#pragma unroll
                for (int bj = 0; bj < 2; ++bj) { const int s0 = bj * HALF + wc * 32 + fq * 8; f32x4 a = acc[ai][bj][m][0], b = acc[ai][bj][m][1];
#pragma unroll
                    for (int e = 0; e < 4; ++e) { if (s0 + e > t) a[e] = 0.f; if (s0 + 4 + e > t) b[e] = 0.f; }
                    *(u32x4*)(AQ + (size_t)(u.aux + t) * 2048 + h * 512 + s0) = pack8(a, b); } }
    }
};
struct EpiRetO {
    static constexpr bool PERM = true, AFTER_DRAIN = false, KHOOK = false;
    const bf16_t* GC; bf16_t* MIX2; float* SS;
    __device__ __forceinline__ void operator()(const f32x4 (&acc)[2][2][4][2], const Unit& u, int wr, int wc, int fr, int fq) const {
        const int h = (u.pm >> 5) & 3;
        int rb = u.aux + wr * 64 + fr; asm volatile("" : "+v"(rb));
#pragma unroll
        for (int ai = 0; ai < 2; ++ai)
#pragma unroll
            for (int m = 0; m < 4; ++m) { const size_t row = (size_t)(rb + ai * HALF + m * 16); float ss = 0.f;
#pragma unroll
                for (int bj = 0; bj < 2; ++bj) { const int col = h * 512 + u.pn * 256 + bj * HALF + wc * 32 + fq * 8; f32x4 a = acc[ai][bj][m][0], b = acc[ai][bj][m][1];
                    ss += (a[0] * a[0] + a[1] * a[1]) + (a[2] * a[2] + a[3] * a[3]) + (b[0] * b[0] + b[1] * b[1]) + (b[2] * b[2] + b[3] * b[3]);
                    const u32x4 g = *(const u32x4*)(GC + row * 2048 + col);
                    a[0] *= __builtin_bit_cast(float, g.x << 16); a[1] *= __builtin_bit_cast(float, g.x & 0xffff0000u); a[2] *= __builtin_bit_cast(float, g.y << 16); a[3] *= __builtin_bit_cast(float, g.y & 0xffff0000u);
                    b[0] *= __builtin_bit_cast(float, g.z << 16); b[1] *= __builtin_bit_cast(float, g.z & 0xffff0000u); b[2] *= __builtin_bit_cast(float, g.w << 16); b[3] *= __builtin_bit_cast(float, g.w & 0xffff0000u);
                    *(u32x4*)(MIX2 + row * 2048 + col) = pack8(a, b); }
                ss += __shfl_xor(ss, 16); ss += __shfl_xor(ss, 32);
                if (fq == 0) atomicAdd(SS + row * 4 + h, ss); }
    }
};

struct SchedSplit {
    const char *A, *Bt; int nN, nP, G, c; size_t lda2, ldb2;
    __device__ __forceinline__ bool next(int i, Unit& u) const { const int L = i * G + c; if (L >= nN * nP) return false; u.pn = L / nP; u.aux = L % nP; u.pm = 0; u.kind = 0; return true; }
    __device__ __forceinline__ const char* a_base(const Unit& u) const { return A + (size_t)u.aux * 512; }
    __device__ __forceinline__ const char* b_base(const Unit& u) const { return Bt + (size_t)u.pn * 256 * ldb2 + (size_t)u.aux * 512; }
    __device__ __forceinline__ void a_ready(const Unit&) const {}
    __device__ __forceinline__ void done(const Unit&) const {}
};
struct EpiSlab {
    static constexpr bool PERM = true, AFTER_DRAIN = false, KHOOK = false;
    bf16_t* slab; int ncols;
    __device__ __forceinline__ void operator()(const f32x4 (&acc)[2][2][4][2], const Unit& u, int wr, int wc, int fr, int fq) const {
        int rb = wr * 64 + fr; asm volatile("" : "+v"(rb));
        bf16_t* base = slab + (size_t)u.aux * 256 * ncols + u.pn * BM + wc * 32 + 8 * fq;
#pragma unroll
        for (int ai = 0; ai < 2; ++ai)
#pragma unroll
            for (int m = 0; m < 4; ++m) { bf16_t* rp = base + (size_t)(rb + ai * HALF + m * 16) * ncols;
#pragma unroll
                for (int bj = 0; bj < 2; ++bj) *(u32x4*)(rp + bj * HALF) = pack8(acc[ai][bj][m][0], acc[ai][bj][m][1]); }
    }
};
struct EpiOut {
    static constexpr bool PERM = false, AFTER_DRAIN = false, KHOOK = true;
    const bf16_t* Y1; float* out; const float* SS;
    __device__ __forceinline__ float rstd(int row, int h) const { return __builtin_amdgcn_rsqf(SS[(size_t)row * 4 + h] * (1.f / 512.f) + 1e-6f); }
    __device__ __forceinline__ void khook(f32x4 (&acc)[2][2][4][2], const Unit& u, int hb, int wr, int fr) const {
        int rb = u.pm * BM + wr * 64 + fr; asm volatile("" : "+v"(rb));
#pragma unroll
        for (int ai = 0; ai < 2; ++ai)
#pragma unroll
            for (int m = 0; m < 4; ++m) { const int row = rb + ai * HALF + m * 16; const float ratio = rstd(row, hb - 1) * __builtin_amdgcn_rcpf(rstd(row, hb));
#pragma unroll
                for (int bj = 0; bj < 2; ++bj)
#pragma unroll
                    for (int n = 0; n < 2; ++n) acc[ai][bj][m][n] = acc[ai][bj][m][n] * ratio; }
    }
    __device__ __forceinline__ void operator()(const f32x4 (&acc)[2][2][4][2], const Unit& u, int wr, int wc, int fr, int fq) const {
        int row0 = u.pm * BM + wr * 64 + fr; asm volatile("" : "+v"(row0));
        const int col0 = u.pn * BM + wc * 32 + 4 * fq;
#pragma unroll
        for (int ai = 0; ai < 2; ++ai)
#pragma unroll
            for (int m = 0; m < 4; ++m) { const int row = row0 + ai * HALF + m * 16; const float r3 = rstd(row, 3);
#pragma unroll
                for (int bj = 0; bj < 2; ++bj)
#pragma unroll
                    for (int n = 0; n < 2; ++n) { const int c = col0 + bj * HALF + n * 16; const unsigned long long yq = *(const unsigned long long*)(Y1 + (size_t)row * 1024 + c);
                        const f32x4 yv = {__builtin_bit_cast(float, (unsigned)yq << 16), __builtin_bit_cast(float, (unsigned)yq & 0xffff0000u), __builtin_bit_cast(float, (unsigned)(yq >> 32) << 16), __builtin_bit_cast(float, (unsigned)(yq >> 32) & 0xffff0000u)};
                        *(f32x4*)(out + (size_t)row * 1024 + c) = acc[ai][bj][m][n] * r3 + yv; } }
    }
};
}
#define GAS __attribute__((address_space(1)))
#define LAS __attribute__((address_space(3)))
typedef unsigned short bf16;
typedef unsigned v4u __attribute__((ext_vector_type(4)));
typedef float f32x4 __attribute__((ext_vector_type(4)));
typedef short bf16x8 __attribute__((ext_vector_type(8)));
typedef GAS unsigned gu32;
typedef GAS unsigned long long gu64;
#define RLX_AGENT __ATOMIC_RELAXED, __HIP_MEMORY_SCOPE_AGENT
#define LDS_WAIT() asm volatile("s_waitcnt lgkmcnt(0)" ::: "memory")
#define VM_WAIT() asm volatile("s_waitcnt vmcnt(0)" ::: "memory")
__device__ __forceinline__ unsigned long long rt() { return __builtin_amdgcn_s_memrealtime(); }
__device__ __forceinline__ unsigned f2bf(float f) { unsigned u = __builtin_bit_cast(unsigned, f); return (u + 0x7fffu + ((u >> 16) & 1u)) >> 16; }
__device__ __forceinline__ unsigned pk2(float lo, float hi) { return f2bf(lo) | (f2bf(hi) << 16); }
#define XB_TMO      128
#define XB_XCNT(j)  (256  + 64 * (j))
#define XB_XSUB(j)  (1280 + 64 * (j))
#define XB_XGEN(j)  (2304 + 64 * (j))
#define XB_TOP      3328
#define XB_TOPGEN   3392
#define XCD_BAR_WORDS 3456
#define XB_SPIN_CAP (1u << 18)

__device__ __forceinline__ unsigned xb_ld(unsigned* p)              { return __hip_atomic_load(p, __ATOMIC_RELAXED, __HIP_MEMORY_SCOPE_AGENT); }
__device__ __forceinline__ unsigned xb_add(unsigned* p, unsigned v) { return __hip_atomic_fetch_add(p, v, __ATOMIC_RELAXED, __HIP_MEMORY_SCOPE_AGENT); }
__device__ __forceinline__ unsigned xb_xcc_id() { return (unsigned)__builtin_amdgcn_s_getreg((3 << 11) | 20) & 0xFu; }
#define XB_SPIN(cond, bar) do { unsigned _sp = 0; while (cond) { __builtin_amdgcn_s_sleep(1); \
    if ((++_sp & 255u) == 0u) { if (xb_ld(&(bar)[XB_TMO])) break; if (_sp > XB_SPIN_CAP) { atomicAdd(&(bar)[XB_TMO], 1u); break; } } } } while (0)

struct XcdBarrier {
    unsigned* bar; unsigned x;
    volatile LAS unsigned* st;
};

__device__ __forceinline__ XcdBarrier xcd_barrier_post(unsigned* bar, volatile LAS unsigned* st) {
    XcdBarrier b; b.bar = bar; b.x = xb_xcc_id(); b.st = st;
    if (threadIdx.x == 0) (void)xb_add(&bar[XB_XCNT(b.x)], 1u);
    return b;
}
__device__ __forceinline__ void xcd_barrier_complete(unsigned* bar, unsigned x, unsigned& nloc, unsigned& nx) {
    const unsigned G = gridDim.x * gridDim.y * gridDim.z;
    unsigned sum, cnt, mine, sp = 0u;
    for (;;) {
        sum = 0u; cnt = 0u; mine = 0u;
#pragma unroll
        for (unsigned j = 0; j < 16; ++j) { const unsigned c = xb_ld(&bar[XB_XCNT(j)]); sum += c; cnt += (c > 0u) ? 1u : 0u; mine = (j == x) ? c : mine; }
        if (sum == G) break;
        __builtin_amdgcn_s_sleep(1);
        if ((++sp & 255u) == 0u) { if (xb_ld(&bar[XB_TMO])) break; if (sp > XB_SPIN_CAP) { atomicAdd(&bar[XB_TMO], 1u); break; } }
    }
    nloc = mine > 0u ? mine : 1u; nx = cnt > 0u ? cnt : 1u;
}

__device__ __forceinline__ void xcd_barrier(const XcdBarrier& b) {
    asm volatile("s_waitcnt vmcnt(0)" ::: "memory");
    __syncthreads();
    if (threadIdx.x == 0) {
        unsigned* bar = b.bar;
        __builtin_amdgcn_s_waitcnt(0);
        unsigned nloc = b.st[0], nx = b.st[1];
        if (nloc == 0u) { xcd_barrier_complete(bar, b.x, nloc, nx); b.st[0] = nloc; b.st[1] = nx; }
        const unsigned old = xb_add(&bar[XB_XSUB(b.x)], 1u);
        const unsigned gen = old / nloc;
        if (old + 1u == (gen + 1u) * nloc) {
            __builtin_amdgcn_fence(__ATOMIC_RELEASE, "agent");
            asm volatile("s_waitcnt vmcnt(0)" ::: "memory");
            const unsigned og = xb_add(&bar[XB_TOP], 1u);
            const unsigned tg = og / nx;
            if (og + 1u == (tg + 1u) * nx) xb_add(&bar[XB_TOPGEN], 1u);
            else XB_SPIN(xb_ld(&bar[XB_TOPGEN]) == tg, bar);
            __builtin_amdgcn_fence(__ATOMIC_ACQUIRE, "agent");
            xb_add(&bar[XB_XGEN(b.x)], 1u);
            asm volatile("s_waitcnt vmcnt(0)" ::: "memory");
        } else {
            XB_SPIN(xb_ld(&bar[XB_XGEN(b.x)]) == gen, bar);
            __builtin_amdgcn_fence(__ATOMIC_ACQUIRE, "agent");
            asm volatile("s_waitcnt vmcnt(0)" ::: "memory");
        }
    }
    __syncthreads();
}
constexpr size_t MiB = 1u << 20;
constexpr size_t WS_CTL = 0, CTL_ZERO_BYTES = 1 * MiB;
constexpr size_t WS_W1T = 2 * MiB;
constexpr size_t WS_W2T = 10 * MiB;
constexpr size_t WS_W3T = 12 * MiB;
constexpr size_t WS_W4T = 24 * MiB;
constexpr size_t WS_RCOS = 28 * MiB, WS_RSIN = 33 * MiB;
constexpr size_t SZ_H = (size_t)MT * 1024 * 2;
constexpr size_t SZ_S = (size_t)MT * 512 * 2;
constexpr size_t WS_H = 40 * MiB;
constexpr size_t WS_QA = WS_H + 33 * MiB, WS_KA = WS_QA + 17 * MiB, WS_VAT = WS_KA + 17 * MiB, WS_GA = WS_VAT + 17 * MiB;
constexpr size_t WS_QB = WS_GA + 17 * MiB, WS_KB = WS_QB + 17 * MiB, WS_VB = WS_KB + 17 * MiB, WS_GB = WS_VB + 17 * MiB;
constexpr size_t WS_LOGF = WS_GB + 17 * MiB;
constexpr size_t WS_OB = WS_LOGF + 33 * MiB;
constexpr size_t WS_MIX = WS_OB + 33 * MiB;
constexpr size_t WS_Y1 = WS_MIX + 33 * MiB;
constexpr size_t WS_QC = WS_Y1 + 65 * MiB, WS_KC = WS_QC + 33 * MiB;
constexpr size_t WS_VC = WS_KC + 33 * MiB, WS_GC = WS_VC + 65 * MiB;
constexpr size_t WS_OC = WS_GC + 65 * MiB;
constexpr size_t WS_MIX2 = WS_OC + 130 * MiB;
constexpr size_t WS_AQ = WS_MIX2 + 65 * MiB;
constexpr size_t WS_KCH = WS_AQ + 64 * MiB;
constexpr size_t WS_KCT = WS_KCH + 32 * MiB;
constexpr size_t WS_BV = WS_KCT + 32 * MiB;
constexpr size_t WS_DST = WS_BV + 128 * MiB;
constexpr size_t WS_RCOST = WS_DST + 128 * MiB, WS_RSINT = WS_RCOST + 5 * MiB;
constexpr size_t WS_DSH = WS_RSINT + 5 * MiB;
constexpr size_t WS_SST = WS_DSH + 16 * MiB;
constexpr size_t WS_DD = WS_SST + 16 * MiB;
constexpr size_t WS_SLAB = WS_DD + 1 * MiB;
constexpr size_t WS_SLAB4 = WS_SLAB + 24 * MiB;
constexpr size_t WS_END = WS_SLAB4 + 8 * MiB;
constexpr size_t CTL_SS = 65536;
constexpr size_t CTL_SS1 = CTL_SS + (size_t)MP * 16;
constexpr size_t CTL_SSS = CTL_SS1 + (size_t)MT * 4;
static_assert(CTL_SSS + 4096 <= CTL_ZERO_BYTES, "SS / SS1 / SSS inside the zeroed region");
static_assert(SZ_H <= 33 * MiB && SZ_S <= 17 * MiB && (size_t)MT * 2048 * 4 <= 130 * MiB, "ws map");

constexpr int CW_TMO = 0, CW_CODE = 1, CW_BAR = 4096;

constexpr int RING_OFF = 0, RING_BYTES = 131072;
constexpr int LDSCTL_OFF = RING_BYTES, MISC_OFF = LDSCTL_OFF + 320;
constexpr int LDS_BYTES = 147456;
constexpr int NWAVES = 8;

typedef float f32x16 __attribute__((ext_vector_type(16)));
__device__ __forceinline__ float bf2f(bf16 b) { return __builtin_bit_cast(float, (unsigned)b << 16); }
__device__ __forceinline__ float bflo(unsigned w) { return __builtin_bit_cast(float, w << 16); }
__device__ __forceinline__ float bfhi(unsigned w) { return __builtin_bit_cast(float, w & 0xffff0000u); }
__device__ __forceinline__ int crow(int r, int hi) { return (r & 3) + 8 * (r >> 2) + 4 * hi; }
__device__ __forceinline__ float wave_sum(float v) {
#pragma unroll
    for (int o = 1; o < 64; o <<= 1) v += __shfl_xor(v, o);
    return v;
}

struct Frame {
    LAS unsigned char* lds;
    volatile LAS unsigned* MISC;
    gu32* ctl;
    int tid, lane, wave, G, bid;
    const float *xp, *xs, *ck, *cv, *st_h, *st_r, *ng, *w1, *w2, *qg, *kg, *sbb, *hlb, *og, *w3, *w4; const int* pt;
    float* out;
    unsigned char* ws;
    __device__ __forceinline__ float* SSS() const { return (float*)(ws + WS_CTL + CTL_SSS); }
    __device__ __forceinline__ float* SS1() const { return (float*)(ws + WS_CTL + CTL_SS1); }
    __device__ __forceinline__ bf16* SLAB() const { return (bf16*)(ws + WS_SLAB); }
    __device__ __forceinline__ bf16* Y1B() const { return (bf16*)(ws + WS_OB); }
    __device__ __forceinline__ bf16* SLAB4() const { return (bf16*)(ws + WS_SLAB4); }
    __device__ __forceinline__ bf16* W1T() const { return (bf16*)(ws + WS_W1T); }
    __device__ __forceinline__ bf16* W2T() const { return (bf16*)(ws + WS_W2T); }
    __device__ __forceinline__ bf16* W3T() const { return (bf16*)(ws + WS_W3T); }
    __device__ __forceinline__ bf16* W4T() const { return (bf16*)(ws + WS_W4T); }
    __device__ __forceinline__ bf16* H() const { return (bf16*)(ws + WS_H); }
    __device__ __forceinline__ bf16* QA() const { return (bf16*)(ws + WS_QA); }
    __device__ __forceinline__ bf16* KA() const { return (bf16*)(ws + WS_KA); }
    __device__ __forceinline__ bf16* VAT() const { return (bf16*)(ws + WS_VAT); }
    __device__ __forceinline__ bf16* VA() const { return (bf16*)(ws + WS_VAT); }
    __device__ __forceinline__ bf16* GA() const { return (bf16*)(ws + WS_GA); }
    __device__ __forceinline__ bf16* QB() const { return (bf16*)(ws + WS_QB); }
    __device__ __forceinline__ bf16* KB() const { return (bf16*)(ws + WS_KB); }
    __device__ __forceinline__ bf16* VB() const { return (bf16*)(ws + WS_VB); }
    __device__ __forceinline__ bf16* GB() const { return (bf16*)(ws + WS_GB); }
    __device__ __forceinline__ bf16* MIX() const { return (bf16*)(ws + WS_MIX); }
    __device__ __forceinline__ bf16* QC() const { return (bf16*)(ws + WS_QC); }
    __device__ __forceinline__ bf16* KC() const { return (bf16*)(ws + WS_KC); }
    __device__ __forceinline__ bf16* VC() const { return (bf16*)(ws + WS_VC); }
    __device__ __forceinline__ bf16* GC() const { return (bf16*)(ws + WS_GC); }
    __device__ __forceinline__ bf16* MIX2() const { return (bf16*)(ws + WS_MIX2); }
    __device__ __forceinline__ float* RCOS() const { return (float*)(ws + WS_RCOS); }
    __device__ __forceinline__ float* RSIN() const { return (float*)(ws + WS_RSIN); }
    __device__ __forceinline__ float* LOGF() const { return (float*)(ws + WS_LOGF); }
    __device__ __forceinline__ float* OB() const { return (float*)(ws + WS_OB); }
    __device__ __forceinline__ float* Y1() const { return (float*)(ws + WS_Y1); }
    __device__ __forceinline__ float* OC() const { return (float*)(ws + WS_OC); }
    __device__ __forceinline__ bf16* AQ() const { return (bf16*)(ws + WS_AQ); }
    __device__ __forceinline__ bf16* KCH() const { return (bf16*)(ws + WS_KCH); }
    __device__ __forceinline__ bf16* KCT() const { return (bf16*)(ws + WS_KCT); }
    __device__ __forceinline__ bf16* BV() const { return (bf16*)(ws + WS_BV); }
    __device__ __forceinline__ float* DST() const { return (float*)(ws + WS_DST); }
    __device__ __forceinline__ float* RCOST() const { return (float*)(ws + WS_RCOST); }
    __device__ __forceinline__ float* RSINT() const { return (float*)(ws + WS_RSINT); }
    __device__ __forceinline__ float* SS() const { return (float*)(ws + WS_CTL + CTL_SS); }
    __device__ __forceinline__ float* DSH() const { return (float*)(ws + WS_DSH); }
    __device__ __forceinline__ float* SST() const { return (float*)(ws + WS_SST); }
    __device__ __forceinline__ float* DD() const { return (float*)(ws + WS_DD); }
};

template <bool HP>
__device__ __forceinline__ void p0_transpose_item(const float* W, int K, int N, bf16* WT, LAS float* scr, int item, int lane, const float* gk = nullptr) {
    const int nblk = N / 32, kb = item / nblk, nb = item % nblk, k0 = 64 * kb, n0 = 32 * nb;
#pragma unroll 8
    for (int i = 0; i < 32; ++i) { const int kk = 2 * i + (lane >> 5); float w = W[(size_t)(k0 + kk) * N + n0 + (lane & 31)]; if (gk) w *= gk[k0 + kk]; scr[kk * 33 + (lane & 31)] = w; }
    LDS_WAIT(); asm volatile("" ::: "memory");
    const int c = lane & 7;
#pragma unroll
    for (int j = 0; j < 4; ++j) { const int n = (lane >> 3) + 8 * j; const LAS float* s = scr + (8 * c) * 33 + n;
        v4u o; o.x = pk2(s[0 * 33], s[1 * 33]); o.y = pk2(s[2 * 33], s[3 * 33]); o.z = pk2(s[4 * 33], s[5 * 33]); o.w = pk2(s[6 * 33], s[7 * 33]);
        int ca = n0 + n;
        if (HP) ca = (ca & ~255) | (((ca >> 5) & 1) << 7) | (((ca >> 6) & 3) << 5) | (ca & 31);
        *(GAS v4u*)(WT + (size_t)ca * K + k0 + 8 * c) = o; }
    LDS_WAIT(); asm volatile("" ::: "memory");
}
__device__ __forceinline__ void rms_row_to_bf16(int lane, const float* xrow, const float* g, bf16* orow) {
    const GAS f32x4* xr = (const GAS f32x4*)xrow + lane;
    f32x4 v[4]; float s2 = 0.f;
#pragma unroll
    for (int j = 0; j < 4; ++j) { v[j] = xr[64 * j]; s2 += (v[j].x * v[j].x + v[j].y * v[j].y) + (v[j].z * v[j].z + v[j].w * v[j].w); }
    const float rstd = 1.f / sqrtf(wave_sum(s2) * (1.f / 1024.f) + EPS);
    GAS unsigned long long* o8 = (GAS unsigned long long*)orow + lane;
#pragma unroll
    for (int j = 0; j < 4; ++j) { const f32x4 gv = *((const GAS f32x4*)g + lane + 64 * j);
        o8[64 * j] = (unsigned long long)pk2(v[j].x * rstd * gv.x, v[j].y * rstd * gv.y) | ((unsigned long long)pk2(v[j].z * rstd * gv.z, v[j].w * rstd * gv.w) << 32); }
}
__device__ __forceinline__ void sincos_acc(float a, float& s, float& c) {
    const double x = (double)a;
    const double kd = __builtin_rint(x * 0.63661977236758134308);
    const double r = (x - kd * 1.57079632673412561417e+00) - kd * 6.07710050650619224932e-11;
    const double r2 = r * r;
    const double sp = r * (1.0 + r2 * (-1.66666666666666324348e-01 + r2 * (8.33333333332248946124e-03 + r2 * (-1.98412698298579493134e-04 + r2 * (2.75573137070700676789e-06 + r2 * (-2.50507602534068634195e-08 + r2 * 1.58969099521155010221e-10))))));
    const double cp = 1.0 + r2 * (-0.5 + r2 * (4.16666666666666019037e-02 + r2 * (-1.38888888888741095749e-03 + r2 * (2.48015872894767294178e-05 + r2 * (-2.75573143513906633035e-07 + r2 * (2.08757232129817482790e-09 + r2 * -1.13596475577881948265e-11))))));
    const int q = (int)((long long)kd & 3);
    const double sv = (q & 1) ? cp : sp, cv = (q & 1) ? sp : cp;
    s = (float)((q & 2) ? -sv : sv);
    c = (float)(((q + 1) & 2) ? -cv : cv);
}
__device__ __forceinline__ void p0_prologue(Frame& F) {
    LAS float* scr = (LAS float*)(F.lds + RING_OFF + F.wave * 16384);
    const int gw = F.bid * NWAVES + F.wave, NGW = F.G * NWAVES;
    constexpr int I1 = (1024 / 64) * (N1 / 32), I2 = (1024 / 64) * (1024 / 32), I3 = (1024 / 64) * (N3 / 32), I4 = (2048 / 64) * (1024 / 32);
    for (int it = gw; it < I1 + I2 + I3 + I4; it += NGW) {
        int r = it;
        if (r < I1) { p0_transpose_item<true>(F.w1, 1024, N1, F.W1T(), scr, r, F.lane); continue; } r -= I1;
        if (r < I2) { p0_transpose_item<false>(F.w2, 1024, 1024, F.W2T(), scr, r, F.lane); continue; } r -= I2;
        if (r < I3) { p0_transpose_item<false>(F.w3, 1024, N3, F.W3T(), scr, r, F.lane, F.ng + 1024); continue; } r -= I3;
        p0_transpose_item<false>(F.w4, 2048, 1024, F.W4T(), scr, r, F.lane);
    }
    for (int m = gw; m < MT; m += NGW) rms_row_to_bf16(F.lane, (m < MP) ? F.xp + (size_t)m * DM : F.xs + (size_t)(m - MP) * DM, F.ng, F.H() + (size_t)m * DM);
    const int ri = F.tid & 127;
    const float rinv = (float)(1.0 / exp2((double)((float)ri / 127.0f) * 13.287712379549449));
    for (int e = F.bid * (NWAVES * 64) + F.tid; e < (PAST + TSQ) * 128; e += F.G * NWAVES * 64) {
        const int pos = e >> 7, i = ri;
        const float inv = rinv;
        const float ang = (float)pos * inv;
        float s, c; sincos_acc(ang, s, c);
        F.RCOS()[e] = c; F.RSIN()[e] = s; F.RCOST()[(size_t)i * 8200 + pos] = c; F.RSINT()[(size_t)i * 8200 + pos] = s;
    }
}

__device__ __forceinline__ void sb_tile(f32x16& p0, f32x16& p1, float& carry, int hi, int kb0, int qpos, bool need_mask, v4u (&pw)[4]) {
#pragma unroll
    for (int r = 0; r < 16; ++r) {
        float b0 = __builtin_amdgcn_rcpf(1.f + __builtin_amdgcn_exp2f(p0[r]));
        float b1 = __builtin_amdgcn_rcpf(1.f + __builtin_amdgcn_exp2f(p1[r]));
        if (need_mask) { if (kb0 + r >= qpos) b0 = 0.f; if (kb0 + 32 + r >= qpos) b1 = 0.f; }
        p0[r] = b0; p1[r] = b1;
    }
    float s0 = 1.f, s1 = 1.f;
#pragma unroll
    for (int r = 15; r >= 0; --r) {
        const float b0 = p0[r], b1 = p1[r];
        p0[r] = b0 * s0; p1[r] = b1 * s1;
        s0 = __builtin_fmaf(-s0, b0, s0); s1 = __builtin_fmaf(-s1, b1, s1);
    }
    float t0, t1;
    {
      auto a = __builtin_amdgcn_permlane32_swap(__float_as_uint(s0), __float_as_uint(s0), false, false);
      auto b = __builtin_amdgcn_permlane32_swap(__float_as_uint(s1), __float_as_uint(s1), false, false);
      t0 = hi ? __uint_as_float(a[0]) : __uint_as_float(a[1]); t1 = hi ? __uint_as_float(b[0]) : __uint_as_float(b[1]); }
    const float pre1 = hi ? carry : carry * t1;
    const float pre0 = hi ? carry * s1 * t1 : carry * t1 * s1 * t0;
    carry = carry * ((s0 * s1) * (t0 * t1));
#pragma unroll
    for (int r = 0; r < 16; ++r) { p0[r] *= pre0; p1[r] *= pre1; }
    pw[0] = (v4u){pg8::cvt_pk_bf16(p0[0], p0[1]), pg8::cvt_pk_bf16(p0[2], p0[3]), pg8::cvt_pk_bf16(p0[4], p0[5]), pg8::cvt_pk_bf16(p0[6], p0[7])};
    pw[1] = (v4u){pg8::cvt_pk_bf16(p0[8], p0[9]), pg8::cvt_pk_bf16(p0[10], p0[11]), pg8::cvt_pk_bf16(p0[12], p0[13]), pg8::cvt_pk_bf16(p0[14], p0[15])};
    pw[2] = (v4u){pg8::cvt_pk_bf16(p1[0], p1[1]), pg8::cvt_pk_bf16(p1[2], p1[3]), pg8::cvt_pk_bf16(p1[4], p1[5]), pg8::cvt_pk_bf16(p1[6], p1[7])};
    pw[3] = (v4u){pg8::cvt_pk_bf16(p1[8], p1[9]), pg8::cvt_pk_bf16(p1[10], p1[11]), pg8::cvt_pk_bf16(p1[12], p1[13]), pg8::cvt_pk_bf16(p1[14], p1[15])};
}
typedef float f32x2v __attribute__((ext_vector_type(2)));
__device__ __forceinline__ void sb_tile2(f32x16& p0, f32x16& p1, float& carry, int hi, int kb0, int qpos, bool need_mask, v4u (&pw)[4]) {
#pragma unroll
    for (int r = 0; r < 16; ++r) { p0[r] = __builtin_amdgcn_exp2f(p0[r]); p1[r] = __builtin_amdgcn_exp2f(p1[r]); }
#define SB_INV4(P, j0) do { const f32x2v ea_ = {P[2 * (j0)], P[2 * (j0) + 1]}, eb_ = {P[2 * (j0) + 2], P[2 * (j0) + 3]}, ec_ = {P[2 * (j0) + 4], P[2 * (j0) + 5]}, ed_ = {P[2 * (j0) + 6], P[2 * (j0) + 7]}; \
        const f32x2v b_ = eb_ + (f32x2v){1.f, 1.f}; const f32x2v ab_ = ea_ * b_ + b_, abc_ = ab_ * ec_ + ab_, abcd_ = abc_ * ed_ + abc_; \
        f32x2v R_ = {__builtin_amdgcn_rcpf(abcd_.x), __builtin_amdgcn_rcpf(abcd_.y)}; \
        const f32x2v id_ = R_ * abc_; R_ = R_ * ed_ + R_; const f32x2v ic_ = R_ * ab_; R_ = R_ * ec_ + R_; const f32x2v ib_ = R_ * ea_ + R_, ia_ = R_ * b_; \
        P[2 * (j0)] = ia_.x; P[2 * (j0) + 1] = ia_.y; P[2 * (j0) + 2] = ib_.x; P[2 * (j0) + 3] = ib_.y; P[2 * (j0) + 4] = ic_.x; P[2 * (j0) + 5] = ic_.y; P[2 * (j0) + 6] = id_.x; P[2 * (j0) + 7] = id_.y; } while (0)
    SB_INV4(p0, 0); SB_INV4(p1, 0); SB_INV4(p0, 4); SB_INV4(p1, 4);
#undef SB_INV4
    if (need_mask) {
        asm volatile("" ::: "memory");
#pragma unroll
        for (int r = 0; r < 16; ++r) { const int kk = kb0 + 8 * (1 - (r & 1)) + (r >> 1); if (kk >= qpos) p0[r] = 0.f; if (kk + 32 >= qpos) p1[r] = 0.f; }
    }
    f32x2v s0 = {1.f, 1.f}, s1 = {1.f, 1.f};
#pragma unroll
    for (int k = 7; k >= 0; --k) {
        const f32x2v b0 = {p0[2 * k], p0[2 * k + 1]}, b1 = {p1[2 * k], p1[2 * k + 1]};
        const f32x2v w0 = b0 * s0, w1 = b1 * s1;
        s0 = s0 - s0 * b0; s1 = s1 - s1 * b1;
        p0[2 * k] = w0.x; p0[2 * k + 1] = w0.y; p1[2 * k] = w1.x; p1[2 * k + 1] = w1.y;
    }
    const float a0 = s0.x * s0.y, a1 = s1.x * s1.y;
    float t0, t1;
    { auto a = __builtin_amdgcn_permlane32_swap(__float_as_uint(a0), __float_as_uint(a0), false, false);
      auto b = __builtin_amdgcn_permlane32_swap(__float_as_uint(a1), __float_as_uint(a1), false, false);
      t0 = hi ? __uint_as_float(a[0]) : __uint_as_float(a[1]); t1 = hi ? __uint_as_float(b[0]) : __uint_as_float(b[1]); }
    const float pre1 = hi ? carry : carry * t1;
    const float pre0 = hi ? carry * a1 * t1 : carry * t1 * a1 * t0;
    carry = carry * ((a0 * a1) * (t0 * t1));
    const f32x2v q0 = {pre0, pre0 * s0.x}, q1 = {pre1, pre1 * s1.x};
#pragma unroll
    for (int k = 0; k < 8; ++k) { const f32x2v w0 = (f32x2v){p0[2 * k], p0[2 * k + 1]} * q0, w1 = (f32x2v){p1[2 * k], p1[2 * k + 1]} * q1;
        p0[2 * k] = w0.x; p0[2 * k + 1] = w0.y; p1[2 * k] = w1.x; p1[2 * k + 1] = w1.y; }
    pw[0] = (v4u){pg8::cvt_pk_bf16(p0[1], p0[3]), pg8::cvt_pk_bf16(p0[5], p0[7]), pg8::cvt_pk_bf16(p0[9], p0[11]), pg8::cvt_pk_bf16(p0[13], p0[15])};
    pw[1] = (v4u){pg8::cvt_pk_bf16(p0[0], p0[2]), pg8::cvt_pk_bf16(p0[4], p0[6]), pg8::cvt_pk_bf16(p0[8], p0[10]), pg8::cvt_pk_bf16(p0[12], p0[14])};
    pw[2] = (v4u){pg8::cvt_pk_bf16(p1[1], p1[3]), pg8::cvt_pk_bf16(p1[5], p1[7]), pg8::cvt_pk_bf16(p1[9], p1[11]), pg8::cvt_pk_bf16(p1[13], p1[15])};
    pw[3] = (v4u){pg8::cvt_pk_bf16(p1[0], p1[2]), pg8::cvt_pk_bf16(p1[4], p1[6]), pg8::cvt_pk_bf16(p1[8], p1[10]), pg8::cvt_pk_bf16(p1[12], p1[14])};
}
#define MFMA32(a, b, c) __builtin_amdgcn_mfma_f32_32x32x16_bf16((a), (b), (c), 0, 0, 0)
__device__ __forceinline__ f32x16 splat16(float v) { f32x16 r;
#pragma unroll
    for (int i = 0; i < 16; ++i) r[i] = v; return r; }

__device__ __forceinline__ bf16x8 cvt8(const f32x4 a, const f32x4 b) { return __builtin_bit_cast(bf16x8, pg8::pack8(a, b)); }

__device__ __forceinline__ void ret_passB(Frame& F) {
    for (int e = F.bid * (NWAVES * 64) + F.tid; e < 8 * 512 * 32; e += F.G * NWAVES * 64) {
        const int bh = e >> 14, dv = (e >> 5) & 511, dk8 = (e & 31) * 8, h = bh & 3;
        const float lg = pg8::lg2gamma(h), g1 = 1.f - __builtin_amdgcn_exp2f(-5.f - (float)h), g255 = __builtin_amdgcn_exp2f(255.f * lg), g256 = __builtin_amdgcn_exp2f(256.f * lg);
        f32x4 S0 = {0.f, 0.f, 0.f, 0.f}, S1 = {0.f, 0.f, 0.f, 0.f};
        for (int c0 = 0; c0 < 32; c0 += 16) {
            v4u dq[16];
#pragma unroll
            for (int j = 0; j < 16; ++j) dq[j] = *(const v4u*)((const bf16*)F.DST() + ((size_t)(bh * 32 + c0 + j) * 512 + dv) * 256 + dk8);
#pragma unroll
            for (int j = 0; j < 16; ++j) { const size_t ro = (size_t)(bh * 32 + c0 + j) * 512 + dv;
                const f32x4 d0 = {bflo(dq[j][0]), bfhi(dq[j][0]), bflo(dq[j][1]), bfhi(dq[j][1])}, d1 = {bflo(dq[j][2]), bfhi(dq[j][2]), bflo(dq[j][3]), bfhi(dq[j][3])};
                *(pg8::u32x4*)(F.BV() + ro * 512 + 256 + dk8) = pg8::pack8(S0 * g1, S1 * g1);
                S0 = S0 * g256 + d0 * g255; S1 = S1 * g256 + d1 * g255; }
        }
        float* so = F.out + ORT_P + ((size_t)bh * 256 + dk8) * 512 + dv;
#pragma unroll
        for (int i = 0; i < 4; ++i) { so[(size_t)i * 512] = S0[i]; so[(size_t)(i + 4) * 512] = S1[i]; }
    }
}

typedef unsigned u32x2 __attribute__((ext_vector_type(2)));
constexpr int HQ_STR = 136, HT_STR = 72;
constexpr int H_QT = 0, H_KH = 17408, H_KHT = 34816, H_VT = 53248, H_PP = 71680, H_CS = 80896, H_RR = 82944, H_A63 = 83456, H_C63 = 83968, H_SSQ = 84480;
#define MFMA16(a, b, c) __builtin_amdgcn_mfma_f32_16x16x32_bf16((a), (b), (c), 0, 0, 0)
__device__ __forceinline__ void hgrn_passB(Frame& F) {
    const int vb = (F.bid + F.G / 2) % F.G;
    for (int e = vb * (NWAVES * 64) + F.tid; e < 8 * 128 * 32; e += F.G * NWAVES * 64) {
        const int bh = e >> 12, dk = (e >> 5) & 127, dv4 = (e & 31) * 4;
        f32x4 S = {0.f, 0.f, 0.f, 0.f};
        for (int s0 = 0; s0 < 32; s0 += 16) {
            f32x4 dv[16]; float dd[16];
#pragma unroll
            for (int j = 0; j < 16; ++j) { dv[j] = *(const f32x4*)(F.DSH() + ((size_t)(bh * 32 + s0 + j) * 128 + dk) * 128 + dv4); dd[j] = F.DD()[(size_t)(bh * 32 + s0 + j) * 128 + dk]; }
#pragma unroll
            for (int j = 0; j < 16; ++j) { *(f32x4*)(F.SST() + ((size_t)(bh * 32 + s0 + j) * 128 + dk) * 128 + dv4) = S; S = S * __expf(dd[j]) + dv[j]; }
        }
        *(f32x4*)(F.out + OHG_P + ((size_t)bh * 128 + dk) * 128 + dv4) = S;
    }
}

__device__ __forceinline__ void ret_sample_unit(Frame& F, int s, int h, int vhalf) {
    const int tid = F.tid, v = tid & 255, kh = tid >> 8, col = vhalf * 256 + v;
    LAS float* QL = (LAS float*)(F.lds + RING_OFF);
    LAS float* KL = QL + 8 * 256;
    LAS float* OP = KL + 8 * 256;
    const size_t row0 = (size_t)MP + s * 8;
    for (int e = tid; e < 8 * 256; e += NWAVES * 64) { const int t = e >> 8, kk = e & 255;
        QL[e] = bf2f(F.QC()[(row0 + t) * 1024 + h * 256 + kk]); KL[e] = bf2f(F.KC()[(row0 + t) * 1024 + h * 256 + kk]); }
    float vt[8];
#pragma unroll
    for (int t = 0; t < 8; ++t) vt[t] = bf2f(F.VC()[(row0 + t) * 2048 + h * 512 + col]);
    const float gamma = 1.f - __builtin_amdgcn_exp2f(-5.f - (float)h);
    float S[128];
    const float* s0 = F.st_r + (((size_t)s * HC + h) * DKC + kh * 128) * DVC + col;
#pragma unroll
    for (int i = 0; i < 128; ++i) S[i] = s0[(size_t)i * DVC];
    __syncthreads();
    float o[8];
#pragma unroll
    for (int t = 0; t < 8; ++t) {
        float acc = 0.f;
#pragma unroll
        for (int i4 = 0; i4 < 32; ++i4) {
            const f32x4 kq = *(const LAS f32x4*)(KL + t * 256 + kh * 128 + 4 * i4), qq = *(const LAS f32x4*)(QL + t * 256 + kh * 128 + 4 * i4);
#pragma unroll
            for (int j = 0; j < 4; ++j) { S[4 * i4 + j] = gamma * S[4 * i4 + j] + kq[j] * vt[t]; acc += qq[j] * S[4 * i4 + j]; }
        }
        o[t] = acc;
    }
#pragma unroll
    for (int t = 0; t < 8; ++t) OP[(kh * 8 + t) * 256 + v] = o[t];
    float* so = F.out + ORT_S + (((size_t)s * HC + h) * DKC + kh * 128) * DVC + col;
#pragma unroll
    for (int i = 0; i < 128; ++i) so[(size_t)i * DVC] = S[i];
    __syncthreads();
    for (int e = tid; e < 8 * 256; e += NWAVES * 64) {
        const int t = e >> 8, vv = e & 255; const float ov = OP[e] + OP[8 * 256 + e];
        const size_t gi = (row0 + t) * 2048 + h * 512 + vhalf * 256 + vv;
        F.MIX2()[gi] = pg8::bf1(ov * bf2f(F.GC()[gi]));
        const float sq = wave_sum(ov * ov);
        if (F.lane == 0) atomicAdd(F.SSS() + (s * 8 + t) * 4 + h, sq);
    }
    __syncthreads();
}
__device__ __forceinline__ void hgrn_sample_unit(Frame& F, int s, int h) {
    const int tid = F.tid, v = tid & 127, kq = tid >> 7;
    LAS float* FL = (LAS float*)(F.lds + RING_OFF);
    LAS float* KL = FL + 8 * 128; LAS float* QL = KL + 8 * 128; LAS float* OP = QL + 8 * 128;
    const size_t row0 = (size_t)MP + s * 8;
    for (int e = tid; e < 8 * 128; e += NWAVES * 64) { const int t = e >> 7, kk = e & 127; const size_t gi = (row0 + t) * 512 + h * 128 + kk;
        FL[e] = __expf(F.LOGF()[gi]); KL[e] = bf2f(F.KB()[gi]); QL[e] = bf2f(F.QB()[gi]); }
    float vt[8];
#pragma unroll
    for (int t = 0; t < 8; ++t) vt[t] = bf2f(F.VB()[(row0 + t) * 512 + h * 128 + v]);
    float S[32];
    const float* s0 = F.st_h + (((size_t)s * HB + h) * DKB + kq * 32) * DVB + v;
#pragma unroll
    for (int i = 0; i < 32; ++i) S[i] = s0[(size_t)i * DVB];
    __syncthreads();
#pragma unroll
    for (int t = 0; t < 8; ++t) {
        float acc = 0.f;
#pragma unroll
        for (int i4 = 0; i4 < 8; ++i4) {
            const f32x4 ff = *(const LAS f32x4*)(FL + t * 128 + kq * 32 + 4 * i4), kk = *(const LAS f32x4*)(KL + t * 128 + kq * 32 + 4 * i4), qq = *(const LAS f32x4*)(QL + t * 128 + kq * 32 + 4 * i4);
#pragma unroll
            for (int j = 0; j < 4; ++j) { S[4 * i4 + j] = ff[j] * S[4 * i4 + j] + kk[j] * vt[t]; acc += qq[j] * S[4 * i4 + j]; }
        }
        OP[(kq * 8 + t) * 128 + v] = acc;
    }
    float* so = F.out + OHG_S + (((size_t)s * HB + h) * DKB + kq * 32) * DVB + v;
#pragma unroll
    for (int i = 0; i < 32; ++i) so[(size_t)i * DVB] = S[i];
    __syncthreads();
    {
        const int t = F.wave, c0 = 2 * F.lane;
        float a = 0.f, b = 0.f;
#pragma unroll
        for (int q4 = 0; q4 < 4; ++q4) { a += OP[(q4 * 8 + t) * 128 + c0]; b += OP[(q4 * 8 + t) * 128 + c0 + 1]; }
        const float rstd = 1.f / sqrtf(wave_sum(a * a + b * b) * (1.f / 128.f) + EPS);
        const size_t row = row0 + t;
        const unsigned gt = *(const unsigned*)(F.GB() + row * 512 + h * 128 + c0);
        *(unsigned*)(F.MIX() + row * 1024 + 512 + h * 128 + c0) = pg8::cvt_pk_bf16(a * rstd * F.og[c0] * bflo(gt), b * rstd * F.og[c0 + 1] * bfhi(gt));
    }
    __syncthreads();
}

constexpr int AT_K = 0, AT_V = 24576, AT_O = 49152, AT_SLOT = 8192;
__device__ __forceinline__ void glds16(const void* gsrc, unsigned lds_dst) { unsigned keep;
    asm volatile("s_mov_b32 %0, m0\n\ts_mov_b32 m0, %2\n\ts_nop 0\n\tglobal_load_lds_dwordx4 %1, off\n\ts_mov_b32 m0, %0" : "=&s"(keep) : "v"(gsrc), "s"(lds_dst) : "memory"); }
typedef short v4i16_t __attribute__((ext_vector_type(4)));
__device__ __forceinline__ v4i16_t vtr(const LAS unsigned char* p) { return __builtin_amdgcn_ds_read_tr16_b64_v4i16((LAS v4i16_t*)p); }

__device__ __forceinline__ void bf8_add(const bf16* p, f32x4& a, f32x4& b) { const v4u w = *(const v4u*)p; a[0] += bflo(w[0]); a[1] += bfhi(w[0]); a[2] += bflo(w[1]); a[3] += bfhi(w[1]); b[0] += bflo(w[2]); b[1] += bfhi(w[2]); b[2] += bflo(w[3]); b[3] += bfhi(w[3]); }
__device__ __forceinline__ void slab_sum8(const bf16* slab, int nparts, size_t pstride, size_t off, f32x4& a, f32x4& b) {
    a = (f32x4){0.f, 0.f, 0.f, 0.f}; b = a;
    for (int p = 0; p < nparts; ++p) bf8_add(slab + p * pstride + off, a, b);
}
__device__ __forceinline__ void pp1_item(Frame& F, int item) {
    const int r = item >> 3, gi = item & 7, lane = F.lane, c = lane * 8, a0 = gi * 512 + c;
    const int g0 = (a0 & ~255) | (((a0 >> 5) & 1) << 7) | (((a0 >> 6) & 3) << 5) | (a0 & 31);
    f32x4 x, y; slab_sum8(F.SLAB(), 4, (size_t)256 * N1, (size_t)r * N1 + g0, x, y);
    const size_t row = (size_t)MP + r;
    if (gi <= 1) {
        float ss = (x[0] * x[0] + x[1] * x[1]) + (x[2] * x[2] + x[3] * x[3]) + (y[0] * y[0] + y[1] * y[1]) + (y[2] * y[2] + y[3] * y[3]);
        ss += __shfl_xor(ss, 1); ss += __shfl_xor(ss, 2); ss += __shfl_xor(ss, 4);
        const float rstd = __builtin_amdgcn_rsqf(ss * (1.f / 64.f) + EPS) * (gi == 0 ? -0.125f * LOG2E : 1.f);
        const float* g = (gi == 0 ? F.qg : F.kg) + (c & 63);
        x = x * *(const f32x4*)g * rstd; y = y * *(const f32x4*)(g + 4) * rstd;
        if (gi == 0) *(pg8::u32x4*)(F.QA() + row * 512 + c) = pg8::pack8(x, y);
        else { *(pg8::u32x4*)(F.KA() + row * 512 + c) = pg8::pack8(x, y); float* ko = F.out + OK_S + (size_t)r * 512 + c; *(f32x4*)ko = x; *(f32x4*)(ko + 4) = y; }
    } else if (gi == 2) {
        *(pg8::u32x4*)(F.VA() + row * 512 + c) = pg8::pack8(x, y); float* vo = F.out + OV_S + (size_t)r * 512 + c; *(f32x4*)vo = x; *(f32x4*)(vo + 4) = y;
    } else if (gi == 5) {
        f32x4 lf0, lf1, k0, k1;
#pragma unroll
        for (int e = 0; e < 8; ++e) { const int cc = c + e; const float lb = __builtin_amdgcn_rcpf(1.f + __expf(F.hlb[512 + cc] - F.hlb[cc])); const float v = e < 4 ? x[e & 3] : y[e & 3];
            const float sg = pg8::sigm_f(v); const float lf = __logf(lb + (1.f - lb) * sg), kk = (1.f - lb) * (1.f - sg);
            if (e < 4) { lf0[e & 3] = lf; k0[e & 3] = kk; } else { lf1[e & 3] = lf; k1[e & 3] = kk; } }
        *(f32x4*)(F.LOGF() + row * 512 + c) = lf0; *(f32x4*)(F.LOGF() + row * 512 + c + 4) = lf1;
        *(pg8::u32x4*)(F.KB() + row * 512 + c) = pg8::pack8(k0, k1);
    } else {
        bf16* dst = (gi == 3) ? F.GA() : (gi == 4) ? F.QB() : (gi == 6) ? F.VB() : F.GB();
        if (gi != 6) {
#pragma unroll
            for (int e = 0; e < 4; ++e) { x[e] = pg8::silu_f(x[e]); y[e] = pg8::silu_f(y[e]); } }
        *(pg8::u32x4*)(dst + row * 512 + c) = pg8::pack8(x, y);
    }
}
__device__ __forceinline__ void pp2_row(Frame& F, int r) {
    const int lane = F.lane; f32x4 v[4]; float s2 = 0.f;
#pragma unroll
    for (int j = 0; j < 2; ++j) { const int c = 8 * lane + 512 * j; f32x4 a, b2; slab_sum8(F.SLAB(), 4, (size_t)256 * 1024, (size_t)r * 1024 + c, a, b2);
        a += *(const f32x4*)(F.xs + (size_t)r * DM + c); b2 += *(const f32x4*)(F.xs + (size_t)r * DM + c + 4);
        *(f32x4*)(F.Y1() + ((size_t)MP + r) * DM + c) = a; *(f32x4*)(F.Y1() + ((size_t)MP + r) * DM + c + 4) = b2;
        s2 += (a[0] * a[0] + a[1] * a[1]) + (a[2] * a[2] + a[3] * a[3]) + (b2[0] * b2[0] + b2[1] * b2[1]) + (b2[2] * b2[2] + b2[3] * b2[3]);
        v[2 * j] = a; v[2 * j + 1] = b2; }
    s2 = wave_sum(s2); if (lane == 0) F.SS1()[MP + r] = s2;
#pragma unroll
    for (int j = 0; j < 2; ++j) { const int c = 8 * lane + 512 * j;
        *(pg8::u32x4*)(F.H() + ((size_t)MP + r) * DM + c) = pg8::pack8(v[2 * j], v[2 * j + 1]); }
}
__device__ __forceinline__ void pp3_item(Frame& F, int item) {
    const int r = item / 24, pn = item % 24, lane = F.lane; const size_t row = (size_t)MP + r;
    if (lane >= 32) return;
    const size_t off = (size_t)r * N3 + pn * 256, ps = (size_t)256 * N3;
    const float rs = __builtin_amdgcn_rsqf(F.SS1()[MP + r] * (1.f / 1024.f) + EPS);
    if (pn < 8) {
        const int j = 8 * (lane & 15), up = lane >> 4;
        f32x4 x1a, x1b, x2a, x2b; slab_sum8(F.SLAB(), 4, ps, off + j, x1a, x1b); slab_sum8(F.SLAB(), 4, ps, off + 128 + j, x2a, x2b);
        const int pos = PAST + (r & 7);
        const f32x4 ca = *(const f32x4*)(F.RCOS() + (size_t)pos * 128 + j), cb = *(const f32x4*)(F.RCOS() + (size_t)pos * 128 + j + 4), sa = *(const f32x4*)(F.RSIN() + (size_t)pos * 128 + j), sb = *(const f32x4*)(F.RSIN() + (size_t)pos * 128 + j + 4);
        const float sc = rs * (pn < 4 ? 1.f : 0.0625f);
        const f32x4 oa = (up ? (x2a * ca + x1a * sa) : (x1a * ca - x2a * sa)) * sc, ob = (up ? (x2b * cb + x1b * sb) : (x1b * cb - x2b * sb)) * sc;
        *(pg8::u32x4*)((pn < 4 ? F.QC() : F.KC()) + row * 1024 + (pn & 3) * 256 + up * 128 + j) = pg8::pack8(oa, ob);
    } else {
        const int j = 8 * lane; f32x4 xa, xb; slab_sum8(F.SLAB(), 4, ps, off + j, xa, xb);
        xa = xa * rs; xb = xb * rs;
        const bool isg = pn >= 16;
        if (isg) {
#pragma unroll
            for (int e = 0; e < 4; ++e) { xa[e] = pg8::silu_f(xa[e]); xb[e] = pg8::silu_f(xb[e]); } }
        *(pg8::u32x4*)((isg ? F.GC() : F.VC()) + row * 2048 + ((pn - 8) & 7) * 256 + j) = pg8::pack8(xa, xb);
    }
}
__device__ __forceinline__ void pp4_row(Frame& F, int r) {
    float rs[4];
#pragma unroll
    for (int hh = 0; hh < 4; ++hh) rs[hh] = __builtin_amdgcn_rsqf(F.SSS()[r * 4 + hh] * (1.f / 512.f) + EPS);
#pragma unroll
    for (int j = 0; j < 2; ++j) { const int c = 8 * F.lane + 512 * j;
        f32x4 a = *(const f32x4*)(F.Y1() + ((size_t)MP + r) * DM + c), b2 = *(const f32x4*)(F.Y1() + ((size_t)MP + r) * DM + c + 4);
#pragma unroll
        for (int p = 0; p < 8; ++p) { f32x4 pa = {0.f, 0.f, 0.f, 0.f}, pb = pa; bf8_add(F.SLAB4() + ((size_t)p * 256 + r) * 1024 + c, pa, pb); a += pa * rs[p >> 1]; b2 += pb * rs[p >> 1]; }
        *(f32x4*)(F.out + OY_S + (size_t)r * DM + c) = a; *(f32x4*)(F.out + OY_S + (size_t)r * DM + c + 4) = b2; }
}

constexpr int G_QT = 0, G_KH = 17408, G_VV = 34816, G_PP = 52224, G_CS = 61440, G_RR = 69632, G_A63 = 70144, G_C63 = 70656, G_OST = 73728, OST_STR = 132;
__device__ __forceinline__ bf16x8 tr8(const LAS unsigned char* p, int rowbytes4) { const v4i16_t a = vtr(p), b = vtr(p + rowbytes4); return (bf16x8){a[0], a[1], a[2], a[3], b[0], b[1], b[2], b[3]}; }
#define LDS_BAR() asm volatile("s_waitcnt lgkmcnt(0)\n\ts_barrier" ::: "memory")
template <bool OUT>
__device__ __forceinline__ void hgrn_chunk_unit2(Frame& F, int bh, int sc) {
    const int tid = F.tid, lane = F.lane, w = F.wave, l15 = lane & 15, g = lane >> 4;
    const int b = bh >> 2, h = bh & 3, cg = tid & 31, tq = tid >> 5;
    LAS unsigned char* L = F.lds + RING_OFF;
    LAS bf16* QT = (LAS bf16*)(L + G_QT); LAS bf16* KH = (LAS bf16*)(L + G_KH); LAS bf16* VV = (LAS bf16*)(L + G_VV); LAS bf16* PP = (LAS bf16*)(L + G_PP);
    LAS float* CS = (LAS float*)(L + G_CS); LAS float* RR = (LAS float*)(L + G_RR); LAS float* A63 = (LAS float*)(L + G_A63); LAS float* C63 = (LAS float*)(L + G_C63); LAS float* OST = (LAS float*)(L + G_OST);
    f32x4 S[8];
    unsigned sbase = (unsigned)(((bh * 32 + sc) * 128 + 4 * g) * 128 + 16 * w + l15);
    asm volatile("" : "+v"(sbase));
#pragma unroll
    for (int i = 0; i < 8; ++i)
#pragma unroll
        for (int r = 0; r < 4; ++r) S[i][r] = OUT ? F.SST()[sbase + (unsigned)(16 * i + r) * 128u] : 0.f;
    f32x4 dsum = {0.f, 0.f, 0.f, 0.f};
    f32x4 lf[4]; u32x2 kq[4], qq[4], vq[4];
    unsigned e0 = (unsigned)((b * TP + sc * 256 + 4 * tq) * 512 + h * 128 + 4 * cg);
#define HG_LOAD(ch_) do { unsigned ee = e0 + (unsigned)(ch_) * 64u * 512u; asm volatile("" : "+v"(ee)); \
        _Pragma("unroll") for (int i = 0; i < 4; ++i) { lf[i] = *(const f32x4*)(F.LOGF() + ee + (unsigned)i * 512u); kq[i] = *(const u32x2*)(F.KB() + ee + (unsigned)i * 512u); \
            vq[i] = *(const u32x2*)(F.VB() + ee + (unsigned)i * 512u); if (OUT) qq[i] = *(const u32x2*)(F.QB() + ee + (unsigned)i * 512u); } } while (0)
    HG_LOAD(0);
    const LAS unsigned char* trK = (const LAS unsigned char*)KH + ((8 * g + (l15 >> 2)) * HQ_STR + (l15 & 3) * 4) * 2;
    const LAS unsigned char* trV = (const LAS unsigned char*)VV + ((8 * g + (l15 >> 2)) * HQ_STR + 16 * w + (l15 & 3) * 4) * 2;
    for (int ch = 0; ch < 4; ++ch) {
        f32x4 c[4]; c[0] = lf[0]; c[1] = c[0] + lf[1]; c[2] = c[1] + lf[2]; c[3] = c[2] + lf[3];
        *(LAS f32x4*)(CS + tq * 128 + 4 * cg) = c[3];
        LDS_BAR();
        f32x4 off = {0.f, 0.f, 0.f, 0.f}, run = {0.f, 0.f, 0.f, 0.f}, r = {0.f, 0.f, 0.f, 0.f};
#pragma unroll
        for (int q = 0; q < 16; ++q) { const f32x4 v = *(const LAS f32x4*)(CS + q * 128 + 4 * cg); if (q == 8) r = run; if (q < tq) off += v; run += v; }
        const f32x4 b63 = run;
#pragma unroll
        for (int i = 0; i < 4; ++i) {
            const int t = 4 * tq + i; const f32x4 bt = off + c[i];
            f32x4 kf = {bflo(kq[i].x), bfhi(kq[i].x), bflo(kq[i].y), bfhi(kq[i].y)};
#pragma unroll
            for (int e = 0; e < 4; ++e) kf[e] *= __expf(r[e] - bt[e]);
            *(LAS u32x2*)(KH + t * HQ_STR + 4 * cg) = (u32x2){pg8::cvt_pk_bf16(kf[0], kf[1]), pg8::cvt_pk_bf16(kf[2], kf[3])};
            *(LAS u32x2*)(VV + t * HQ_STR + 4 * cg) = vq[i];
            if (OUT) { f32x4 qf = {bflo(qq[i].x), bfhi(qq[i].x), bflo(qq[i].y), bfhi(qq[i].y)};
#pragma unroll
                for (int e = 0; e < 4; ++e) qf[e] *= __expf(bt[e] - r[e]);
                *(LAS u32x2*)(QT + t * HQ_STR + 4 * cg) = (u32x2){pg8::cvt_pk_bf16(qf[0], qf[1]), pg8::cvt_pk_bf16(qf[2], qf[3])}; }
        }
        if (tq == 0) { f32x4 er, ea, ec;
#pragma unroll
            for (int e = 0; e < 4; ++e) { er[e] = __expf(r[e]); ea[e] = __expf(b63[e]); ec[e] = __expf(b63[e] - r[e]); }
            *(LAS f32x4*)(RR + 4 * cg) = er; *(LAS f32x4*)(A63 + 4 * cg) = ea; *(LAS f32x4*)(C63 + 4 * cg) = ec; dsum += b63; }
        if (ch < 3) HG_LOAD(ch + 1);
        v4u gq0, gq1; unsigned rowe = 0;
        if (OUT) { rowe = (unsigned)(b * TP + sc * 256 + ch * 64 + (tid >> 3)); asm volatile("" : "+v"(rowe));
            gq0 = *(const v4u*)(F.GB() + rowe * 512u + h * 128 + (tid & 7) * 16); gq1 = *(const v4u*)(F.GB() + rowe * 512u + h * 128 + (tid & 7) * 16 + 8); }
        LDS_BAR();
        f32x4 o[4];
        bf16x8 vf[2];
#pragma unroll
        for (int kk = 0; kk < 2; ++kk) vf[kk] = tr8(trV + (32 * kk) * HQ_STR * 2, 4 * HQ_STR * 2);
        if (OUT) {
#pragma unroll
            for (int tt = 0; tt < 2; ++tt) {
                const int tile = 2 * w + tt, ti = tile >> 2, si = tile & 3;
                f32x4 p = {0.f, 0.f, 0.f, 0.f};
#pragma unroll
                for (int kk = 0; kk < 4; ++kk) {
                    const bf16x8 a = *(const LAS bf16x8*)(QT + (16 * ti + l15) * HQ_STR + 32 * kk + 8 * g), bb = *(const LAS bf16x8*)(KH + (16 * si + l15) * HQ_STR + 32 * kk + 8 * g);
                    p = MFMA16(a, bb, p);
                }
#pragma unroll
                for (int rr = 0; rr < 4; ++rr) { const int tl = 16 * ti + 4 * g + rr, sl = 16 * si + l15; PP[tl * HT_STR + sl] = pg8::bf1(sl <= tl ? p[rr] : 0.f); }
            }
            LDS_BAR();
#pragma unroll
            for (int ti = 0; ti < 4; ++ti) { o[ti] = (f32x4){0.f, 0.f, 0.f, 0.f};
#pragma unroll
                for (int kk = 0; kk < 2; ++kk) { const bf16x8 a = *(const LAS bf16x8*)(PP + (16 * ti + l15) * HT_STR + 32 * kk + 8 * g); o[ti] = MFMA16(a, vf[kk], o[ti]); } }
#pragma unroll
            for (int kk = 0; kk < 4; ++kk) {
                const f32x4 r0 = *(const LAS f32x4*)(RR + 32 * kk + 4 * g), r1 = *(const LAS f32x4*)(RR + 32 * kk + 16 + 4 * g);
                const bf16x8 sb = __builtin_bit_cast(bf16x8, pg8::pack8(S[2 * kk] * r0, S[2 * kk + 1] * r1));
#pragma unroll
                for (int ti = 0; ti < 4; ++ti) {
                    const u32x2 a0 = *(const LAS u32x2*)(QT + (16 * ti + l15) * HQ_STR + 32 * kk + 4 * g), a1 = *(const LAS u32x2*)(QT + (16 * ti + l15) * HQ_STR + 32 * kk + 16 + 4 * g);
                    const v4u av = {a0.x, a0.y, a1.x, a1.y};
                    o[ti] = MFMA16(__builtin_bit_cast(bf16x8, av), sb, o[ti]);
                }
            }
        }
#pragma unroll
        for (int i = 0; i < 8; ++i) {
            f32x4 U = {0.f, 0.f, 0.f, 0.f};
#pragma unroll
            for (int kk = 0; kk < 2; ++kk) { const bf16x8 a = tr8(trK + ((32 * kk) * HQ_STR + 16 * i) * 2, 4 * HQ_STR * 2); U = MFMA16(a, vf[kk], U); }
            const f32x4 a63 = *(const LAS f32x4*)(A63 + 16 * i + 4 * g), c63 = *(const LAS f32x4*)(C63 + 16 * i + 4 * g);
            S[i] = a63 * S[i] + c63 * U;
        }
        if (OUT) {
#pragma unroll
            for (int ti = 0; ti < 4; ++ti)
#pragma unroll
                for (int rr = 0; rr < 4; ++rr) OST[(16 * ti + 4 * g + rr) * OST_STR + 16 * w + l15] = o[ti][rr];
            LDS_BAR();
            const int t = tid >> 3, c16 = (tid & 7) * 16;
            f32x4 x[4]; float sq = 0.f;
#pragma unroll
            for (int j = 0; j < 4; ++j) { x[j] = *(const LAS f32x4*)(OST + t * OST_STR + c16 + 4 * j); sq += (x[j][0] * x[j][0] + x[j][1] * x[j][1]) + (x[j][2] * x[j][2] + x[j][3] * x[j][3]); }
            sq += __shfl_xor(sq, 1); sq += __shfl_xor(sq, 2); sq += __shfl_xor(sq, 4);
            const float rstd = __builtin_amdgcn_rsqf(sq * (1.f / 128.f) + EPS);
            const v4u g0 = gq0, g1 = gq1;
#pragma unroll
            for (int j = 0; j < 4; ++j) { const f32x4 gn = *(const f32x4*)(F.og + c16 + 4 * j); x[j] = x[j] * gn * rstd; }
            x[0][0] *= bflo(g0[0]); x[0][1] *= bfhi(g0[0]); x[0][2] *= bflo(g0[1]); x[0][3] *= bfhi(g0[1]); x[1][0] *= bflo(g0[2]); x[1][1] *= bfhi(g0[2]); x[1][2] *= bflo(g0[3]); x[1][3] *= bfhi(g0[3]);
            x[2][0] *= bflo(g1[0]); x[2][1] *= bfhi(g1[0]); x[2][2] *= bflo(g1[1]); x[2][3] *= bfhi(g1[1]); x[3][0] *= bflo(g1[2]); x[3][1] *= bfhi(g1[2]); x[3][2] *= bflo(g1[3]); x[3][3] *= bfhi(g1[3]);
            *(pg8::u32x4*)(F.MIX() + rowe * 1024u + 512u + h * 128 + c16) = pg8::pack8(x[0], x[1]);
            *(pg8::u32x4*)(F.MIX() + rowe * 1024u + 512u + h * 128 + c16 + 8) = pg8::pack8(x[2], x[3]);
        }
    }
#undef HG_LOAD
    if (!OUT) {
#pragma unroll
        for (int i = 0; i < 8; ++i)
#pragma unroll
            for (int r = 0; r < 4; ++r) F.DSH()[sbase + (unsigned)(16 * i + r) * 128u] = S[i][r];
        if (tq == 0) *(f32x4*)(F.DD() + (size_t)(bh * 32 + sc) * 128 + 4 * cg) = dsum;
    }
    __syncthreads();
}

typedef short s16x4 __attribute__((ext_vector_type(4)));

struct DecStage2 { f32x4 k[4]; f32x4 v[4]; };
constexpr int DW_T = 107008;
struct DecW { DecStage2 S; f32x4 o[4]; float carry; bf16x8 qb[2]; int i, last, w, s, h, pagev; LAS unsigned char* tb; u32x2 wpk; bool pend; };
__device__ __forceinline__ void decw_load(Frame& F, DecW& D, int l15, int g) {
    const int kb = 1024 * D.w + 1024 - 16 * D.i;
    const int page = __builtin_amdgcn_readlane(D.pagev, (kb >> 7) & 7);
    const unsigned sbase = (unsigned)__builtin_amdgcn_readfirstlane((int)((((unsigned)page * PAGE + (unsigned)(kb & 127)) * 512u + (unsigned)(D.h * 64)) * 4u));
    const __amdgpu_buffer_rsrc_t rk = __builtin_amdgcn_make_buffer_rsrc((void*)F.ck, 0, 0x7fffffff, 0x00020000), rv = __builtin_amdgcn_make_buffer_rsrc((void*)F.cv, 0, 0x7fffffff, 0x00020000);
    int vk = l15 * 2048 + 32 * g; asm volatile("" : "+v"(vk)); const int vv = vk - 16 * g;
#pragma unroll
    for (int ks = 0; ks < 2; ++ks) { D.S.k[2 * ks] = __builtin_bit_cast(f32x4, __builtin_amdgcn_raw_buffer_load_b128(rk, vk + 128 * ks, sbase, 0)); D.S.k[2 * ks + 1] = __builtin_bit_cast(f32x4, __builtin_amdgcn_raw_buffer_load_b128(rk, vk + 128 * ks + 16, sbase, 0)); }
#pragma unroll
    for (int j = 0; j < 4; ++j) D.S.v[j] = __builtin_bit_cast(f32x4, __builtin_amdgcn_raw_buffer_load_b128(rv, vv + 64 * j, sbase, 0));
}
__device__ __forceinline__ void decw_procA(DecW& D, bool newk, float cinit, int l15, int g) {
    f32x4 p = {cinit, cinit, cinit, cinit};
    p = MFMA16(cvt8(D.S.k[0], D.S.k[1]), D.qb[0], p); p = MFMA16(cvt8(D.S.k[2], D.S.k[3]), D.qb[1], p);
    float bt[4];
#pragma unroll
    for (int r = 0; r < 4; ++r) { bt[r] = __builtin_amdgcn_rcpf(1.f + __builtin_amdgcn_exp2f(p[r])); if (newk && (4 * g + r >= l15 || 4 * g + r >= 8)) bt[r] = 0.f; }
    float suf = 1.f, wl[4];
#pragma unroll
    for (int r = 3; r >= 0; --r) { wl[r] = bt[r] * suf; suf = __builtin_fmaf(-suf, bt[r], suf); }
    float t1, po;
    { auto a = __builtin_amdgcn_permlane16_swap(__float_as_uint(suf), __float_as_uint(suf), false, false); t1 = (g & 1) ? __uint_as_float(a[0]) : __uint_as_float(a[1]); }
    const float pp = suf * t1;
    { auto b = __builtin_amdgcn_permlane32_swap(__float_as_uint(pp), __float_as_uint(pp), false, false); po = (g & 2) ? __uint_as_float(b[0]) : __uint_as_float(b[1]); }
    const float pre = D.carry * ((g & 2) ? 1.f : po) * ((g & 1) ? 1.f : t1);
    D.carry = D.carry * pp * po;
    D.wpk = (u32x2){pg8::cvt_pk_bf16(wl[0] * pre, wl[1] * pre), pg8::cvt_pk_bf16(wl[2] * pre, wl[3] * pre)};
#pragma unroll
    for (int j = 0; j < 4; ++j) *(LAS u32x2*)(D.tb + j * 512 + l15 * 32 + g * 8) = (u32x2){pg8::cvt_pk_bf16(D.S.v[j][0], D.S.v[j][1]), pg8::cvt_pk_bf16(D.S.v[j][2], D.S.v[j][3])};
}
__device__ __forceinline__ void decw_procB(DecW& D, int l15, int g) {
    asm volatile("s_waitcnt lgkmcnt(0)" ::: "memory");
#pragma unroll
    for (int dt = 0; dt < 4; ++dt) { const v4i16_t vb = vtr(D.tb + dt * 512 + (4 * g + (l15 >> 2)) * 32 + (l15 & 3) * 8);
        D.o[dt] = __builtin_amdgcn_mfma_f32_16x16x16bf16_1k(__builtin_bit_cast(s16x4, D.wpk), vb, D.o[dt], 0, 0, 0); }
}
__device__ __forceinline__ void decw_proc(DecW& D, bool newk, float cinit, int l15, int g) { decw_procA(D, newk, cinit, l15, g); decw_procB(D, l15, g); }
__device__ __forceinline__ void attn_unit_dec(Frame& F, int b, int h, int qb, DecW& D) {
    const int lane = F.lane, r32 = lane & 31, hi = lane >> 5, wid = F.wave, l15 = lane & 15, g4 = lane >> 4;
    const int rowbase = b * TP, q0 = qb * 256 + 32 * wid, qpos = q0 + r32;
    const float cinit = -F.sbb[h] * LOG2E, dcinit = -F.sbb[D.h] * LOG2E;
    LAS unsigned char* L = F.lds + RING_OFF;
    const unsigned lds0 = (unsigned)(uintptr_t)L;
    bf16x8 qr[4];
#pragma unroll
    for (int d0 = 0; d0 < 4; ++d0) qr[d0] = *(const bf16x8*)(F.QA() + (size_t)(rowbase + qpos) * 512 + h * 64 + d0 * 16 + hi * 8);
    asm volatile("" :: "v"(qr[0]), "v"(qr[1]), "v"(qr[2]), "v"(qr[3]));
    const int NT = 4 * (qb + 1);
    const int rr_ = (lane & 3) + 4 * ((lane & 31) >> 3), pil = 16 * ((lane >> 2) & 1) + 8 * (1 - (rr_ & 1)) + (rr_ >> 1) + (lane & 32);
    const bf16* ksrc = F.KA() + (size_t)(rowbase + pil) * 512 + h * 64 + wid * 8;
    const bf16* vsrc = F.VA() + (size_t)(rowbase + 16 * (wid & 3) + (lane >> 2)) * 512 + h * 64 + (wid >> 2) * 32 + (lane & 3) * 8;
    const unsigned kdst = lds0 + AT_K + wid * 1024, vdst = lds0 + AT_V + wid * 1024;
#define AT_DMA(t, slot) do { glds16(ksrc + (size_t)(t) * 64 * 512, (unsigned)__builtin_amdgcn_readfirstlane(kdst + (slot))); glds16(vsrc + (size_t)(t) * 64 * 512, (unsigned)__builtin_amdgcn_readfirstlane(vdst + (slot))); } while (0)
    const LAS unsigned char* kfb = L + AT_K + hi * 1024 + r32 * 16;
    const LAS unsigned char* vfb = L + AT_V + ((lane >> 4) & 1) * 32 + (lane & 3) * 8 + ((lane & 15) >> 2) * 64 + hi * 1024;
    f32x16 o0 = splat16(0.f), o1 = splat16(0.f); float carry = 1.f;
    int s_cur = 0, s_nxt = AT_SLOT, s_fre = 2 * AT_SLOT;
    bool l1 = false, l2 = false;
    AT_DMA(NT - 1, 0); AT_DMA(NT - 2, AT_SLOT);
    if (wid >= 4) __builtin_amdgcn_s_setprio(1);
    for (int t = NT - 1; t >= 0; --t) {
        if (t == 0) asm volatile("s_waitcnt vmcnt(0) lgkmcnt(0)\n\ts_barrier" ::: "memory");
        else if (l1 || l2) asm volatile("s_waitcnt vmcnt(10) lgkmcnt(0)\n\ts_barrier" ::: "memory");
        else asm volatile("s_waitcnt vmcnt(2) lgkmcnt(0)\n\ts_barrier" ::: "memory");
        const bool dstep = ((t & 1) == (wid >> 2)) && (D.i <= D.last) && !D.pend;
        if (dstep) decw_procA(D, false, dcinit, l15, g4);
        else if (D.pend) { decw_procB(D, l15, g4); D.pend = false; }
        if (t >= 2) AT_DMA(t - 2, s_fre);
        l2 = l1; l1 = false;
        const int kbase = 64 * t;
        if (kbase <= q0 + 30) {
            f32x16 p0 = splat16(cinit), p1 = splat16(cinit);
#pragma unroll
            for (int d0 = 0; d0 < 4; ++d0) {
                const bf16x8 k0 = *(const LAS bf16x8*)(kfb + s_cur + d0 * 2048), k1 = *(const LAS bf16x8*)(kfb + s_cur + d0 * 2048 + 512);
                p0 = MFMA32(k0, qr[d0], p0); p1 = MFMA32(k1, qr[d0], p1);
            }
            v4u pw[4];
            sb_tile2(p0, p1, carry, hi, kbase + 16 * hi, qpos, kbase + 63 >= q0, pw);
#pragma unroll
            for (int ks = 0; ks < 4; ++ks) {
                const LAS unsigned char* vp = vfb + s_cur + (ks >> 1) * 2048 + (ks & 1) * 512;
                const v4i16_t a0 = vtr(vp), a1 = vtr(vp + 256), b0 = vtr(vp + 4096), b1 = vtr(vp + 4096 + 256);
                const bf16x8 v0 = {a0[0], a0[1], a0[2], a0[3], a1[0], a1[1], a1[2], a1[3]}, v1 = {b0[0], b0[1], b0[2], b0[3], b1[0], b1[1], b1[2], b1[3]};
                o0 = MFMA32(__builtin_bit_cast(bf16x8, pw[ks]), v0, o0); o1 = MFMA32(__builtin_bit_cast(bf16x8, pw[ks]), v1, o1);
            }
        }
        if (dstep) { D.pend = true; ++D.i; if (D.i <= D.last) { decw_load(F, D, l15, g4); l1 = true; } }
        const int tmp = s_fre; s_fre = s_cur; s_cur = s_nxt; s_nxt = tmp;
    }
    __builtin_amdgcn_s_setprio(0);
    LAS bf16* stg = (LAS bf16*)(L + AT_O) + wid * 2048;
#pragma unroll
    for (int r = 0; r < 16; ++r) { const int orow = crow(r, hi); stg[orow * 64 + r32] = pg8::bf1(o0[r]); stg[orow * 64 + 32 + r32] = pg8::bf1(o1[r]); }
    asm volatile("s_waitcnt lgkmcnt(0)" ::: "memory");
#pragma unroll
    for (int i = 0; i < 4; ++i) {
        const int row = i * 8 + (lane >> 3), ch = lane & 7; const size_t grow = (size_t)rowbase + q0 + row;
        const v4u ov = *(const LAS v4u*)(stg + row * 64 + ch * 8), gv = *(const v4u*)(F.GA() + grow * 512 + h * 64 + ch * 8);
        f32x4 x, y;
        x[0] = bflo(ov[0]) * bflo(gv[0]); x[1] = bfhi(ov[0]) * bfhi(gv[0]); x[2] = bflo(ov[1]) * bflo(gv[1]); x[3] = bfhi(ov[1]) * bfhi(gv[1]);
        y[0] = bflo(ov[2]) * bflo(gv[2]); y[1] = bfhi(ov[2]) * bfhi(gv[2]); y[2] = bflo(ov[3]) * bflo(gv[3]); y[3] = bfhi(ov[3]) * bfhi(gv[3]);
        *(pg8::u32x4*)(F.MIX() + grow * 1024 + h * 64 + ch * 8) = pg8::pack8(x, y);
    }
    asm volatile("s_waitcnt lgkmcnt(0)\n\ts_barrier" ::: "memory");
#undef AT_DMA
}
constexpr int DW_OB = 90112, DW_CB = 106496;
__device__ __forceinline__ void attn_pair_dec(Frame& F, int it) {
    const int lane = F.lane, l15 = lane & 15, g4 = lane >> 4, wid = F.wave;
    const int bh = it >> 4, x = it & 15;
    DecW D; D.s = it >> 3; D.h = it & 7; D.w = wid; D.carry = 1.f; D.i = 1; D.last = 64; D.pend = false;
    D.pagev = F.pt[D.s * NPG + 8 * wid + (lane & 7)];
    D.tb = F.lds + RING_OFF + DW_T + wid * 2048;
#pragma unroll
    for (int dt = 0; dt < 4; ++dt) D.o[dt] = (f32x4){0.f, 0.f, 0.f, 0.f};
#pragma unroll
    for (int ks = 0; ks < 2; ++ks) D.qb[ks] = *(const bf16x8*)(F.QA() + ((size_t)MP + D.s * 8 + (l15 & 7)) * 512 + D.h * 64 + 32 * ks + 8 * g4);
    const float dcinit = -F.sbb[D.h] * LOG2E;
    if (wid == 7) {
        const size_t row = (size_t)MP + D.s * 8;
        const bf16* kp = F.KA() + (row + (l15 & 7)) * 512 + D.h * 64 + 8 * g4;
#pragma unroll
        for (int ks = 0; ks < 2; ++ks) { const v4u w = *(const v4u*)(kp + 32 * ks);
            D.S.k[2 * ks] = (f32x4){bflo(w[0]), bfhi(w[0]), bflo(w[1]), bfhi(w[1])}; D.S.k[2 * ks + 1] = (f32x4){bflo(w[2]), bfhi(w[2]), bflo(w[3]), bfhi(w[3])}; }
        const bf16* vp = F.VA() + (row + (l15 & 7)) * 512 + D.h * 64 + 4 * g4;
#pragma unroll
        for (int j = 0; j < 4; ++j) { const u32x2 w = *(const u32x2*)(vp + 16 * j); D.S.v[j] = (f32x4){bflo(w.x), bfhi(w.x), bflo(w.y), bfhi(w.y)}; }
        decw_proc(D, true, dcinit, l15, g4);
    }
    decw_load(F, D, l15, g4);
    asm volatile("s_waitcnt vmcnt(0)" ::: "memory");
    attn_unit_dec(F, bh >> 3, bh & 7, 31 - x, D);
    attn_unit_dec(F, bh >> 3, bh & 7, x, D);
    if (D.pend) { decw_procB(D, l15, g4); D.pend = false; }
    while (D.i <= D.last) { decw_proc(D, false, dcinit, l15, g4); ++D.i; if (D.i <= D.last) decw_load(F, D, l15, g4); }
    LAS float* ob = (LAS float*)(F.lds + RING_OFF + DW_OB); LAS float* cb = (LAS float*)(F.lds + RING_OFF + DW_CB);
    if (g4 < 2) {
#pragma unroll
        for (int dt = 0; dt < 4; ++dt)
#pragma unroll
            for (int r = 0; r < 4; ++r) ob[(wid * 8 + 4 * g4 + r) * 64 + 16 * dt + l15] = D.o[dt][r];
        if (g4 == 0 && l15 < 8) cb[wid * 8 + l15] = D.carry;
    }
    __syncthreads();
    {
        const int q = F.tid >> 6, d = F.tid & 63; float acc = 0.f, pref = 1.f;
#pragma unroll
        for (int w = 7; w >= 0; --w) { acc += pref * ob[(w * 8 + q) * 64 + d]; pref *= cb[w * 8 + q]; }
        const size_t row = (size_t)MP + D.s * 8 + q;
        F.MIX()[row * 1024 + D.h * 64 + d] = pg8::bf1(acc * bf2f(F.GA()[row * 512 + D.h * 64 + d]));
    }
    __syncthreads();
}

#ifndef MK_N_LAUNCHES
#define MK_N_LAUNCHES 1
#endif
constexpr int NPH = 15;
constexpr int N_LAUNCHES = MK_N_LAUNCHES;
struct Args { const void* in[17]; float* out; unsigned char* ws; int ph_lo, ph_hi, li, pad; };
__global__ void __launch_bounds__(NWAVES * 64, 2) mk_fwd(Args args) {
    extern __shared__ __attribute__((aligned(16))) unsigned char lds[];
    Frame F;
    F.lds = (LAS unsigned char*)lds;
    F.MISC = (volatile LAS unsigned*)(F.lds + MISC_OFF);
    F.tid = threadIdx.x; F.lane = F.tid & 63; F.wave = __builtin_amdgcn_readfirstlane(F.tid >> 6);
    F.G = gridDim.x; F.bid = blockIdx.x;
    unsigned char* ws = args.ws;
    F.ctl = (gu32*)(ws + WS_CTL);
    F.xp = (const float*)args.in[0]; F.xs = (const float*)args.in[1]; F.ck = (const float*)args.in[2]; F.cv = (const float*)args.in[3]; F.pt = (const int*)args.in[4];
    F.st_h = (const float*)args.in[5]; F.st_r = (const float*)args.in[6]; F.ng = (const float*)args.in[7]; F.w1 = (const float*)args.in[8]; F.w2 = (const float*)args.in[9];
    F.qg = (const float*)args.in[10]; F.kg = (const float*)args.in[11]; F.sbb = (const float*)args.in[12]; F.hlb = (const float*)args.in[13]; F.og = (const float*)args.in[14];
    F.w3 = (const float*)args.in[15]; F.w4 = (const float*)args.in[16]; F.out = args.out;
    F.ws = ws;
    for (int u = F.tid; u < (LDS_BYTES - LDSCTL_OFF) / 4; u += NWAVES * 64) ((LAS unsigned*)(F.lds + LDSCTL_OFF))[u] = 0u;
    __syncthreads();
    XcdBarrier bar; bar.bar = (unsigned*)(F.ctl + CW_BAR); bar.x = 0; bar.st = nullptr;
    if (N_LAUNCHES == 1) bar = xcd_barrier_post((unsigned*)(F.ctl + CW_BAR), F.MISC + 8);
#define GRID_BAR() do { if (N_LAUNCHES == 1) xcd_barrier(bar); } while (0)
    const int lo = args.ph_lo, hi = args.ph_hi;
#define IN(k) (lo <= (k) && (k) < hi)
    const int gw = F.bid * NWAVES + F.wave, NGW = F.G * NWAVES;
    const int vcu_ = (F.G % 8 == 0) ? (F.bid % 8) * (F.G / 8) + F.bid / 8 : F.bid;

    if (IN(0)) { p0_prologue(F); GRID_BAR(); }
    if (IN(1)) {
        pg8::Gemm g{1024, 1024, 1024}; pg8::SchedPlain S; S.init(F.H(), F.W1T(), MP, N1, 1024, F.G, F.bid);
        pg8::EpiEven E{F.QA(), F.KA(), F.VAT(), F.GA(), F.QB(), F.KB(), F.VB(), F.GB(), F.LOGF(), F.out, F.qg, F.kg, F.hlb, -0.125f * LOG2E, MT, MP, OK_P, OK_S, OV_P, OV_S};
        pg8::gemm_phase<pg8::EpiEven, pg8::SchedPlain, true, true>(F.lds + RING_OFF, g, S, E);
        { pg8::Gemm gs{256, 1024, 1024}; pg8::SchedSplit Ss{(const char*)(F.H() + (size_t)MP * 1024), (const char*)F.W1T(), N1 / 256, 4, F.G, F.bid, 2048, 2048};
          pg8::EpiSlab Es{F.SLAB(), N1}; pg8::gemm_phase<pg8::EpiSlab, pg8::SchedSplit, true, true>(F.lds + RING_OFF, gs, Ss, Es); }
        GRID_BAR();
    }
    if (IN(2)) {
        for (int it = gw; it < MSM * 8; it += NGW) pp1_item(F, it);
        for (int u = F.bid; u < 8 * 32; u += F.G) hgrn_chunk_unit2<false>(F, u >> 5, u & 31);
        GRID_BAR();
    }
    if (IN(3)) {
        hgrn_passB(F);
        for (int u = F.bid; u < NSQ * HB; u += F.G) hgrn_sample_unit(F, u >> 2, u & 3);
        { const int vcu = (F.G % 8 == 0) ? (F.bid % 8) * (F.G / 8) + F.bid / 8 : F.bid;
          for (int it = vcu; it < 256; it += F.G) attn_pair_dec(F, it); }
        GRID_BAR();
    }
    if (IN(4)) {
        for (int u = F.bid; u < 8 * 32; u += F.G) hgrn_chunk_unit2<true>(F, u >> 5, u & 31);
        { pg8::Gemm gs{256, 1024, 1024}; pg8::SchedSplit Ss{(const char*)(F.MIX() + (size_t)MP * 1024), (const char*)F.W2T(), 4, 4, F.G, F.bid, 2048, 2048};
          pg8::EpiSlab Es{F.SLAB(), 1024}; pg8::gemm_phase<pg8::EpiSlab, pg8::SchedSplit, true, true>(F.lds + RING_OFF, gs, Ss, Es); }
        GRID_BAR();
    }
    if (IN(6)) {
        pg8::Gemm g{1024, 1024, 1024}; pg8::SchedPlain S; S.init(F.MIX(), F.W2T(), MP, 1024, 1024, F.G, F.bid);
        pg8::EpiY1 E{F.xp, F.Y1B(), F.SS1()};
        pg8::gemm_phase<pg8::EpiY1, pg8::SchedPlain, true, true>(F.lds + RING_OFF, g, S, E);
        for (int r = gw; r < MSM; r += NGW) pp2_row(F, r);
        GRID_BAR();
    }
    if (IN(8)) {
        pg8::Gemm g{1024, 1024, 1024};
        { pg8::Sched3<0> S; S.init(F.Y1B(), F.W3T(), F.G, F.bid); pg8::EpiOdd3<0> E{F.AQ(), F.KCH(), F.KCT(), F.BV(), F.GC(), F.QC(), F.KC(), F.VC(), F.RCOS(), F.RSIN(), F.RCOST(), F.RSINT(), MP, F.SS1()};
          pg8::gemm_phase<pg8::EpiOdd3<0>, pg8::Sched3<0>, true, true>(F.lds + RING_OFF, g, S, E); }
        { pg8::Sched3<1> S; S.init(F.Y1B(), F.W3T(), F.G, F.bid); pg8::EpiOdd3<1> E{F.AQ(), F.KCH(), F.KCT(), F.BV(), F.GC(), F.QC(), F.KC(), F.VC(), F.RCOS(), F.RSIN(), F.RCOST(), F.RSINT(), MP, F.SS1()};
          pg8::gemm_phase<pg8::EpiOdd3<1>, pg8::Sched3<1>, true, true>(F.lds + RING_OFF, g, S, E); }
        { pg8::Gemm gs{256, 1024, 1024}; pg8::SchedSplit Ss{(const char*)(F.H() + (size_t)MP * 1024), (const char*)F.W3T(), N3 / 256, 4, F.G, F.bid, 2048, 2048};
          pg8::EpiSlab Es{F.SLAB(), N3}; pg8::gemm_phase<pg8::EpiSlab, pg8::SchedSplit, true, true>(F.lds + RING_OFF, gs, Ss, Es); }
        GRID_BAR();
    }
    if (IN(9)) {
        { pg8::Gemm g{256, 512, 256}; pg8::SchedRet S{(const char*)F.BV(), (const char*)F.KCT(), F.G, vcu_, 0};
          pg8::EpiRetA E{(pg8::bf16_t*)F.DST()};
          pg8::gemm_phase<pg8::EpiRetA, pg8::SchedRet, true, true>(F.lds + RING_OFF, g, S, E); }
        { pg8::Gemm g{256, 2048, 1024}; pg8::SchedRet S{(const char*)F.AQ(), (const char*)F.KCH(), F.G, vcu_, 1};
          pg8::EpiRetP E{F.AQ()};
          pg8::gemm_phase<pg8::EpiRetP, pg8::SchedRet, true, true>(F.lds + RING_OFF, g, S, E); }
        for (int it = gw; it < MSM * 24; it += NGW) pp3_item(F, it);
        GRID_BAR();
    }
    if (IN(10)) {
        ret_passB(F);
        for (int u = F.bid; u < NSQ * HC * 2; u += F.G) ret_sample_unit(F, u >> 3, (u >> 1) & 3, u & 1);
        GRID_BAR();
    }
    if (IN(12)) {
        pg8::Gemm g{512, 2048, 512}; pg8::SchedRet S{(const char*)F.AQ(), (const char*)F.BV(), F.G, vcu_, 2};
        pg8::EpiRetO E{F.GC(), F.MIX2(), F.SS()};
        pg8::gemm_phase<pg8::EpiRetO, pg8::SchedRet, true, true>(F.lds + RING_OFF, g, S, E);
        { pg8::Gemm gs{256, 2048, 2048}; pg8::SchedSplit Ss{(const char*)(F.MIX2() + (size_t)MP * 2048), (const char*)F.W4T(), 4, 8, F.G, F.bid, 4096, 4096};
          pg8::EpiSlab Es{F.SLAB4(), 1024}; pg8::gemm_phase<pg8::EpiSlab, pg8::SchedSplit, true, true>(F.lds + RING_OFF, gs, Ss, Es); }
        GRID_BAR();
    }
    if (IN(14)) {
        pg8::Gemm g{2048, 2048, 2048}; pg8::SchedPlain S; S.init(F.MIX2(), F.W4T(), MP, 1024, 2048, F.G, F.bid);
        pg8::EpiOut E{F.Y1B(), F.out + OY_P, F.SS()};
        pg8::gemm_phase<pg8::EpiOut, pg8::SchedPlain, true, true>(F.lds + RING_OFF, g, S, E);
        for (int r = gw; r < MSM; r += NGW) pp4_row(F, r);
    }
#undef IN
}

extern "C" void kernel_launch(void* const* d_in, const int* in_sizes, int n_in, void* d_out, int out_size, void* d_ws, size_t ws_size, hipStream_t stream) {
    static int grid = 0;
    if (grid == 0) {
        if (n_in != 17 || (size_t)out_size != OUT_TOTAL || ws_size < WS_END) { fprintf(stderr, "kernel_launch: unexpected shapes: n_in %d out %d ws %zu (need %zu)\n", n_in, out_size, ws_size, (size_t)WS_END); grid = -1; return; }
        int dev = 0, cus = 0, per_cu = 0;
        if (hipGetDevice(&dev) != hipSuccess || hipDeviceGetAttribute(&cus, hipDeviceAttributeMultiprocessorCount, dev) != hipSuccess) { grid = -1; return; }
        if (hipFuncSetAttribute((const void*)mk_fwd, hipFuncAttributeMaxDynamicSharedMemorySize, LDS_BYTES) != hipSuccess) { fprintf(stderr, "kernel_launch: hipFuncSetAttribute failed\n"); grid = -1; return; }
        if (hipOccupancyMaxActiveBlocksPerMultiprocessor(&per_cu, (const void*)mk_fwd, NWAVES * 64, LDS_BYTES) != hipSuccess || per_cu < 1) { fprintf(stderr, "kernel_launch: occupancy query says %d\n", per_cu); }
        (void)hipGetLastError();
        grid = cus;
    }
    if (grid < 0) return;
    if (hipMemsetAsync((char*)d_ws + WS_CTL, 0, CTL_ZERO_BYTES, stream) != hipSuccess) return;
    Args a{};
    for (int i = 0; i < 17; ++i) a.in[i] = d_in[i];
    a.out = (float*)d_out; a.ws = (unsigned char*)d_ws;
    for (int li = 0; li < N_LAUNCHES; ++li) {
        a.ph_lo = (N_LAUNCHES == 1) ? 0 : li; a.ph_hi = (N_LAUNCHES == 1) ? NPH : li + 1; a.li = li;
        hipLaunchKernelGGL(mk_fwd, dim3(grid), dim3(NWAVES * 64), LDS_BYTES, stream, a);
        if (hipPeekAtLastError() != hipSuccess) break;
    }
}
```

```cpp
#include <hip/hip_runtime.h>
#include <cstdio>
#include <cstdint>

constexpr int DM = 1024, TP = 8192, NBP = 2, MP = NBP * TP;
constexpr int NSQ = 32, TSQ = 8, MSM = NSQ * TSQ;
constexpr int MT = MP + MSM;
constexpr int PAST = 8192, PAGE = 128, NPG = PAST / PAGE;
constexpr int HA = 8, HDA = 64, WA = 512, HB = 4, DKB = 128, DVB = 128, HC = 4, DKC = 256, DVC = 512, WC = 2048;
constexpr int N1 = 4096, N3 = 6144;
constexpr float EPS = 1e-6f;
constexpr float LOG2E = 1.4426950408889634f;
constexpr size_t OY_P = 0, OY_S = 16777216, OK_P = 17039360, OV_P = 25427968, OK_S = 33816576, OV_S = 33947648,
                 OHG_P = 34078720, OHG_S = 34209792, ORT_P = 36306944, ORT_S = 37355520, OUT_TOTAL = 54132736;
#define MK_N_LAUNCHES 1
namespace pg8 {
#define PG8_LAS __attribute__((address_space(3)))
typedef unsigned short bf16_t;
typedef short bf16x8 __attribute__((ext_vector_type(8)));
typedef float f32x4 __attribute__((ext_vector_type(4)));
typedef unsigned u32x4 __attribute__((ext_vector_type(4)));
constexpr int BM = 256, BK = 64, HALF = 128, HTB = HALF * BK * 2  , STAGE_BYTES = 8 * HTB, NXCD = 8, WGM = 8;

__host__ __device__ __forceinline__ int lds_byte(int r, int c) { const int st = (r >> 4) * 2 + (c >> 5), rr = r & 15, cc = c & 31, ob = rr * 64 + cc * 2; return st * 1024 + (ob ^ (((ob >> 9) & 1) << 5)); }
__host__ __device__ __forceinline__ void stage_rc(int b, int& R, int& C) { const int st = b / 1024, sb = b % 1024, swz = sb ^ (((sb >> 9) & 1) << 5); R = (st >> 1) * 16 + swz / 64; C = (st & 1) * 32 + (swz % 64) / 2; }
__host__ __device__ __forceinline__ int perm32(int rho) { const int n = rho >> 4, i = rho & 15; return 8 * (i >> 2) + 4 * n + (i & 3); }

struct Unit { int pm, pn, kind, aux; };
struct Gemm { int K, lda, ldb; };

struct StaticOrder {
    int nM, nN, nwg, G, c;
    __host__ __device__ void init(int M, int N, int G_, int c_) { nM = M / BM; nN = N / BM; nwg = nM * nN; G = G_; c = c_; }
    __host__ __device__ bool next(int i, Unit& u) const {
        const long L = (long)i * G + c; if (L >= nwg) return false;
        int wgid = (int)L; { const int q = nwg / NXCD, r = nwg % NXCD, xcd = wgid % NXCD, off = wgid / NXCD; wgid = (xcd < r ? xcd * (q + 1) : r * (q + 1) + (xcd - r) * q) + off; }
        const int nig = WGM * nN, gid = wgid / nig, fm = gid * WGM, gsz = (nM - fm) < WGM ? (nM - fm) : WGM;
        u.pm = fm + ((wgid % nig) % gsz); u.pn = (wgid % nig) / gsz; return true;
    }
    __device__ __forceinline__ void a_ready(const Unit&) const {}
    __device__ __forceinline__ void done(const Unit&) const {}
};
typedef float f32x2_t __attribute__((ext_vector_type(2))); typedef __bf16 bf16x2_t __attribute__((ext_vector_type(2)));
__device__ __forceinline__ unsigned cvt_pk_bf16(float lo, float hi) { f32x2_t v = {lo, hi}; bf16x2_t b = __builtin_convertvector(v, bf16x2_t); return __builtin_bit_cast(unsigned, b); }
typedef float f32x2 __attribute__((ext_vector_type(2)));
template <class Epi, class Sched, bool ALIGN_EPI = false, bool SP2 = false>
__device__ __forceinline__ void gemm_phase(PG8_LAS unsigned char* lds, const Gemm g, const Sched& S, const Epi& E) {
    const int tid = threadIdx.x, wid = __builtin_amdgcn_readfirstlane(tid >> 6), lane = tid & 63, wr = wid >> 2, wc = wid & 3, fr = lane & 15, fq = lane >> 4;
    const int K = g.K, nt = K / BK;
    unsigned voffA[2], voffB[2];
#pragma unroll
    for (int i = 0; i < 2; ++i) { int R, C; stage_rc(tid * 16 + i * 8192, R, C); const int Rb = Epi::PERM ? ((R & ~31) + perm32(R & 31)) : R;
        voffA[i] = (unsigned)(R * g.lda + C) * 2u; voffB[i] = (unsigned)(Rb * g.ldb + C) * 2u; }
    const size_t kstep = (size_t)(BK * 2);
    const size_t hstepA = (size_t)HALF * g.lda * 2, hstepB = (size_t)HALF * g.ldb * 2;
    const unsigned ldsw = (unsigned)wid * 1024u;
    const int aoff = lds_byte(wr * 64 + fr, fq * 8), boff = lds_byte(wc * 32 + fr, fq * 8);
#define PG8_SA(b, h) (((b) * 2 + (h)) * HTB)
#define PG8_SB(b, h) ((4 + (b) * 2 + (h)) * HTB)
#define PG8_STAGE(bufoff, gbase, voff) do { _Pragma("unroll") for (int _i = 0; _i < 2; ++_i) \
        __builtin_amdgcn_global_load_lds((const unsigned*)((const char*)(gbase) + (voff)[_i]), (PG8_LAS unsigned*)(lds + (bufoff) + ldsw + _i * 8192), 16, 0, 0); } while (0)
#define PG8_LDA(dst, b, h) do { _Pragma("unroll") for (int m = 0; m < 4; ++m) _Pragma("unroll") for (int k = 0; k < 2; ++k) dst[m][k] = *(const PG8_LAS bf16x8*)(lds + PG8_SA(b, h) + aoff + m * 2048 + k * 1024); } while (0)
#define PG8_LDB(dst, b, h) do { _Pragma("unroll") for (int n = 0; n < 2; ++n) _Pragma("unroll") for (int k = 0; k < 2; ++k) dst[n][k] = *(const PG8_LAS bf16x8*)(lds + PG8_SB(b, h) + boff + n * 2048 + k * 1024); } while (0)
#define PG8_MMA(ai, bj, At, Bt) do { __builtin_amdgcn_s_setprio(1); _Pragma("unroll") for (int m = 0; m < 4; ++m) _Pragma("unroll") for (int n = 0; n < 2; ++n) _Pragma("unroll") for (int k = 0; k < 2; ++k) \
        acc[ai][bj][m][n] = __builtin_amdgcn_mfma_f32_16x16x32_bf16(Bt[n][k], At[m][k], acc[ai][bj][m][n], 0, 0, 0); __builtin_amdgcn_s_setprio(0); } while (0)
#define PG8_WAIT_V(n) asm volatile("s_waitcnt vmcnt(" #n ")" ::: "memory")
#define PG8_WAIT_L(n) asm volatile("s_waitcnt lgkmcnt(" #n ")" ::: "memory")
#define PG8_BAR __builtin_amdgcn_s_barrier()
#define PG8_SCHED __builtin_amdgcn_sched_barrier(0)
    Unit cur, nxt; int ui = 0;
    if (!S.next(0, cur)) return;
    f32x4 acc[2][2][4][2];
#pragma unroll
    for (int a = 0; a < 2; ++a)
#pragma unroll
        for (int b = 0; b < 2; ++b)
#pragma unroll
            for (int m = 0; m < 4; ++m)
#pragma unroll
                for (int n = 0; n < 2; ++n) acc[a][b][m][n] = (f32x4){0.f, 0.f, 0.f, 0.f};
    bf16x8 At[4][2], B0[2][2], B1[2][2];
    const char* cA = S.a_base(cur); const char* cB = S.b_base(cur);
    S.a_ready(cur);
    if constexpr (SP2) {
        PG8_STAGE(PG8_SB(0, 0), cB, voffB); PG8_STAGE(PG8_SB(0, 1), cB + hstepB, voffB); PG8_STAGE(PG8_SA(0, 0), cA, voffA); PG8_STAGE(PG8_SA(0, 1), cA + hstepA, voffA);
        if (wr == 1) PG8_BAR;
        PG8_WAIT_V(2); PG8_BAR;
        PG8_STAGE(PG8_SB(1, 0), cB + kstep, voffB); PG8_STAGE(PG8_SA(1, 0), cA + kstep, voffA); PG8_STAGE(PG8_SB(1, 1), cB + hstepB + kstep, voffB);
        PG8_WAIT_V(6); PG8_BAR;
    } else {
        PG8_STAGE(PG8_SB(0, 0), cB, voffB); PG8_STAGE(PG8_SA(0, 0), cA, voffA); PG8_STAGE(PG8_SB(0, 1), cB + hstepB, voffB); PG8_STAGE(PG8_SA(0, 1), cA + hstepA, voffA);
        if (wr == 1) PG8_BAR;
        PG8_WAIT_V(4); PG8_BAR;
        PG8_STAGE(PG8_SB(1, 0), cB + kstep, voffB); PG8_STAGE(PG8_SA(1, 0), cA + kstep, voffA); PG8_STAGE(PG8_SB(1, 1), cB + hstepB + kstep, voffB);
        PG8_WAIT_V(6); PG8_BAR;
    }
    for (;;) {
        const bool has_next = S.next(ui + 1, nxt);
        const char* nA = has_next ? S.a_base(nxt) : cA; const char* nB = has_next ? S.b_base(nxt) : cB;
#pragma unroll 1
        for (int t = 0; t < nt; t += 2) {
            if constexpr (Epi::KHOOK) { if (t != 0 && (t & 7) == 0) E.khook(acc, cur, t >> 3, wr, fr); }
            const bool last = (t == nt - 2);
            const char* a1 = cA + (size_t)(t + 1) * kstep;
            const char* a2 = last ? nA : cA + (size_t)(t + 2) * kstep; const char* b2 = last ? nB : cB + (size_t)(t + 2) * kstep;
            const char* a3 = a2 + kstep; const char* b3 = b2 + kstep;
            if (last && has_next) S.a_ready(nxt);
            if constexpr (SP2) {
            PG8_LDB(B0, 0, 0); PG8_LDB(B1, 0, 1); PG8_SCHED; PG8_LDA(At, 0, 0); PG8_STAGE(PG8_SA(1, 1), a1 + hstepA, voffA);
            PG8_WAIT_V(8); PG8_WAIT_L(0); PG8_BAR; PG8_MMA(0, 0, At, B0); PG8_MMA(0, 1, At, B1); PG8_BAR; PG8_SCHED;
            PG8_LDA(At, 0, 1); PG8_STAGE(PG8_SB(0, 0), b2, voffB); PG8_STAGE(PG8_SB(0, 1), b2 + hstepB, voffB); PG8_STAGE(PG8_SA(0, 0), a2, voffA);
            PG8_WAIT_V(8); PG8_WAIT_L(0); PG8_BAR; PG8_MMA(1, 0, At, B0); PG8_MMA(1, 1, At, B1); PG8_BAR; PG8_SCHED;
            PG8_LDB(B0, 1, 0); PG8_LDB(B1, 1, 1); PG8_SCHED; PG8_LDA(At, 1, 0); PG8_STAGE(PG8_SA(0, 1), a2 + hstepA, voffA);
            PG8_WAIT_V(8); PG8_WAIT_L(0); PG8_BAR; PG8_MMA(0, 0, At, B0); PG8_MMA(0, 1, At, B1); PG8_BAR; PG8_SCHED;
            PG8_LDA(At, 1, 1); PG8_STAGE(PG8_SB(1, 0), b3, voffB); PG8_STAGE(PG8_SB(1, 1), b3 + hstepB, voffB); PG8_STAGE(PG8_SA(1, 0), a3, voffA);
            PG8_WAIT_V(8); PG8_WAIT_L(0); PG8_BAR; PG8_MMA(1, 0, At, B0); PG8_MMA(1, 1, At, B1); PG8_BAR; PG8_SCHED;
            } else {
            PG8_LDB(B0, 0, 0); PG8_SCHED; PG8_LDA(At, 0, 0); PG8_STAGE(PG8_SA(1, 1), a1 + hstepA, voffA);
            PG8_WAIT_L(8); PG8_BAR; PG8_WAIT_L(0); PG8_MMA(0, 0, At, B0); PG8_BAR; PG8_SCHED;
            PG8_LDB(B1, 0, 1); PG8_STAGE(PG8_SB(0, 0), b2, voffB);
            PG8_BAR; PG8_WAIT_L(0); PG8_MMA(0, 1, At, B1); PG8_BAR;
            PG8_LDA(At, 0, 1); PG8_STAGE(PG8_SA(0, 0), a2, voffA);
            PG8_BAR; PG8_WAIT_L(0); PG8_MMA(1, 0, At, B0); PG8_BAR; PG8_SCHED;
            PG8_STAGE(PG8_SB(0, 1), b2 + hstepB, voffB);
            PG8_WAIT_V(6); PG8_BAR; PG8_MMA(1, 1, At, B1); PG8_BAR;
            PG8_LDB(B0, 1, 0); PG8_SCHED; PG8_LDA(At, 1, 0); PG8_STAGE(PG8_SA(0, 1), a2 + hstepA, voffA);
            PG8_WAIT_L(8); PG8_BAR; PG8_WAIT_L(0); PG8_MMA(0, 0, At, B0); PG8_BAR; PG8_SCHED;
            PG8_LDB(B1, 1, 1); PG8_STAGE(PG8_SB(1, 0), b3, voffB);
            PG8_BAR; PG8_WAIT_L(0); PG8_MMA(0, 1, At, B1); PG8_BAR;
            PG8_LDA(At, 1, 1); PG8_STAGE(PG8_SA(1, 0), a3, voffA);
            PG8_BAR; PG8_WAIT_L(0); PG8_MMA(1, 0, At, B0); PG8_BAR; PG8_SCHED;
            PG8_STAGE(PG8_SB(1, 1), b3 + hstepB, voffB);
            PG8_WAIT_V(6); PG8_BAR; PG8_MMA(1, 1, At, B1); PG8_BAR;
            }
        }
        if constexpr (ALIGN_EPI) { if (wr == 0) PG8_BAR; }
        if constexpr (!Epi::AFTER_DRAIN) { E(acc, cur, wr, wc, fr, fq); S.done(cur); }
        if (!has_next) break;
#pragma unroll
        for (int a = 0; a < 2; ++a)
#pragma unroll
            for (int b = 0; b < 2; ++b)
#pragma unroll
                for (int m = 0; m < 4; ++m)
#pragma unroll
                    for (int n = 0; n < 2; ++n) acc[a][b][m][n] = (f32x4){0.f, 0.f, 0.f, 0.f};
        cur = nxt; cA = nA; cB = nB; ++ui;
        if constexpr (ALIGN_EPI) { if (wr == 1) PG8_BAR; }
    }
    PG8_WAIT_V(0);
    if constexpr (!ALIGN_EPI) { if (wr == 0) PG8_BAR; }
    PG8_BAR;
    if constexpr (Epi::AFTER_DRAIN) { E.fused(acc, cur, wr, wc, fr, fq, lds, wid, lane); S.done(cur); }
#undef PG8_SA
#undef PG8_SB
#undef PG8_STAGE
#undef PG8_LDA
#undef PG8_LDB
#undef PG8_MMA
#undef PG8_WAIT_V
#undef PG8_WAIT_L
#undef PG8_BAR
#undef PG8_SCHED
}
__device__ __forceinline__ float silu_f(float x) { return x * __builtin_amdgcn_rcpf(1.f + __builtin_amdgcn_exp2f(-1.4426950408889634f * x)); }
__device__ __forceinline__ float sigm_f(float x) { return __builtin_amdgcn_rcpf(1.f + __builtin_amdgcn_exp2f(-1.4426950408889634f * x)); }
__device__ __forceinline__ u32x4 pack8(const f32x4 a, const f32x4 b) { u32x4 w; w.x = cvt_pk_bf16(a[0], a[1]); w.y = cvt_pk_bf16(a[2], a[3]); w.z = cvt_pk_bf16(b[0], b[1]); w.w = cvt_pk_bf16(b[2], b[3]); return w; }
__device__ __forceinline__ unsigned short bf1(float f) { return (unsigned short)(cvt_pk_bf16(f, 0.f) & 0xffffu); }

struct EpiEven {
    static constexpr bool PERM = true, AFTER_DRAIN = false, KHOOK = false;
    bf16_t *QA, *KA, *VAT, *GA, *QB, *KB, *VB, *GB; float* LOGF; float* out;
    const float *qg, *kg, *hlb; float qscale; int MTOT, MPR; size_t okp, oks, ovp, ovs;
    __device__ __forceinline__ void operator()(const f32x4 (&acc)[2][2][4][2], const Unit& u, int wr, int wc, int fr, int fq) const {
        const int typ = u.pn >> 1;
        int rb = u.pm * BM + wr * 64 + fr; asm volatile("" : "+v"(rb));
        const int c0 = (u.pn & 1) * 256 + wc * 64 + fq * 8;
        const int d0 = fq * 8;
#pragma unroll
        for (int ai = 0; ai < 2; ++ai)
#pragma unroll
            for (int m = 0; m < 4; ++m) {
                const int row = rb + ai * HALF + m * 16;
                f32x4 v[2][2];
#pragma unroll
                for (int bj = 0; bj < 2; ++bj)
#pragma unroll
                    for (int n = 0; n < 2; ++n) v[bj][n] = acc[ai][bj][m][n];
                if (typ <= 1) {
                    float ss = 0.f;
#pragma unroll
                    for (int bj = 0; bj < 2; ++bj)
#pragma unroll
                        for (int n = 0; n < 2; ++n) ss += (v[bj][n][0] * v[bj][n][0] + v[bj][n][1] * v[bj][n][1]) + (v[bj][n][2] * v[bj][n][2] + v[bj][n][3] * v[bj][n][3]);
                    ss += __shfl_xor(ss, 16); ss += __shfl_xor(ss, 32);
                    const float rstd = __builtin_amdgcn_rsqf(ss * (1.f / 64.f) + 1e-6f) * (typ == 0 ? qscale : 1.f);
                    const float* g = (typ == 0) ? qg : kg;
#pragma unroll
                    for (int bj = 0; bj < 2; ++bj) {
#pragma unroll
                        for (int n = 0; n < 2; ++n) { const f32x4 gv = *(const f32x4*)(g + d0 + 32 * bj + 4 * n); v[bj][n] = v[bj][n] * gv * rstd; }
                        const int c = c0 + 32 * bj;
                        if (typ == 0) *(u32x4*)(QA + (size_t)row * 512 + c) = pack8(v[bj][0], v[bj][1]);
                        else {
                            *(u32x4*)(KA + (size_t)row * 512 + c) = pack8(v[bj][0], v[bj][1]);
                            float* ko = out + (row < MPR ? okp + (size_t)row * 512 : oks + (size_t)(row - MPR) * 512) + c;
                            *(f32x4*)ko = v[bj][0]; *(f32x4*)(ko + 4) = v[bj][1];
                        }
                    }
                } else if (typ == 2) {
#pragma unroll
                    for (int bj = 0; bj < 2; ++bj) {
                        const int c = c0 + 32 * bj;
                        float* vo = out + (row < MPR ? ovp + (size_t)row * 512 : ovs + (size_t)(row - MPR) * 512) + c;
                        *(f32x4*)vo = v[bj][0]; *(f32x4*)(vo + 4) = v[bj][1];
                        *(u32x4*)(VAT + (size_t)row * 512 + c) = pack8(v[bj][0], v[bj][1]);
                    }
                } else if (typ == 5) {
#pragma unroll
                    for (int bj = 0; bj < 2; ++bj) {
                        const int c = c0 + 32 * bj;
                        f32x4 lf[2], kk[2];
#pragma unroll
                        for (int n = 0; n < 2; ++n)
#pragma unroll
                            for (int e = 0; e < 4; ++e) {
                                const int cc = c + 4 * n + e;
                                const float lb = __builtin_amdgcn_rcpf(1.f + __expf(hlb[512 + cc] - hlb[cc]));
                                const float sg = sigm_f(v[bj][n][e]);
                                lf[n][e] = __logf(lb + (1.f - lb) * sg);
                                kk[n][e] = (1.f - lb) * (1.f - sg);
                            }
                        *(f32x4*)(LOGF + (size_t)row * 512 + c) = lf[0]; *(f32x4*)(LOGF + (size_t)row * 512 + c + 4) = lf[1];
                        *(u32x4*)(KB + (size_t)row * 512 + c) = pack8(kk[0], kk[1]);
                    }
                } else {
                    bf16_t* dst = (typ == 3) ? GA : (typ == 4) ? QB : (typ == 6) ? VB : GB;
#pragma unroll
                    for (int bj = 0; bj < 2; ++bj) {
                        if (typ != 6) {
#pragma unroll
                            for (int n = 0; n < 2; ++n)
#pragma unroll
                                for (int e = 0; e < 4; ++e) v[bj][n][e] = silu_f(v[bj][n][e]);
                        }
                        *(u32x4*)(dst + (size_t)row * 512 + c0 + 32 * bj) = pack8(v[bj][0], v[bj][1]);
                    }
                }
            }
    }
};


struct EpiY1 {
    static constexpr bool PERM = false, AFTER_DRAIN = false, KHOOK = false;
    const float* x; bf16_t* Y1; float* SS1;
    __device__ __forceinline__ void operator()(const f32x4 (&acc)[2][2][4][2], const Unit& u, int wr, int wc, int fr, int fq) const {
        int row0 = u.pm * BM + wr * 64 + fr; asm volatile("" : "+v"(row0));
        const int col0 = u.pn * BM + wc * 32 + 4 * fq;
#pragma unroll
        for (int ai = 0; ai < 2; ++ai)
#pragma unroll
            for (int m = 0; m < 4; ++m) {
                const int row = row0 + ai * HALF + m * 16; float ss = 0.f;
#pragma unroll
                for (int bj = 0; bj < 2; ++bj)
#pragma unroll
                    for (int n = 0; n < 2; ++n) { const int c = col0 + bj * HALF + n * 16;
                        const f32x4 y = acc[ai][bj][m][n] + *(const f32x4*)(x + (size_t)row * 1024 + c);
                        *(unsigned long long*)(Y1 + (size_t)row * 1024 + c) = (unsigned long long)cvt_pk_bf16(y[0], y[1]) | ((unsigned long long)cvt_pk_bf16(y[2], y[3]) << 32);
                        ss += (y[0] * y[0] + y[1] * y[1]) + (y[2] * y[2] + y[3] * y[3]); }
                ss += __shfl_xor(ss, 16); ss += __shfl_xor(ss, 32);
                if (fq == 0) atomicAdd(SS1 + row, ss);
            }
    }
};


__device__ __forceinline__ float lg2gamma(int h) { return __builtin_amdgcn_logf(1.f - __builtin_amdgcn_exp2f(-5.f - (float)h)); }

template <int KIND> struct EpiOdd3 {
    static constexpr bool PERM = true, AFTER_DRAIN = false, KHOOK = false;
    bf16_t *AQ, *KCH, *KCT, *BV, *GC, *QC, *KC, *VC; const float *rcos, *rsin, *rcosT, *rsinT; int MPR; const float* SS1;
    __device__ __forceinline__ void operator()(const f32x4 (&acc)[2][2][4][2], const Unit& u, int wr, int wc, int fr, int fq) const {

        if (KIND == 0) {
            const int j0 = wc * 32 + fq * 8;
            int rb = u.pm * BM + wr * 64 + fr; asm volatile("" : "+v"(rb));
#pragma unroll
            for (int ai = 0; ai < 2; ++ai)
#pragma unroll
                for (int m = 0; m < 4; ++m) {
                    const int row = rb + ai * HALF + m * 16;
                    const float rs = __builtin_amdgcn_rsqf(SS1[row] * (1.f / 1024.f) + 1e-6f);
                    if (u.pn < 8) {
                        const int pos = row & (TP - 1), h = u.pn & 3, tl = row & 255;
                        const float sc = rs * ((u.pn < 4) ? __builtin_amdgcn_exp2f((float)tl * lg2gamma(h)) : 0.0625f * __builtin_amdgcn_exp2f(-(float)tl * lg2gamma(h)));
                        f32x4 o1[2], o2[2];
#pragma unroll
                        for (int n = 0; n < 2; ++n) {
                            const f32x4 c = *(const f32x4*)(rcos + (size_t)pos * 128 + j0 + 4 * n), s = *(const f32x4*)(rsin + (size_t)pos * 128 + j0 + 4 * n);
                            const f32x4 x1 = acc[ai][0][m][n], x2 = acc[ai][1][m][n];
                            o1[n] = (x1 * c - x2 * s) * sc; o2[n] = (x2 * c + x1 * s) * sc;
                        }
                        bf16_t* dst = (u.pn < 4) ? AQ + (size_t)row * 2048 + h * 512 + 256 + j0 : KCH + (size_t)row * 1024 + h * 256 + j0;
                        *(u32x4*)dst = pack8(o1[0], o1[1]); *(u32x4*)(dst + 128) = pack8(o2[0], o2[1]);
                        if (u.pn >= 4) {
                            bf16_t* kt = KCT + ((size_t)(((row >> 13) * 4 + h) * 32 + ((row >> 8) & 31)) * 256 + j0) * 256 + tl;
#pragma unroll
                            for (int n = 0; n < 2; ++n)
#pragma unroll
                                for (int e = 0; e < 4; ++e) { kt[(size_t)(4 * n + e) * 256] = bf1(o1[n][e]); kt[(size_t)(128 + 4 * n + e) * 256] = bf1(o2[n][e]); }
                        }
                        asm volatile("" ::: "memory");
                    } else {
                        bf16_t* dst = GC + (size_t)row * 2048 + (u.pn - 8) * 256 + j0;
#pragma unroll
                        for (int bj = 0; bj < 2; ++bj) {
                            f32x4 a = acc[ai][bj][m][0] * rs, b = acc[ai][bj][m][1] * rs;
#pragma unroll
                            for (int e = 0; e < 4; ++e) { a[e] = silu_f(a[e]); b[e] = silu_f(b[e]); }
                            *(u32x4*)(dst + 128 * bj) = pack8(a, b);
                        }
                    }
                }
            return;
        }
        int fro = fr; asm volatile("" : "+v"(fro));
        {
#pragma unroll
            for (int ai = 0; ai < 2; ++ai)
#pragma unroll
                for (int m = 0; m < 4; ++m) {
                    const int vf = (u.pm - 4) * BM + ai * HALF + wr * 64 + m * 16 + fro, h = vf >> 9, dv = vf & 511;
#pragma unroll
                    for (int bj = 0; bj < 2; ++bj) {
                        const int tok0 = u.pn * BM + bj * HALF + wc * 32 + fq * 8, b = tok0 >> 13, c = (tok0 >> 8) & 31, sl = tok0 & 255;
                        f32x4 r0 = *(const f32x4*)(SS1 + tok0), r1 = *(const f32x4*)(SS1 + tok0 + 4);
#pragma unroll
                        for (int e = 0; e < 4; ++e) { r0[e] = __builtin_amdgcn_rsqf(r0[e] * (1.f / 1024.f) + 1e-6f); r1[e] = __builtin_amdgcn_rsqf(r1[e] * (1.f / 1024.f) + 1e-6f); }
                        *(u32x4*)(BV + ((size_t)((b * 4 + h) * 32 + c) * 512 + dv) * 512 + sl) = pack8(acc[ai][bj][m][0] * r0, acc[ai][bj][m][1] * r1);
                    }
                }
        }
    }
};
template <int KIND> struct Sched3 {
    StaticOrder so; const char *H, *W3T; int G, c;
    __device__ __forceinline__ void init(const void* H_, const void* W3T_, int G_, int c_) { H = (const char*)H_; W3T = (const char*)W3T_; G = G_; c = c_; so.init(16384, 4096, G_, c_); }
    __device__ __forceinline__ bool next(int i, Unit& u) const {
        const int L = i * G + c; u.aux = 0; u.kind = KIND;
        if (KIND == 0) return so.next(i, u);
        if (KIND == 1) { if (L >= 512) return false; u.pm = 4 + (L & 7); u.pn = L >> 3; return true; }
        if (L >= 24) return false; u.pm = 64; u.pn = L; return true;
    }
    __device__ __forceinline__ const char* a_base(const Unit& u) const { return (KIND == 1) ? W3T + (size_t)(1024 + 256 * u.pm) * 2048 : H + (size_t)u.pm * 256 * 2048; }
    __device__ __forceinline__ const char* b_base(const Unit& u) const {
        if (KIND == 1) return H + (size_t)u.pn * 256 * 2048;
        const int r0 = (KIND == 0 && u.pn >= 8) ? 4096 + 256 * (u.pn - 8) : 256 * u.pn;
        return W3T + (size_t)r0 * 2048; }
    __device__ __forceinline__ void a_ready(const Unit&) const {}
    __device__ __forceinline__ void done(const Unit&) const {}
};
struct SchedPlain {
    StaticOrder so; const char *A, *Bt; size_t ta, tb;
    __device__ __forceinline__ void init(const void* A_, const void* Bt_, int M, int N, int K, int G, int c) { A = (const char*)A_; Bt = (const char*)Bt_; ta = (size_t)256 * K * 2; tb = ta; so.init(M, N, G, c); }
    __device__ __forceinline__ bool next(int i, Unit& u) const { u.kind = 0; u.aux = 0; return so.next(i, u); }
    __device__ __forceinline__ const char* a_base(const Unit& u) const { return A + (size_t)u.pm * ta; }
    __device__ __forceinline__ const char* b_base(const Unit& u) const { return Bt + (size_t)u.pn * tb; }
    __device__ __forceinline__ void a_ready(const Unit&) const {}
    __device__ __forceinline__ void done(const Unit&) const {}
};
struct SchedRet {
    const char *Ab, *Bb; int G, c, mode;
    __device__ __forceinline__ bool next(int i, Unit& u) const {
        const int L = i * G + c, n = (mode == 1) ? 256 : 512; if (L >= n) return false;
        int bc, half; if (mode == 1) { bc = L; half = 0; } else { bc = L >> 1; half = L & 1; }
        u.pm = bc; u.pn = half; u.kind = 0; u.aux = (bc >> 7) * TP + (bc & 31) * 256; return true;
    }
    __device__ __forceinline__ const char* a_base(const Unit& u) const {
        if (mode == 0) return Ab + ((size_t)u.pm * 512 + u.pn * 256) * 512 * 2;
        const int h = (u.pm >> 5) & 3;
        return Ab + ((size_t)u.aux * 2048 + h * 512 + (mode == 1 ? 256 : 0)) * 2; }
    __device__ __forceinline__ const char* b_base(const Unit& u) const {
        const int h = (u.pm >> 5) & 3;
        if (mode == 0) return Bb + (size_t)u.pm * 256 * 256 * 2;
        if (mode == 1) return Bb + ((size_t)u.aux * 1024 + h * 256) * 2;
        return Bb + ((size_t)u.pm * 512 + u.pn * 256) * 512 * 2; }
    __device__ __forceinline__ void a_ready(const Unit&) const {}
    __device__ __forceinline__ void done(const Unit&) const {}
};
struct EpiRetA {
    static constexpr bool PERM = true, AFTER_DRAIN = false, KHOOK = false;
    bf16_t* DST;
    __device__ __forceinline__ void operator()(const f32x4 (&acc)[2][2][4][2], const Unit& u, int wr, int wc, int fr, int fq) const {
        bf16_t* base = DST + ((size_t)u.pm * 512 + u.pn * 256) * 256;
        int rb = wr * 64 + fr; asm volatile("" : "+v"(rb));
#pragma unroll
        for (int ai = 0; ai < 2; ++ai)
#pragma unroll
            for (int m = 0; m < 4; ++m) { bf16_t* rp = base + (size_t)(ai * HALF + m * 16 + rb) * 256 + wc * 32 + 8 * fq;
#pragma unroll
                for (int bj = 0; bj < 2; ++bj) *(u32x4*)(rp + bj * HALF) = pack8(acc[ai][bj][m][0], acc[ai][bj][m][1]); }
    }
};
struct EpiRetP {
    static constexpr bool PERM = true, AFTER_DRAIN = false, KHOOK = false;
    bf16_t* AQ;
    __device__ __forceinline__ void operator()(const f32x4 (&acc)[2][2][4][2], const Unit& u, int wr, int wc, int fr, int fq) const {
        const int h = (u.pm >> 5) & 3;
        int rb = wr * 64 + fr; asm volatile("" : "+v"(rb));
#pragma unroll
        for (int ai = 0; ai < 2; ++ai)
#pragma unroll
            for (int m = 0; m < 4; ++m) { const int t = ai * HALF + m * 16 + rb;
#pragma unroll
                for (int bj = 0; bj < 2; ++bj) { const int s0 = bj * HALF + wc * 32 + fq * 8; f32x4 a = acc[ai][bj][m][0], b = acc[ai][bj][m][1];
#pragma unroll
                    for (int e = 0; e < 4; ++e) { if (s0 + e > t) a[e] = 0.f; if (s0 + 4 + e > t) b[e] = 0.f; }
                    *(u32x4*)(AQ + (size_t)(u.aux + t) * 2048 + h * 512 + s0) = pack8(a, b); } }
    }
};
struct EpiRetO {
    static constexpr bool PERM = true, AFTER_DRAIN = false, KHOOK = false;
    const bf16_t* GC; bf16_t* MIX2; float* SS;
    __device__ __forceinline__ void operator()(const f32x4 (&acc)[2][2][4][2], const Unit& u, int wr, int wc, int fr, int fq) const {
        const int h = (u.pm >> 5) & 3;
        int rb = u.aux + wr * 64 + fr; asm volatile("" : "+v"(rb));
#pragma unroll
        for (int ai = 0; ai < 2; ++ai)
#pragma unroll
            for (int m = 0; m < 4; ++m) { const size_t row = (size_t)(rb + ai * HALF + m * 16); float ss = 0.f;
#pragma unroll
                for (int bj = 0; bj < 2; ++bj) { const int col = h * 512 + u.pn * 256 + bj * HALF + wc * 32 + fq * 8; f32x4 a = acc[ai][bj][m][0], b = acc[ai][bj][m][1];
                    ss += (a[0] * a[0] + a[1] * a[1]) + (a[2] * a[2] + a[3] * a[3]) + (b[0] * b[0] + b[1] * b[1]) + (b[2] * b[2] + b[3] * b[3]);
                    const u32x4 g = *(const u32x4*)(GC + row * 2048 + col);
                    a[0] *= __builtin_bit_cast(float, g.x << 16); a[1] *= __builtin_bit_cast(float, g.x & 0xffff0000u); a[2] *= __builtin_bit_cast(float, g.y << 16); a[3] *= __builtin_bit_cast(float, g.y & 0xffff0000u);
                    b[0] *= __builtin_bit_cast(float, g.z << 16); b[1] *= __builtin_bit_cast(float, g.z & 0xffff0000u); b[2] *= __builtin_bit_cast(float, g.w << 16); b[3] *= __builtin_bit_cast(float, g.w & 0xffff0000u);
                    *(u32x4*)(MIX2 + row * 2048 + col) = pack8(a, b); }
                ss += __shfl_xor(ss, 16); ss += __shfl_xor(ss, 32);
                if (fq == 0) atomicAdd(SS + row * 4 + h, ss); }
    }
};

struct SchedSplit {
    const char *A, *Bt; int nN, nP, G, c; size_t lda2, ldb2;
    __device__ __forceinline__ bool next(int i, Unit& u) const { const int L = i * G + c; if (L >= nN * nP) return false; u.pn = L / nP; u.aux = L % nP; u.pm = 0; u.kind = 0; return true; }
    __device__ __forceinline__ const char* a_base(const Unit& u) const { return A + (size_t)u.aux * 512; }
    __device__ __forceinline__ const char* b_base(const Unit& u) const { return Bt + (size_t)u.pn * 256 * ldb2 + (size_t)u.aux * 512; }
    __device__ __forceinline__ void a_ready(const Unit&) const {}
    __device__ __forceinline__ void done(const Unit&) const {}
};
struct EpiSlab {
    static constexpr bool PERM = true, AFTER_DRAIN = false, KHOOK = false;
    bf16_t* slab; int ncols;
    __device__ __forceinline__ void operator()(const f32x4 (&acc)[2][2][4][2], const Unit& u, int wr, int wc, int fr, int fq) const {
        int rb = wr * 64 + fr; asm volatile("" : "+v"(rb));
        bf16_t* base = slab + (size_t)u.aux * 256 * ncols + u.pn * BM + wc * 32 + 8 * fq;
#pragma unroll
        for (int ai = 0; ai < 2; ++ai)
#pragma unroll
            for (int m = 0; m < 4; ++m) { bf16_t* rp = base + (size_t)(rb + ai * HALF + m * 16) * ncols;
#pragma unroll
                for (int bj = 0; bj < 2; ++bj) *(u32x4*)(rp + bj * HALF) = pack8(acc[ai][bj][m][0], acc[ai][bj][m][1]); }
    }
};
struct EpiOut {
    static constexpr bool PERM = false, AFTER_DRAIN = false, KHOOK = true;
    const bf16_t* Y1; float* out; const float* SS;
    __device__ __forceinline__ float rstd(int row, int h) const { return __builtin_amdgcn_rsqf(SS[(size_t)row * 4 + h] * (1.f / 512.f) + 1e-6f); }
    __device__ __forceinline__ void khook(f32x4 (&acc)[2][2][4][2], const Unit& u, int hb, int wr, int fr) const {
        int rb = u.pm * BM + wr * 64 + fr; asm volatile("" : "+v"(rb));
#pragma unroll
        for (int ai = 0; ai < 2; ++ai)
#pragma unroll
            for (int m = 0; m < 4; ++m) { const int row = rb + ai * HALF + m * 16; const float ratio = rstd(row, hb - 1) * __builtin_amdgcn_rcpf(rstd(row, hb));
#pragma unroll
                for (int bj = 0; bj < 2; ++bj)
#pragma unroll
                    for (int n = 0; n < 2; ++n) acc[ai][bj][m][n] = acc[ai][bj][m][n] * ratio; }
    }
    __device__ __forceinline__ void operator()(const f32x4 (&acc)[2][2][4][2], const Unit& u, int wr, int wc, int fr, int fq) const {
        int row0 = u.pm * BM + wr * 64 + fr; asm volatile("" : "+v"(row0));
        const int col0 = u.pn * BM + wc * 32 + 4 * fq;
#pragma unroll
        for (int ai = 0; ai < 2; ++ai)
#pragma unroll
            for (int m = 0; m < 4; ++m) { const int row = row0 + ai * HALF + m * 16; const float r3 = rstd(row, 3);
#pragma unroll
                for (int bj = 0; bj < 2; ++bj)
#pragma unroll
                    for (int n = 0; n < 2; ++n) { const int c = col0 + bj * HALF + n * 16; const unsigned long long yq = *(const unsigned long long*)(Y1 + (size_t)row * 1024 + c);
                        const f32x4 yv = {__builtin_bit_cast(float, (unsigned)yq << 16), __builtin_bit_cast(float, (unsigned)yq & 0xffff0000u), __builtin_bit_cast(float, (unsigned)(yq >> 32) << 16), __builtin_bit_cast(float, (unsigned)(yq >> 32) & 0xffff0000u)};
                        *(f32x4*)(out + (size_t)row * 1024 + c) = acc[ai][bj][m][n] * r3 + yv; } }
    }
};
}
#define GAS __attribute__((address_space(1)))
#define LAS __attribute__((address_space(3)))
typedef unsigned short bf16;
typedef unsigned v4u __attribute__((ext_vector_type(4)));
typedef float f32x4 __attribute__((ext_vector_type(4)));
typedef short bf16x8 __attribute__((ext_vector_type(8)));
typedef GAS unsigned gu32;
typedef GAS unsigned long long gu64;
#define RLX_AGENT __ATOMIC_RELAXED, __HIP_MEMORY_SCOPE_AGENT
#define LDS_WAIT() asm volatile("s_waitcnt lgkmcnt(0)" ::: "memory")
#define VM_WAIT() asm volatile("s_waitcnt vmcnt(0)" ::: "memory")
__device__ __forceinline__ unsigned long long rt() { return __builtin_amdgcn_s_memrealtime(); }
__device__ __forceinline__ unsigned f2bf(float f) { unsigned u = __builtin_bit_cast(unsigned, f); return (u + 0x7fffu + ((u >> 16) & 1u)) >> 16; }
__device__ __forceinline__ unsigned pk2(float lo, float hi) { return f2bf(lo) | (f2bf(hi) << 16); }
#define XB_TMO      128
#define XB_XCNT(j)  (256  + 64 * (j))
#define XB_XSUB(j)  (1280 + 64 * (j))
#define XB_XGEN(j)  (2304 + 64 * (j))
#define XB_TOP      3328
#define XB_TOPGEN   3392
#define XCD_BAR_WORDS 3456
#define XB_SPIN_CAP (1u << 18)

__device__ __forceinline__ unsigned xb_ld(unsigned* p)              { return __hip_atomic_load(p, __ATOMIC_RELAXED, __HIP_MEMORY_SCOPE_AGENT); }
__device__ __forceinline__ unsigned xb_add(unsigned* p, unsigned v) { return __hip_atomic_fetch_add(p, v, __ATOMIC_RELAXED, __HIP_MEMORY_SCOPE_AGENT); }
__device__ __forceinline__ unsigned xb_xcc_id() { return (unsigned)__builtin_amdgcn_s_getreg((3 << 11) | 20) & 0xFu; }
#define XB_SPIN(cond, bar) do { unsigned _sp = 0; while (cond) { __builtin_amdgcn_s_sleep(1); \
    if ((++_sp & 255u) == 0u) { if (xb_ld(&(bar)[XB_TMO])) break; if (_sp > XB_SPIN_CAP) { atomicAdd(&(bar)[XB_TMO], 1u); break; } } } } while (0)

struct XcdBarrier {
    unsigned* bar; unsigned x;
    volatile LAS unsigned* st;
};

__device__ __forceinline__ XcdBarrier xcd_barrier_post(unsigned* bar, volatile LAS unsigned* st) {
    XcdBarrier b; b.bar = bar; b.x = xb_xcc_id(); b.st = st;
    if (threadIdx.x == 0) (void)xb_add(&bar[XB_XCNT(b.x)], 1u);
    return b;
}
__device__ __forceinline__ void xcd_barrier_complete(unsigned* bar, unsigned x, unsigned& nloc, unsigned& nx) {
    const unsigned G = gridDim.x * gridDim.y * gridDim.z;
    unsigned sum, cnt, mine, sp = 0u;
    for (;;) {
        sum = 0u; cnt = 0u; mine = 0u;
#pragma unroll
        for (unsigned j = 0; j < 16; ++j) { const unsigned c = xb_ld(&bar[XB_XCNT(j)]); sum += c; cnt += (c > 0u) ? 1u : 0u; mine = (j == x) ? c : mine; }
        if (sum == G) break;
        __builtin_amdgcn_s_sleep(1);
        if ((++sp & 255u) == 0u) { if (xb_ld(&bar[XB_TMO])) break; if (sp > XB_SPIN_CAP) { atomicAdd(&bar[XB_TMO], 1u); break; } }
    }
    nloc = mine > 0u ? mine : 1u; nx = cnt > 0u ? cnt : 1u;
}

__device__ __forceinline__ void xcd_barrier(const XcdBarrier& b) {
    asm volatile("s_waitcnt vmcnt(0)" ::: "memory");
    __syncthreads();
    if (threadIdx.x == 0) {
        unsigned* bar = b.bar;
        __builtin_amdgcn_s_waitcnt(0);
        unsigned nloc = b.st[0], nx = b.st[1];
        if (nloc == 0u) { xcd_barrier_complete(bar, b.x, nloc, nx); b.st[0] = nloc; b.st[1] = nx; }
        const unsigned old = xb_add(&bar[XB_XSUB(b.x)], 1u);
        const unsigned gen = old / nloc;
        if (old + 1u == (gen + 1u) * nloc) {
            __builtin_amdgcn_fence(__ATOMIC_RELEASE, "agent");
            asm volatile("s_waitcnt vmcnt(0)" ::: "memory");
            const unsigned og = xb_add(&bar[XB_TOP], 1u);
            const unsigned tg = og / nx;
            if (og + 1u == (tg + 1u) * nx) xb_add(&bar[XB_TOPGEN], 1u);
            else XB_SPIN(xb_ld(&bar[XB_TOPGEN]) == tg, bar);
            __builtin_amdgcn_fence(__ATOMIC_ACQUIRE, "agent");
            xb_add(&bar[XB_XGEN(b.x)], 1u);
            asm volatile("s_waitcnt vmcnt(0)" ::: "memory");
        } else {
            XB_SPIN(xb_ld(&bar[XB_XGEN(b.x)]) == gen, bar);
            __builtin_amdgcn_fence(__ATOMIC_ACQUIRE, "agent");
            asm volatile("s_waitcnt vmcnt(0)" ::: "memory");
        }
    }
    __syncthreads();
}
constexpr size_t MiB = 1u << 20;
constexpr size_t WS_CTL = 0, CTL_ZERO_BYTES = 1 * MiB;
constexpr size_t WS_W1T = 2 * MiB;
constexpr size_t WS_W2T = 10 * MiB;
constexpr size_t WS_W3T = 12 * MiB;
constexpr size_t WS_W4T = 24 * MiB;
constexpr size_t WS_RCOS = 28 * MiB, WS_RSIN = 33 * MiB;
constexpr size_t SZ_H = (size_t)MT * 1024 * 2;
constexpr size_t SZ_S = (size_t)MT * 512 * 2;
constexpr size_t WS_H = 40 * MiB;
constexpr size_t WS_QA = WS_H + 33 * MiB, WS_KA = WS_QA + 17 * MiB, WS_VAT = WS_KA + 17 * MiB, WS_GA = WS_VAT + 17 * MiB;
constexpr size_t WS_QB = WS_GA + 17 * MiB, WS_KB = WS_QB + 17 * MiB, WS_VB = WS_KB + 17 * MiB, WS_GB = WS_VB + 17 * MiB;
constexpr size_t WS_LOGF = WS_GB + 17 * MiB;
constexpr size_t WS_OB = WS_LOGF + 33 * MiB;
constexpr size_t WS_MIX = WS_OB + 33 * MiB;
constexpr size_t WS_Y1 = WS_MIX + 33 * MiB;
constexpr size_t WS_QC = WS_Y1 + 65 * MiB, WS_KC = WS_QC + 33 * MiB;
constexpr size_t WS_VC = WS_KC + 33 * MiB, WS_GC = WS_VC + 65 * MiB;
constexpr size_t WS_OC = WS_GC + 65 * MiB;
constexpr size_t WS_MIX2 = WS_OC + 130 * MiB;
constexpr size_t WS_AQ = WS_MIX2 + 65 * MiB;
constexpr size_t WS_KCH = WS_AQ + 64 * MiB;
constexpr size_t WS_KCT = WS_KCH + 32 * MiB;
constexpr size_t WS_BV = WS_KCT + 32 * MiB;
constexpr size_t WS_DST = WS_BV + 128 * MiB;
constexpr size_t WS_RCOST = WS_DST + 128 * MiB, WS_RSINT = WS_RCOST + 5 * MiB;
constexpr size_t WS_DSH = WS_RSINT + 5 * MiB;
constexpr size_t WS_SST = WS_DSH + 16 * MiB;
constexpr size_t WS_DD = WS_SST + 16 * MiB;
constexpr size_t WS_SLAB = WS_DD + 1 * MiB;
constexpr size_t WS_SLAB4 = WS_SLAB + 24 * MiB;
constexpr size_t WS_END = WS_SLAB4 + 8 * MiB;
constexpr size_t CTL_SS = 65536;
constexpr size_t CTL_SS1 = CTL_SS + (size_t)MP * 16;
constexpr size_t CTL_SSS = CTL_SS1 + (size_t)MT * 4;
static_assert(CTL_SSS + 4096 <= CTL_ZERO_BYTES, "SS / SS1 / SSS inside the zeroed region");
static_assert(SZ_H <= 33 * MiB && SZ_S <= 17 * MiB && (size_t)MT * 2048 * 4 <= 130 * MiB, "ws map");

constexpr int CW_TMO = 0, CW_CODE = 1, CW_BAR = 4096;

constexpr int RING_OFF = 0, RING_BYTES = 131072;
constexpr int LDSCTL_OFF = RING_BYTES, MISC_OFF = LDSCTL_OFF + 320;
constexpr int LDS_BYTES = 147456;
constexpr int NWAVES = 8;

typedef float f32x16 __attribute__((ext_vector_type(16)));
__device__ __forceinline__ float bf2f(bf16 b) { return __builtin_bit_cast(float, (unsigned)b << 16); }
__device__ __forceinline__ float bflo(unsigned w) { return __builtin_bit_cast(float, w << 16); }
__device__ __forceinline__ float bfhi(unsigned w) { return __builtin_bit_cast(float, w & 0xffff0000u); }
__device__ __forceinline__ int crow(int r, int hi) { return (r & 3) + 8 * (r >> 2) + 4 * hi; }
__device__ __forceinline__ float wave_sum(float v) {
#pragma unroll
    for (int o = 1; o < 64; o <<= 1) v += __shfl_xor(v, o);
    return v;
}

struct Frame {
    LAS unsigned char* lds;
    volatile LAS unsigned* MISC;
    gu32* ctl;
    int tid, lane, wave, G, bid;
    const float *xp, *xs, *ck, *cv, *st_h, *st_r, *ng, *w1, *w2, *qg, *kg, *sbb, *hlb, *og, *w3, *w4; const int* pt;
    float* out;
    unsigned char* ws;
    __device__ __forceinline__ float* SSS() const { return (float*)(ws + WS_CTL + CTL_SSS); }
    __device__ __forceinline__ float* SS1() const { return (float*)(ws + WS_CTL + CTL_SS1); }
    __device__ __forceinline__ bf16* SLAB() const { return (bf16*)(ws + WS_SLAB); }
    __device__ __forceinline__ bf16* Y1B() const { return (bf16*)(ws + WS_OB); }
    __device__ __forceinline__ bf16* SLAB4() const { return (bf16*)(ws + WS_SLAB4); }
    __device__ __forceinline__ bf16* W1T() const { return (bf16*)(ws + WS_W1T); }
    __device__ __forceinline__ bf16* W2T() const { return (bf16*)(ws + WS_W2T); }
    __device__ __forceinline__ bf16* W3T() const { return (bf16*)(ws + WS_W3T); }
    __device__ __forceinline__ bf16* W4T() const { return (bf16*)(ws + WS_W4T); }
    __device__ __forceinline__ bf16* H() const { return (bf16*)(ws + WS_H); }
    __device__ __forceinline__ bf16* QA() const { return (bf16*)(ws + WS_QA); }
    __device__ __forceinline__ bf16* KA() const { return (bf16*)(ws + WS_KA); }
    __device__ __forceinline__ bf16* VAT() const { return (bf16*)(ws + WS_VAT); }
    __device__ __forceinline__ bf16* VA() const { return (bf16*)(ws + WS_VAT); }
    __device__ __forceinline__ bf16* GA() const { return (bf16*)(ws + WS_GA); }
    __device__ __forceinline__ bf16* QB() const { return (bf16*)(ws + WS_QB); }
    __device__ __forceinline__ bf16* KB() const { return (bf16*)(ws + WS_KB); }
    __device__ __forceinline__ bf16* VB() const { return (bf16*)(ws + WS_VB); }
    __device__ __forceinline__ bf16* GB() const { return (bf16*)(ws + WS_GB); }
    __device__ __forceinline__ bf16* MIX() const { return (bf16*)(ws + WS_MIX); }
    __device__ __forceinline__ bf16* QC() const { return (bf16*)(ws + WS_QC); }
    __device__ __forceinline__ bf16* KC() const { return (bf16*)(ws + WS_KC); }
    __device__ __forceinline__ bf16* VC() const { return (bf16*)(ws + WS_VC); }
    __device__ __forceinline__ bf16* GC() const { return (bf16*)(ws + WS_GC); }
    __device__ __forceinline__ bf16* MIX2() const { return (bf16*)(ws + WS_MIX2); }
    __device__ __forceinline__ float* RCOS() const { return (float*)(ws + WS_RCOS); }
    __device__ __forceinline__ float* RSIN() const { return (float*)(ws + WS_RSIN); }
    __device__ __forceinline__ float* LOGF() const { return (float*)(ws + WS_LOGF); }
    __device__ __forceinline__ float* OB() const { return (float*)(ws + WS_OB); }
    __device__ __forceinline__ float* Y1() const { return (float*)(ws + WS_Y1); }
    __device__ __forceinline__ float* OC() const { return (float*)(ws + WS_OC); }
    __device__ __forceinline__ bf16* AQ() const { return (bf16*)(ws + WS_AQ); }
    __device__ __forceinline__ bf16* KCH() const { return (bf16*)(ws + WS_KCH); }
    __device__ __forceinline__ bf16* KCT() const { return (bf16*)(ws + WS_KCT); }
    __device__ __forceinline__ bf16* BV() const { return (bf16*)(ws + WS_BV); }
    __device__ __forceinline__ float* DST() const { return (float*)(ws + WS_DST); }
    __device__ __forceinline__ float* RCOST() const { return (float*)(ws + WS_RCOST); }
    __device__ __forceinline__ float* RSINT() const { return (float*)(ws + WS_RSINT); }
    __device__ __forceinline__ float* SS() const { return (float*)(ws + WS_CTL + CTL_SS); }
    __device__ __forceinline__ float* DSH() const { return (float*)(ws + WS_DSH); }
    __device__ __forceinline__ float* SST() const { return (float*)(ws + WS_SST); }
    __device__ __forceinline__ float* DD() const { return (float*)(ws + WS_DD); }
};

template <bool HP>
__device__ __forceinline__ void p0_transpose_item(const float* W, int K, int N, bf16* WT, LAS float* scr, int item, int lane, const float* gk = nullptr) {
    const int nblk = N / 32, kb = item / nblk, nb = item % nblk, k0 = 64 * kb, n0 = 32 * nb;
#pragma unroll 8
    for (int i = 0; i < 32; ++i) { const int kk = 2 * i + (lane >> 5); float w = W[(size_t)(k0 + kk) * N + n0 + (lane & 31)]; if (gk) w *= gk[k0 + kk]; scr[kk * 33 + (lane & 31)] = w; }
    LDS_WAIT(); asm volatile("" ::: "memory");
    const int c = lane & 7;
#pragma unroll
    for (int j = 0; j < 4; ++j) { const int n = (lane >> 3) + 8 * j; const LAS float* s = scr + (8 * c) * 33 + n;
        v4u o; o.x = pk2(s[0 * 33], s[1 * 33]); o.y = pk2(s[2 * 33], s[3 * 33]); o.z = pk2(s[4 * 33], s[5 * 33]); o.w = pk2(s[6 * 33], s[7 * 33]);
        int ca = n0 + n;
        if (HP) ca = (ca & ~255) | (((ca >> 5) & 1) << 7) | (((ca >> 6) & 3) << 5) | (ca & 31);
        *(GAS v4u*)(WT + (size_t)ca * K + k0 + 8 * c) = o; }
    LDS_WAIT(); asm volatile("" ::: "memory");
}
__device__ __forceinline__ void rms_row_to_bf16(int lane, const float* xrow, const float* g, bf16* orow) {
    const GAS f32x4* xr = (const GAS f32x4*)xrow + lane;
    f32x4 v[4]; float s2 = 0.f;
#pragma unroll
    for (int j = 0; j < 4; ++j) { v[j] = xr[64 * j]; s2 += (v[j].x * v[j].x + v[j].y * v[j].y) + (v[j].z * v[j].z + v[j].w * v[j].w); }
    const float rstd = 1.f / sqrtf(wave_sum(s2) * (1.f / 1024.f) + EPS);
    GAS unsigned long long* o8 = (GAS unsigned long long*)orow + lane;
#pragma unroll
    for (int j = 0; j < 4; ++j) { const f32x4 gv = *((const GAS f32x4*)g + lane + 64 * j);
        o8[64 * j] = (unsigned long long)pk2(v[j].x * rstd * gv.x, v[j].y * rstd * gv.y) | ((unsigned long long)pk2(v[j].z * rstd * gv.z, v[j].w * rstd * gv.w) << 32); }
}
__device__ __forceinline__ void sincos_acc(float a, float& s, float& c) {
    const double x = (double)a;
    const double kd = __builtin_rint(x * 0.63661977236758134308);
    const double r = (x - kd * 1.57079632673412561417e+00) - kd * 6.07710050650619224932e-11;
    const double r2 = r * r;
    const double sp = r * (1.0 + r2 * (-1.66666666666666324348e-01 + r2 * (8.33333333332248946124e-03 + r2 * (-1.98412698298579493134e-04 + r2 * (2.75573137070700676789e-06 + r2 * (-2.50507602534068634195e-08 + r2 * 1.58969099521155010221e-10))))));
    const double cp = 1.0 + r2 * (-0.5 + r2 * (4.16666666666666019037e-02 + r2 * (-1.38888888888741095749e-03 + r2 * (2.48015872894767294178e-05 + r2 * (-2.75573143513906633035e-07 + r2 * (2.08757232129817482790e-09 + r2 * -1.13596475577881948265e-11))))));
    const int q = (int)((long long)kd & 3);
    const double sv = (q & 1) ? cp : sp, cv = (q & 1) ? sp : cp;
    s = (float)((q & 2) ? -sv : sv);
    c = (float)(((q + 1) & 2) ? -cv : cv);
}
__device__ __forceinline__ void p0_prologue(Frame& F) {
    LAS float* scr = (LAS float*)(F.lds + RING_OFF + F.wave * 16384);
    const int gw = F.bid * NWAVES + F.wave, NGW = F.G * NWAVES;
    constexpr int I1 = (1024 / 64) * (N1 / 32), I2 = (1024 / 64) * (1024 / 32), I3 = (1024 / 64) * (N3 / 32), I4 = (2048 / 64) * (1024 / 32);
    for (int it = gw; it < I1 + I2 + I3 + I4; it += NGW) {
        int r = it;
        if (r < I1) { p0_transpose_item<true>(F.w1, 1024, N1, F.W1T(), scr, r, F.lane); continue; } r -= I1;
        if (r < I2) { p0_transpose_item<false>(F.w2, 1024, 1024, F.W2T(), scr, r, F.lane); continue; } r -= I2;
        if (r < I3) { p0_transpose_item<false>(F.w3, 1024, N3, F.W3T(), scr, r, F.lane, F.ng + 1024); continue; } r -= I3;
        p0_transpose_item<false>(F.w4, 2048, 1024, F.W4T(), scr, r, F.lane);
    }
    for (int m = gw; m < MT; m += NGW) rms_row_to_bf16(F.lane, (m < MP) ? F.xp + (size_t)m * DM : F.xs + (size_t)(m - MP) * DM, F.ng, F.H() + (size_t)m * DM);
    const int ri = F.tid & 127;
    const float rinv = (float)(1.0 / exp2((double)((float)ri / 127.0f) * 13.287712379549449));
    for (int e = F.bid * (NWAVES * 64) + F.tid; e < (PAST + TSQ) * 128; e += F.G * NWAVES * 64) {
        const int pos = e >> 7, i = ri;
        const float inv = rinv;
        const float ang = (float)pos * inv;
        float s, c; sincos_acc(ang, s, c);
        F.RCOS()[e] = c; F.RSIN()[e] = s;
    }
}

__device__ __forceinline__ void sb_tile(f32x16& p0, f32x16& p1, float& carry, int hi, int kb0, int qpos, bool need_mask, v4u (&pw)[4]) {
#pragma unroll
    for (int r = 0; r < 16; ++r) {
        float b0 = __builtin_amdgcn_rcpf(1.f + __builtin_amdgcn_exp2f(p0[r]));
        float b1 = __builtin_amdgcn_rcpf(1.f + __builtin_amdgcn_exp2f(p1[r]));
        if (need_mask) { if (kb0 + r >= qpos) b0 = 0.f; if (kb0 + 32 + r >= qpos) b1 = 0.f; }
        p0[r] = b0; p1[r] = b1;
    }
    float s0 = 1.f, s1 = 1.f;
#pragma unroll
    for (int r = 15; r >= 0; --r) {
        const float b0 = p0[r], b1 = p1[r];
        p0[r] = b0 * s0; p1[r] = b1 * s1;
        s0 = __builtin_fmaf(-s0, b0, s0); s1 = __builtin_fmaf(-s1, b1, s1);
    }
    float t0, t1;
    {
      auto a = __builtin_amdgcn_permlane32_swap(__float_as_uint(s0), __float_as_uint(s0), false, false);
      auto b = __builtin_amdgcn_permlane32_swap(__float_as_uint(s1), __float_as_uint(s1), false, false);
      t0 = hi ? __uint_as_float(a[0]) : __uint_as_float(a[1]); t1 = hi ? __uint_as_float(b[0]) : __uint_as_float(b[1]); }
    const float pre1 = hi ? carry : carry * t1;
    const float pre0 = hi ? carry * s1 * t1 : carry * t1 * s1 * t0;
    carry = carry * ((s0 * s1) * (t0 * t1));
#pragma unroll
    for (int r = 0; r < 16; ++r) { p0[r] *= pre0; p1[r] *= pre1; }
    pw[0] = (v4u){pg8::cvt_pk_bf16(p0[0], p0[1]), pg8::cvt_pk_bf16(p0[2], p0[3]), pg8::cvt_pk_bf16(p0[4], p0[5]), pg8::cvt_pk_bf16(p0[6], p0[7])};
    pw[1] = (v4u){pg8::cvt_pk_bf16(p0[8], p0[9]), pg8::cvt_pk_bf16(p0[10], p0[11]), pg8::cvt_pk_bf16(p0[12], p0[13]), pg8::cvt_pk_bf16(p0[14], p0[15])};
    pw[2] = (v4u){pg8::cvt_pk_bf16(p1[0], p1[1]), pg8::cvt_pk_bf16(p1[2], p1[3]), pg8::cvt_pk_bf16(p1[4], p1[5]), pg8::cvt_pk_bf16(p1[6], p1[7])};
    pw[3] = (v4u){pg8::cvt_pk_bf16(p1[8], p1[9]), pg8::cvt_pk_bf16(p1[10], p1[11]), pg8::cvt_pk_bf16(p1[12], p1[13]), pg8::cvt_pk_bf16(p1[14], p1[15])};
}
typedef float f32x2v __attribute__((ext_vector_type(2)));
__device__ __forceinline__ void sb_tile2(f32x16& p0, f32x16& p1, float& carry, int hi, int kb0, int qpos, bool need_mask, v4u (&pw)[4]) {
#pragma unroll
    for (int r = 0; r < 16; ++r) { p0[r] = __builtin_amdgcn_exp2f(p0[r]); p1[r] = __builtin_amdgcn_exp2f(p1[r]); }
#define SB_INV4(P, j0) do { const f32x2v ea_ = {P[2 * (j0)], P[2 * (j0) + 1]}, eb_ = {P[2 * (j0) + 2], P[2 * (j0) + 3]}, ec_ = {P[2 * (j0) + 4], P[2 * (j0) + 5]}, ed_ = {P[2 * (j0) + 6], P[2 * (j0) + 7]}; \
        const f32x2v b_ = eb_ + (f32x2v){1.f, 1.f}; const f32x2v ab_ = ea_ * b_ + b_, abc_ = ab_ * ec_ + ab_, abcd_ = abc_ * ed_ + abc_; \
        f32x2v R_ = {__builtin_amdgcn_rcpf(abcd_.x), __builtin_amdgcn_rcpf(abcd_.y)}; \
        const f32x2v id_ = R_ * abc_; R_ = R_ * ed_ + R_; const f32x2v ic_ = R_ * ab_; R_ = R_ * ec_ + R_; const f32x2v ib_ = R_ * ea_ + R_, ia_ = R_ * b_; \
        P[2 * (j0)] = ia_.x; P[2 * (j0) + 1] = ia_.y; P[2 * (j0) + 2] = ib_.x; P[2 * (j0) + 3] = ib_.y; P[2 * (j0) + 4] = ic_.x; P[2 * (j0) + 5] = ic_.y; P[2 * (j0) + 6] = id_.x; P[2 * (j0) + 7] = id_.y; } while (0)
    SB_INV4(p0, 0); SB_INV4(p1, 0); SB_INV4(p0, 4); SB_INV4(p1, 4);
#undef SB_INV4
    if (need_mask) {
        asm volatile("" ::: "memory");
#pragma unroll
        for (int r = 0; r < 16; ++r) { const int kk = kb0 + 8 * (1 - (r & 1)) + (r >> 1); if (kk >= qpos) p0[r] = 0.f; if (kk + 32 >= qpos) p1[r] = 0.f; }
    }
    f32x2v s0 = {1.f, 1.f}, s1 = {1.f, 1.f};
#pragma unroll
    for (int k = 7; k >= 0; --k) {
        const f32x2v b0 = {p0[2 * k], p0[2 * k + 1]}, b1 = {p1[2 * k], p1[2 * k + 1]};
        const f32x2v w0 = b0 * s0, w1 = b1 * s1;
        s0 = s0 - s0 * b0; s1 = s1 - s1 * b1;
        p0[2 * k] = w0.x; p0[2 * k + 1] = w0.y; p1[2 * k] = w1.x; p1[2 * k + 1] = w1.y;
    }
    const float a0 = s0.x * s0.y, a1 = s1.x * s1.y;
    float t0, t1;
    { auto a = __builtin_amdgcn_permlane32_swap(__float_as_uint(a0), __float_as_uint(a0), false, false);
      auto b = __builtin_amdgcn_permlane32_swap(__float_as_uint(a1), __float_as_uint(a1), false, false);
      t0 = hi ? __uint_as_float(a[0]) : __uint_as_float(a[1]); t1 = hi ? __uint_as_float(b[0]) : __uint_as_float(b[1]); }
    const float pre1 = hi ? carry : carry * t1;
    const float pre0 = hi ? carry * a1 * t1 : carry * t1 * a1 * t0;
    carry = carry * ((a0 * a1) * (t0 * t1));
    const f32x2v q0 = {pre0, pre0 * s0.x}, q1 = {pre1, pre1 * s1.x};
#pragma unroll
    for (int k = 0; k < 8; ++k) { const f32x2v w0 = (f32x2v){p0[2 * k], p0[2 * k + 1]} * q0, w1 = (f32x2v){p1[2 * k], p1[2 * k + 1]} * q1;
        p0[2 * k] = w0.x; p0[2 * k + 1] = w0.y; p1[2 * k] = w1.x; p1[2 * k + 1] = w1.y; }
    pw[0] = (v4u){pg8::cvt_pk_bf16(p0[1], p0[3]), pg8::cvt_pk_bf16(p0[5], p0[7]), pg8::cvt_pk_bf16(p0[9], p0[11]), pg8::cvt_pk_bf16(p0[13], p0[15])};
    pw[1] = (v4u){pg8::cvt_pk_bf16(p0[0], p0[2]), pg8::cvt_pk_bf16(p0[4], p0[6]), pg8::cvt_pk_bf16(p0[8], p0[10]), pg8::cvt_pk_bf16(p0[12], p0[14])};
    pw[2] = (v4u){pg8::cvt_pk_bf16(p1[1], p1[3]), pg8::cvt_pk_bf16(p1[5], p1[7]), pg8::cvt_pk_bf16(p1[9], p1[11]), pg8::cvt_pk_bf16(p1[13], p1[15])};
    pw[3] = (v4u){pg8::cvt_pk_bf16(p1[0], p1[2]), pg8::cvt_pk_bf16(p1[4], p1[6]), pg8::cvt_pk_bf16(p1[8], p1[10]), pg8::cvt_pk_bf16(p1[12], p1[14])};
}
#define MFMA32(a, b, c) __builtin_amdgcn_mfma_f32_32x32x16_bf16((a), (b), (c), 0, 0, 0)
__device__ __forceinline__ f32x16 splat16(float v) { f32x16 r;
#pragma unroll
    for (int i = 0; i < 16; ++i) r[i] = v; return r; }

__device__ __forceinline__ bf16x8 cvt8(const f32x4 a, const f32x4 b) { return __builtin_bit_cast(bf16x8, pg8::pack8(a, b)); }

__device__ __forceinline__ void ret_passB(Frame& F) {
    for (int e = F.bid * (NWAVES * 64) + F.tid; e < 8 * 512 * 32; e += F.G * NWAVES * 64) {
        const int bh = e >> 14, dv = (e >> 5) & 511, dk8 = (e & 31) * 8, h = bh & 3;
        const float lg = pg8::lg2gamma(h), g1 = 1.f - __builtin_amdgcn_exp2f(-5.f - (float)h), g255 = __builtin_amdgcn_exp2f(255.f * lg), g256 = __builtin_amdgcn_exp2f(256.f * lg);
        f32x4 S0 = {0.f, 0.f, 0.f, 0.f}, S1 = {0.f, 0.f, 0.f, 0.f};
        for (int c0 = 0; c0 < 32; c0 += 16) {
            v4u dq[16];
#pragma unroll
            for (int j = 0; j < 16; ++j) dq[j] = *(const v4u*)((const bf16*)F.DST() + ((size_t)(bh * 32 + c0 + j) * 512 + dv) * 256 + dk8);
#pragma unroll
            for (int j = 0; j < 16; ++j) { const size_t ro = (size_t)(bh * 32 + c0 + j) * 512 + dv;
                const f32x4 d0 = {bflo(dq[j][0]), bfhi(dq[j][0]), bflo(dq[j][1]), bfhi(dq[j][1])}, d1 = {bflo(dq[j][2]), bfhi(dq[j][2]), bflo(dq[j][3]), bfhi(dq[j][3])};
                *(pg8::u32x4*)(F.BV() + ro * 512 + 256 + dk8) = pg8::pack8(S0 * g1, S1 * g1);
                S0 = S0 * g256 + d0 * g255; S1 = S1 * g256 + d1 * g255; }
        }
        float* so = F.out + ORT_P + ((size_t)bh * 256 + dk8) * 512 + dv;
#pragma unroll
        for (int i = 0; i < 4; ++i) { so[(size_t)i * 512] = S0[i]; so[(size_t)(i + 4) * 512] = S1[i]; }
    }
}

typedef unsigned u32x2 __attribute__((ext_vector_type(2)));
constexpr int HQ_STR = 136, HT_STR = 72;
constexpr int H_QT = 0, H_KH = 17408, H_KHT = 34816, H_VT = 53248, H_PP = 71680, H_CS = 80896, H_RR = 82944, H_A63 = 83456, H_C63 = 83968, H_SSQ = 84480;
#define MFMA16(a, b, c) __builtin_amdgcn_mfma_f32_16x16x32_bf16((a), (b), (c), 0, 0, 0)
__device__ __forceinline__ void hgrn_passB(Frame& F) {
    const int vb = (F.bid + F.G / 2) % F.G;
    for (int e = vb * (NWAVES * 64) + F.tid; e < 8 * 128 * 32; e += F.G * NWAVES * 64) {
        const int bh = e >> 12, dk = (e >> 5) & 127, dv4 = (e & 31) * 4;
        f32x4 S = {0.f, 0.f, 0.f, 0.f};
        for (int s0 = 0; s0 < 32; s0 += 16) {
            f32x4 dv[16]; float dd[16];
#pragma unroll
            for (int j = 0; j < 16; ++j) { dv[j] = *(const f32x4*)(F.DSH() + ((size_t)(bh * 32 + s0 + j) * 128 + dk) * 128 + dv4); dd[j] = F.DD()[(size_t)(bh * 32 + s0 + j) * 128 + dk]; }
#pragma unroll
            for (int j = 0; j < 16; ++j) { *(f32x4*)(F.SST() + ((size_t)(bh * 32 + s0 + j) * 128 + dk) * 128 + dv4) = S; S = S * __expf(dd[j]) + dv[j]; }
        }
        *(f32x4*)(F.out + OHG_P + ((size_t)bh * 128 + dk) * 128 + dv4) = S;
    }
}

__device__ __forceinline__ void ret_sample_unit(Frame& F, int s, int h, int vhalf) {
    const int tid = F.tid, v = tid & 255, kh = tid >> 8, col = vhalf * 256 + v;
    LAS float* QL = (LAS float*)(F.lds + RING_OFF);
    LAS float* KL = QL + 8 * 256;
    LAS float* OP = KL + 8 * 256;
    const size_t row0 = (size_t)MP + s * 8;
    for (int e = tid; e < 8 * 256; e += NWAVES * 64) { const int t = e >> 8, kk = e & 255;
        QL[e] = bf2f(F.QC()[(row0 + t) * 1024 + h * 256 + kk]); KL[e] = bf2f(F.KC()[(row0 + t) * 1024 + h * 256 + kk]); }
    float vt[8];
#pragma unroll
    for (int t = 0; t < 8; ++t) vt[t] = bf2f(F.VC()[(row0 + t) * 2048 + h * 512 + col]);
    const float gamma = 1.f - __builtin_amdgcn_exp2f(-5.f - (float)h);
    float S[128];
    const float* s0 = F.st_r + (((size_t)s * HC + h) * DKC + kh * 128) * DVC + col;
#pragma unroll
    for (int i = 0; i < 128; ++i) S[i] = s0[(size_t)i * DVC];
    __syncthreads();
    float o[8];
#pragma unroll
    for (int t = 0; t < 8; ++t) {
        float acc = 0.f;
#pragma unroll
        for (int i4 = 0; i4 < 32; ++i4) {
            const f32x4 kq = *(const LAS f32x4*)(KL + t * 256 + kh * 128 + 4 * i4), qq = *(const LAS f32x4*)(QL + t * 256 + kh * 128 + 4 * i4);
#pragma unroll
            for (int j = 0; j < 4; ++j) { S[4 * i4 + j] = gamma * S[4 * i4 + j] + kq[j] * vt[t]; acc += qq[j] * S[4 * i4 + j]; }
        }
        o[t] = acc;
    }
#pragma unroll
    for (int t = 0; t < 8; ++t) OP[(kh * 8 + t) * 256 + v] = o[t];
    float* so = F.out + ORT_S + (((size_t)s * HC + h) * DKC + kh * 128) * DVC + col;
#pragma unroll
    for (int i = 0; i < 128; ++i) so[(size_t)i * DVC] = S[i];
    __syncthreads();
    for (int e = tid; e < 8 * 256; e += NWAVES * 64) {
        const int t = e >> 8, vv = e & 255; const float ov = OP[e] + OP[8 * 256 + e];
        const size_t gi = (row0 + t) * 2048 + h * 512 + vhalf * 256 + vv;
        F.MIX2()[gi] = pg8::bf1(ov * bf2f(F.GC()[gi]));
        const float sq = wave_sum(ov * ov);
        if (F.lane == 0) atomicAdd(F.SSS() + (s * 8 + t) * 4 + h, sq);
    }
    __syncthreads();
}
__device__ __forceinline__ void hgrn_sample_unit(Frame& F, int s, int h) {
    const int tid = F.tid, v = tid & 127, kq = tid >> 7;
    LAS float* FL = (LAS float*)(F.lds + RING_OFF);
    LAS float* KL = FL + 8 * 128; LAS float* QL = KL + 8 * 128; LAS float* OP = QL + 8 * 128;
    const size_t row0 = (size_t)MP + s * 8;
    for (int e = tid; e < 8 * 128; e += NWAVES * 64) { const int t = e >> 7, kk = e & 127; const size_t gi = (row0 + t) * 512 + h * 128 + kk;
        FL[e] = __expf(F.LOGF()[gi]); KL[e] = bf2f(F.KB()[gi]); QL[e] = bf2f(F.QB()[gi]); }
    float vt[8];
#pragma unroll
    for (int t = 0; t < 8; ++t) vt[t] = bf2f(F.VB()[(row0 + t) * 512 + h * 128 + v]);
    float S[32];
    const float* s0 = F.st_h + (((size_t)s * HB + h) * DKB + kq * 32) * DVB + v;
#pragma unroll
    for (int i = 0; i < 32; ++i) S[i] = s0[(size_t)i * DVB];
    __syncthreads();
#pragma unroll
    for (int t = 0; t < 8; ++t) {
        float acc = 0.f;
#pragma unroll
        for (int i4 = 0; i4 < 8; ++i4) {
            const f32x4 ff = *(const LAS f32x4*)(FL + t * 128 + kq * 32 + 4 * i4), kk = *(const LAS f32x4*)(KL + t * 128 + kq * 32 + 4 * i4), qq = *(const LAS f32x4*)(QL + t * 128 + kq * 32 + 4 * i4);
#pragma unroll
            for (int j = 0; j < 4; ++j) { S[4 * i4 + j] = ff[j] * S[4 * i4 + j] + kk[j] * vt[t]; acc += qq[j] * S[4 * i4 + j]; }
        }
        OP[(kq * 8 + t) * 128 + v] = acc;
    }
    float* so = F.out + OHG_S + (((size_t)s * HB + h) * DKB + kq * 32) * DVB + v;
#pragma unroll
    for (int i = 0; i < 32; ++i) so[(size_t)i * DVB] = S[i];
    __syncthreads();
    {
        const int t = F.wave, c0 = 2 * F.lane;
        float a = 0.f, b = 0.f;
#pragma unroll
        for (int q4 = 0; q4 < 4; ++q4) { a += OP[(q4 * 8 + t) * 128 + c0]; b += OP[(q4 * 8 + t) * 128 + c0 + 1]; }
        const float rstd = 1.f / sqrtf(wave_sum(a * a + b * b) * (1.f / 128.f) + EPS);
        const size_t row = row0 + t;
        const unsigned gt = *(const unsigned*)(F.GB() + row * 512 + h * 128 + c0);
        *(unsigned*)(F.MIX() + row * 1024 + 512 + h * 128 + c0) = pg8::cvt_pk_bf16(a * rstd * F.og[c0] * bflo(gt), b * rstd * F.og[c0 + 1] * bfhi(gt));
    }
    __syncthreads();
}

constexpr int AT_K = 0, AT_V = 24576, AT_O = 49152, AT_SLOT = 8192;
__device__ __forceinline__ void glds16(const void* gsrc, unsigned lds_dst) { unsigned keep;
    asm volatile("s_mov_b32 %0, m0\n\ts_mov_b32 m0, %2\n\ts_nop 0\n\tglobal_load_lds_dwordx4 %1, off\n\ts_mov_b32 m0, %0" : "=&s"(keep) : "v"(gsrc), "s"(lds_dst) : "memory"); }
typedef short v4i16_t __attribute__((ext_vector_type(4)));
__device__ __forceinline__ v4i16_t vtr(const LAS unsigned char* p) { return __builtin_amdgcn_ds_read_tr16_b64_v4i16((LAS v4i16_t*)p); }

__device__ __forceinline__ void bf8_add(const bf16* p, f32x4& a, f32x4& b) { const v4u w = *(const v4u*)p; a[0] += bflo(w[0]); a[1] += bfhi(w[0]); a[2] += bflo(w[1]); a[3] += bfhi(w[1]); b[0] += bflo(w[2]); b[1] += bfhi(w[2]); b[2] += bflo(w[3]); b[3] += bfhi(w[3]); }
__device__ __forceinline__ void slab_sum8(const bf16* slab, int nparts, size_t pstride, size_t off, f32x4& a, f32x4& b) {
    a = (f32x4){0.f, 0.f, 0.f, 0.f}; b = a;
    for (int p = 0; p < nparts; ++p) bf8_add(slab + p * pstride + off, a, b);
}
__device__ __forceinline__ void pp1_item(Frame& F, int item) {
    const int r = item >> 3, gi = item & 7, lane = F.lane, c = lane * 8, a0 = gi * 512 + c;
    const int g0 = (a0 & ~255) | (((a0 >> 5) & 1) << 7) | (((a0 >> 6) & 3) << 5) | (a0 & 31);
    f32x4 x, y; slab_sum8(F.SLAB(), 4, (size_t)256 * N1, (size_t)r * N1 + g0, x, y);
    const size_t row = (size_t)MP + r;
    if (gi <= 1) {
        float ss = (x[0] * x[0] + x[1] * x[1]) + (x[2] * x[2] + x[3] * x[3]) + (y[0] * y[0] + y[1] * y[1]) + (y[2] * y[2] + y[3] * y[3]);
        ss += __shfl_xor(ss, 1); ss += __shfl_xor(ss, 2); ss += __shfl_xor(ss, 4);
        const float rstd = __builtin_amdgcn_rsqf(ss * (1.f / 64.f) + EPS) * (gi == 0 ? -0.125f * LOG2E : 1.f);
        const float* g = (gi == 0 ? F.qg : F.kg) + (c & 63);
        x = x * *(const f32x4*)g * rstd; y = y * *(const f32x4*)(g + 4) * rstd;
        if (gi == 0) *(pg8::u32x4*)(F.QA() + row * 512 + c) = pg8::pack8(x, y);
        else { *(pg8::u32x4*)(F.KA() + row * 512 + c) = pg8::pack8(x, y); float* ko = F.out + OK_S + (size_t)r * 512 + c; *(f32x4*)ko = x; *(f32x4*)(ko + 4) = y; }
    } else if (gi == 2) {
        *(pg8::u32x4*)(F.VA() + row * 512 + c) = pg8::pack8(x, y); float* vo = F.out + OV_S + (size_t)r * 512 + c; *(f32x4*)vo = x; *(f32x4*)(vo + 4) = y;
    } else if (gi == 5) {
        f32x4 lf0, lf1, k0, k1;
#pragma unroll
        for (int e = 0; e < 8; ++e) { const int cc = c + e; const float lb = __builtin_amdgcn_rcpf(1.f + __expf(F.hlb[512 + cc] - F.hlb[cc])); const float v = e < 4 ? x[e & 3] : y[e & 3];
            const float sg = pg8::sigm_f(v); const float lf = __logf(lb + (1.f - lb) * sg), kk = (1.f - lb) * (1.f - sg);
            if (e < 4) { lf0[e & 3] = lf; k0[e & 3] = kk; } else { lf1[e & 3] = lf; k1[e & 3] = kk; } }
        *(f32x4*)(F.LOGF() + row * 512 + c) = lf0; *(f32x4*)(F.LOGF() + row * 512 + c + 4) = lf1;
        *(pg8::u32x4*)(F.KB() + row * 512 + c) = pg8::pack8(k0, k1);
    } else {
        bf16* dst = (gi == 3) ? F.GA() : (gi == 4) ? F.QB() : (gi == 6) ? F.VB() : F.GB();
        if (gi != 6) {
#pragma unroll
            for (int e = 0; e < 4; ++e) { x[e] = pg8::silu_f(x[e]); y[e] = pg8::silu_f(y[e]); } }
        *(pg8::u32x4*)(dst + row * 512 + c) = pg8::pack8(x, y);
    }
}
__device__ __forceinline__ void pp2_row(Frame& F, int r) {
    const int lane = F.lane; f32x4 v[4]; float s2 = 0.f;
#pragma unroll
    for (int j = 0; j < 2; ++j) { const int c = 8 * lane + 512 * j; f32x4 a, b2; slab_sum8(F.SLAB(), 4, (size_t)256 * 1024, (size_t)r * 1024 + c, a, b2);
        a += *(const f32x4*)(F.xs + (size_t)r * DM + c); b2 += *(const f32x4*)(F.xs + (size_t)r * DM + c + 4);
        *(f32x4*)(F.Y1() + ((size_t)MP + r) * DM + c) = a; *(f32x4*)(F.Y1() + ((size_t)MP + r) * DM + c + 4) = b2;
        s2 += (a[0] * a[0] + a[1] * a[1]) + (a[2] * a[2] + a[3] * a[3]) + (b2[0] * b2[0] + b2[1] * b2[1]) + (b2[2] * b2[2] + b2[3] * b2[3]);
        v[2 * j] = a; v[2 * j + 1] = b2; }
    s2 = wave_sum(s2); if (lane == 0) F.SS1()[MP + r] = s2;
#pragma unroll
    for (int j = 0; j < 2; ++j) { const int c = 8 * lane + 512 * j;
        *(pg8::u32x4*)(F.H() + ((size_t)MP + r) * DM + c) = pg8::pack8(v[2 * j], v[2 * j + 1]); }
}
__device__ __forceinline__ void pp3_item(Frame& F, int item) {
    const int r = item / 24, pn = item % 24, lane = F.lane; const size_t row = (size_t)MP + r;
    if (lane >= 32) return;
    const size_t off = (size_t)r * N3 + pn * 256, ps = (size_t)256 * N3;
    const float rs = __builtin_amdgcn_rsqf(F.SS1()[MP + r] * (1.f / 1024.f) + EPS);
    if (pn < 8) {
        const int j = 8 * (lane & 15), up = lane >> 4;
        f32x4 x1a, x1b, x2a, x2b; slab_sum8(F.SLAB(), 4, ps, off + j, x1a, x1b); slab_sum8(F.SLAB(), 4, ps, off + 128 + j, x2a, x2b);
        const int pos = PAST + (r & 7);
        const f32x4 ca = *(const f32x4*)(F.RCOS() + (size_t)pos * 128 + j), cb = *(const f32x4*)(F.RCOS() + (size_t)pos * 128 + j + 4), sa = *(const f32x4*)(F.RSIN() + (size_t)pos * 128 + j), sb = *(const f32x4*)(F.RSIN() + (size_t)pos * 128 + j + 4);
        const float sc = rs * (pn < 4 ? 1.f : 0.0625f);
        const f32x4 oa = (up ? (x2a * ca + x1a * sa) : (x1a * ca - x2a * sa)) * sc, ob = (up ? (x2b * cb + x1b * sb) : (x1b * cb - x2b * sb)) * sc;
        *(pg8::u32x4*)((pn < 4 ? F.QC() : F.KC()) + row * 1024 + (pn & 3) * 256 + up * 128 + j) = pg8::pack8(oa, ob);
    } else {
        const int j = 8 * lane; f32x4 xa, xb; slab_sum8(F.SLAB(), 4, ps, off + j, xa, xb);
        xa = xa * rs; xb = xb * rs;
        const bool isg = pn >= 16;
        if (isg) {
#pragma unroll
            for (int e = 0; e < 4; ++e) { xa[e] = pg8::silu_f(xa[e]); xb[e] = pg8::silu_f(xb[e]); } }
        *(pg8::u32x4*)((isg ? F.GC() : F.VC()) + row * 2048 + ((pn - 8) & 7) * 256 + j) = pg8::pack8(xa, xb);
    }
}
__device__ __forceinline__ void pp4_row(Frame& F, int r) {
    float rs[4];
#pragma unroll
    for (int hh = 0; hh < 4; ++hh) rs[hh] = __builtin_amdgcn_rsqf(F.SSS()[r * 4 + hh] * (1.f / 512.f) + EPS);
#pragma unroll
    for (int j = 0; j < 2; ++j) { const int c = 8 * F.lane + 512 * j;
        f32x4 a = *(const f32x4*)(F.Y1() + ((size_t)MP + r) * DM + c), b2 = *(const f32x4*)(F.Y1() + ((size_t)MP + r) * DM + c + 4);
#pragma unroll
        for (int p = 0; p < 8; ++p) { f32x4 pa = {0.f, 0.f, 0.f, 0.f}, pb = pa; bf8_add(F.SLAB4() + ((size_t)p * 256 + r) * 1024 + c, pa, pb); a += pa * rs[p >> 1]; b2 += pb * rs[p >> 1]; }
        *(f32x4*)(F.out + OY_S + (size_t)r * DM + c) = a; *(f32x4*)(F.out + OY_S + (size_t)r * DM + c + 4) = b2; }
}

constexpr int G_QT = 0, G_KH = 17408, G_VV = 34816, G_PP = 52224, G_CS = 61440, G_RR = 69632, G_A63 = 70144, G_C63 = 70656, G_OST = 73728, OST_STR = 132;
__device__ __forceinline__ bf16x8 tr8(const LAS unsigned char* p, int rowbytes4) { const v4i16_t a = vtr(p), b = vtr(p + rowbytes4); return (bf16x8){a[0], a[1], a[2], a[3], b[0], b[1], b[2], b[3]}; }
#define LDS_BAR() asm volatile("s_waitcnt lgkmcnt(0)\n\ts_barrier" ::: "memory")
template <bool OUT>
__device__ __forceinline__ void hgrn_chunk_unit2(Frame& F, int bh, int sc) {
    const int tid = F.tid, lane = F.lane, w = F.wave, l15 = lane & 15, g = lane >> 4;
    const int b = bh >> 2, h = bh & 3, cg = tid & 31, tq = tid >> 5;
    LAS unsigned char* L = F.lds + RING_OFF;
    LAS bf16* QT = (LAS bf16*)(L + G_QT); LAS bf16* KH = (LAS bf16*)(L + G_KH); LAS bf16* VV = (LAS bf16*)(L + G_VV); LAS bf16* PP = (LAS bf16*)(L + G_PP);
    LAS float* CS = (LAS float*)(L + G_CS); LAS float* RR = (LAS float*)(L + G_RR); LAS float* A63 = (LAS float*)(L + G_A63); LAS float* C63 = (LAS float*)(L + G_C63); LAS float* OST = (LAS float*)(L + G_OST);
    f32x4 S[8];
    unsigned sbase = (unsigned)(((bh * 32 + sc) * 128 + 4 * g) * 128 + 16 * w + l15);
    asm volatile("" : "+v"(sbase));
#pragma unroll
    for (int i = 0; i < 8; ++i)
#pragma unroll
        for (int r = 0; r < 4; ++r) S[i][r] = OUT ? F.SST()[sbase + (unsigned)(16 * i + r) * 128u] : 0.f;
    f32x4 dsum = {0.f, 0.f, 0.f, 0.f};
    f32x4 lf[4]; u32x2 kq[4], qq[4], vq[4];
    unsigned e0 = (unsigned)((b * TP + sc * 256 + 4 * tq) * 512 + h * 128 + 4 * cg);
#define HG_LOAD(ch_) do { unsigned ee = e0 + (unsigned)(ch_) * 64u * 512u; asm volatile("" : "+v"(ee)); \
        _Pragma("unroll") for (int i = 0; i < 4; ++i) { lf[i] = *(const f32x4*)(F.LOGF() + ee + (unsigned)i * 512u); kq[i] = *(const u32x2*)(F.KB() + ee + (unsigned)i * 512u); \
            vq[i] = *(const u32x2*)(F.VB() + ee + (unsigned)i * 512u); if (OUT) qq[i] = *(const u32x2*)(F.QB() + ee + (unsigned)i * 512u); } } while (0)
    HG_LOAD(0);
    const LAS unsigned char* trK = (const LAS unsigned char*)KH + ((8 * g + (l15 >> 2)) * HQ_STR + (l15 & 3) * 4) * 2;
    const LAS unsigned char* trV = (const LAS unsigned char*)VV + ((8 * g + (l15 >> 2)) * HQ_STR + 16 * w + (l15 & 3) * 4) * 2;
    for (int ch = 0; ch < 4; ++ch) {
        f32x4 c[4]; c[0] = lf[0]; c[1] = c[0] + lf[1]; c[2] = c[1] + lf[2]; c[3] = c[2] + lf[3];
        *(LAS f32x4*)(CS + tq * 128 + 4 * cg) = c[3];
        LDS_BAR();
        f32x4 off = {0.f, 0.f, 0.f, 0.f}, run = {0.f, 0.f, 0.f, 0.f}, r = {0.f, 0.f, 0.f, 0.f};
#pragma unroll
        for (int q = 0; q < 16; ++q) { const f32x4 v = *(const LAS f32x4*)(CS + q * 128 + 4 * cg); if (q == 8) r = run; if (q < tq) off += v; run += v; }
        const f32x4 b63 = run;
#pragma unroll
        for (int i = 0; i < 4; ++i) {
            const int t = 4 * tq + i; const f32x4 bt = off + c[i];
            f32x4 kf = {bflo(kq[i].x), bfhi(kq[i].x), bflo(kq[i].y), bfhi(kq[i].y)};
#pragma unroll
            for (int e = 0; e < 4; ++e) kf[e] *= __expf(r[e] - bt[e]);
            *(LAS u32x2*)(KH + t * HQ_STR + 4 * cg) = (u32x2){pg8::cvt_pk_bf16(kf[0], kf[1]), pg8::cvt_pk_bf16(kf[2], kf[3])};
            *(LAS u32x2*)(VV + t * HQ_STR + 4 * cg) = vq[i];
            if (OUT) { f32x4 qf = {bflo(qq[i].x), bfhi(qq[i].x), bflo(qq[i].y), bfhi(qq[i].y)};
#pragma unroll
                for (int e = 0; e < 4; ++e) qf[e] *= __expf(bt[e] - r[e]);
                *(LAS u32x2*)(QT + t * HQ_STR + 4 * cg) = (u32x2){pg8::cvt_pk_bf16(qf[0], qf[1]), pg8::cvt_pk_bf16(qf[2], qf[3])}; }
        }
        if (tq == 0) { f32x4 er, ea, ec;
#pragma unroll
            for (int e = 0; e < 4; ++e) { er[e] = __expf(r[e]); ea[e] = __expf(b63[e]); ec[e] = __expf(b63[e] - r[e]); }
            *(LAS f32x4*)(RR + 4 * cg) = er; *(LAS f32x4*)(A63 + 4 * cg) = ea; *(LAS f32x4*)(C63 + 4 * cg) = ec; dsum += b63; }
        if (ch < 3) HG_LOAD(ch + 1);
        v4u gq0, gq1; unsigned rowe = 0;
        if (OUT) { rowe = (unsigned)(b * TP + sc * 256 + ch * 64 + (tid >> 3)); asm volatile("" : "+v"(rowe));
            gq0 = *(const v4u*)(F.GB() + rowe * 512u + h * 128 + (tid & 7) * 16); gq1 = *(const v4u*)(F.GB() + rowe * 512u + h * 128 + (tid & 7) * 16 + 8); }
        LDS_BAR();
        f32x4 o[4];
        bf16x8 vf[2];
#pragma unroll
        for (int kk = 0; kk < 2; ++kk) vf[kk] = tr8(trV + (32 * kk) * HQ_STR * 2, 4 * HQ_STR * 2);
        if (OUT) {
#pragma unroll
            for (int tt = 0; tt < 2; ++tt) {
                const int tile = 2 * w + tt, ti = tile >> 2, si = tile & 3;
                f32x4 p = {0.f, 0.f, 0.f, 0.f};
#pragma unroll
                for (int kk = 0; kk < 4; ++kk) {
                    const bf16x8 a = *(const LAS bf16x8*)(QT + (16 * ti + l15) * HQ_STR + 32 * kk + 8 * g), bb = *(const LAS bf16x8*)(KH + (16 * si + l15) * HQ_STR + 32 * kk + 8 * g);
                    p = MFMA16(a, bb, p);
                }
#pragma unroll
                for (int rr = 0; rr < 4; ++rr) { const int tl = 16 * ti + 4 * g + rr, sl = 16 * si + l15; PP[tl * HT_STR + sl] = pg8::bf1(sl <= tl ? p[rr] : 0.f); }
            }
            LDS_BAR();
#pragma unroll
            for (int ti = 0; ti < 4; ++ti) { o[ti] = (f32x4){0.f, 0.f, 0.f, 0.f};
#pragma unroll
                for (int kk = 0; kk < 2; ++kk) { const bf16x8 a = *(const LAS bf16x8*)(PP + (16 * ti + l15) * HT_STR + 32 * kk + 8 * g); o[ti] = MFMA16(a, vf[kk], o[ti]); } }
#pragma unroll
            for (int kk = 0; kk < 4; ++kk) {
                const f32x4 r0 = *(const LAS f32x4*)(RR + 32 * kk + 4 * g), r1 = *(const LAS f32x4*)(RR + 32 * kk + 16 + 4 * g);
                const bf16x8 sb = __builtin_bit_cast(bf16x8, pg8::pack8(S[2 * kk] * r0, S[2 * kk + 1] * r1));
#pragma unroll
                for (int ti = 0; ti < 4; ++ti) {
                    const u32x2 a0 = *(const LAS u32x2*)(QT + (16 * ti + l15) * HQ_STR + 32 * kk + 4 * g), a1 = *(const LAS u32x2*)(QT + (16 * ti + l15) * HQ_STR + 32 * kk + 16 + 4 * g);
                    const v4u av = {a0.x, a0.y, a1.x, a1.y};
                    o[ti] = MFMA16(__builtin_bit_cast(bf16x8, av), sb, o[ti]);
                }
            }
        }
#pragma unroll
        for (int i = 0; i < 8; ++i) {
            f32x4 U = {0.f, 0.f, 0.f, 0.f};
#pragma unroll
            for (int kk = 0; kk < 2; ++kk) { const bf16x8 a = tr8(trK + ((32 * kk) * HQ_STR + 16 * i) * 2, 4 * HQ_STR * 2); U = MFMA16(a, vf[kk], U); }
            const f32x4 a63 = *(const LAS f32x4*)(A63 + 16 * i + 4 * g), c63 = *(const LAS f32x4*)(C63 + 16 * i + 4 * g);
            S[i] = a63 * S[i] + c63 * U;
        }
        if (OUT) {
#pragma unroll
            for (int ti = 0; ti < 4; ++ti)
#pragma unroll
                for (int rr = 0; rr < 4; ++rr) OST[(16 * ti + 4 * g + rr) * OST_STR + 16 * w + l15] = o[ti][rr];
            LDS_BAR();
            const int t = tid >> 3, c16 = (tid & 7) * 16;
            f32x4 x[4]; float sq = 0.f;
#pragma unroll
            for (int j = 0; j < 4; ++j) { x[j] = *(const LAS f32x4*)(OST + t * OST_STR + c16 + 4 * j); sq += (x[j][0] * x[j][0] + x[j][1] * x[j][1]) + (x[j][2] * x[j][2] + x[j][3] * x[j][3]); }
            sq += __shfl_xor(sq, 1); sq += __shfl_xor(sq, 2); sq += __shfl_xor(sq, 4);
            const float rstd = __builtin_amdgcn_rsqf(sq * (1.f / 128.f) + EPS);
            const v4u g0 = gq0, g1 = gq1;
#pragma unroll
            for (int j = 0; j < 4; ++j) { const f32x4 gn = *(const f32x4*)(F.og + c16 + 4 * j); x[j] = x[j] * gn * rstd; }
            x[0][0] *= bflo(g0[0]); x[0][1] *= bfhi(g0[0]); x[0][2] *= bflo(g0[1]); x[0][3] *= bfhi(g0[1]); x[1][0] *= bflo(g0[2]); x[1][1] *= bfhi(g0[2]); x[1][2] *= bflo(g0[3]); x[1][3] *= bfhi(g0[3]);
            x[2][0] *= bflo(g1[0]); x[2][1] *= bfhi(g1[0]); x[2][2] *= bflo(g1[1]); x[2][3] *= bfhi(g1[1]); x[3][0] *= bflo(g1[2]); x[3][1] *= bfhi(g1[2]); x[3][2] *= bflo(g1[3]); x[3][3] *= bfhi(g1[3]);
            *(pg8::u32x4*)(F.MIX() + rowe * 1024u + 512u + h * 128 + c16) = pg8::pack8(x[0], x[1]);
            *(pg8::u32x4*)(F.MIX() + rowe * 1024u + 512u + h * 128 + c16 + 8) = pg8::pack8(x[2], x[3]);
        }
    }
#undef HG_LOAD
    if (!OUT) {
#pragma unroll
        for (int i = 0; i < 8; ++i)
#pragma unroll
            for (int r = 0; r < 4; ++r) F.DSH()[sbase + (unsigned)(16 * i + r) * 128u] = S[i][r];
        if (tq == 0) *(f32x4*)(F.DD() + (size_t)(bh * 32 + sc) * 128 + 4 * cg) = dsum;
    }
    __syncthreads();
}

typedef short s16x4 __attribute__((ext_vector_type(4)));

struct DecStage2 { f32x4 k[4]; f32x4 v[4]; };
constexpr int DW_T = 107008;
struct DecW { DecStage2 S; f32x4 o[4]; float carry; bf16x8 qb[2]; int i, last, w, s, h, pagev; LAS unsigned char* tb; u32x2 wpk; bool pend; };
__device__ __forceinline__ void decw_load(Frame& F, DecW& D, int l15, int g) {
    const int kb = 1024 * D.w + 1024 - 16 * D.i;
    const int page = __builtin_amdgcn_readlane(D.pagev, (kb >> 7) & 7);
    const unsigned sbase = (unsigned)__builtin_amdgcn_readfirstlane((int)((((unsigned)page * PAGE + (unsigned)(kb & 127)) * 512u + (unsigned)(D.h * 64)) * 4u));
    const __amdgpu_buffer_rsrc_t rk = __builtin_amdgcn_make_buffer_rsrc((void*)F.ck, 0, 0x7fffffff, 0x00020000), rv = __builtin_amdgcn_make_buffer_rsrc((void*)F.cv, 0, 0x7fffffff, 0x00020000);
    int vk = l15 * 2048 + 32 * g; asm volatile("" : "+v"(vk)); const int vv = vk - 16 * g;
#pragma unroll
    for (int ks = 0; ks < 2; ++ks) { D.S.k[2 * ks] = __builtin_bit_cast(f32x4, __builtin_amdgcn_raw_buffer_load_b128(rk, vk + 128 * ks, sbase, 0)); D.S.k[2 * ks + 1] = __builtin_bit_cast(f32x4, __builtin_amdgcn_raw_buffer_load_b128(rk, vk + 128 * ks + 16, sbase, 0)); }
#pragma unroll
    for (int j = 0; j < 4; ++j) D.S.v[j] = __builtin_bit_cast(f32x4, __builtin_amdgcn_raw_buffer_load_b128(rv, vv + 64 * j, sbase, 0));
}
__device__ __forceinline__ void decw_procA(DecW& D, bool newk, float cinit, int l15, int g) {
    f32x4 p = {cinit, cinit, cinit, cinit};
    p = MFMA16(cvt8(D.S.k[0], D.S.k[1]), D.qb[0], p); p = MFMA16(cvt8(D.S.k[2], D.S.k[3]), D.qb[1], p);
    float bt[4];
#pragma unroll
    for (int r = 0; r < 4; ++r) { bt[r] = __builtin_amdgcn_rcpf(1.f + __builtin_amdgcn_exp2f(p[r])); if (newk && (4 * g + r >= l15 || 4 * g + r >= 8)) bt[r] = 0.f; }
    float suf = 1.f, wl[4];
#pragma unroll
    for (int r = 3; r >= 0; --r) { wl[r] = bt[r] * suf; suf = __builtin_fmaf(-suf, bt[r], suf); }
    float t1, po;
    { auto a = __builtin_amdgcn_permlane16_swap(__float_as_uint(suf), __float_as_uint(suf), false, false); t1 = (g & 1) ? __uint_as_float(a[0]) : __uint_as_float(a[1]); }
    const float pp = suf * t1;
    { auto b = __builtin_amdgcn_permlane32_swap(__float_as_uint(pp), __float_as_uint(pp), false, false); po = (g & 2) ? __uint_as_float(b[0]) : __uint_as_float(b[1]); }
    const float pre = D.carry * ((g & 2) ? 1.f : po) * ((g & 1) ? 1.f : t1);
    D.carry = D.carry * pp * po;
    D.wpk = (u32x2){pg8::cvt_pk_bf16(wl[0] * pre, wl[1] * pre), pg8::cvt_pk_bf16(wl[2] * pre, wl[3] * pre)};
#pragma unroll
    for (int j = 0; j < 4; ++j) *(LAS u32x2*)(D.tb + j * 512 + l15 * 32 + g * 8) = (u32x2){pg8::cvt_pk_bf16(D.S.v[j][0], D.S.v[j][1]), pg8::cvt_pk_bf16(D.S.v[j][2], D.S.v[j][3])};
}
__device__ __forceinline__ void decw_procB(DecW& D, int l15, int g) {
    asm volatile("s_waitcnt lgkmcnt(0)" ::: "memory");
#pragma unroll
    for (int dt = 0; dt < 4; ++dt) { const v4i16_t vb = vtr(D.tb + dt * 512 + (4 * g + (l15 >> 2)) * 32 + (l15 & 3) * 8);
        D.o[dt] = __builtin_amdgcn_mfma_f32_16x16x16bf16_1k(__builtin_bit_cast(s16x4, D.wpk), vb, D.o[dt], 0, 0, 0); }
}
__device__ __forceinline__ void decw_proc(DecW& D, bool newk, float cinit, int l15, int g) { decw_procA(D, newk, cinit, l15, g); decw_procB(D, l15, g); }
__device__ __forceinline__ void attn_unit_dec(Frame& F, int b, int h, int qb, DecW& D) {
    const int lane = F.lane, r32 = lane & 31, hi = lane >> 5, wid = F.wave, l15 = lane & 15, g4 = lane >> 4;
    const int rowbase = b * TP, q0 = qb * 256 + 32 * wid, qpos = q0 + r32;
    const float cinit = -F.sbb[h] * LOG2E, dcinit = -F.sbb[D.h] * LOG2E;
    LAS unsigned char* L = F.lds + RING_OFF;
    const unsigned lds0 = (unsigned)(uintptr_t)L;
    bf16x8 qr[4];
#pragma unroll
    for (int d0 = 0; d0 < 4; ++d0) qr[d0] = *(const bf16x8*)(F.QA() + (size_t)(rowbase + qpos) * 512 + h * 64 + d0 * 16 + hi * 8);
    asm volatile("" :: "v"(qr[0]), "v"(qr[1]), "v"(qr[2]), "v"(qr[3]));
    const int NT = 4 * (qb + 1);
    const int rr_ = (lane & 3) + 4 * ((lane & 31) >> 3), pil = 16 * ((lane >> 2) & 1) + 8 * (1 - (rr_ & 1)) + (rr_ >> 1) + (lane & 32);
    const bf16* ksrc = F.KA() + (size_t)(rowbase + pil) * 512 + h * 64 + wid * 8;
    const bf16* vsrc = F.VA() + (size_t)(rowbase + 16 * (wid & 3) + (lane >> 2)) * 512 + h * 64 + (wid >> 2) * 32 + (lane & 3) * 8;
    const unsigned kdst = lds0 + AT_K + wid * 1024, vdst = lds0 + AT_V + wid * 1024;
#define AT_DMA(t, slot) do { glds16(ksrc + (size_t)(t) * 64 * 512, (unsigned)__builtin_amdgcn_readfirstlane(kdst + (slot))); glds16(vsrc + (size_t)(t) * 64 * 512, (unsigned)__builtin_amdgcn_readfirstlane(vdst + (slot))); } while (0)
    const LAS unsigned char* kfb = L + AT_K + hi * 1024 + r32 * 16;
    const LAS unsigned char* vfb = L + AT_V + ((lane >> 4) & 1) * 32 + (lane & 3) * 8 + ((lane & 15) >> 2) * 64 + hi * 1024;
    f32x16 o0 = splat16(0.f), o1 = splat16(0.f); float carry = 1.f;
    int s_cur = 0, s_nxt = AT_SLOT, s_fre = 2 * AT_SLOT;
    bool l1 = false, l2 = false;
    AT_DMA(NT - 1, 0); AT_DMA(NT - 2, AT_SLOT);
    if (wid >= 4) __builtin_amdgcn_s_setprio(1);
    for (int t = NT - 1; t >= 0; --t) {
        if (t == 0) asm volatile("s_waitcnt vmcnt(0) lgkmcnt(0)\n\ts_barrier" ::: "memory");
        else if (l1 || l2) asm volatile("s_waitcnt vmcnt(10) lgkmcnt(0)\n\ts_barrier" ::: "memory");
        else asm volatile("s_waitcnt vmcnt(2) lgkmcnt(0)\n\ts_barrier" ::: "memory");
        const bool dstep = ((t & 1) == (wid >> 2)) && (D.i <= D.last) && !D.pend;
        if (dstep) decw_procA(D, false, dcinit, l15, g4);
        else if (D.pend) { decw_procB(D, l15, g4); D.pend = false; }
        if (t >= 2) AT_DMA(t - 2, s_fre);
        l2 = l1; l1 = false;
        const int kbase = 64 * t;
        if (kbase <= q0 + 30) {
            f32x16 p0 = splat16(cinit), p1 = splat16(cinit);
#pragma unroll
            for (int d0 = 0; d0 < 4; ++d0) {
                const bf16x8 k0 = *(const LAS bf16x8*)(kfb + s_cur + d0 * 2048), k1 = *(const LAS bf16x8*)(kfb + s_cur + d0 * 2048 + 512);
                p0 = MFMA32(k0, qr[d0], p0); p1 = MFMA32(k1, qr[d0], p1);
            }
            v4u pw[4];
            sb_tile2(p0, p1, carry, hi, kbase + 16 * hi, qpos, kbase + 63 >= q0, pw);
#pragma unroll
            for (int ks = 0; ks < 4; ++ks) {
                const LAS unsigned char* vp = vfb + s_cur + (ks >> 1) * 2048 + (ks & 1) * 512;
                const v4i16_t a0 = vtr(vp), a1 = vtr(vp + 256), b0 = vtr(vp + 4096), b1 = vtr(vp + 4096 + 256);
                const bf16x8 v0 = {a0[0], a0[1], a0[2], a0[3], a1[0], a1[1], a1[2], a1[3]}, v1 = {b0[0], b0[1], b0[2], b0[3], b1[0], b1[1], b1[2], b1[3]};
                o0 = MFMA32(__builtin_bit_cast(bf16x8, pw[ks]), v0, o0); o1 = MFMA32(__builtin_bit_cast(bf16x8, pw[ks]), v1, o1);
            }
        }
        if (dstep) { D.pend = true; ++D.i; if (D.i <= D.last) { decw_load(F, D, l15, g4); l1 = true; } }
        const int tmp = s_fre; s_fre = s_cur; s_cur = s_nxt; s_nxt = tmp;
    }
    __builtin_amdgcn_s_setprio(0);
    LAS bf16* stg = (LAS bf16*)(L + AT_O) + wid * 2048;
#pragma unroll
    for (int r = 0; r < 16; ++r) { const int orow = crow(r, hi); stg[orow * 64 + r32] = pg8::bf1(o0[r]); stg[orow * 64 + 32 + r32] = pg8::bf1(o1[r]); }
    asm volatile("s_waitcnt lgkmcnt(0)" ::: "memory");
#pragma unroll
    for (int i = 0; i < 4; ++i) {
        const int row = i * 8 + (lane >> 3), ch = lane & 7; const size_t grow = (size_t)rowbase + q0 + row;
        const v4u ov = *(const LAS v4u*)(stg + row * 64 + ch * 8), gv = *(const v4u*)(F.GA() + grow * 512 + h * 64 + ch * 8);
        f32x4 x, y;
        x[0] = bflo(ov[0]) * bflo(gv[0]); x[1] = bfhi(ov[0]) * bfhi(gv[0]); x[2] = bflo(ov[1]) * bflo(gv[1]); x[3] = bfhi(ov[1]) * bfhi(gv[1]);
        y[0] = bflo(ov[2]) * bflo(gv[2]); y[1] = bfhi(ov[2]) * bfhi(gv[2]); y[2] = bflo(ov[3]) * bflo(gv[3]); y[3] = bfhi(ov[3]) * bfhi(gv[3]);
        *(pg8::u32x4*)(F.MIX() + grow * 1024 + h * 64 + ch * 8) = pg8::pack8(x, y);
    }
    asm volatile("s_waitcnt lgkmcnt(0)\n\ts_barrier" ::: "memory");
#undef AT_DMA
}
constexpr int DW_OB = 90112, DW_CB = 106496;
__device__ __forceinline__ void attn_pair_dec(Frame& F, int it) {
    const int lane = F.lane, l15 = lane & 15, g4 = lane >> 4, wid = F.wave;
    const int bh = it >> 4, x = it & 15;
    DecW D; D.s = it >> 3; D.h = it & 7; D.w = wid; D.carry = 1.f; D.i = 1; D.last = 64; D.pend = false;
    D.pagev = F.pt[D.s * NPG + 8 * wid + (lane & 7)];
    D.tb = F.lds + RING_OFF + DW_T + wid * 2048;
#pragma unroll
    for (int dt = 0; dt < 4; ++dt) D.o[dt] = (f32x4){0.f, 0.f, 0.f, 0.f};
#pragma unroll
    for (int ks = 0; ks < 2; ++ks) D.qb[ks] = *(const bf16x8*)(F.QA() + ((size_t)MP + D.s * 8 + (l15 & 7)) * 512 + D.h * 64 + 32 * ks + 8 * g4);
    const float dcinit = -F.sbb[D.h] * LOG2E;
    if (wid == 7) {
        const size_t row = (size_t)MP + D.s * 8;
        const bf16* kp = F.KA() + (row + (l15 & 7)) * 512 + D.h * 64 + 8 * g4;
#pragma unroll
        for (int ks = 0; ks < 2; ++ks) { const v4u w = *(const v4u*)(kp + 32 * ks);
            D.S.k[2 * ks] = (f32x4){bflo(w[0]), bfhi(w[0]), bflo(w[1]), bfhi(w[1])}; D.S.k[2 * ks + 1] = (f32x4){bflo(w[2]), bfhi(w[2]), bflo(w[3]), bfhi(w[3])}; }
        const bf16* vp = F.VA() + (row + (l15 & 7)) * 512 + D.h * 64 + 4 * g4;
#pragma unroll
        for (int j = 0; j < 4; ++j) { const u32x2 w = *(const u32x2*)(vp + 16 * j); D.S.v[j] = (f32x4){bflo(w.x), bfhi(w.x), bflo(w.y), bfhi(w.y)}; }
        decw_proc(D, true, dcinit, l15, g4);
    }
    decw_load(F, D, l15, g4);
    asm volatile("s_waitcnt vmcnt(0)" ::: "memory");
    attn_unit_dec(F, bh >> 3, bh & 7, 31 - x, D);
    attn_unit_dec(F, bh >> 3, bh & 7, x, D);
    if (D.pend) { decw_procB(D, l15, g4); D.pend = false; }
    while (D.i <= D.last) { decw_proc(D, false, dcinit, l15, g4); ++D.i; if (D.i <= D.last) decw_load(F, D, l15, g4); }
    LAS float* ob = (LAS float*)(F.lds + RING_OFF + DW_OB); LAS float* cb = (LAS float*)(F.lds + RING_OFF + DW_CB);
    if (g4 < 2) {
#pragma unroll
        for (int dt = 0; dt < 4; ++dt)
#pragma unroll
            for (int r = 0; r < 4; ++r) ob[(wid * 8 + 4 * g4 + r) * 64 + 16 * dt + l15] = D.o[dt][r];
        if (g4 == 0 && l15 < 8) cb[wid * 8 + l15] = D.carry;
    }
    __syncthreads();
    {
        const int q = F.tid >> 6, d = F.tid & 63; float acc = 0.f, pref = 1.f;
#pragma unroll
        for (int w = 7; w >= 0; --w) { acc += pref * ob[(w * 8 + q) * 64 + d]; pref *= cb[w * 8 + q]; }
        const size_t row = (size_t)MP + D.s * 8 + q;
        F.MIX()[row * 1024 + D.h * 64 + d] = pg8::bf1(acc * bf2f(F.GA()[row * 512 + D.h * 64 + d]));
    }
    __syncthreads();
}

#ifndef MK_N_LAUNCHES
#define MK_N_LAUNCHES 1
#endif
constexpr int NPH = 15;
constexpr int N_LAUNCHES = MK_N_LAUNCHES;
struct Args { const void* in[17]; float* out; unsigned char* ws; int ph_lo, ph_hi, li, pad; };
__global__ void __launch_bounds__(NWAVES * 64, 2) mk_fwd(Args args) {
    extern __shared__ __attribute__((aligned(16))) unsigned char lds[];
    Frame F;
    F.lds = (LAS unsigned char*)lds;
    F.MISC = (volatile LAS unsigned*)(F.lds + MISC_OFF);
    F.tid = threadIdx.x; F.lane = F.tid & 63; F.wave = __builtin_amdgcn_readfirstlane(F.tid >> 6);
    F.G = gridDim.x; F.bid = blockIdx.x;
    unsigned char* ws = args.ws;
    F.ctl = (gu32*)(ws + WS_CTL);
    F.xp = (const float*)args.in[0]; F.xs = (const float*)args.in[1]; F.ck = (const float*)args.in[2]; F.cv = (const float*)args.in[3]; F.pt = (const int*)args.in[4];
    F.st_h = (const float*)args.in[5]; F.st_r = (const float*)args.in[6]; F.ng = (const float*)args.in[7]; F.w1 = (const float*)args.in[8]; F.w2 = (const float*)args.in[9];
    F.qg = (const float*)args.in[10]; F.kg = (const float*)args.in[11]; F.sbb = (const float*)args.in[12]; F.hlb = (const float*)args.in[13]; F.og = (const float*)args.in[14];
    F.w3 = (const float*)args.in[15]; F.w4 = (const float*)args.in[16]; F.out = args.out;
    F.ws = ws;
    for (int u = F.tid; u < (LDS_BYTES - LDSCTL_OFF) / 4; u += NWAVES * 64) ((LAS unsigned*)(F.lds + LDSCTL_OFF))[u] = 0u;
    __syncthreads();
    XcdBarrier bar; bar.bar = (unsigned*)(F.ctl + CW_BAR); bar.x = 0; bar.st = nullptr;
    if (N_LAUNCHES == 1) bar = xcd_barrier_post((unsigned*)(F.ctl + CW_BAR), F.MISC + 8);
#define GRID_BAR() do { if (N_LAUNCHES == 1) xcd_barrier(bar); } while (0)
    const int lo = args.ph_lo, hi = args.ph_hi;
#define IN(k) (lo <= (k) && (k) < hi)
    const int gw = F.bid * NWAVES + F.wave, NGW = F.G * NWAVES;
    const int vcu_ = (F.G % 8 == 0) ? (F.bid % 8) * (F.G / 8) + F.bid / 8 : F.bid;

    if (IN(0)) { p0_prologue(F); GRID_BAR(); }
    if (IN(1)) {
        pg8::Gemm g{1024, 1024, 1024}; pg8::SchedPlain S; S.init(F.H(), F.W1T(), MP, N1, 1024, F.G, F.bid);
        pg8::EpiEven E{F.QA(), F.KA(), F.VAT(), F.GA(), F.QB(), F.KB(), F.VB(), F.GB(), F.LOGF(), F.out, F.qg, F.kg, F.hlb, -0.125f * LOG2E, MT, MP, OK_P, OK_S, OV_P, OV_S};
        pg8::gemm_phase<pg8::EpiEven, pg8::SchedPlain, true, true>(F.lds + RING_OFF, g, S, E);
        { pg8::Gemm gs{256, 1024, 1024}; pg8::SchedSplit Ss{(const char*)(F.H() + (size_t)MP * 1024), (const char*)F.W1T(), N1 / 256, 4, F.G, F.bid, 2048, 2048};
          pg8::EpiSlab Es{F.SLAB(), N1}; pg8::gemm_phase<pg8::EpiSlab, pg8::SchedSplit, true, true>(F.lds + RING_OFF, gs, Ss, Es); }
        GRID_BAR();
    }
    if (IN(2)) {
        for (int it = gw; it < MSM * 8; it += NGW) pp1_item(F, it);
        for (int u = F.bid; u < 8 * 32; u += F.G) hgrn_chunk_unit2<false>(F, u >> 5, u & 31);
        GRID_BAR();
    }
    if (IN(3)) {
        hgrn_passB(F);
        for (int u = F.bid; u < NSQ * HB; u += F.G) hgrn_sample_unit(F, u >> 2, u & 3);
        { const int vcu = (F.G % 8 == 0) ? (F.bid % 8) * (F.G / 8) + F.bid / 8 : F.bid;
          for (int it = vcu; it < 256; it += F.G) attn_pair_dec(F, it); }
        GRID_BAR();
    }
    if (IN(4)) {
        for (int u = F.bid; u < 8 * 32; u += F.G) hgrn_chunk_unit2<true>(F, u >> 5, u & 31);
        { pg8::Gemm gs{256, 1024, 1024}; pg8::SchedSplit Ss{(const char*)(F.MIX() + (size_t)MP * 1024), (const char*)F.W2T(), 4, 4, F.G, F.bid, 2048, 2048};
          pg8::EpiSlab Es{F.SLAB(), 1024}; pg8::gemm_phase<pg8::EpiSlab, pg8::SchedSplit, true, true>(F.lds + RING_OFF, gs, Ss, Es); }
        GRID_BAR();
    }
    if (IN(6)) {
        pg8::Gemm g{1024, 1024, 1024}; pg8::SchedPlain S; S.init(F.MIX(), F.W2T(), MP, 1024, 1024, F.G, F.bid);
        pg8::EpiY1 E{F.xp, F.Y1B(), F.SS1()};
        pg8::gemm_phase<pg8::EpiY1, pg8::SchedPlain, true, true>(F.lds + RING_OFF, g, S, E);
        for (int r = gw; r < MSM; r += NGW) pp2_row(F, r);
        GRID_BAR();
    }
    if (IN(8)) {
        pg8::Gemm g{1024, 1024, 1024};
        { pg8::Sched3<0> S; S.init(F.Y1B(), F.W3T(), F.G, F.bid); pg8::EpiOdd3<0> E{F.AQ(), F.KCH(), F.KCT(), F.BV(), F.GC(), F.QC(), F.KC(), F.VC(), F.RCOS(), F.RSIN(), F.RCOST(), F.RSINT(), MP, F.SS1()};
          pg8::gemm_phase<pg8::EpiOdd3<0>, pg8::Sched3<0>, true, true>(F.lds + RING_OFF, g, S, E); }
        { pg8::Sched3<1> S; S.init(F.Y1B(), F.W3T(), F.G, F.bid); pg8::EpiOdd3<1> E{F.AQ(), F.KCH(), F.KCT(), F.BV(), F.GC(), F.QC(), F.KC(), F.VC(), F.RCOS(), F.RSIN(), F.RCOST(), F.RSINT(), MP, F.SS1()};
          pg8::gemm_phase<pg8::EpiOdd3<1>, pg8::Sched3<1>, true, true>(F.lds + RING_OFF, g, S, E); }
        { pg8::Gemm gs{256, 1024, 1024}; pg8::SchedSplit Ss{(const char*)(F.H() + (size_t)MP * 1024), (const char*)F.W3T(), N3 / 256, 4, F.G, F.bid, 2048, 2048};
          pg8::EpiSlab Es{F.SLAB(), N3}; pg8::gemm_phase<pg8::EpiSlab, pg8::SchedSplit, true, true>(F.lds + RING_OFF, gs, Ss, Es); }
        GRID_BAR();
    }
    if (IN(9)) {
        { pg8::Gemm g{256, 512, 256}; pg8::SchedRet S{(const char*)F.BV(), (const char*)F.KCT(), F.G, vcu_, 0};
          pg8::EpiRetA E{(pg8::bf16_t*)F.DST()};
          pg8::gemm_phase<pg8::EpiRetA, pg8::SchedRet, true, true>(F.lds + RING_OFF, g, S, E); }
        { pg8::Gemm g{256, 2048, 1024}; pg8::SchedRet S{(const char*)F.AQ(), (const char*)F.KCH(), F.G, vcu_, 1};
          pg8::EpiRetP E{F.AQ()};
          pg8::gemm_phase<pg8::EpiRetP, pg8::SchedRet, true, true>(F.lds + RING_OFF, g, S, E); }
        for (int it = gw; it < MSM * 24; it += NGW) pp3_item(F, it);
        GRID_BAR();
    }
    if (IN(10)) {
        ret_passB(F);
        for (int u = F.bid; u < NSQ * HC * 2; u += F.G) ret_sample_unit(F, u >> 3, (u >> 1) & 3, u & 1);
        GRID_BAR();
    }
    if (IN(12)) {
        pg8::Gemm g{512, 2048, 512}; pg8::SchedRet S{(const char*)F.AQ(), (const char*)F.BV(), F.G, vcu_, 2};
        pg8::EpiRetO E{F.GC(), F.MIX2(), F.SS()};
        pg8::gemm_phase<pg8::EpiRetO, pg8::SchedRet, true, true>(F.lds + RING_OFF, g, S, E);
        { pg8::Gemm gs{256, 2048, 2048}; pg8::SchedSplit Ss{(const char*)(F.MIX2() + (size_t)MP * 2048), (const char*)F.W4T(), 4, 8, F.G, F.bid, 4096, 4096};
          pg8::EpiSlab Es{F.SLAB4(), 1024}; pg8::gemm_phase<pg8::EpiSlab, pg8::SchedSplit, true, true>(F.lds + RING_OFF, gs, Ss, Es); }
        GRID_BAR();
    }
    if (IN(14)) {
        pg8::Gemm g{2048, 2048, 2048}; pg8::SchedPlain S; S.init(F.MIX2(), F.W4T(), MP, 1024, 2048, F.G, F.bid);
        pg8::EpiOut E{F.Y1B(), F.out + OY_P, F.SS()};
        pg8::gemm_phase<pg8::EpiOut, pg8::SchedPlain, true, true>(F.lds + RING_OFF, g, S, E);
        for (int r = gw; r < MSM; r += NGW) pp4_row(F, r);
    }
#undef IN
}

extern "C" void kernel_launch(void* const* d_in, const int* in_sizes, int n_in, void* d_out, int out_size, void* d_ws, size_t ws_size, hipStream_t stream) {
    static int grid = 0;
    if (grid == 0) {
        if (n_in != 17 || (size_t)out_size != OUT_TOTAL || ws_size < WS_END) { fprintf(stderr, "kernel_launch: unexpected shapes: n_in %d out %d ws %zu (need %zu)\n", n_in, out_size, ws_size, (size_t)WS_END); grid = -1; return; }
        int dev = 0, cus = 0, per_cu = 0;
        if (hipGetDevice(&dev) != hipSuccess || hipDeviceGetAttribute(&cus, hipDeviceAttributeMultiprocessorCount, dev) != hipSuccess) { grid = -1; return; }
        if (hipFuncSetAttribute((const void*)mk_fwd, hipFuncAttributeMaxDynamicSharedMemorySize, LDS_BYTES) != hipSuccess) { fprintf(stderr, "kernel_launch: hipFuncSetAttribute failed\n"); grid = -1; return; }
        if (hipOccupancyMaxActiveBlocksPerMultiprocessor(&per_cu, (const void*)mk_fwd, NWAVES * 64, LDS_BYTES) != hipSuccess || per_cu < 1) { fprintf(stderr, "kernel_launch: occupancy query says %d\n", per_cu); }
        (void)hipGetLastError();
        grid = cus;
    }
    if (grid < 0) return;
    if (hipMemsetAsync((char*)d_ws + WS_CTL, 0, CTL_ZERO_BYTES, stream) != hipSuccess) return;
    Args a{};
    for (int i = 0; i < 17; ++i) a.in[i] = d_in[i];
    a.out = (float*)d_out; a.ws = (unsigned char*)d_ws;
    for (int li = 0; li < N_LAUNCHES; ++li) {
        a.ph_lo = (N_LAUNCHES == 1) ? 0 : li; a.ph_hi = (N_LAUNCHES == 1) ? NPH : li + 1; a.li = li;
        hipLaunchKernelGGL(mk_fwd, dim3(grid), dim3(NWAVES * 64), LDS_BYTES, stream, a);
        if (hipPeekAtLastError() != hipSuccess) break;
    }
}
```

```cpp
#include <hip/hip_runtime.h>
#include <cstdio>
#include <cstdint>

constexpr int DM = 1024, TP = 8192, NBP = 2, MP = NBP * TP;
constexpr int NSQ = 32, TSQ = 8, MSM = NSQ * TSQ;
constexpr int MT = MP + MSM;
constexpr int PAST = 8192, PAGE = 128, NPG = PAST / PAGE;
constexpr int HA = 8, HDA = 64, WA = 512, HB = 4, DKB = 128, DVB = 128, HC = 4, DKC = 256, DVC = 512, WC = 2048;
constexpr int N1 = 4096, N3 = 6144;
constexpr float EPS = 1e-6f;
constexpr float LOG2E = 1.4426950408889634f;
constexpr size_t OY_P = 0, OY_S = 16777216, OK_P = 17039360, OV_P = 25427968, OK_S = 33816576, OV_S = 33947648,
                 OHG_P = 34078720, OHG_S = 34209792, ORT_P = 36306944, ORT_S = 37355520, OUT_TOTAL = 54132736;
#define MK_N_LAUNCHES 1
namespace pg8 {
#define PG8_LAS __attribute__((address_space(3)))
typedef unsigned short bf16_t;
typedef short bf16x8 __attribute__((ext_vector_type(8)));
typedef float f32x4 __attribute__((ext_vector_type(4)));
typedef unsigned u32x4 __attribute__((ext_vector_type(4)));
constexpr int BM = 256, BK = 64, HALF = 128, HTB = HALF * BK * 2  , STAGE_BYTES = 8 * HTB, NXCD = 8, WGM = 8;

__host__ __device__ __forceinline__ int lds_byte(int r, int c) { const int st = (r >> 4) * 2 + (c >> 5), rr = r & 15, cc = c & 31, ob = rr * 64 + cc * 2; return st * 1024 + (ob ^ (((ob >> 9) & 1) << 5)); }
__host__ __device__ __forceinline__ void stage_rc(int b, int& R, int& C) { const int st = b / 1024, sb = b % 1024, swz = sb ^ (((sb >> 9) & 1) << 5); R = (st >> 1) * 16 + swz / 64; C = (st & 1) * 32 + (swz % 64) / 2; }
__host__ __device__ __forceinline__ int perm32(int rho) { const int n = rho >> 4, i = rho & 15; return 8 * (i >> 2) + 4 * n + (i & 3); }

struct Unit { int pm, pn, kind, aux; };
struct Gemm { int K, lda, ldb; };

struct StaticOrder {
    int nM, nN, nwg, G, c;
    __host__ __device__ void init(int M, int N, int G_, int c_) { nM = M / BM; nN = N / BM; nwg = nM * nN; G = G_; c = c_; }
    __host__ __device__ bool next(int i, Unit& u) const {
        const long L = (long)i * G + c; if (L >= nwg) return false;
        int wgid = (int)L; { const int q = nwg / NXCD, r = nwg % NXCD, xcd = wgid % NXCD, off = wgid / NXCD; wgid = (xcd < r ? xcd * (q + 1) : r * (q + 1) + (xcd - r) * q) + off; }
        const int nig = WGM * nN, gid = wgid / nig, fm = gid * WGM, gsz = (nM - fm) < WGM ? (nM - fm) : WGM;
        u.pm = fm + ((wgid % nig) % gsz); u.pn = (wgid % nig) / gsz; return true;
    }
    __device__ __forceinline__ void a_ready(const Unit&) const {}
    __device__ __forceinline__ void done(const Unit&) const {}
};
typedef float f32x2_t __attribute__((ext_vector_type(2))); typedef __bf16 bf16x2_t __attribute__((ext_vector_type(2)));
__device__ __forceinline__ unsigned cvt_pk_bf16(float lo, float hi) { f32x2_t v = {lo, hi}; bf16x2_t b = __builtin_convertvector(v, bf16x2_t); return __builtin_bit_cast(unsigned, b); }
typedef float f32x2 __attribute__((ext_vector_type(2)));
template <class Epi, class Sched, bool ALIGN_EPI = false, bool SP2 = false>
__device__ __forceinline__ void gemm_phase(PG8_LAS unsigned char* lds, const Gemm g, const Sched& S, const Epi& E) {
    const int tid = threadIdx.x, wid = __builtin_amdgcn_readfirstlane(tid >> 6), lane = tid & 63, wr = wid >> 2, wc = wid & 3, fr = lane & 15, fq = lane >> 4;
    const int K = g.K, nt = K / BK;
    unsigned voffA[2], voffB[2];
#pragma unroll
    for (int i = 0; i < 2; ++i) { int R, C; stage_rc(tid * 16 + i * 8192, R, C); const int Rb = Epi::PERM ? ((R & ~31) + perm32(R & 31)) : R;
        voffA[i] = (unsigned)(R * g.lda + C) * 2u; voffB[i] = (unsigned)(Rb * g.ldb + C) * 2u; }
    const size_t kstep = (size_t)(BK * 2);
    const size_t hstepA = (size_t)HALF * g.lda * 2, hstepB = (size_t)HALF * g.ldb * 2;
    const unsigned ldsw = (unsigned)wid * 1024u;
    const int aoff = lds_byte(wr * 64 + fr, fq * 8), boff = lds_byte(wc * 32 + fr, fq * 8);
#define PG8_SA(b, h) (((b) * 2 + (h)) * HTB)
#define PG8_SB(b, h) ((4 + (b) * 2 + (h)) * HTB)
#define PG8_STAGE(bufoff, gbase, voff) do { _Pragma("unroll") for (int _i = 0; _i < 2; ++_i) \
        __builtin_amdgcn_global_load_lds((const unsigned*)((const char*)(gbase) + (voff)[_i]), (PG8_LAS unsigned*)(lds + (bufoff) + ldsw + _i * 8192), 16, 0, 0); } while (0)
#define PG8_LDA(dst, b, h) do { _Pragma("unroll") for (int m = 0; m < 4; ++m) _Pragma("unroll") for (int k = 0; k < 2; ++k) dst[m][k] = *(const PG8_LAS bf16x8*)(lds + PG8_SA(b, h) + aoff + m * 2048 + k * 1024); } while (0)
#define PG8_LDB(dst, b, h) do { _Pragma("unroll") for (int n = 0; n < 2; ++n) _Pragma("unroll") for (int k = 0; k < 2; ++k) dst[n][k] = *(const PG8_LAS bf16x8*)(lds + PG8_SB(b, h) + boff + n * 2048 + k * 1024); } while (0)
#define PG8_MMA(ai, bj, At, Bt) do { __builtin_amdgcn_s_setprio(1); _Pragma("unroll") for (int m = 0; m < 4; ++m) _Pragma("unroll") for (int n = 0; n < 2; ++n) _Pragma("unroll") for (int k = 0; k < 2; ++k) \
        acc[ai][bj][m][n] = __builtin_amdgcn_mfma_f32_16x16x32_bf16(Bt[n][k], At[m][k], acc[ai][bj][m][n], 0, 0, 0); __builtin_amdgcn_s_setprio(0); } while (0)
#define PG8_WAIT_V(n) asm volatile("s_waitcnt vmcnt(" #n ")" ::: "memory")
#define PG8_WAIT_L(n) asm volatile("s_waitcnt lgkmcnt(" #n ")" ::: "memory")
#define PG8_BAR __builtin_amdgcn_s_barrier()
#define PG8_SCHED __builtin_amdgcn_sched_barrier(0)
    Unit cur, nxt; int ui = 0;
    if (!S.next(0, cur)) return;
    f32x4 acc[2][2][4][2];
#pragma unroll
    for (int a = 0; a < 2; ++a)
#pragma unroll
        for (int b = 0; b < 2; ++b)
#pragma unroll
            for (int m = 0; m < 4; ++m)
#pragma unroll
                for (int n = 0; n < 2; ++n) acc[a][b][m][n] = (f32x4){0.f, 0.f, 0.f, 0.f};
    bf16x8 At[4][2], B0[2][2], B1[2][2];
    const char* cA = S.a_base(cur); const char* cB = S.b_base(cur);
    S.a_ready(cur);
    if constexpr (SP2) {
        PG8_STAGE(PG8_SB(0, 0), cB, voffB); PG8_STAGE(PG8_SB(0, 1), cB + hstepB, voffB); PG8_STAGE(PG8_SA(0, 0), cA, voffA); PG8_STAGE(PG8_SA(0, 1), cA + hstepA, voffA);
        if (wr == 1) PG8_BAR;
        PG8_WAIT_V(2); PG8_BAR;
        PG8_STAGE(PG8_SB(1, 0), cB + kstep, voffB); PG8_STAGE(PG8_SA(1, 0), cA + kstep, voffA); PG8_STAGE(PG8_SB(1, 1), cB + hstepB + kstep, voffB);
        PG8_WAIT_V(6); PG8_BAR;
    } else {
        PG8_STAGE(PG8_SB(0, 0), cB, voffB); PG8_STAGE(PG8_SA(0, 0), cA, voffA); PG8_STAGE(PG8_SB(0, 1), cB + hstepB, voffB); PG8_STAGE(PG8_SA(0, 1), cA + hstepA, voffA);
        if (wr == 1) PG8_BAR;
        PG8_WAIT_V(4); PG8_BAR;
        PG8_STAGE(PG8_SB(1, 0), cB + kstep, voffB); PG8_STAGE(PG8_SA(1, 0), cA + kstep, voffA); PG8_STAGE(PG8_SB(1, 1), cB + hstepB + kstep, voffB);
        PG8_WAIT_V(6); PG8_BAR;
    }
    for (;;) {
        const bool has_next = S.next(ui + 1, nxt);
        const char* nA = has_next ? S.a_base(nxt) : cA; const char* nB = has_next ? S.b_base(nxt) : cB;
#pragma unroll 1
        for (int t = 0; t < nt; t += 2) {
            if constexpr (Epi::KHOOK) { if (t != 0 && (t & 7) == 0) E.khook(acc, cur, t >> 3, wr, fr); }
            const bool last = (t == nt - 2);
            const char* a1 = cA + (size_t)(t + 1) * kstep;
            const char* a2 = last ? nA : cA + (size_t)(t + 2) * kstep; const char* b2 = last ? nB : cB + (size_t)(t + 2) * kstep;
            const char* a3 = a2 + kstep; const char* b3 = b2 + kstep;
            if (last && has_next) S.a_ready(nxt);
            if constexpr (SP2) {
            PG8_LDB(B0, 0, 0); PG8_LDB(B1, 0, 1); PG8_SCHED; PG8_LDA(At, 0, 0); PG8_STAGE(PG8_SA(1, 1), a1 + hstepA, voffA);
            PG8_WAIT_V(8); PG8_WAIT_L(0); PG8_BAR; PG8_MMA(0, 0, At, B0); PG8_MMA(0, 1, At, B1); PG8_BAR; PG8_SCHED;
            PG8_LDA(At, 0, 1); PG8_STAGE(PG8_SB(0, 0), b2, voffB); PG8_STAGE(PG8_SB(0, 1), b2 + hstepB, voffB); PG8_STAGE(PG8_SA(0, 0), a2, voffA);
            PG8_WAIT_V(8); PG8_WAIT_L(0); PG8_BAR; PG8_MMA(1, 0, At, B0); PG8_MMA(1, 1, At, B1); PG8_BAR; PG8_SCHED;
            PG8_LDB(B0, 1, 0); PG8_LDB(B1, 1, 1); PG8_SCHED; PG8_LDA(At, 1, 0); PG8_STAGE(PG8_SA(0, 1), a2 + hstepA, voffA);
            PG8_WAIT_V(8); PG8_WAIT_L(0); PG8_BAR; PG8_MMA(0, 0, At, B0); PG8_MMA(0, 1, At, B1); PG8_BAR; PG8_SCHED;
            PG8_LDA(At, 1, 1); PG8_STAGE(PG8_SB(1, 0), b3, voffB); PG8_STAGE(PG8_SB(1, 1), b3 + hstepB, voffB); PG8_STAGE(PG8_SA(1, 0), a3, voffA);
            PG8_WAIT_V(8); PG8_WAIT_L(0); PG8_BAR; PG8_MMA(1, 0, At, B0); PG8_MMA(1, 1, At, B1); PG8_BAR; PG8_SCHED;
            } else {
            PG8_LDB(B0, 0, 0); PG8_SCHED; PG8_LDA(At, 0, 0); PG8_STAGE(PG8_SA(1, 1), a1 + hstepA, voffA);
            PG8_WAIT_L(8); PG8_BAR; PG8_WAIT_L(0); PG8_MMA(0, 0, At, B0); PG8_BAR; PG8_SCHED;
            PG8_LDB(B1, 0, 1); PG8_STAGE(PG8_SB(0, 0), b2, voffB);
            PG8_BAR; PG8_WAIT_L(0); PG8_MMA(0, 1, At, B1); PG8_BAR;
            PG8_LDA(At, 0, 1); PG8_STAGE(PG8_SA(0, 0), a2, voffA);
            PG8_BAR; PG8_WAIT_L(0); PG8_MMA(1, 0, At, B0); PG8_BAR; PG8_SCHED;
            PG8_STAGE(PG8_SB(0, 1), b2 + hstepB, voffB);
            PG8_WAIT_V(6); PG8_BAR; PG8_MMA(1, 1, At, B1); PG8_BAR;
            PG8_LDB(B0, 1, 0); PG8_SCHED; PG8_LDA(At, 1, 0); PG8_STAGE(PG8_SA(0, 1), a2 + hstepA, voffA);
            PG8_WAIT_L(8); PG8_BAR; PG8_WAIT_L(0); PG8_MMA(0, 0, At, B0); PG8_BAR; PG8_SCHED;
            PG8_LDB(B1, 1, 1); PG8_STAGE(PG8_SB(1, 0), b3, voffB);
            PG8_BAR; PG8_WAIT_L(0); PG8_MMA(0, 1, At, B1); PG8_BAR;
            PG8_LDA(At, 1, 1); PG8_STAGE(PG8_SA(1, 0), a3, voffA);
            PG8_BAR; PG8_WAIT_L(0); PG8_MMA(1, 0, At, B0); PG8_BAR; PG8_SCHED;
            PG8_STAGE(PG8_SB(1, 1), b3 + hstepB, voffB);
            PG8_WAIT_V(6); PG8_BAR; PG8_MMA(1, 1, At, B1); PG8_BAR;
            }
        }
        if constexpr (ALIGN_EPI) { if (wr == 0) PG8_BAR; }
        if constexpr (!Epi::AFTER_DRAIN) { E(acc, cur, wr, wc, fr, fq); S.done(cur); }
        if (!has_next) break;
#pragma unroll
        for (int a = 0; a < 2; ++a)
#pragma unroll
            for (int b = 0; b < 2; ++b)
#pragma unroll
                for (int m = 0; m < 4; ++m)
#pragma unroll
                    for (int n = 0; n < 2; ++n) acc[a][b][m][n] = (f32x4){0.f, 0.f, 0.f, 0.f};
        cur = nxt; cA = nA; cB = nB; ++ui;
        if constexpr (ALIGN_EPI) { if (wr == 1) PG8_BAR; }
    }
    PG8_WAIT_V(0);
    if constexpr (!ALIGN_EPI) { if (wr == 0) PG8_BAR; }
    PG8_BAR;
    if constexpr (Epi::AFTER_DRAIN) { E.fused(acc, cur, wr, wc, fr, fq, lds, wid, lane); S.done(cur); }
#undef PG8_SA
#undef PG8_SB
#undef PG8_STAGE
#undef PG8_LDA
#undef PG8_LDB
#undef PG8_MMA
#undef PG8_WAIT_V
#undef PG8_WAIT_L
#undef PG8_BAR
#undef PG8_SCHED
}
__device__ __forceinline__ float silu_f(float x) { return x * __builtin_amdgcn_rcpf(1.f + __builtin_amdgcn_exp2f(-1.4426950408889634f * x)); }
__device__ __forceinline__ float sigm_f(float x) { return __builtin_amdgcn_rcpf(1.f + __builtin_amdgcn_exp2f(-1.4426950408889634f * x)); }
__device__ __forceinline__ u32x4 pack8(const f32x4 a, const f32x4 b) { u32x4 w; w.x = cvt_pk_bf16(a[0], a[1]); w.y = cvt_pk_bf16(a[2], a[3]); w.z = cvt_pk_bf16(b[0], b[1]); w.w = cvt_pk_bf16(b[2], b[3]); return w; }
__device__ __forceinline__ unsigned short bf1(float f) { return (unsigned short)(cvt_pk_bf16(f, 0.f) & 0xffffu); }

struct EpiEven {
    static constexpr bool PERM = true, AFTER_DRAIN = false, KHOOK = false;
    bf16_t *QA, *KA, *VAT, *GA, *QB, *KB, *VB, *GB; float* LOGF; float* out;
    const float *qg, *kg, *hlb; float qscale; int MTOT, MPR; size_t okp, oks, ovp, ovs;
    __device__ __forceinline__ void operator()(const f32x4 (&acc)[2][2][4][2], const Unit& u, int wr, int wc, int fr, int fq) const {
        const int typ = u.pn >> 1;
        int rb = u.pm * BM + wr * 64 + fr; asm volatile("" : "+v"(rb));
        const int c0 = (u.pn & 1) * 256 + wc * 64 + fq * 8;
        const int d0 = fq * 8;
#pragma unroll
        for (int ai = 0; ai < 2; ++ai)
#pragma unroll
            for (int m = 0; m < 4; ++m) {
                const int row = rb + ai * HALF + m * 16;
                f32x4 v[2][2];
#pragma unroll
                for (int bj = 0; bj < 2; ++bj)
#pragma unroll
                    for (int n = 0; n < 2; ++n) v[bj][n] = acc[ai][bj][m][n];
                if (typ <= 1) {
                    float ss = 0.f;
#pragma unroll
                    for (int bj = 0; bj < 2; ++bj)
#pragma unroll
                        for (int n = 0; n < 2; ++n) ss += (v[bj][n][0] * v[bj][n][0] + v[bj][n][1] * v[bj][n][1]) + (v[bj][n][2] * v[bj][n][2] + v[bj][n][3] * v[bj][n][3]);
                    ss += __shfl_xor(ss, 16); ss += __shfl_xor(ss, 32);
                    const float rstd = __builtin_amdgcn_rsqf(ss * (1.f / 64.f) + 1e-6f) * (typ == 0 ? qscale : 1.f);
                    const float* g = (typ == 0) ? qg : kg;
#pragma unroll
                    for (int bj = 0; bj < 2; ++bj) {
#pragma unroll
                        for (int n = 0; n < 2; ++n) { const f32x4 gv = *(const f32x4*)(g + d0 + 32 * bj + 4 * n); v[bj][n] = v[bj][n] * gv * rstd; }
                        const int c = c0 + 32 * bj;
                        if (typ == 0) *(u32x4*)(QA + (size_t)row * 512 + c) = pack8(v[bj][0], v[bj][1]);
                        else {
                            *(u32x4*)(KA + (size_t)row * 512 + c) = pack8(v[bj][0], v[bj][1]);
                            float* ko = out + (row < MPR ? okp + (size_t)row * 512 : oks + (size_t)(row - MPR) * 512) + c;
                            *(f32x4*)ko = v[bj][0]; *(f32x4*)(ko + 4) = v[bj][1];
                        }
                    }
                } else if (typ == 2) {
#pragma unroll
                    for (int bj = 0; bj < 2; ++bj) {
                        const int c = c0 + 32 * bj;
                        float* vo = out + (row < MPR ? ovp + (size_t)row * 512 : ovs + (size_t)(row - MPR) * 512) + c;
                        *(f32x4*)vo = v[bj][0]; *(f32x4*)(vo + 4) = v[bj][1];
                        *(u32x4*)(VAT + (size_t)row * 512 + c) = pack8(v[bj][0], v[bj][1]);
                    }
                } else if (typ == 5) {
#pragma unroll
                    for (int bj = 0; bj < 2; ++bj) {
                        const int c = c0 + 32 * bj;
                        f32x4 lf[2], kk[2];
#pragma unroll
                        for (int n = 0; n < 2; ++n)
#pragma unroll
                            for (int e = 0; e < 4; ++e) {
                                const int cc = c + 4 * n + e;
                                const float lb = __builtin_amdgcn_rcpf(1.f + __expf(hlb[512 + cc] - hlb[cc]));
                                const float sg = sigm_f(v[bj][n][e]);
                                lf[n][e] = __logf(lb + (1.f - lb) * sg);
                                kk[n][e] = (1.f - lb) * (1.f - sg);
                            }
                        *(f32x4*)(LOGF + (size_t)row * 512 + c) = lf[0]; *(f32x4*)(LOGF + (size_t)row * 512 + c + 4) = lf[1];
                        *(u32x4*)(KB + (size_t)row * 512 + c) = pack8(kk[0], kk[1]);
                    }
                } else {
                    bf16_t* dst = (typ == 3) ? GA : (typ == 4) ? QB : (typ == 6) ? VB : GB;
#pragma unroll
                    for (int bj = 0; bj < 2; ++bj) {
                        if (typ != 6) {
#pragma unroll
                            for (int n = 0; n < 2; ++n)
#pragma unroll
                                for (int e = 0; e < 4; ++e) v[bj][n][e] = silu_f(v[bj][n][e]);
                        }
                        *(u32x4*)(dst + (size_t)row * 512 + c0 + 32 * bj) = pack8(v[bj][0], v[bj][1]);
                    }
                }
            }
    }
};


struct EpiY1 {
    static constexpr bool PERM = false, AFTER_DRAIN = false, KHOOK = false;
    const float* x; bf16_t* Y1; float* SS1;
    __device__ __forceinline__ void operator()(const f32x4 (&acc)[2][2][4][2], const Unit& u, int wr, int wc, int fr, int fq) const {
        int row0 = u.pm * BM + wr * 64 + fr; asm volatile("" : "+v"(row0));
        const int col0 = u.pn * BM + wc * 32 + 4 * fq;
#pragma unroll
        for (int ai = 0; ai < 2; ++ai)
#pragma unroll
            for (int m = 0; m < 4; ++m) {
                const int row = row0 + ai * HALF + m * 16; float ss = 0.f;
#pragma unroll
                for (int bj = 0; bj < 2; ++bj)
#pragma unroll
                    for (int n = 0; n < 2; ++n) { const int c = col0 + bj * HALF + n * 16;
                        const f32x4 y = acc[ai][bj][m][n] + *(const f32x4*)(x + (size_t)row * 1024 + c);
                        *(unsigned long long*)(Y1 + (size_t)row * 1024 + c) = (unsigned long long)cvt_pk_bf16(y[0], y[1]) | ((unsigned long long)cvt_pk_bf16(y[2], y[3]) << 32);
                        ss += (y[0] * y[0] + y[1] * y[1]) + (y[2] * y[2] + y[3] * y[3]); }
                ss += __shfl_xor(ss, 16); ss += __shfl_xor(ss, 32);
                if (fq == 0) atomicAdd(SS1 + row, ss);
            }
    }
};


__device__ __forceinline__ float lg2gamma(int h) { return __builtin_amdgcn_logf(1.f - __builtin_amdgcn_exp2f(-5.f - (float)h)); }

template <int KIND> struct EpiOdd3 {
    static constexpr bool PERM = true, AFTER_DRAIN = false, KHOOK = false;
    bf16_t *AQ, *KCH, *KCT, *BV, *GC, *QC, *KC, *VC; const float *rcos, *rsin, *rcosT, *rsinT; int MPR; const float* SS1;
    __device__ __forceinline__ void operator()(const f32x4 (&acc)[2][2][4][2], const Unit& u, int wr, int wc, int fr, int fq) const {

        if (KIND == 0) {
            const int j0 = wc * 32 + fq * 8;
            int rb = u.pm * BM + wr * 64 + fr; asm volatile("" : "+v"(rb));
#pragma unroll
            for (int ai = 0; ai < 2; ++ai)
#pragma unroll
                for (int m = 0; m < 4; ++m) {
                    const int row = rb + ai * HALF + m * 16;
                    const float rs = __builtin_amdgcn_rsqf(SS1[row] * (1.f / 1024.f) + 1e-6f);
                    if (u.pn < 8) {
                        const int pos = row & (TP - 1), h = u.pn & 3, tl = row & 255;
                        const float sc = rs * ((u.pn < 4) ? __builtin_amdgcn_exp2f((float)tl * lg2gamma(h)) : 0.0625f * __builtin_amdgcn_exp2f(-(float)tl * lg2gamma(h)));
                        f32x4 o1[2], o2[2];
#pragma unroll
                        for (int n = 0; n < 2; ++n) {
                            const f32x4 c = *(const f32x4*)(rcos + (size_t)pos * 128 + j0 + 4 * n), s = *(const f32x4*)(rsin + (size_t)pos * 128 + j0 + 4 * n);
                            const f32x4 x1 = acc[ai][0][m][n], x2 = acc[ai][1][m][n];
                            o1[n] = (x1 * c - x2 * s) * sc; o2[n] = (x2 * c + x1 * s) * sc;
                        }
                        bf16_t* dst = (u.pn < 4) ? AQ + (size_t)row * 2048 + h * 512 + 256 + j0 : KCH + (size_t)row * 1024 + h * 256 + j0;
                        *(u32x4*)dst = pack8(o1[0], o1[1]); *(u32x4*)(dst + 128) = pack8(o2[0], o2[1]);
                        if (u.pn >= 4) {
                            bf16_t* kt = KCT + ((size_t)(((row >> 13) * 4 + h) * 32 + ((row >> 8) & 31)) * 256 + j0) * 256 + tl;
#pragma unroll
                            for (int n = 0; n < 2; ++n)
#pragma unroll
                                for (int e = 0; e < 4; ++e) { kt[(size_t)(4 * n + e) * 256] = bf1(o1[n][e]); kt[(size_t)(128 + 4 * n + e) * 256] = bf1(o2[n][e]); }
                        }
                        asm volatile("" ::: "memory");
                    } else {
                        bf16_t* dst = GC + (size_t)row * 2048 + (u.pn - 8) * 256 + j0;
#pragma unroll
                        for (int bj = 0; bj < 2; ++bj) {
                            f32x4 a = acc[ai][bj][m][0] * rs, b = acc[ai][bj][m][1] * rs;
#pragma unroll
                            for (int e = 0; e < 4; ++e) { a[e] = silu_f(a[e]); b[e] = silu_f(b[e]); }
                            *(u32x4*)(dst + 128 * bj) = pack8(a, b);
                        }
                    }
                }
            return;
        }
        int fro = fr; asm volatile("" : "+v"(fro));
        {
#pragma unroll
            for (int ai = 0; ai < 2; ++ai)
#pragma unroll
                for (int m = 0; m < 4; ++m) {
                    const int vf = (u.pm - 4) * BM + ai * HALF + wr * 64 + m * 16 + fro, h = vf >> 9, dv = vf & 511;
#pragma unroll
                    for (int bj = 0; bj < 2; ++bj) {
                        const int tok0 = u.pn * BM + bj * HALF + wc * 32 + fq * 8, b = tok0 >> 13, c = (tok0 >> 8) & 31, sl = tok0 & 255;
                        f32x4 r0 = *(const f32x4*)(SS1 + tok0), r1 = *(const f32x4*)(SS1 + tok0 + 4);
#pragma unroll
                        for (int e = 0; e < 4; ++e) { r0[e] = __builtin_amdgcn_rsqf(r0[e] * (1.f / 1024.f) + 1e-6f); r1[e] = __builtin_amdgcn_rsqf(r1[e] * (1.f / 1024.f) + 1e-6f); }
                        *(u32x4*)(BV + ((size_t)((b * 4 + h) * 32 + c) * 512 + dv) * 512 + sl) = pack8(acc[ai][bj][m][0] * r0, acc[ai][bj][m][1] * r1);
                    }
                }
        }
    }
};
template <int KIND> struct Sched3 {
    StaticOrder so; const char *H, *W3T; int G, c;
    __device__ __forceinline__ void init(const void* H_, const void* W3T_, int G_, int c_) { H = (const char*)H_; W3T = (const char*)W3T_; G = G_; c = c_; so.init(16384, 4096, G_, c_); }
    __device__ __forceinline__ bool next(int i, Unit& u) const {
        const int L = i * G + c; u.aux = 0; u.kind = KIND;
        if (KIND == 0) return so.next(i, u);
        if (KIND == 1) { if (L >= 512) return false; u.pm = 4 + (L & 7); u.pn = L >> 3; return true; }
        if (L >= 24) return false; u.pm = 64; u.pn = L; return true;
    }
    __device__ __forceinline__ const char* a_base(const Unit& u) const { return (KIND == 1) ? W3T + (size_t)(1024 + 256 * u.pm) * 2048 : H + (size_t)u.pm * 256 * 2048; }
    __device__ __forceinline__ const char* b_base(const Unit& u) const {
        if (KIND == 1) return H + (size_t)u.pn * 256 * 2048;
        const int r0 = (KIND == 0 && u.pn >= 8) ? 4096 + 256 * (u.pn - 8) : 256 * u.pn;
        return W3T + (size_t)r0 * 2048; }
    __device__ __forceinline__ void a_ready(const Unit&) const {}
    __device__ __forceinline__ void done(const Unit&) const {}
};
struct SchedPlain {
    StaticOrder so; const char *A, *Bt; size_t ta, tb;
    __device__ __forceinline__ void init(const void* A_, const void* Bt_, int M, int N, int K, int G, int c) { A = (const char*)A_; Bt = (const char*)Bt_; ta = (size_t)256 * K * 2; tb = ta; so.init(M, N, G, c); }
    __device__ __forceinline__ bool next(int i, Unit& u) const { u.kind = 0; u.aux = 0; return so.next(i, u); }
    __device__ __forceinline__ const char* a_base(const Unit& u) const { return A + (size_t)u.pm * ta; }
    __device__ __forceinline__ const char* b_base(const Unit& u) const { return Bt + (size_t)u.pn * tb; }
    __device__ __forceinline__ void a_ready(const Unit&) const {}
    __device__ __forceinline__ void done(const Unit&) const {}
};
struct SchedRet {
    const char *Ab, *Bb; int G, c, mode;
    __device__ __forceinline__ bool next(int i, Unit& u) const {
        const int L = i * G + c, n = (mode == 1) ? 256 : 512; if (L >= n) return false;
        int bc, half; if (mode == 1) { bc = L; half = 0; } else { bc = L >> 1; half = L & 1; }
        u.pm = bc; u.pn = half; u.kind = 0; u.aux = (bc >> 7) * TP + (bc & 31) * 256; return true;
    }
    __device__ __forceinline__ const char* a_base(const Unit& u) const {
        if (mode == 0) return Ab + ((size_t)u.pm * 512 + u.pn * 256) * 512 * 2;
        const int h = (u.pm >> 5) & 3;
        return Ab + ((size_t)u.aux * 2048 + h * 512 + (mode == 1 ? 256 : 0)) * 2; }
    __device__ __forceinline__ const char* b_base(const Unit& u) const {
        const int h = (u.pm >> 5) & 3;
        if (mode == 0) return Bb + (size_t)u.pm * 256 * 256 * 2;
        if (mode == 1) return Bb + ((size_t)u.aux * 1024 + h * 256) * 2;
        return Bb + ((size_t)u.pm * 512 + u.pn * 256) * 512 * 2; }
    __device__ __forceinline__ void a_ready(const Unit&) const {}
    __device__ __forceinline__ void done(const Unit&) const {}
};
struct EpiRetA {
    static constexpr bool PERM = true, AFTER_DRAIN = false, KHOOK = false;
    bf16_t* DST;
    __device__ __forceinline__ void operator()(const f32x4 (&acc)[2][2][4][2], const Unit& u, int wr, int wc, int fr, int fq) const {
        bf16_t* base = DST + ((size_t)u.pm * 512 + u.pn * 256) * 256;
        int rb = wr * 64 + fr; asm volatile("" : "+v"(rb));
#pragma unroll
        for (int ai = 0; ai < 2; ++ai)
#pragma unroll
            for (int m = 0; m < 4; ++m) { bf16_t* rp = base + (size_t)(ai * HALF + m * 16 + rb) * 256 + wc * 32 + 8 * fq;
#pragma unroll
                for (int bj = 0; bj < 2; ++bj) *(u32x4*)(rp + bj * HALF) = pack8(acc[ai][bj][m][0], acc[ai][bj][m][1]); }
    }
};
struct EpiRetP {
    static constexpr bool PERM = true, AFTER_DRAIN = false, KHOOK = false;
    bf16_t* AQ;
    __device__ __forceinline__ void operator()(const f32x4 (&acc)[2][2][4][2], const Unit& u, int wr, int wc, int fr, int fq) const {
        const int h = (u.pm >> 5) & 3;
        int rb = wr * 64 + fr; asm volatile("" : "+v"(rb));
#pragma unroll
        for (int ai = 0; ai < 2; ++ai)
#pragma unroll
            for (int m = 0; m < 4; ++m) { const int t = ai * HALF + m * 16 + rb;
#pragma unroll
                for (int bj = 0; bj < 2; ++bj) { const int s0 = bj * HALF + wc * 32 + fq * 8; f32x4 a = acc[ai][bj][m][0], b = acc[ai][bj][m][1];
#pragma unroll
                    for (int e = 0; e < 4; ++e) { if (s0 + e > t) a[e] = 0.f; if (s0 + 4 + e > t) b[e] = 0.f; }
                    *(u32x4*)(AQ + (size_t)(u.aux + t) * 2048 + h * 512 + s0) = pack8(a, b); } }
    }
};
struct EpiRetO {
    static constexpr bool PERM = true, AFTER_DRAIN = false, KHOOK = false;
    const bf16_t* GC; bf16_t* MIX2; float* SS;
    __device__ __forceinline__ void operator()(const f32x4 (&acc)[2][2][4][2], const Unit& u, int wr, int wc, int fr, int fq) const {
        const int h = (u.pm >> 5) & 3;
        int rb = u.aux + wr * 64 + fr; asm volatile("" : "+v"(rb));
#pragma unroll
        for (int ai = 0; ai < 2; ++ai)
#pragma unroll
            for (int m = 0; m < 4; ++m) { const size_t row = (size_t)(rb + ai * HALF + m * 16); float ss = 0.f;
#pragma unroll
                for (int bj = 0; bj < 2; ++bj) { const int col = h * 512 + u.pn * 256 + bj * HALF + wc * 32 + fq * 8; f32x4 a = acc[ai][bj][m][0], b = acc[ai][bj][m][1];
                    ss += (a[0] * a[0] + a[1] * a[1]) + (a[2] * a[2] + a[3] * a[3]) + (b[0] * b[0] + b[1] * b[1]) + (b[2] * b[2] + b[3] * b[3]);
                    const u32x4 g = *(const u32x4*)(GC + row * 2048 + col);
                    a[0] *= __builtin_bit_cast(float, g.x << 16); a[1] *= __builtin_bit_cast(float, g.x & 0xffff0000u); a[2] *= __builtin_bit_cast(float, g.y << 16); a[3] *= __builtin_bit_cast(float, g.y & 0xffff0000u);
                    b[0] *= __builtin_bit_cast(float, g.z << 16); b[1] *= __builtin_bit_cast(float, g.z & 0xffff0000u); b[2] *= __builtin_bit_cast(float, g.w << 16); b[3] *= __builtin_bit_cast(float, g.w & 0xffff0000u);
                    *(u32x4*)(MIX2 + row * 2048 + col) = pack8(a, b); }
                ss += __shfl_xor(ss, 16); ss += __shfl_xor(ss, 32);
                if (fq == 0) atomicAdd(SS + row * 4 + h, ss); }
    }
};

struct SchedSplit {
    const char *A, *Bt; int nN, nP, G, c; size_t lda2, ldb2;
    __device__ __forceinline__ bool next(int i, Unit& u) const { const int L = i * G + c; if (L >= nN * nP) return false; u.pn = L / nP; u.aux = L % nP; u.pm = 0; u.kind = 0; return true; }
    __device__ __forceinline__ const char* a_base(const Unit& u) const { return A + (size_t)u.aux * 512; }
    __device__ __forceinline__ const char* b_base(const Unit& u) const { return Bt + (size_t)u.pn * 256 * ldb2 + (size_t)u.aux * 512; }
    __device__ __forceinline__ void a_ready(const Unit&) const {}
    __device__ __forceinline__ void done(const Unit&) const {}
};
struct EpiSlab {
    static constexpr bool PERM = true, AFTER_DRAIN = false, KHOOK = false;
    bf16_t* slab; int ncols;
    __device__ __forceinline__ void operator()(const f32x4 (&acc)[2][2][4][2], const Unit& u, int wr, int wc, int fr, int fq) const {
        int rb = wr * 64 + fr; asm volatile("" : "+v"(rb));
        bf16_t* base = slab + (size_t)u.aux * 256 * ncols + u.pn * BM + wc * 32 + 8 * fq;
#pragma unroll
        for (int ai = 0; ai < 2; ++ai)
#pragma unroll
            for (int m = 0; m < 4; ++m) { bf16_t* rp = base + (size_t)(rb + ai * HALF + m * 16) * ncols;
#pragma unroll
                for (int bj = 0; bj < 2; ++bj) *(u32x4*)(rp + bj * HALF) = pack8(acc[ai][bj][m][0], acc[ai][bj][m][1]); }
    }
};
struct EpiOut {
    static constexpr bool PERM = false, AFTER_DRAIN = false, KHOOK = true;
    const bf16_t* Y1; float* out; const float* SS;
    __device__ __forceinline__ float rstd(int row, int h) const { return __builtin_amdgcn_rsqf(SS[(size_t)row * 4 + h] * (1.f / 512.f) + 1e-6f); }
    __device__ __forceinline__ void khook(f32x4 (&acc)[2][2][4][2], const Unit& u, int hb, int wr, int fr) const {
        int rb = u.pm * BM + wr * 64 + fr; asm volatile("" : "+v"(rb));
#pragma unroll
        for (int ai = 0; ai < 2; ++ai)
#pragma unroll
            for (int m = 0; m < 4; ++m) { const int row = rb + ai * HALF + m * 16; const float ratio = rstd(row, hb - 1) * __builtin_amdgcn_rcpf(rstd(row, hb));
#pragma unroll
                for (int bj = 0; bj < 2; ++bj)
#pragma unroll
                    for (int n = 0; n < 2; ++n) acc[ai][bj][m][n] = acc[ai][bj][m][n] * ratio; }
    }
    __device__ __forceinline__ void operator()(const f32x4 (&acc)[2][2][4][2], const Unit& u, int wr, int wc, int fr, int fq) const {
        int row0 = u.pm * BM + wr * 64 + fr; asm volatile("" : "+v"(row0));
        const int col0 = u.pn * BM + wc * 32 + 4 * fq;
#pragma unroll
        for (int ai = 0; ai < 2; ++ai)
#pragma unroll
            for (int m = 0; m < 4; ++m) { const int row = row0 + ai * HALF + m * 16; const float r3 = rstd(row, 3);
#pragma unroll
                for (int bj = 0; bj < 2; ++bj)
#pragma unroll
                    for (int n = 0; n < 2; ++n) { const int c = col0 + bj * HALF + n * 16; const unsigned long long yq = *(const unsigned long long*)(Y1 + (size_t)row * 1024 + c);
                        const f32x4 yv = {__builtin_bit_cast(float, (unsigned)yq << 16), __builtin_bit_cast(float, (unsigned)yq & 0xffff0000u), __builtin_bit_cast(float, (unsigned)(yq >> 32) << 16), __builtin_bit_cast(float, (unsigned)(yq >> 32) & 0xffff0000u)};
                        *(f32x4*)(out + (size_t)row * 1024 + c) = acc[ai][bj][m][n] * r3 + yv; } }
    }
};
}
#define GAS __attribute__((address_space(1)))
#define LAS __attribute__((address_space(3)))
typedef unsigned short bf16;
typedef unsigned v4u __attribute__((ext_vector_type(4)));
typedef float f32x4 __attribute__((ext_vector_type(4)));
typedef short bf16x8 __attribute__((ext_vector_type(8)));
typedef GAS unsigned gu32;
typedef GAS unsigned long long gu64;
#define RLX_AGENT __ATOMIC_RELAXED, __HIP_MEMORY_SCOPE_AGENT
#define LDS_WAIT() asm volatile("s_waitcnt lgkmcnt(0)" ::: "memory")
#define VM_WAIT() asm volatile("s_waitcnt vmcnt(0)" ::: "memory")
__device__ __forceinline__ unsigned long long rt() { return __builtin_amdgcn_s_memrealtime(); }
__device__ __forceinline__ unsigned f2bf(float f) { unsigned u = __builtin_bit_cast(unsigned, f); return (u + 0x7fffu + ((u >> 16) & 1u)) >> 16; }
__device__ __forceinline__ unsigned pk2(float lo, float hi) { return f2bf(lo) | (f2bf(hi) << 16); }
#define XB_TMO      128
#define XB_XCNT(j)  (256  + 64 * (j))
#define XB_XSUB(j)  (1280 + 64 * (j))
#define XB_XGEN(j)  (2304 + 64 * (j))
#define XB_TOP      3328
#define XB_TOPGEN   3392
#define XCD_BAR_WORDS 3456
#define XB_SPIN_CAP (1u << 18)

__device__ __forceinline__ unsigned xb_ld(unsigned* p)              { return __hip_atomic_load(p, __ATOMIC_RELAXED, __HIP_MEMORY_SCOPE_AGENT); }
__device__ __forceinline__ unsigned xb_add(unsigned* p, unsigned v) { return __hip_atomic_fetch_add(p, v, __ATOMIC_RELAXED, __HIP_MEMORY_SCOPE_AGENT); }
__device__ __forceinline__ unsigned xb_xcc_id() { return (unsigned)__builtin_amdgcn_s_getreg((3 << 11) | 20) & 0xFu; }
#define XB_SPIN(cond, bar) do { unsigned _sp = 0; while (cond) { __builtin_amdgcn_s_sleep(1); \
    if ((++_sp & 255u) == 0u) { if (xb_ld(&(bar)[XB_TMO])) break; if (_sp > XB_SPIN_CAP) { atomicAdd(&(bar)[XB_TMO], 1u); break; } } } } while (0)

struct XcdBarrier {
    unsigned* bar; unsigned x;
    volatile LAS unsigned* st;
};

__device__ __forceinline__ XcdBarrier xcd_barrier_post(unsigned* bar, volatile LAS unsigned* st) {
    XcdBarrier b; b.bar = bar; b.x = xb_xcc_id(); b.st = st;
    if (threadIdx.x == 0) (void)xb_add(&bar[XB_XCNT(b.x)], 1u);
    return b;
}
__device__ __forceinline__ void xcd_barrier_complete(unsigned* bar, unsigned x, unsigned& nloc, unsigned& nx) {
    const unsigned G = gridDim.x * gridDim.y * gridDim.z;
    unsigned sum, cnt, mine, sp = 0u;
    for (;;) {
        sum = 0u; cnt = 0u; mine = 0u;
#pragma unroll
        for (unsigned j = 0; j < 16; ++j) { const unsigned c = xb_ld(&bar[XB_XCNT(j)]); sum += c; cnt += (c > 0u) ? 1u : 0u; mine = (j == x) ? c : mine; }
        if (sum == G) break;
        __builtin_amdgcn_s_sleep(1);
        if ((++sp & 255u) == 0u) { if (xb_ld(&bar[XB_TMO])) break; if (sp > XB_SPIN_CAP) { atomicAdd(&bar[XB_TMO], 1u); break; } }
    }
    nloc = mine > 0u ? mine : 1u; nx = cnt > 0u ? cnt : 1u;
}

__device__ __forceinline__ void xcd_barrier(const XcdBarrier& b) {
    asm volatile("s_waitcnt vmcnt(0)" ::: "memory");
    __syncthreads();
    if (threadIdx.x == 0) {
        unsigned* bar = b.bar;
        __builtin_amdgcn_s_waitcnt(0);
        unsigned nloc = b.st[0], nx = b.st[1];
        if (nloc == 0u) { xcd_barrier_complete(bar, b.x, nloc, nx); b.st[0] = nloc; b.st[1] = nx; }
        const unsigned old = xb_add(&bar[XB_XSUB(b.x)], 1u);
        const unsigned gen = old / nloc;
        if (old + 1u == (gen + 1u) * nloc) {
            __builtin_amdgcn_fence(__ATOMIC_RELEASE, "agent");
            asm volatile("s_waitcnt vmcnt(0)" ::: "memory");
            const unsigned og = xb_add(&bar[XB_TOP], 1u);
            const unsigned tg = og / nx;
            if (og + 1u == (tg + 1u) * nx) xb_add(&bar[XB_TOPGEN], 1u);
            else XB_SPIN(xb_ld(&bar[XB_TOPGEN]) == tg, bar);
            __builtin_amdgcn_fence(__ATOMIC_ACQUIRE, "agent");
            xb_add(&bar[XB_XGEN(b.x)], 1u);
            asm volatile("s_waitcnt vmcnt(0)" ::: "memory");
        } else {
            XB_SPIN(xb_ld(&bar[XB_XGEN(b.x)]) == gen, bar);
            __builtin_amdgcn_fence(__ATOMIC_ACQUIRE, "agent");
            asm volatile("s_waitcnt vmcnt(0)" ::: "memory");
        }
    }
    __syncthreads();
}
constexpr size_t MiB = 1u << 20;
constexpr size_t WS_CTL = 0, CTL_ZERO_BYTES = 1 * MiB;
constexpr size_t WS_W1T = 2 * MiB;
constexpr size_t WS_W2T = 10 * MiB;
constexpr size_t WS_W3T = 12 * MiB;
constexpr size_t WS_W4T = 24 * MiB;
constexpr size_t WS_RCOS = 28 * MiB, WS_RSIN = 33 * MiB;
constexpr size_t SZ_H = (size_t)MT * 1024 * 2;
constexpr size_t SZ_S = (size_t)MT * 512 * 2;
constexpr size_t WS_H = 40 * MiB;
constexpr size_t WS_QA = WS_H + 33 * MiB, WS_KA = WS_QA + 17 * MiB, WS_VAT = WS_KA + 17 * MiB, WS_GA = WS_VAT + 17 * MiB;
constexpr size_t WS_QB = WS_GA + 17 * MiB, WS_KB = WS_QB + 17 * MiB, WS_VB = WS_KB + 17 * MiB, WS_GB = WS_VB + 17 * MiB;
constexpr size_t WS_LOGF = WS_GB + 17 * MiB;
constexpr size_t WS_OB = WS_LOGF + 33 * MiB;
constexpr size_t WS_MIX = WS_OB + 33 * MiB;
constexpr size_t WS_Y1 = WS_MIX + 33 * MiB;
constexpr size_t WS_QC = WS_Y1 + 65 * MiB, WS_KC = WS_QC + 33 * MiB;
constexpr size_t WS_VC = WS_KC + 33 * MiB, WS_GC = WS_VC + 65 * MiB;
constexpr size_t WS_OC = WS_GC + 65 * MiB;
constexpr size_t WS_MIX2 = WS_OC + 130 * MiB;
constexpr size_t WS_AQ = WS_MIX2 + 65 * MiB;
constexpr size_t WS_KCH = WS_AQ + 64 * MiB;
constexpr size_t WS_KCT = WS_KCH + 32 * MiB;
constexpr size_t WS_BV = WS_KCT + 32 * MiB;
constexpr size_t WS_DST = WS_BV + 128 * MiB;
constexpr size_t WS_RCOST = WS_DST + 128 * MiB, WS_RSINT = WS_RCOST + 5 * MiB;
constexpr size_t WS_DSH = WS_RSINT + 5 * MiB;
constexpr size_t WS_SST = WS_DSH + 16 * MiB;
constexpr size_t WS_DD = WS_SST + 16 * MiB;
constexpr size_t WS_SLAB = WS_DD + 1 * MiB;
constexpr size_t WS_SLAB4 = WS_SLAB + 24 * MiB;
constexpr size_t WS_END = WS_SLAB4 + 8 * MiB;
constexpr size_t CTL_SS = 65536;
constexpr size_t CTL_SS1 = CTL_SS + (size_t)MP * 16;
constexpr size_t CTL_SSS = CTL_SS1 + (size_t)MT * 4;
static_assert(CTL_SSS + 4096 <= CTL_ZERO_BYTES, "SS / SS1 / SSS inside the zeroed region");
static_assert(SZ_H <= 33 * MiB && SZ_S <= 17 * MiB && (size_t)MT * 2048 * 4 <= 130 * MiB, "ws map");

constexpr int CW_TMO = 0, CW_CODE = 1, CW_BAR = 4096;

constexpr int RING_OFF = 0, RING_BYTES = 131072;
constexpr int LDSCTL_OFF = RING_BYTES, MISC_OFF = LDSCTL_OFF + 320;
constexpr int LDS_BYTES = 147456;
constexpr int NWAVES = 8;

typedef float f32x16 __attribute__((ext_vector_type(16)));
__device__ __forceinline__ float bf2f(bf16 b) { return __builtin_bit_cast(float, (unsigned)b << 16); }
__device__ __forceinline__ float bflo(unsigned w) { return __builtin_bit_cast(float, w << 16); }
__device__ __forceinline__ float bfhi(unsigned w) { return __builtin_bit_cast(float, w & 0xffff0000u); }
__device__ __forceinline__ int crow(int r, int hi) { return (r & 3) + 8 * (r >> 2) + 4 * hi; }
__device__ __forceinline__ float wave_sum(float v) {
#pragma unroll
    for (int o = 1; o < 64; o <<= 1) v += __shfl_xor(v, o);
    return v;
}

struct Frame {
    LAS unsigned char* lds;
    volatile LAS unsigned* MISC;
    gu32* ctl;
    int tid, lane, wave, G, bid;
    const float *xp, *xs, *ck, *cv, *st_h, *st_r, *ng, *w1, *w2, *qg, *kg, *sbb, *hlb, *og, *w3, *w4; const int* pt;
    float* out;
    unsigned char* ws;
    __device__ __forceinline__ float* SSS() const { return (float*)(ws + WS_CTL + CTL_SSS); }
    __device__ __forceinline__ float* SS1() const { return (float*)(ws + WS_CTL + CTL_SS1); }
    __device__ __forceinline__ bf16* SLAB() const { return (bf16*)(ws + WS_SLAB); }
    __device__ __forceinline__ bf16* Y1B() const { return (bf16*)(ws + WS_OB); }
    __device__ __forceinline__ bf16* SLAB4() const { return (bf16*)(ws + WS_SLAB4); }
    __device__ __forceinline__ bf16* W1T() const { return (bf16*)(ws + WS_W1T); }
    __device__ __forceinline__ bf16* W2T() const { return (bf16*)(ws + WS_W2T); }
    __device__ __forceinline__ bf16* W3T() const { return (bf16*)(ws + WS_W3T); }
    __device__ __forceinline__ bf16* W4T() const { return (bf16*)(ws + WS_W4T); }
    __device__ __forceinline__ bf16* H() const { return (bf16*)(ws + WS_H); }
    __device__ __forceinline__ bf16* QA() const { return (bf16*)(ws + WS_QA); }
    __device__ __forceinline__ bf16* KA() const { return (bf16*)(ws + WS_KA); }
    __device__ __forceinline__ bf16* VAT() const { return (bf16*)(ws + WS_VAT); }
    __device__ __forceinline__ bf16* VA() const { return (bf16*)(ws + WS_VAT); }
    __device__ __forceinline__ bf16* GA() const { return (bf16*)(ws + WS_GA); }
    __device__ __forceinline__ bf16* QB() const { return (bf16*)(ws + WS_QB); }
    __device__ __forceinline__ bf16* KB() const { return (bf16*)(ws + WS_KB); }
    __device__ __forceinline__ bf16* VB() const { return (bf16*)(ws + WS_VB); }
    __device__ __forceinline__ bf16* GB() const { return (bf16*)(ws + WS_GB); }
    __device__ __forceinline__ bf16* MIX() const { return (bf16*)(ws + WS_MIX); }
    __device__ __forceinline__ bf16* QC() const { return (bf16*)(ws + WS_QC); }
    __device__ __forceinline__ bf16* KC() const { return (bf16*)(ws + WS_KC); }
    __device__ __forceinline__ bf16* VC() const { return (bf16*)(ws + WS_VC); }
    __device__ __forceinline__ bf16* GC() const { return (bf16*)(ws + WS_GC); }
    __device__ __forceinline__ bf16* MIX2() const { return (bf16*)(ws + WS_MIX2); }
    __device__ __forceinline__ float* RCOS() const { return (float*)(ws + WS_RCOS); }
    __device__ __forceinline__ float* RSIN() const { return (float*)(ws + WS_RSIN); }
    __device__ __forceinline__ float* LOGF() const { return (float*)(ws + WS_LOGF); }
    __device__ __forceinline__ float* OB() const { return (float*)(ws + WS_OB); }
    __device__ __forceinline__ float* Y1() const { return (float*)(ws + WS_Y1); }
    __device__ __forceinline__ float* OC() const { return (float*)(ws + WS_OC); }
    __device__ __forceinline__ bf16* AQ() const { return (bf16*)(ws + WS_AQ); }
    __device__ __forceinline__ bf16* KCH() const { return (bf16*)(ws + WS_KCH); }
    __device__ __forceinline__ bf16* KCT() const { return (bf16*)(ws + WS_KCT); }
    __device__ __forceinline__ bf16* BV() const { return (bf16*)(ws + WS_BV); }
    __device__ __forceinline__ float* DST() const { return (float*)(ws + WS_DST); }
    __device__ __forceinline__ float* RCOST() const { return (float*)(ws + WS_RCOST); }
    __device__ __forceinline__ float* RSINT() const { return (float*)(ws + WS_RSINT); }
    __device__ __forceinline__ float* SS() const { return (float*)(ws + WS_CTL + CTL_SS); }
    __device__ __forceinline__ float* DSH() const { return (float*)(ws + WS_DSH); }
    __device__ __forceinline__ float* SST() const { return (float*)(ws + WS_SST); }
    __device__ __forceinline__ float* DD() const { return (float*)(ws + WS_DD); }
};

template <bool HP>
__device__ __forceinline__ void p0_transpose_item(const float* W, int K, int N, bf16* WT, LAS float* scr, int item, int lane, const float* gk = nullptr) {
    const int nblk = N / 32, kb = item / nblk, nb = item % nblk, k0 = 64 * kb, n0 = 32 * nb;
#pragma unroll 8
    for (int i = 0; i < 32; ++i) { const int kk = 2 * i + (lane >> 5); float w = W[(size_t)(k0 + kk) * N + n0 + (lane & 31)]; if (gk) w *= gk[k0 + kk]; scr[kk * 33 + (lane & 31)] = w; }
    LDS_WAIT(); asm volatile("" ::: "memory");
    const int c = lane & 7;
#pragma unroll
    for (int j = 0; j < 4; ++j) { const int n = (lane >> 3) + 8 * j; const LAS float* s = scr + (8 * c) * 33 + n;
        v4u o; o.x = pk2(s[0 * 33], s[1 * 33]); o.y = pk2(s[2 * 33], s[3 * 33]); o.z = pk2(s[4 * 33], s[5 * 33]); o.w = pk2(s[6 * 33], s[7 * 33]);
        int ca = n0 + n;
        if (HP) ca = (ca & ~255) | (((ca >> 5) & 1) << 7) | (((ca >> 6) & 3) << 5) | (ca & 31);
        *(GAS v4u*)(WT + (size_t)ca * K + k0 + 8 * c) = o; }
    LDS_WAIT(); asm volatile("" ::: "memory");
}
__device__ __forceinline__ void rms_row_to_bf16(int lane, const float* xrow, const float* g, bf16* orow) {
    const GAS f32x4* xr = (const GAS f32x4*)xrow + lane;
    f32x4 v[4]; float s2 = 0.f;
#pragma unroll
    for (int j = 0; j < 4; ++j) { v[j] = xr[64 * j]; s2 += (v[j].x * v[j].x + v[j].y * v[j].y) + (v[j].z * v[j].z + v[j].w * v[j].w); }
    const float rstd = 1.f / sqrtf(wave_sum(s2) * (1.f / 1024.f) + EPS);
    GAS unsigned long long* o8 = (GAS unsigned long long*)orow + lane;
#pragma unroll
    for (int j = 0; j < 4; ++j) { const f32x4 gv = *((const GAS f32x4*)g + lane + 64 * j);
        o8[64 * j] = (unsigned long long)pk2(v[j].x * rstd * gv.x, v[j].y * rstd * gv.y) | ((unsigned long long)pk2(v[j].z * rstd * gv.z, v[j].w * rstd * gv.w) << 32); }
}
__device__ __forceinline__ void sincos_acc(float a, float& s, float& c) {
    const double x = (double)a;
    const double kd = __builtin_rint(x * 0.63661977236758134308);
    const double r = (x - kd * 1.57079632673412561417e+00) - kd * 6.07710050650619224932e-11;
    const double r2 = r * r;
    const double sp = r * (1.0 + r2 * (-1.66666666666666324348e-01 + r2 * (8.33333333332248946124e-03 + r2 * (-1.98412698298579493134e-04 + r2 * (2.75573137070700676789e-06 + r2 * (-2.50507602534068634195e-08 + r2 * 1.58969099521155010221e-10))))));
    const double cp = 1.0 + r2 * (-0.5 + r2 * (4.16666666666666019037e-02 + r2 * (-1.38888888888741095749e-03 + r2 * (2.48015872894767294178e-05 + r2 * (-2.75573143513906633035e-07 + r2 * (2.08757232129817482790e-09 + r2 * -1.13596475577881948265e-11))))));
    const int q = (int)((long long)kd & 3);
    const double sv = (q & 1) ? cp : sp, cv = (q & 1) ? sp : cp;
    s = (float)((q & 2) ? -sv : sv);
    c = (float)(((q + 1) & 2) ? -cv : cv);
}
__device__ __forceinline__ void p0_prologue(Frame& F) {
    LAS float* scr = (LAS float*)(F.lds + RING_OFF + F.wave * 16384);
    const int gw = F.bid * NWAVES + F.wave, NGW = F.G * NWAVES;
    constexpr int I1 = (1024 / 64) * (N1 / 32), I2 = (1024 / 64) * (1024 / 32), I3 = (1024 / 64) * (N3 / 32), I4 = (2048 / 64) * (1024 / 32);
    for (int it = gw; it < I1 + I2 + I3 + I4; it += NGW) {
        int r = it;
        if (r < I1) { p0_transpose_item<true>(F.w1, 1024, N1, F.W1T(), scr, r, F.lane); continue; } r -= I1;
        if (r < I2) { p0_transpose_item<false>(F.w2, 1024, 1024, F.W2T(), scr, r, F.lane); continue; } r -= I2;
        if (r < I3) { p0_transpose_item<false>(F.w3, 1024, N3, F.W3T(), scr, r, F.lane, F.ng + 1024); continue; } r -= I3;
        p0_transpose_item<false>(F.w4, 2048, 1024, F.W4T(), scr, r, F.lane);
    }
    {
        f32x4 gv[4], cur[4];
#pragma unroll
        for (int j = 0; j < 4; ++j) gv[j] = *((const GAS f32x4*)F.ng + F.lane + 64 * j);
        int m = gw;
        if (m < MT) { const float* xr = (m < MP) ? F.xp + (size_t)m * DM : F.xs + (size_t)(m - MP) * DM;
#pragma unroll
            for (int j = 0; j < 4; ++j) cur[j] = *((const GAS f32x4*)xr + F.lane + 64 * j); }
        while (m < MT) {
            const int mn = m + NGW; f32x4 nxt[4];
            if (mn < MT) { const float* xr = (mn < MP) ? F.xp + (size_t)mn * DM : F.xs + (size_t)(mn - MP) * DM;
#pragma unroll
                for (int j = 0; j < 4; ++j) nxt[j] = *((const GAS f32x4*)xr + F.lane + 64 * j); }
            float s2 = 0.f;
#pragma unroll
            for (int j = 0; j < 4; ++j) s2 += (cur[j].x * cur[j].x + cur[j].y * cur[j].y) + (cur[j].z * cur[j].z + cur[j].w * cur[j].w);
            const float rstd = 1.f / sqrtf(wave_sum(s2) * (1.f / 1024.f) + EPS);
            GAS unsigned long long* o8 = (GAS unsigned long long*)(F.H() + (size_t)m * DM) + F.lane;
#pragma unroll
            for (int j = 0; j < 4; ++j)
                o8[64 * j] = (unsigned long long)pk2(cur[j].x * rstd * gv[j].x, cur[j].y * rstd * gv[j].y) | ((unsigned long long)pk2(cur[j].z * rstd * gv[j].z, cur[j].w * rstd * gv[j].w) << 32);
#pragma unroll
            for (int j = 0; j < 4; ++j) cur[j] = nxt[j];
            m = mn;
        }
    }
    const int ri = F.tid & 127;
    const float rinv = (float)(1.0 / exp2((double)((float)ri / 127.0f) * 13.287712379549449));
    for (int e = F.bid * (NWAVES * 64) + F.tid; e < (PAST + TSQ) * 128; e += F.G * NWAVES * 64) {
        const int pos = e >> 7, i = ri;
        const float inv = rinv;
        const float ang = (float)pos * inv;
        float s, c; sincos_acc(ang, s, c);
        F.RCOS()[e] = c; F.RSIN()[e] = s;
    }
}

__device__ __forceinline__ void sb_tile(f32x16& p0, f32x16& p1, float& carry, int hi, int kb0, int qpos, bool need_mask, v4u (&pw)[4]) {
#pragma unroll
    for (int r = 0; r < 16; ++r) {
        float b0 = __builtin_amdgcn_rcpf(1.f + __builtin_amdgcn_exp2f(p0[r]));
        float b1 = __builtin_amdgcn_rcpf(1.f + __builtin_amdgcn_exp2f(p1[r]));
        if (need_mask) { if (kb0 + r >= qpos) b0 = 0.f; if (kb0 + 32 + r >= qpos) b1 = 0.f; }
        p0[r] = b0; p1[r] = b1;
    }
    float s0 = 1.f, s1 = 1.f;
#pragma unroll
    for (int r = 15; r >= 0; --r) {
        const float b0 = p0[r], b1 = p1[r];
        p0[r] = b0 * s0; p1[r] = b1 * s1;
        s0 = __builtin_fmaf(-s0, b0, s0); s1 = __builtin_fmaf(-s1, b1, s1);
    }
    float t0, t1;
    {
      auto a = __builtin_amdgcn_permlane32_swap(__float_as_uint(s0), __float_as_uint(s0), false, false);
      auto b = __builtin_amdgcn_permlane32_swap(__float_as_uint(s1), __float_as_uint(s1), false, false);
      t0 = hi ? __uint_as_float(a[0]) : __uint_as_float(a[1]); t1 = hi ? __uint_as_float(b[0]) : __uint_as_float(b[1]); }
    const float pre1 = hi ? carry : carry * t1;
    const float pre0 = hi ? carry * s1 * t1 : carry * t1 * s1 * t0;
    carry = carry * ((s0 * s1) * (t0 * t1));
#pragma unroll
    for (int r = 0; r < 16; ++r) { p0[r] *= pre0; p1[r] *= pre1; }
    pw[0] = (v4u){pg8::cvt_pk_bf16(p0[0], p0[1]), pg8::cvt_pk_bf16(p0[2], p0[3]), pg8::cvt_pk_bf16(p0[4], p0[5]), pg8::cvt_pk_bf16(p0[6], p0[7])};
    pw[1] = (v4u){pg8::cvt_pk_bf16(p0[8], p0[9]), pg8::cvt_pk_bf16(p0[10], p0[11]), pg8::cvt_pk_bf16(p0[12], p0[13]), pg8::cvt_pk_bf16(p0[14], p0[15])};
    pw[2] = (v4u){pg8::cvt_pk_bf16(p1[0], p1[1]), pg8::cvt_pk_bf16(p1[2], p1[3]), pg8::cvt_pk_bf16(p1[4], p1[5]), pg8::cvt_pk_bf16(p1[6], p1[7])};
    pw[3] = (v4u){pg8::cvt_pk_bf16(p1[8], p1[9]), pg8::cvt_pk_bf16(p1[10], p1[11]), pg8::cvt_pk_bf16(p1[12], p1[13]), pg8::cvt_pk_bf16(p1[14], p1[15])};
}
typedef float f32x2v __attribute__((ext_vector_type(2)));
__device__ __forceinline__ void sb_tile2(f32x16& p0, f32x16& p1, float& carry, int hi, int kb0, int qpos, bool need_mask, v4u (&pw)[4]) {
#pragma unroll
    for (int r = 0; r < 16; ++r) { p0[r] = __builtin_amdgcn_exp2f(p0[r]); p1[r] = __builtin_amdgcn_exp2f(p1[r]); }
#define SB_INV4(P, j0) do { const f32x2v ea_ = {P[2 * (j0)], P[2 * (j0) + 1]}, eb_ = {P[2 * (j0) + 2], P[2 * (j0) + 3]}, ec_ = {P[2 * (j0) + 4], P[2 * (j0) + 5]}, ed_ = {P[2 * (j0) + 6], P[2 * (j0) + 7]}; \
        const f32x2v b_ = eb_ + (f32x2v){1.f, 1.f}; const f32x2v ab_ = ea_ * b_ + b_, abc_ = ab_ * ec_ + ab_, abcd_ = abc_ * ed_ + abc_; \
        f32x2v R_ = {__builtin_amdgcn_rcpf(abcd_.x), __builtin_amdgcn_rcpf(abcd_.y)}; \
        const f32x2v id_ = R_ * abc_; R_ = R_ * ed_ + R_; const f32x2v ic_ = R_ * ab_; R_ = R_ * ec_ + R_; const f32x2v ib_ = R_ * ea_ + R_, ia_ = R_ * b_; \
        P[2 * (j0)] = ia_.x; P[2 * (j0) + 1] = ia_.y; P[2 * (j0) + 2] = ib_.x; P[2 * (j0) + 3] = ib_.y; P[2 * (j0) + 4] = ic_.x; P[2 * (j0) + 5] = ic_.y; P[2 * (j0) + 6] = id_.x; P[2 * (j0) + 7] = id_.y; } while (0)
    SB_INV4(p0, 0); SB_INV4(p1, 0); SB_INV4(p0, 4); SB_INV4(p1, 4);
#undef SB_INV4
    if (need_mask) {
        asm volatile("" ::: "memory");
#pragma unroll
        for (int r = 0; r < 16; ++r) { const int kk = kb0 + 8 * (1 - (r & 1)) + (r >> 1); if (kk >= qpos) p0[r] = 0.f; if (kk + 32 >= qpos) p1[r] = 0.f; }
    }
    f32x2v s0 = {1.f, 1.f}, s1 = {1.f, 1.f};
#pragma unroll
    for (int k = 7; k >= 0; --k) {
        const f32x2v b0 = {p0[2 * k], p0[2 * k + 1]}, b1 = {p1[2 * k], p1[2 * k + 1]};
        const f32x2v w0 = b0 * s0, w1 = b1 * s1;
        s0 = s0 - s0 * b0; s1 = s1 - s1 * b1;
        p0[2 * k] = w0.x; p0[2 * k + 1] = w0.y; p1[2 * k] = w1.x; p1[2 * k + 1] = w1.y;
    }
    const float a0 = s0.x * s0.y, a1 = s1.x * s1.y;
    float t0, t1;
    { auto a = __builtin_amdgcn_permlane32_swap(__float_as_uint(a0), __float_as_uint(a0), false, false);
      auto b = __builtin_amdgcn_permlane32_swap(__float_as_uint(a1), __float_as_uint(a1), false, false);
      t0 = hi ? __uint_as_float(a[0]) : __uint_as_float(a[1]); t1 = hi ? __uint_as_float(b[0]) : __uint_as_float(b[1]); }
    const float pre1 = hi ? carry : carry * t1;
    const float pre0 = hi ? carry * a1 * t1 : carry * t1 * a1 * t0;
    carry = carry * ((a0 * a1) * (t0 * t1));
    const f32x2v q0 = {pre0, pre0 * s0.x}, q1 = {pre1, pre1 * s1.x};
#pragma unroll
    for (int k = 0; k < 8; ++k) { const f32x2v w0 = (f32x2v){p0[2 * k], p0[2 * k + 1]} * q0, w1 = (f32x2v){p1[2 * k], p1[2 * k + 1]} * q1;
        p0[2 * k] = w0.x; p0[2 * k + 1] = w0.y; p1[2 * k] = w1.x; p1[2 * k + 1] = w1.y; }
    pw[0] = (v4u){pg8::cvt_pk_bf16(p0[1], p0[3]), pg8::cvt_pk_bf16(p0[5], p0[7]), pg8::cvt_pk_bf16(p0[9], p0[11]), pg8::cvt_pk_bf16(p0[13], p0[15])};
    pw[1] = (v4u){pg8::cvt_pk_bf16(p0[0], p0[2]), pg8::cvt_pk_bf16(p0[4], p0[6]), pg8::cvt_pk_bf16(p0[8], p0[10]), pg8::cvt_pk_bf16(p0[12], p0[14])};
    pw[2] = (v4u){pg8::cvt_pk_bf16(p1[1], p1[3]), pg8::cvt_pk_bf16(p1[5], p1[7]), pg8::cvt_pk_bf16(p1[9], p1[11]), pg8::cvt_pk_bf16(p1[13], p1[15])};
    pw[3] = (v4u){pg8::cvt_pk_bf16(p1[0], p1[2]), pg8::cvt_pk_bf16(p1[4], p1[6]), pg8::cvt_pk_bf16(p1[8], p1[10]), pg8::cvt_pk_bf16(p1[12], p1[14])};
}
#define MFMA32(a, b, c) __builtin_amdgcn_mfma_f32_32x32x16_bf16((a), (b), (c), 0, 0, 0)
__device__ __forceinline__ f32x16 splat16(float v) { f32x16 r;
#pragma unroll
    for (int i = 0; i < 16; ++i) r[i] = v; return r; }

__device__ __forceinline__ bf16x8 cvt8(const f32x4 a, const f32x4 b) { return __builtin_bit_cast(bf16x8, pg8::pack8(a, b)); }

__device__ __forceinline__ void ret_passB(Frame& F) {
    for (int e = F.bid * (NWAVES * 64) + F.tid; e < 8 * 512 * 32; e += F.G * NWAVES * 64) {
        const int bh = e >> 14, dv = (e >> 5) & 511, dk8 = (e & 31) * 8, h = bh & 3;
        const float lg = pg8::lg2gamma(h), g1 = 1.f - __builtin_amdgcn_exp2f(-5.f - (float)h), g255 = __builtin_amdgcn_exp2f(255.f * lg), g256 = __builtin_amdgcn_exp2f(256.f * lg);
        f32x4 S0 = {0.f, 0.f, 0.f, 0.f}, S1 = {0.f, 0.f, 0.f, 0.f};
        for (int c0 = 0; c0 < 32; c0 += 16) {
            v4u dq[16];
#pragma unroll
            for (int j = 0; j < 16; ++j) dq[j] = *(const v4u*)((const bf16*)F.DST() + ((size_t)(bh * 32 + c0 + j) * 512 + dv) * 256 + dk8);
#pragma unroll
            for (int j = 0; j < 16; ++j) { const size_t ro = (size_t)(bh * 32 + c0 + j) * 512 + dv;
                const f32x4 d0 = {bflo(dq[j][0]), bfhi(dq[j][0]), bflo(dq[j][1]), bfhi(dq[j][1])}, d1 = {bflo(dq[j][2]), bfhi(dq[j][2]), bflo(dq[j][3]), bfhi(dq[j][3])};
                *(pg8::u32x4*)(F.BV() + ro * 512 + 256 + dk8) = pg8::pack8(S0 * g1, S1 * g1);
                S0 = S0 * g256 + d0 * g255; S1 = S1 * g256 + d1 * g255; }
        }
        float* so = F.out + ORT_P + ((size_t)bh * 256 + dk8) * 512 + dv;
#pragma unroll
        for (int i = 0; i < 4; ++i) { so[(size_t)i * 512] = S0[i]; so[(size_t)(i + 4) * 512] = S1[i]; }
    }
}

typedef unsigned u32x2 __attribute__((ext_vector_type(2)));
constexpr int HQ_STR = 136, HT_STR = 72;
constexpr int H_QT = 0, H_KH = 17408, H_KHT = 34816, H_VT = 53248, H_PP = 71680, H_CS = 80896, H_RR = 82944, H_A63 = 83456, H_C63 = 83968, H_SSQ = 84480;
#define MFMA16(a, b, c) __builtin_amdgcn_mfma_f32_16x16x32_bf16((a), (b), (c), 0, 0, 0)
__device__ __forceinline__ void hgrn_passB(Frame& F) {
    const int vb = (F.bid + F.G / 2) % F.G;
    for (int e = vb * (NWAVES * 64) + F.tid; e < 8 * 128 * 32; e += F.G * NWAVES * 64) {
        const int bh = e >> 12, dk = (e >> 5) & 127, dv4 = (e & 31) * 4;
        f32x4 S = {0.f, 0.f, 0.f, 0.f};
        for (int s0 = 0; s0 < 32; s0 += 16) {
            f32x4 dv[16]; float dd[16];
#pragma unroll
            for (int j = 0; j < 16; ++j) { dv[j] = *(const f32x4*)(F.DSH() + ((size_t)(bh * 32 + s0 + j) * 128 + dk) * 128 + dv4); dd[j] = F.DD()[(size_t)(bh * 32 + s0 + j) * 128 + dk]; }
#pragma unroll
            for (int j = 0; j < 16; ++j) { *(f32x4*)(F.SST() + ((size_t)(bh * 32 + s0 + j) * 128 + dk) * 128 + dv4) = S; S = S * __expf(dd[j]) + dv[j]; }
        }
        *(f32x4*)(F.out + OHG_P + ((size_t)bh * 128 + dk) * 128 + dv4) = S;
    }
}

__device__ __forceinline__ void ret_sample_unit(Frame& F, int s, int h, int vhalf) {
    const int tid = F.tid, v = tid & 255, kh = tid >> 8, col = vhalf * 256 + v;
    LAS float* QL = (LAS float*)(F.lds + RING_OFF);
    LAS float* KL = QL + 8 * 256;
    LAS float* OP = KL + 8 * 256;
    const size_t row0 = (size_t)MP + s * 8;
    for (int e = tid; e < 8 * 256; e += NWAVES * 64) { const int t = e >> 8, kk = e & 255;
        QL[e] = bf2f(F.QC()[(row0 + t) * 1024 + h * 256 + kk]); KL[e] = bf2f(F.KC()[(row0 + t) * 1024 + h * 256 + kk]); }
    float vt[8];
#pragma unroll
    for (int t = 0; t < 8; ++t) vt[t] = bf2f(F.VC()[(row0 + t) * 2048 + h * 512 + col]);
    const float gamma = 1.f - __builtin_amdgcn_exp2f(-5.f - (float)h);
    float S[128];
    const float* s0 = F.st_r + (((size_t)s * HC + h) * DKC + kh * 128) * DVC + col;
#pragma unroll
    for (int i = 0; i < 128; ++i) S[i] = s0[(size_t)i * DVC];
    __syncthreads();
    float o[8];
#pragma unroll
    for (int t = 0; t < 8; ++t) {
        float acc = 0.f;
#pragma unroll
        for (int i4 = 0; i4 < 32; ++i4) {
            const f32x4 kq = *(const LAS f32x4*)(KL + t * 256 + kh * 128 + 4 * i4), qq = *(const LAS f32x4*)(QL + t * 256 + kh * 128 + 4 * i4);
#pragma unroll
            for (int j = 0; j < 4; ++j) { S[4 * i4 + j] = gamma * S[4 * i4 + j] + kq[j] * vt[t]; acc += qq[j] * S[4 * i4 + j]; }
        }
        o[t] = acc;
    }
#pragma unroll
    for (int t = 0; t < 8; ++t) OP[(kh * 8 + t) * 256 + v] = o[t];
    float* so = F.out + ORT_S + (((size_t)s * HC + h) * DKC + kh * 128) * DVC + col;
#pragma unroll
    for (int i = 0; i < 128; ++i) so[(size_t)i * DVC] = S[i];
    __syncthreads();
    for (int e = tid; e < 8 * 256; e += NWAVES * 64) {
        const int t = e >> 8, vv = e & 255; const float ov = OP[e] + OP[8 * 256 + e];
        const size_t gi = (row0 + t) * 2048 + h * 512 + vhalf * 256 + vv;
        F.MIX2()[gi] = pg8::bf1(ov * bf2f(F.GC()[gi]));
        const float sq = wave_sum(ov * ov);
        if (F.lane == 0) atomicAdd(F.SSS() + (s * 8 + t) * 4 + h, sq);
    }
    __syncthreads();
}
__device__ __forceinline__ void hgrn_sample_unit(Frame& F, int s, int h) {
    const int tid = F.tid, v = tid & 127, kq = tid >> 7;
    LAS float* FL = (LAS float*)(F.lds + RING_OFF);
    LAS float* KL = FL + 8 * 128; LAS float* QL = KL + 8 * 128; LAS float* OP = QL + 8 * 128;
    const size_t row0 = (size_t)MP + s * 8;
    for (int e = tid; e < 8 * 128; e += NWAVES * 64) { const int t = e >> 7, kk = e & 127; const size_t gi = (row0 + t) * 512 + h * 128 + kk;
        FL[e] = __expf(F.LOGF()[gi]); KL[e] = bf2f(F.KB()[gi]); QL[e] = bf2f(F.QB()[gi]); }
    float vt[8];
#pragma unroll
    for (int t = 0; t < 8; ++t) vt[t] = bf2f(F.VB()[(row0 + t) * 512 + h * 128 + v]);
    float S[32];
    const float* s0 = F.st_h + (((size_t)s * HB + h) * DKB + kq * 32) * DVB + v;
#pragma unroll
    for (int i = 0; i < 32; ++i) S[i] = s0[(size_t)i * DVB];
    __syncthreads();
#pragma unroll
    for (int t = 0; t < 8; ++t) {
        float acc = 0.f;
#pragma unroll
        for (int i4 = 0; i4 < 8; ++i4) {
            const f32x4 ff = *(const LAS f32x4*)(FL + t * 128 + kq * 32 + 4 * i4), kk = *(const LAS f32x4*)(KL + t * 128 + kq * 32 + 4 * i4), qq = *(const LAS f32x4*)(QL + t * 128 + kq * 32 + 4 * i4);
#pragma unroll
            for (int j = 0; j < 4; ++j) { S[4 * i4 + j] = ff[j] * S[4 * i4 + j] + kk[j] * vt[t]; acc += qq[j] * S[4 * i4 + j]; }
        }
        OP[(kq * 8 + t) * 128 + v] = acc;
    }
    float* so = F.out + OHG_S + (((size_t)s * HB + h) * DKB + kq * 32) * DVB + v;
#pragma unroll
    for (int i = 0; i < 32; ++i) so[(size_t)i * DVB] = S[i];
    __syncthreads();
    {
        const int t = F.wave, c0 = 2 * F.lane;
        float a = 0.f, b = 0.f;
#pragma unroll
        for (int q4 = 0; q4 < 4; ++q4) { a += OP[(q4 * 8 + t) * 128 + c0]; b += OP[(q4 * 8 + t) * 128 + c0 + 1]; }
        const float rstd = 1.f / sqrtf(wave_sum(a * a + b * b) * (1.f / 128.f) + EPS);
        const size_t row = row0 + t;
        const unsigned gt = *(const unsigned*)(F.GB() + row * 512 + h * 128 + c0);
        *(unsigned*)(F.MIX() + row * 1024 + 512 + h * 128 + c0) = pg8::cvt_pk_bf16(a * rstd * F.og[c0] * bflo(gt), b * rstd * F.og[c0 + 1] * bfhi(gt));
    }
    __syncthreads();
}

constexpr int AT_K = 0, AT_V = 24576, AT_O = 49152, AT_SLOT = 8192;
__device__ __forceinline__ void glds16(const void* gsrc, unsigned lds_dst) { unsigned keep;
    asm volatile("s_mov_b32 %0, m0\n\ts_mov_b32 m0, %2\n\ts_nop 0\n\tglobal_load_lds_dwordx4 %1, off\n\ts_mov_b32 m0, %0" : "=&s"(keep) : "v"(gsrc), "s"(lds_dst) : "memory"); }
typedef short v4i16_t __attribute__((ext_vector_type(4)));
__device__ __forceinline__ v4i16_t vtr(const LAS unsigned char* p) { return __builtin_amdgcn_ds_read_tr16_b64_v4i16((LAS v4i16_t*)p); }

__device__ __forceinline__ void bf8_add(const bf16* p, f32x4& a, f32x4& b) { const v4u w = *(const v4u*)p; a[0] += bflo(w[0]); a[1] += bfhi(w[0]); a[2] += bflo(w[1]); a[3] += bfhi(w[1]); b[0] += bflo(w[2]); b[1] += bfhi(w[2]); b[2] += bflo(w[3]); b[3] += bfhi(w[3]); }
__device__ __forceinline__ void slab_sum8(const bf16* slab, int nparts, size_t pstride, size_t off, f32x4& a, f32x4& b) {
    a = (f32x4){0.f, 0.f, 0.f, 0.f}; b = a;
    for (int p = 0; p < nparts; ++p) bf8_add(slab + p * pstride + off, a, b);
}
__device__ __forceinline__ void pp1_item(Frame& F, int item) {
    const int r = item >> 3, gi = item & 7, lane = F.lane, c = lane * 8, a0 = gi * 512 + c;
    const int g0 = (a0 & ~255) | (((a0 >> 5) & 1) << 7) | (((a0 >> 6) & 3) << 5) | (a0 & 31);
    f32x4 x, y; slab_sum8(F.SLAB(), 4, (size_t)256 * N1, (size_t)r * N1 + g0, x, y);
    const size_t row = (size_t)MP + r;
    if (gi <= 1) {
        float ss = (x[0] * x[0] + x[1] * x[1]) + (x[2] * x[2] + x[3] * x[3]) + (y[0] * y[0] + y[1] * y[1]) + (y[2] * y[2] + y[3] * y[3]);
        ss += __shfl_xor(ss, 1); ss += __shfl_xor(ss, 2); ss += __shfl_xor(ss, 4);
        const float rstd = __builtin_amdgcn_rsqf(ss * (1.f / 64.f) + EPS) * (gi == 0 ? -0.125f * LOG2E : 1.f);
        const float* g = (gi == 0 ? F.qg : F.kg) + (c & 63);
        x = x * *(const f32x4*)g * rstd; y = y * *(const f32x4*)(g + 4) * rstd;
        if (gi == 0) *(pg8::u32x4*)(F.QA() + row * 512 + c) = pg8::pack8(x, y);
        else { *(pg8::u32x4*)(F.KA() + row * 512 + c) = pg8::pack8(x, y); float* ko = F.out + OK_S + (size_t)r * 512 + c; *(f32x4*)ko = x; *(f32x4*)(ko + 4) = y; }
    } else if (gi == 2) {
        *(pg8::u32x4*)(F.VA() + row * 512 + c) = pg8::pack8(x, y); float* vo = F.out + OV_S + (size_t)r * 512 + c; *(f32x4*)vo = x; *(f32x4*)(vo + 4) = y;
    } else if (gi == 5) {
        f32x4 lf0, lf1, k0, k1;
#pragma unroll
        for (int e = 0; e < 8; ++e) { const int cc = c + e; const float lb = __builtin_amdgcn_rcpf(1.f + __expf(F.hlb[512 + cc] - F.hlb[cc])); const float v = e < 4 ? x[e & 3] : y[e & 3];
            const float sg = pg8::sigm_f(v); const float lf = __logf(lb + (1.f - lb) * sg), kk = (1.f - lb) * (1.f - sg);
            if (e < 4) { lf0[e & 3] = lf; k0[e & 3] = kk; } else { lf1[e & 3] = lf; k1[e & 3] = kk; } }
        *(f32x4*)(F.LOGF() + row * 512 + c) = lf0; *(f32x4*)(F.LOGF() + row * 512 + c + 4) = lf1;
        *(pg8::u32x4*)(F.KB() + row * 512 + c) = pg8::pack8(k0, k1);
    } else {
        bf16* dst = (gi == 3) ? F.GA() : (gi == 4) ? F.QB() : (gi == 6) ? F.VB() : F.GB();
        if (gi != 6) {
#pragma unroll
            for (int e = 0; e < 4; ++e) { x[e] = pg8::silu_f(x[e]); y[e] = pg8::silu_f(y[e]); } }
        *(pg8::u32x4*)(dst + row * 512 + c) = pg8::pack8(x, y);
    }
}
__device__ __forceinline__ void pp2_row(Frame& F, int r) {
    const int lane = F.lane; f32x4 v[4]; float s2 = 0.f;
#pragma unroll
    for (int j = 0; j < 2; ++j) { const int c = 8 * lane + 512 * j; f32x4 a, b2; slab_sum8(F.SLAB(), 4, (size_t)256 * 1024, (size_t)r * 1024 + c, a, b2);
        a += *(const f32x4*)(F.xs + (size_t)r * DM + c); b2 += *(const f32x4*)(F.xs + (size_t)r * DM + c + 4);
        *(f32x4*)(F.Y1() + ((size_t)MP + r) * DM + c) = a; *(f32x4*)(F.Y1() + ((size_t)MP + r) * DM + c + 4) = b2;
        s2 += (a[0] * a[0] + a[1] * a[1]) + (a[2] * a[2] + a[3] * a[3]) + (b2[0] * b2[0] + b2[1] * b2[1]) + (b2[2] * b2[2] + b2[3] * b2[3]);
        v[2 * j] = a; v[2 * j + 1] = b2; }
    s2 = wave_sum(s2); if (lane == 0) F.SS1()[MP + r] = s2;
#pragma unroll
    for (int j = 0; j < 2; ++j) { const int c = 8 * lane + 512 * j;
        *(pg8::u32x4*)(F.H() + ((size_t)MP + r) * DM + c) = pg8::pack8(v[2 * j], v[2 * j + 1]); }
}
__device__ __forceinline__ void pp3_item(Frame& F, int item) {
    const int r = item / 24, pn = item % 24, lane = F.lane; const size_t row = (size_t)MP + r;
    if (lane >= 32) return;
    const size_t off = (size_t)r * N3 + pn * 256, ps = (size_t)256 * N3;
    const float rs = __builtin_amdgcn_rsqf(F.SS1()[MP + r] * (1.f / 1024.f) + EPS);
    if (pn < 8) {
        const int j = 8 * (lane & 15), up = lane >> 4;
        f32x4 x1a, x1b, x2a, x2b; slab_sum8(F.SLAB(), 4, ps, off + j, x1a, x1b); slab_sum8(F.SLAB(), 4, ps, off + 128 + j, x2a, x2b);
        const int pos = PAST + (r & 7);
        const f32x4 ca = *(const f32x4*)(F.RCOS() + (size_t)pos * 128 + j), cb = *(const f32x4*)(F.RCOS() + (size_t)pos * 128 + j + 4), sa = *(const f32x4*)(F.RSIN() + (size_t)pos * 128 + j), sb = *(const f32x4*)(F.RSIN() + (size_t)pos * 128 + j + 4);
        const float sc = rs * (pn < 4 ? 1.f : 0.0625f);
        const f32x4 oa = (up ? (x2a * ca + x1a * sa) : (x1a * ca - x2a * sa)) * sc, ob = (up ? (x2b * cb + x1b * sb) : (x1b * cb - x2b * sb)) * sc;
        *(pg8::u32x4*)((pn < 4 ? F.QC() : F.KC()) + row * 1024 + (pn & 3) * 256 + up * 128 + j) = pg8::pack8(oa, ob);
    } else {
        const int j = 8 * lane; f32x4 xa, xb; slab_sum8(F.SLAB(), 4, ps, off + j, xa, xb);
        xa = xa * rs; xb = xb * rs;
        const bool isg = pn >= 16;
        if (isg) {
#pragma unroll
            for (int e = 0; e < 4; ++e) { xa[e] = pg8::silu_f(xa[e]); xb[e] = pg8::silu_f(xb[e]); } }
        *(pg8::u32x4*)((isg ? F.GC() : F.VC()) + row * 2048 + ((pn - 8) & 7) * 256 + j) = pg8::pack8(xa, xb);
    }
}
__device__ __forceinline__ void pp4_row(Frame& F, int r) {
    float rs[4];
#pragma unroll
    for (int hh = 0; hh < 4; ++hh) rs[hh] = __builtin_amdgcn_rsqf(F.SSS()[r * 4 + hh] * (1.f / 512.f) + EPS);
#pragma unroll
    for (int j = 0; j < 2; ++j) { const int c = 8 * F.lane + 512 * j;
        f32x4 a = *(const f32x4*)(F.Y1() + ((size_t)MP + r) * DM + c), b2 = *(const f32x4*)(F.Y1() + ((size_t)MP + r) * DM + c + 4);
#pragma unroll
        for (int p = 0; p < 8; ++p) { f32x4 pa = {0.f, 0.f, 0.f, 0.f}, pb = pa; bf8_add(F.SLAB4() + ((size_t)p * 256 + r) * 1024 + c, pa, pb); a += pa * rs[p >> 1]; b2 += pb * rs[p >> 1]; }
        *(f32x4*)(F.out + OY_S + (size_t)r * DM + c) = a; *(f32x4*)(F.out + OY_S + (size_t)r * DM + c + 4) = b2; }
}

constexpr int G_QT = 0, G_KH = 17408, G_VV = 34816, G_PP = 52224, G_CS = 61440, G_RR = 69632, G_A63 = 70144, G_C63 = 70656, G_OST = 73728, OST_STR = 132;
__device__ __forceinline__ bf16x8 tr8(const LAS unsigned char* p, int rowbytes4) { const v4i16_t a = vtr(p), b = vtr(p + rowbytes4); return (bf16x8){a[0], a[1], a[2], a[3], b[0], b[1], b[2], b[3]}; }
#define LDS_BAR() asm volatile("s_waitcnt lgkmcnt(0)\n\ts_barrier" ::: "memory")
template <bool OUT>
__device__ __forceinline__ void hgrn_chunk_unit2(Frame& F, int bh, int sc) {
    const int tid = F.tid, lane = F.lane, w = F.wave, l15 = lane & 15, g = lane >> 4;
    const int b = bh >> 2, h = bh & 3, cg = tid & 31, tq = tid >> 5;
    LAS unsigned char* L = F.lds + RING_OFF;
    LAS bf16* QT = (LAS bf16*)(L + G_QT); LAS bf16* KH = (LAS bf16*)(L + G_KH); LAS bf16* VV = (LAS bf16*)(L + G_VV); LAS bf16* PP = (LAS bf16*)(L + G_PP);
    LAS float* CS = (LAS float*)(L + G_CS); LAS float* RR = (LAS float*)(L + G_RR); LAS float* A63 = (LAS float*)(L + G_A63); LAS float* C63 = (LAS float*)(L + G_C63); LAS float* OST = (LAS float*)(L + G_OST);
    f32x4 S[8];
    unsigned sbase = (unsigned)(((bh * 32 + sc) * 128 + 4 * g) * 128 + 16 * w + l15);
    asm volatile("" : "+v"(sbase));
#pragma unroll
    for (int i = 0; i < 8; ++i)
#pragma unroll
        for (int r = 0; r < 4; ++r) S[i][r] = OUT ? F.SST()[sbase + (unsigned)(16 * i + r) * 128u] : 0.f;
    f32x4 dsum = {0.f, 0.f, 0.f, 0.f};
    f32x4 lf[4]; u32x2 kq[4], qq[4], vq[4];
    unsigned e0 = (unsigned)((b * TP + sc * 256 + 4 * tq) * 512 + h * 128 + 4 * cg);
#define HG_LOAD(ch_) do { unsigned ee = e0 + (unsigned)(ch_) * 64u * 512u; asm volatile("" : "+v"(ee)); \
        _Pragma("unroll") for (int i = 0; i < 4; ++i) { lf[i] = *(const f32x4*)(F.LOGF() + ee + (unsigned)i * 512u); kq[i] = *(const u32x2*)(F.KB() + ee + (unsigned)i * 512u); \
            vq[i] = *(const u32x2*)(F.VB() + ee + (unsigned)i * 512u); if (OUT) qq[i] = *(const u32x2*)(F.QB() + ee + (unsigned)i * 512u); } } while (0)
    HG_LOAD(0);
    const LAS unsigned char* trK = (const LAS unsigned char*)KH + ((8 * g + (l15 >> 2)) * HQ_STR + (l15 & 3) * 4) * 2;
    const LAS unsigned char* trV = (const LAS unsigned char*)VV + ((8 * g + (l15 >> 2)) * HQ_STR + 16 * w + (l15 & 3) * 4) * 2;
    for (int ch = 0; ch < 4; ++ch) {
        f32x4 c[4]; c[0] = lf[0]; c[1] = c[0] + lf[1]; c[2] = c[1] + lf[2]; c[3] = c[2] + lf[3];
        *(LAS f32x4*)(CS + tq * 128 + 4 * cg) = c[3];
        LDS_BAR();
        f32x4 off = {0.f, 0.f, 0.f, 0.f}, run = {0.f, 0.f, 0.f, 0.f}, r = {0.f, 0.f, 0.f, 0.f};
#pragma unroll
        for (int q = 0; q < 16; ++q) { const f32x4 v = *(const LAS f32x4*)(CS + q * 128 + 4 * cg); if (q == 8) r = run; if (q < tq) off += v; run += v; }
        const f32x4 b63 = run;
#pragma unroll
        for (int i = 0; i < 4; ++i) {
            const int t = 4 * tq + i; const f32x4 bt = off + c[i];
            f32x4 kf = {bflo(kq[i].x), bfhi(kq[i].x), bflo(kq[i].y), bfhi(kq[i].y)};
#pragma unroll
            for (int e = 0; e < 4; ++e) kf[e] *= __expf(r[e] - bt[e]);
            *(LAS u32x2*)(KH + t * HQ_STR + 4 * cg) = (u32x2){pg8::cvt_pk_bf16(kf[0], kf[1]), pg8::cvt_pk_bf16(kf[2], kf[3])};
            *(LAS u32x2*)(VV + t * HQ_STR + 4 * cg) = vq[i];
            if (OUT) { f32x4 qf = {bflo(qq[i].x), bfhi(qq[i].x), bflo(qq[i].y), bfhi(qq[i].y)};
#pragma unroll
                for (int e = 0; e < 4; ++e) qf[e] *= __expf(bt[e] - r[e]);
                *(LAS u32x2*)(QT + t * HQ_STR + 4 * cg) = (u32x2){pg8::cvt_pk_bf16(qf[0], qf[1]), pg8::cvt_pk_bf16(qf[2], qf[3])}; }
        }
        if (tq == 0) { f32x4 er, ea, ec;
#pragma unroll
            for (int e = 0; e < 4; ++e) { er[e] = __expf(r[e]); ea[e] = __expf(b63[e]); ec[e] = __expf(b63[e] - r[e]); }
            *(LAS f32x4*)(RR + 4 * cg) = er; *(LAS f32x4*)(A63 + 4 * cg) = ea; *(LAS f32x4*)(C63 + 4 * cg) = ec; dsum += b63; }
        if (ch < 3) HG_LOAD(ch + 1);
        v4u gq0, gq1; unsigned rowe = 0;
        if (OUT) { rowe = (unsigned)(b * TP + sc * 256 + ch * 64 + (tid >> 3)); asm volatile("" : "+v"(rowe));
            gq0 = *(const v4u*)(F.GB() + rowe * 512u + h * 128 + (tid & 7) * 16); gq1 = *(const v4u*)(F.GB() + rowe * 512u + h * 128 + (tid & 7) * 16 + 8); }
        LDS_BAR();
        f32x4 o[4];
        bf16x8 vf[2];
#pragma unroll
        for (int kk = 0; kk < 2; ++kk) vf[kk] = tr8(trV + (32 * kk) * HQ_STR * 2, 4 * HQ_STR * 2);
        if (OUT) {
#pragma unroll
            for (int tt = 0; tt < 2; ++tt) {
                const int tile = 2 * w + tt, ti = tile >> 2, si = tile & 3;
                f32x4 p = {0.f, 0.f, 0.f, 0.f};
#pragma unroll
                for (int kk = 0; kk < 4; ++kk) {
                    const bf16x8 a = *(const LAS bf16x8*)(QT + (16 * ti + l15) * HQ_STR + 32 * kk + 8 * g), bb = *(const LAS bf16x8*)(KH + (16 * si + l15) * HQ_STR + 32 * kk + 8 * g);
                    p = MFMA16(a, bb, p);
                }
#pragma unroll
                for (int rr = 0; rr < 4; ++rr) { const int tl = 16 * ti + 4 * g + rr, sl = 16 * si + l15; PP[tl * HT_STR + sl] = pg8::bf1(sl <= tl ? p[rr] : 0.f); }
            }
            LDS_BAR();
#pragma unroll
            for (int ti = 0; ti < 4; ++ti) { o[ti] = (f32x4){0.f, 0.f, 0.f, 0.f};
#pragma unroll
                for (int kk = 0; kk < 2; ++kk) { const bf16x8 a = *(const LAS bf16x8*)(PP + (16 * ti + l15) * HT_STR + 32 * kk + 8 * g); o[ti] = MFMA16(a, vf[kk], o[ti]); } }
#pragma unroll
            for (int kk = 0; kk < 4; ++kk) {
                const f32x4 r0 = *(const LAS f32x4*)(RR + 32 * kk + 4 * g), r1 = *(const LAS f32x4*)(RR + 32 * kk + 16 + 4 * g);
                const bf16x8 sb = __builtin_bit_cast(bf16x8, pg8::pack8(S[2 * kk] * r0, S[2 * kk + 1] * r1));
#pragma unroll
                for (int ti = 0; ti < 4; ++ti) {
                    const u32x2 a0 = *(const LAS u32x2*)(QT + (16 * ti + l15) * HQ_STR + 32 * kk + 4 * g), a1 = *(const LAS u32x2*)(QT + (16 * ti + l15) * HQ_STR + 32 * kk + 16 + 4 * g);
                    const v4u av = {a0.x, a0.y, a1.x, a1.y};
                    o[ti] = MFMA16(__builtin_bit_cast(bf16x8, av), sb, o[ti]);
                }
            }
        }
#pragma unroll
        for (int i = 0; i < 8; ++i) {
            f32x4 U = {0.f, 0.f, 0.f, 0.f};
#pragma unroll
            for (int kk = 0; kk < 2; ++kk) { const bf16x8 a = tr8(trK + ((32 * kk) * HQ_STR + 16 * i) * 2, 4 * HQ_STR * 2); U = MFMA16(a, vf[kk], U); }
            const f32x4 a63 = *(const LAS f32x4*)(A63 + 16 * i + 4 * g), c63 = *(const LAS f32x4*)(C63 + 16 * i + 4 * g);
            S[i] = a63 * S[i] + c63 * U;
        }
        if (OUT) {
#pragma unroll
            for (int ti = 0; ti < 4; ++ti)
#pragma unroll
                for (int rr = 0; rr < 4; ++rr) OST[(16 * ti + 4 * g + rr) * OST_STR + 16 * w + l15] = o[ti][rr];
            LDS_BAR();
            const int t = tid >> 3, c16 = (tid & 7) * 16;
            f32x4 x[4]; float sq = 0.f;
#pragma unroll
            for (int j = 0; j < 4; ++j) { x[j] = *(const LAS f32x4*)(OST + t * OST_STR + c16 + 4 * j); sq += (x[j][0] * x[j][0] + x[j][1] * x[j][1]) + (x[j][2] * x[j][2] + x[j][3] * x[j][3]); }
            sq += __shfl_xor(sq, 1); sq += __shfl_xor(sq, 2); sq += __shfl_xor(sq, 4);
            const float rstd = __builtin_amdgcn_rsqf(sq * (1.f / 128.f) + EPS);
            const v4u g0 = gq0, g1 = gq1;
#pragma unroll
            for (int j = 0; j < 4; ++j) { const f32x4 gn = *(const f32x4*)(F.og + c16 + 4 * j); x[j] = x[j] * gn * rstd; }
            x[0][0] *= bflo(g0[0]); x[0][1] *= bfhi(g0[0]); x[0][2] *= bflo(g0[1]); x[0][3] *= bfhi(g0[1]); x[1][0] *= bflo(g0[2]); x[1][1] *= bfhi(g0[2]); x[1][2] *= bflo(g0[3]); x[1][3] *= bfhi(g0[3]);
            x[2][0] *= bflo(g1[0]); x[2][1] *= bfhi(g1[0]); x[2][2] *= bflo(g1[1]); x[2][3] *= bfhi(g1[1]); x[3][0] *= bflo(g1[2]); x[3][1] *= bfhi(g1[2]); x[3][2] *= bflo(g1[3]); x[3][3] *= bfhi(g1[3]);
            *(pg8::u32x4*)(F.MIX() + rowe * 1024u + 512u + h * 128 + c16) = pg8::pack8(x[0], x[1]);
            *(pg8::u32x4*)(F.MIX() + rowe * 1024u + 512u + h * 128 + c16 + 8) = pg8::pack8(x[2], x[3]);
        }
    }
#undef HG_LOAD
    if (!OUT) {
#pragma unroll
        for (int i = 0; i < 8; ++i)
#pragma unroll
            for (int r = 0; r < 4; ++r) F.DSH()[sbase + (unsigned)(16 * i + r) * 128u] = S[i][r];
        if (tq == 0) *(f32x4*)(F.DD() + (size_t)(bh * 32 + sc) * 128 + 4 * cg) = dsum;
    }
    __syncthreads();
}

typedef short s16x4 __attribute__((ext_vector_type(4)));

struct DecStage2 { f32x4 k[4]; f32x4 v[4]; };
constexpr int DW_T = 107008;
struct DecW { DecStage2 S; f32x4 o[4]; float carry; bf16x8 qb[2]; int i, last, w, s, h, pagev; LAS unsigned char* tb; u32x2 wpk; bool pend; };
__device__ __forceinline__ void decw_load(Frame& F, DecW& D, int l15, int g) {
    const int kb = 1024 * D.w + 1024 - 16 * D.i;
    const int page = __builtin_amdgcn_readlane(D.pagev, (kb >> 7) & 7);
    const unsigned sbase = (unsigned)__builtin_amdgcn_readfirstlane((int)((((unsigned)page * PAGE + (unsigned)(kb & 127)) * 512u + (unsigned)(D.h * 64)) * 4u));
    const __amdgpu_buffer_rsrc_t rk = __builtin_amdgcn_make_buffer_rsrc((void*)F.ck, 0, 0x7fffffff, 0x00020000), rv = __builtin_amdgcn_make_buffer_rsrc((void*)F.cv, 0, 0x7fffffff, 0x00020000);
    int vk = l15 * 2048 + 32 * g; asm volatile("" : "+v"(vk)); const int vv = vk - 16 * g;
#pragma unroll
    for (int ks = 0; ks < 2; ++ks) { D.S.k[2 * ks] = __builtin_bit_cast(f32x4, __builtin_amdgcn_raw_buffer_load_b128(rk, vk + 128 * ks, sbase, 0)); D.S.k[2 * ks + 1] = __builtin_bit_cast(f32x4, __builtin_amdgcn_raw_buffer_load_b128(rk, vk + 128 * ks + 16, sbase, 0)); }
#pragma unroll
    for (int j = 0; j < 4; ++j) D.S.v[j] = __builtin_bit_cast(f32x4, __builtin_amdgcn_raw_buffer_load_b128(rv, vv + 64 * j, sbase, 0));
}
__device__ __forceinline__ void decw_procA(DecW& D, bool newk, float cinit, int l15, int g) {
    f32x4 p = {cinit, cinit, cinit, cinit};
    p = MFMA16(cvt8(D.S.k[0], D.S.k[1]), D.qb[0], p); p = MFMA16(cvt8(D.S.k[2], D.S.k[3]), D.qb[1], p);
    float bt[4];
#pragma unroll
    for (int r = 0; r < 4; ++r) { bt[r] = __builtin_amdgcn_rcpf(1.f + __builtin_amdgcn_exp2f(p[r])); if (newk && (4 * g + r >= l15 || 4 * g + r >= 8)) bt[r] = 0.f; }
    float suf = 1.f, wl[4];
#pragma unroll
    for (int r = 3; r >= 0; --r) { wl[r] = bt[r] * suf; suf = __builtin_fmaf(-suf, bt[r], suf); }
    float t1, po;
    { auto a = __builtin_amdgcn_permlane16_swap(__float_as_uint(suf), __float_as_uint(suf), false, false); t1 = (g & 1) ? __uint_as_float(a[0]) : __uint_as_float(a[1]); }
    const float pp = suf * t1;
    { auto b = __builtin_amdgcn_permlane32_swap(__float_as_uint(pp), __float_as_uint(pp), false, false); po = (g & 2) ? __uint_as_float(b[0]) : __uint_as_float(b[1]); }
    const float pre = D.carry * ((g & 2) ? 1.f : po) * ((g & 1) ? 1.f : t1);
    D.carry = D.carry * pp * po;
    D.wpk = (u32x2){pg8::cvt_pk_bf16(wl[0] * pre, wl[1] * pre), pg8::cvt_pk_bf16(wl[2] * pre, wl[3] * pre)};
#pragma unroll
    for (int j = 0; j < 4; ++j) *(LAS u32x2*)(D.tb + j * 512 + l15 * 32 + g * 8) = (u32x2){pg8::cvt_pk_bf16(D.S.v[j][0], D.S.v[j][1]), pg8::cvt_pk_bf16(D.S.v[j][2], D.S.v[j][3])};
}
__device__ __forceinline__ void decw_procB(DecW& D, int l15, int g) {
    asm volatile("s_waitcnt lgkmcnt(0)" ::: "memory");
#pragma unroll
    for (int dt = 0; dt < 4; ++dt) { const v4i16_t vb = vtr(D.tb + dt * 512 + (4 * g + (l15 >> 2)) * 32 + (l15 & 3) * 8);
        D.o[dt] = __builtin_amdgcn_mfma_f32_16x16x16bf16_1k(__builtin_bit_cast(s16x4, D.wpk), vb, D.o[dt], 0, 0, 0); }
}
__device__ __forceinline__ void decw_proc(DecW& D, bool newk, float cinit, int l15, int g) { decw_procA(D, newk, cinit, l15, g); decw_procB(D, l15, g); }
__device__ __forceinline__ void attn_unit_dec(Frame& F, int b, int h, int qb, DecW& D) {
    const int lane = F.lane, r32 = lane & 31, hi = lane >> 5, wid = F.wave, l15 = lane & 15, g4 = lane >> 4;
    const int rowbase = b * TP, q0 = qb * 256 + 32 * wid, qpos = q0 + r32;
    const float cinit = -F.sbb[h] * LOG2E, dcinit = -F.sbb[D.h] * LOG2E;
    LAS unsigned char* L = F.lds + RING_OFF;
    const unsigned lds0 = (unsigned)(uintptr_t)L;
    bf16x8 qr[4];
#pragma unroll
    for (int d0 = 0; d0 < 4; ++d0) qr[d0] = *(const bf16x8*)(F.QA() + (size_t)(rowbase + qpos) * 512 + h * 64 + d0 * 16 + hi * 8);
    asm volatile("" :: "v"(qr[0]), "v"(qr[1]), "v"(qr[2]), "v"(qr[3]));
    const int NT = 4 * (qb + 1);
    const int rr_ = (lane & 3) + 4 * ((lane & 31) >> 3), pil = 16 * ((lane >> 2) & 1) + 8 * (1 - (rr_ & 1)) + (rr_ >> 1) + (lane & 32);
    const bf16* ksrc = F.KA() + (size_t)(rowbase + pil) * 512 + h * 64 + wid * 8;
    const bf16* vsrc = F.VA() + (size_t)(rowbase + 16 * (wid & 3) + (lane >> 2)) * 512 + h * 64 + (wid >> 2) * 32 + (lane & 3) * 8;
    const unsigned kdst = lds0 + AT_K + wid * 1024, vdst = lds0 + AT_V + wid * 1024;
#define AT_DMA(t, slot) do { glds16(ksrc + (size_t)(t) * 64 * 512, (unsigned)__builtin_amdgcn_readfirstlane(kdst + (slot))); glds16(vsrc + (size_t)(t) * 64 * 512, (unsigned)__builtin_amdgcn_readfirstlane(vdst + (slot))); } while (0)
    const LAS unsigned char* kfb = L + AT_K + hi * 1024 + r32 * 16;
    const LAS unsigned char* vfb = L + AT_V + ((lane >> 4) & 1) * 32 + (lane & 3) * 8 + ((lane & 15) >> 2) * 64 + hi * 1024;
    f32x16 o0 = splat16(0.f), o1 = splat16(0.f); float carry = 1.f;
    int s_cur = 0, s_nxt = AT_SLOT, s_fre = 2 * AT_SLOT;
    bool l1 = false, l2 = false;
    AT_DMA(NT - 1, 0); AT_DMA(NT - 2, AT_SLOT);
    if (wid >= 4) __builtin_amdgcn_s_setprio(1);
    for (int t = NT - 1; t >= 0; --t) {
        if (t == 0) asm volatile("s_waitcnt vmcnt(0) lgkmcnt(0)\n\ts_barrier" ::: "memory");
        else if (l1 || l2) asm volatile("s_waitcnt vmcnt(10) lgkmcnt(0)\n\ts_barrier" ::: "memory");
        else asm volatile("s_waitcnt vmcnt(2) lgkmcnt(0)\n\ts_barrier" ::: "memory");
        const bool dstep = ((t & 1) == (wid >> 2)) && (D.i <= D.last) && !D.pend;
        if (dstep) decw_procA(D, false, dcinit, l15, g4);
        else if (D.pend) { decw_procB(D, l15, g4); D.pend = false; }
        if (t >= 2) AT_DMA(t - 2, s_fre);
        l2 = l1; l1 = false;
        const int kbase = 64 * t;
        if (kbase <= q0 + 30) {
            f32x16 p0 = splat16(cinit), p1 = splat16(cinit);
#pragma unroll
            for (int d0 = 0; d0 < 4; ++d0) {
                const bf16x8 k0 = *(const LAS bf16x8*)(kfb + s_cur + d0 * 2048), k1 = *(const LAS bf16x8*)(kfb + s_cur + d0 * 2048 + 512);
                p0 = MFMA32(k0, qr[d0], p0); p1 = MFMA32(k1, qr[d0], p1);
            }
            v4u pw[4];
            sb_tile2(p0, p1, carry, hi, kbase + 16 * hi, qpos, kbase + 63 >= q0, pw);
#pragma unroll
            for (int ks = 0; ks < 4; ++ks) {
                const LAS unsigned char* vp = vfb + s_cur + (ks >> 1) * 2048 + (ks & 1) * 512;
                const v4i16_t a0 = vtr(vp), a1 = vtr(vp + 256), b0 = vtr(vp + 4096), b1 = vtr(vp + 4096 + 256);
                const bf16x8 v0 = {a0[0], a0[1], a0[2], a0[3], a1[0], a1[1], a1[2], a1[3]}, v1 = {b0[0], b0[1], b0[2], b0[3], b1[0], b1[1], b1[2], b1[3]};
                o0 = MFMA32(__builtin_bit_cast(bf16x8, pw[ks]), v0, o0); o1 = MFMA32(__builtin_bit_cast(bf16x8, pw[ks]), v1, o1);
            }
        }
        if (dstep) { D.pend = true; ++D.i; if (D.i <= D.last) { decw_load(F, D, l15, g4); l1 = true; } }
        const int tmp = s_fre; s_fre = s_cur; s_cur = s_nxt; s_nxt = tmp;
    }
    __builtin_amdgcn_s_setprio(0);
    LAS bf16* stg = (LAS bf16*)(L + AT_O) + wid * 2048;
#pragma unroll
    for (int r = 0; r < 16; ++r) { const int orow = crow(r, hi); stg[orow * 64 + r32] = pg8::bf1(o0[r]); stg[orow * 64 + 32 + r32] = pg8::bf1(o1[r]); }
    asm volatile("s_waitcnt lgkmcnt(0)" ::: "memory");
#pragma unroll
    for (int i = 0; i < 4; ++i) {
        const int row = i * 8 + (lane >> 3), ch = lane & 7; const size_t grow = (size_t)rowbase + q0 + row;
        const v4u ov = *(const LAS v4u*)(stg + row * 64 + ch * 8), gv = *(const v4u*)(F.GA() + grow * 512 + h * 64 + ch * 8);
        f32x4 x, y;
        x[0] = bflo(ov[0]) * bflo(gv[0]); x[1] = bfhi(ov[0]) * bfhi(gv[0]); x[2] = bflo(ov[1]) * bflo(gv[1]); x[3] = bfhi(ov[1]) * bfhi(gv[1]);
        y[0] = bflo(ov[2]) * bflo(gv[2]); y[1] = bfhi(ov[2]) * bfhi(gv[2]); y[2] = bflo(ov[3]) * bflo(gv[3]); y[3] = bfhi(ov[3]) * bfhi(gv[3]);
        *(pg8::u32x4*)(F.MIX() + grow * 1024 + h * 64 + ch * 8) = pg8::pack8(x, y);
    }
    asm volatile("s_waitcnt lgkmcnt(0)\n\ts_barrier" ::: "memory");
#undef AT_DMA
}
constexpr int DW_OB = 90112, DW_CB = 106496;
__device__ __forceinline__ void attn_pair_dec(Frame& F, int it) {
    const int lane = F.lane, l15 = lane & 15, g4 = lane >> 4, wid = F.wave;
    const int bh = it >> 4, x = it & 15;
    DecW D; D.s = it >> 3; D.h = it & 7; D.w = wid; D.carry = 1.f; D.i = 1; D.last = 64; D.pend = false;
    D.pagev = F.pt[D.s * NPG + 8 * wid + (lane & 7)];
    D.tb = F.lds + RING_OFF + DW_T + wid * 2048;
#pragma unroll
    for (int dt = 0; dt < 4; ++dt) D.o[dt] = (f32x4){0.f, 0.f, 0.f, 0.f};
#pragma unroll
    for (int ks = 0; ks < 2; ++ks) D.qb[ks] = *(const bf16x8*)(F.QA() + ((size_t)MP + D.s * 8 + (l15 & 7)) * 512 + D.h * 64 + 32 * ks + 8 * g4);
    const float dcinit = -F.sbb[D.h] * LOG2E;
    if (wid == 7) {
        const size_t row = (size_t)MP + D.s * 8;
        const bf16* kp = F.KA() + (row + (l15 & 7)) * 512 + D.h * 64 + 8 * g4;
#pragma unroll
        for (int ks = 0; ks < 2; ++ks) { const v4u w = *(const v4u*)(kp + 32 * ks);
            D.S.k[2 * ks] = (f32x4){bflo(w[0]), bfhi(w[0]), bflo(w[1]), bfhi(w[1])}; D.S.k[2 * ks + 1] = (f32x4){bflo(w[2]), bfhi(w[2]), bflo(w[3]), bfhi(w[3])}; }
        const bf16* vp = F.VA() + (row + (l15 & 7)) * 512 + D.h * 64 + 4 * g4;
#pragma unroll
        for (int j = 0; j < 4; ++j) { const u32x2 w = *(const u32x2*)(vp + 16 * j); D.S.v[j] = (f32x4){bflo(w.x), bfhi(w.x), bflo(w.y), bfhi(w.y)}; }
        decw_proc(D, true, dcinit, l15, g4);
    }
    decw_load(F, D, l15, g4);
    asm volatile("s_waitcnt vmcnt(0)" ::: "memory");
    attn_unit_dec(F, bh >> 3, bh & 7, 31 - x, D);
    attn_unit_dec(F, bh >> 3, bh & 7, x, D);
    if (D.pend) { decw_procB(D, l15, g4); D.pend = false; }
    while (D.i <= D.last) { decw_proc(D, false, dcinit, l15, g4); ++D.i; if (D.i <= D.last) decw_load(F, D, l15, g4); }
    LAS float* ob = (LAS float*)(F.lds + RING_OFF + DW_OB); LAS float* cb = (LAS float*)(F.lds + RING_OFF + DW_CB);
    if (g4 < 2) {
#pragma unroll
        for (int dt = 0; dt < 4; ++dt)
#pragma unroll
            for (int r = 0; r < 4; ++r) ob[(wid * 8 + 4 * g4 + r) * 64 + 16 * dt + l15] = D.o[dt][r];
        if (g4 == 0 && l15 < 8) cb[wid * 8 + l15] = D.carry;
    }
    __syncthreads();
    {
        const int q = F.tid >> 6, d = F.tid & 63; float acc = 0.f, pref = 1.f;
#pragma unroll
        for (int w = 7; w >= 0; --w) { acc += pref * ob[(w * 8 + q) * 64 + d]; pref *= cb[w * 8 + q]; }
        const size_t row = (size_t)MP + D.s * 8 + q;
        F.MIX()[row * 1024 + D.h * 64 + d] = pg8::bf1(acc * bf2f(F.GA()[row * 512 + D.h * 64 + d]));
    }
    __syncthreads();
}

#ifndef MK_N_LAUNCHES
#define MK_N_LAUNCHES 1
#endif
constexpr int NPH = 15;
constexpr int N_LAUNCHES = MK_N_LAUNCHES;
struct Args { const void* in[17]; float* out; unsigned char* ws; int ph_lo, ph_hi, li, pad; };
__global__ void __launch_bounds__(NWAVES * 64, 2) mk_fwd(Args args) {
    extern __shared__ __attribute__((aligned(16))) unsigned char lds[];
    Frame F;
    F.lds = (LAS unsigned char*)lds;
    F.MISC = (volatile LAS unsigned*)(F.lds + MISC_OFF);
    F.tid = threadIdx.x; F.lane = F.tid & 63; F.wave = __builtin_amdgcn_readfirstlane(F.tid >> 6);
    F.G = gridDim.x; F.bid = blockIdx.x;
    unsigned char* ws = args.ws;
    F.ctl = (gu32*)(ws + WS_CTL);
    F.xp = (const float*)args.in[0]; F.xs = (const float*)args.in[1]; F.ck = (const float*)args.in[2]; F.cv = (const float*)args.in[3]; F.pt = (const int*)args.in[4];
    F.st_h = (const float*)args.in[5]; F.st_r = (const float*)args.in[6]; F.ng = (const float*)args.in[7]; F.w1 = (const float*)args.in[8]; F.w2 = (const float*)args.in[9];
    F.qg = (const float*)args.in[10]; F.kg = (const float*)args.in[11]; F.sbb = (const float*)args.in[12]; F.hlb = (const float*)args.in[13]; F.og = (const float*)args.in[14];
    F.w3 = (const float*)args.in[15]; F.w4 = (const float*)args.in[16]; F.out = args.out;
    F.ws = ws;
    for (int u = F.tid; u < (LDS_BYTES - LDSCTL_OFF) / 4; u += NWAVES * 64) ((LAS unsigned*)(F.lds + LDSCTL_OFF))[u] = 0u;
    __syncthreads();
    XcdBarrier bar; bar.bar = (unsigned*)(F.ctl + CW_BAR); bar.x = 0; bar.st = nullptr;
    if (N_LAUNCHES == 1) bar = xcd_barrier_post((unsigned*)(F.ctl + CW_BAR), F.MISC + 8);
#define GRID_BAR() do { if (N_LAUNCHES == 1) xcd_barrier(bar); } while (0)
    const int lo = args.ph_lo, hi = args.ph_hi;
#define IN(k) (lo <= (k) && (k) < hi)
    const int gw = F.bid * NWAVES + F.wave, NGW = F.G * NWAVES;
    const int vcu_ = (F.G % 8 == 0) ? (F.bid % 8) * (F.G / 8) + F.bid / 8 : F.bid;

    if (IN(0)) { p0_prologue(F); GRID_BAR(); }
    if (IN(1)) {
        pg8::Gemm g{1024, 1024, 1024}; pg8::SchedPlain S; S.init(F.H(), F.W1T(), MP, N1, 1024, F.G, F.bid);
        pg8::EpiEven E{F.QA(), F.KA(), F.VAT(), F.GA(), F.QB(), F.KB(), F.VB(), F.GB(), F.LOGF(), F.out, F.qg, F.kg, F.hlb, -0.125f * LOG2E, MT, MP, OK_P, OK_S, OV_P, OV_S};
        pg8::gemm_phase<pg8::EpiEven, pg8::SchedPlain, true, true>(F.lds + RING_OFF, g, S, E);
        { pg8::Gemm gs{256, 1024, 1024}; pg8::SchedSplit Ss{(const char*)(F.H() + (size_t)MP * 1024), (const char*)F.W1T(), N1 / 256, 4, F.G, F.bid, 2048, 2048};
          pg8::EpiSlab Es{F.SLAB(), N1}; pg8::gemm_phase<pg8::EpiSlab, pg8::SchedSplit, true, true>(F.lds + RING_OFF, gs, Ss, Es); }
        GRID_BAR();
    }
    if (IN(2)) {
        for (int it = gw; it < MSM * 8; it += NGW) pp1_item(F, it);
        for (int u = F.bid; u < 8 * 32; u += F.G) hgrn_chunk_unit2<false>(F, u >> 5, u & 31);
        GRID_BAR();
    }
    if (IN(3)) {
        hgrn_passB(F);
        for (int u = F.bid; u < NSQ * HB; u += F.G) hgrn_sample_unit(F, u >> 2, u & 3);
        { const int vcu = (F.G % 8 == 0) ? (F.bid % 8) * (F.G / 8) + F.bid / 8 : F.bid;
          for (int it = vcu; it < 256; it += F.G) attn_pair_dec(F, it); }
        GRID_BAR();
    }
    if (IN(4)) {
        for (int u = F.bid; u < 8 * 32; u += F.G) hgrn_chunk_unit2<true>(F, u >> 5, u & 31);
        { pg8::Gemm gs{256, 1024, 1024}; pg8::SchedSplit Ss{(const char*)(F.MIX() + (size_t)MP * 1024), (const char*)F.W2T(), 4, 4, F.G, F.bid, 2048, 2048};
          pg8::EpiSlab Es{F.SLAB(), 1024}; pg8::gemm_phase<pg8::EpiSlab, pg8::SchedSplit, true, true>(F.lds + RING_OFF, gs, Ss, Es); }
        GRID_BAR();
    }
    if (IN(6)) {
        pg8::Gemm g{1024, 1024, 1024}; pg8::SchedPlain S; S.init(F.MIX(), F.W2T(), MP, 1024, 1024, F.G, F.bid);
        pg8::EpiY1 E{F.xp, F.Y1B(), F.SS1()};
        pg8::gemm_phase<pg8::EpiY1, pg8::SchedPlain, true, true>(F.lds + RING_OFF, g, S, E);
        for (int r = gw; r < MSM; r += NGW) pp2_row(F, r);
        GRID_BAR();
    }
    if (IN(8)) {
        pg8::Gemm g{1024, 1024, 1024};
        { pg8::Sched3<0> S; S.init(F.Y1B(), F.W3T(), F.G, F.bid); pg8::EpiOdd3<0> E{F.AQ(), F.KCH(), F.KCT(), F.BV(), F.GC(), F.QC(), F.KC(), F.VC(), F.RCOS(), F.RSIN(), F.RCOST(), F.RSINT(), MP, F.SS1()};
          pg8::gemm_phase<pg8::EpiOdd3<0>, pg8::Sched3<0>, true, true>(F.lds + RING_OFF, g, S, E); }
        { pg8::Sched3<1> S; S.init(F.Y1B(), F.W3T(), F.G, F.bid); pg8::EpiOdd3<1> E{F.AQ(), F.KCH(), F.KCT(), F.BV(), F.GC(), F.QC(), F.KC(), F.VC(), F.RCOS(), F.RSIN(), F.RCOST(), F.RSINT(), MP, F.SS1()};
          pg8::gemm_phase<pg8::EpiOdd3<1>, pg8::Sched3<1>, true, true>(F.lds + RING_OFF, g, S, E); }
        { pg8::Gemm gs{256, 1024, 1024}; pg8::SchedSplit Ss{(const char*)(F.H() + (size_t)MP * 1024), (const char*)F.W3T(), N3 / 256, 4, F.G, F.bid, 2048, 2048};
          pg8::EpiSlab Es{F.SLAB(), N3}; pg8::gemm_phase<pg8::EpiSlab, pg8::SchedSplit, true, true>(F.lds + RING_OFF, gs, Ss, Es); }
        GRID_BAR();
    }
    if (IN(9)) {
        { pg8::Gemm g{256, 512, 256}; pg8::SchedRet S{(const char*)F.BV(), (const char*)F.KCT(), F.G, vcu_, 0};
          pg8::EpiRetA E{(pg8::bf16_t*)F.DST()};
          pg8::gemm_phase<pg8::EpiRetA, pg8::SchedRet, true, true>(F.lds + RING_OFF, g, S, E); }
        { pg8::Gemm g{256, 2048, 1024}; pg8::SchedRet S{(const char*)F.AQ(), (const char*)F.KCH(), F.G, vcu_, 1};
          pg8::EpiRetP E{F.AQ()};
          pg8::gemm_phase<pg8::EpiRetP, pg8::SchedRet, true, true>(F.lds + RING_OFF, g, S, E); }
        for (int it = gw; it < MSM * 24; it += NGW) pp3_item(F, it);
        GRID_BAR();
    }
    if (IN(10)) {
        ret_passB(F);
        for (int u = F.bid; u < NSQ * HC * 2; u += F.G) ret_sample_unit(F, u >> 3, (u >> 1) & 3, u & 1);
        GRID_BAR();
    }
    if (IN(12)) {
        pg8::Gemm g{512, 2048, 512}; pg8::SchedRet S{(const char*)F.AQ(), (const char*)F.BV(), F.G, vcu_, 2};
        pg8::EpiRetO E{F.GC(), F.MIX2(), F.SS()};
        pg8::gemm_phase<pg8::EpiRetO, pg8::SchedRet, true, true>(F.lds + RING_OFF, g, S, E);
        { pg8::Gemm gs{256, 2048, 2048}; pg8::SchedSplit Ss{(const char*)(F.MIX2() + (size_t)MP * 2048), (const char*)F.W4T(), 4, 8, F.G, F.bid, 4096, 4096};
          pg8::EpiSlab Es{F.SLAB4(), 1024}; pg8::gemm_phase<pg8::EpiSlab, pg8::SchedSplit, true, true>(F.lds + RING_OFF, gs, Ss, Es); }
        GRID_BAR();
    }
    if (IN(14)) {
        pg8::Gemm g{2048, 2048, 2048}; pg8::SchedPlain S; S.init(F.MIX2(), F.W4T(), MP, 1024, 2048, F.G, F.bid);
        pg8::EpiOut E{F.Y1B(), F.out + OY_P, F.SS()};
        pg8::gemm_phase<pg8::EpiOut, pg8::SchedPlain, true, true>(F.lds + RING_OFF, g, S, E);
        for (int r = gw; r < MSM; r += NGW) pp4_row(F, r);
    }
#undef IN
}

extern "C" void kernel_launch(void* const* d_in, const int* in_sizes, int n_in, void* d_out, int out_size, void* d_ws, size_t ws_size, hipStream_t stream) {
    static int grid = 0;
    if (grid == 0) {
        if (n_in != 17 || (size_t)out_size != OUT_TOTAL || ws_size < WS_END) { fprintf(stderr, "kernel_launch: unexpected shapes: n_in %d out %d ws %zu (need %zu)\n", n_in, out_size, ws_size, (size_t)WS_END); grid = -1; return; }
        int dev = 0, cus = 0, per_cu = 0;
        if (hipGetDevice(&dev) != hipSuccess || hipDeviceGetAttribute(&cus, hipDeviceAttributeMultiprocessorCount, dev) != hipSuccess) { grid = -1; return; }
        if (hipFuncSetAttribute((const void*)mk_fwd, hipFuncAttributeMaxDynamicSharedMemorySize, LDS_BYTES) != hipSuccess) { fprintf(stderr, "kernel_launch: hipFuncSetAttribute failed\n"); grid = -1; return; }
        if (hipOccupancyMaxActiveBlocksPerMultiprocessor(&per_cu, (const void*)mk_fwd, NWAVES * 64, LDS_BYTES) != hipSuccess || per_cu < 1) { fprintf(stderr, "kernel_launch: occupancy query says %d\n", per_cu); }
        (void)hipGetLastError();
        grid = cus;
    }
    if (grid < 0) return;
    if (hipMemsetAsync((char*)d_ws + WS_CTL, 0, CTL_ZERO_BYTES, stream) != hipSuccess) return;
    Args a{};
    for (int i = 0; i < 17; ++i) a.in[i] = d_in[i];
    a.out = (float*)d_out; a.ws = (unsigned char*)d_ws;
    for (int li = 0; li < N_LAUNCHES; ++li) {
        a.ph_lo = (N_LAUNCHES == 1) ? 0 : li; a.ph_hi = (N_LAUNCHES == 1) ? NPH : li + 1; a.li = li;
        hipLaunchKernelGGL(mk_fwd, dim3(grid), dim3(NWAVES * 64), LDS_BYTES, stream, a);
        if (hipPeekAtLastError() != hipSuccess) break;
    }
}
```

```cpp
#include <hip/hip_runtime.h>
#include <cstdio>
#include <cstdint>

constexpr int DM = 1024, TP = 8192, NBP = 2, MP = NBP * TP;
constexpr int NSQ = 32, TSQ = 8, MSM = NSQ * TSQ;
constexpr int MT = MP + MSM;
constexpr int PAST = 8192, PAGE = 128, NPG = PAST / PAGE;
constexpr int HA = 8, HDA = 64, WA = 512, HB = 4, DKB = 128, DVB = 128, HC = 4, DKC = 256, DVC = 512, WC = 2048;
constexpr int N1 = 4096, N3 = 6144;
constexpr float EPS = 1e-6f;
constexpr float LOG2E = 1.4426950408889634f;
constexpr size_t OY_P = 0, OY_S = 16777216, OK_P = 17039360, OV_P = 25427968, OK_S = 33816576, OV_S = 33947648,
                 OHG_P = 34078720, OHG_S = 34209792, ORT_P = 36306944, ORT_S = 37355520, OUT_TOTAL = 54132736;
#define MK_N_LAUNCHES 1
namespace pg8 {
#define PG8_LAS __attribute__((address_space(3)))
typedef unsigned short bf16_t;
typedef short bf16x8 __attribute__((ext_vector_type(8)));
typedef float f32x4 __attribute__((ext_vector_type(4)));
typedef unsigned u32x4 __attribute__((ext_vector_type(4)));
constexpr int BM = 256, BK = 64, HALF = 128, HTB = HALF * BK * 2  , STAGE_BYTES = 8 * HTB, NXCD = 8, WGM = 8;

__host__ __device__ __forceinline__ int lds_byte(int r, int c) { const int st = (r >> 4) * 2 + (c >> 5), rr = r & 15, cc = c & 31, ob = rr * 64 + cc * 2; return st * 1024 + (ob ^ (((ob >> 9) & 1) << 5)); }
__host__ __device__ __forceinline__ void stage_rc(int b, int& R, int& C) { const int st = b / 1024, sb = b % 1024, swz = sb ^ (((sb >> 9) & 1) << 5); R = (st >> 1) * 16 + swz / 64; C = (st & 1) * 32 + (swz % 64) / 2; }
__host__ __device__ __forceinline__ int perm32(int rho) { const int n = rho >> 4, i = rho & 15; return 8 * (i >> 2) + 4 * n + (i & 3); }

struct Unit { int pm, pn, kind, aux; };
struct Gemm { int K, lda, ldb; };

struct StaticOrder {
    int nM, nN, nwg, G, c;
    __host__ __device__ void init(int M, int N, int G_, int c_) { nM = M / BM; nN = N / BM; nwg = nM * nN; G = G_; c = c_; }
    __host__ __device__ bool next(int i, Unit& u) const {
        const long L = (long)i * G + c; if (L >= nwg) return false;
        int wgid = (int)L; { const int q = nwg / NXCD, r = nwg % NXCD, xcd = wgid % NXCD, off = wgid / NXCD; wgid = (xcd < r ? xcd * (q + 1) : r * (q + 1) + (xcd - r) * q) + off; }
        const int nig = WGM * nN, gid = wgid / nig, fm = gid * WGM, gsz = (nM - fm) < WGM ? (nM - fm) : WGM;
        u.pm = fm + ((wgid % nig) % gsz); u.pn = (wgid % nig) / gsz; return true;
    }
    __device__ __forceinline__ void a_ready(const Unit&) const {}
    __device__ __forceinline__ void done(const Unit&) const {}
};
typedef float f32x2_t __attribute__((ext_vector_type(2))); typedef __bf16 bf16x2_t __attribute__((ext_vector_type(2)));
__device__ __forceinline__ unsigned cvt_pk_bf16(float lo, float hi) { f32x2_t v = {lo, hi}; bf16x2_t b = __builtin_convertvector(v, bf16x2_t); return __builtin_bit_cast(unsigned, b); }
typedef float f32x2 __attribute__((ext_vector_type(2)));
template <class Epi, class Sched, bool ALIGN_EPI = false, bool SP2 = false>
__device__ __forceinline__ void gemm_phase(PG8_LAS unsigned char* lds, const Gemm g, const Sched& S, const Epi& E) {
    const int tid = threadIdx.x, wid = __builtin_amdgcn_readfirstlane(tid >> 6), lane = tid & 63, wr = wid >> 2, wc = wid & 3, fr = lane & 15, fq = lane >> 4;
    const int K = g.K, nt = K / BK;
    unsigned voffA[2], voffB[2];
#pragma unroll
    for (int i = 0; i < 2; ++i) { int R, C; stage_rc(tid * 16 + i * 8192, R, C); const int Rb = Epi::PERM ? ((R & ~31) + perm32(R & 31)) : R;
        voffA[i] = (unsigned)(R * g.lda + C) * 2u; voffB[i] = (unsigned)(Rb * g.ldb + C) * 2u; }
    const size_t kstep = (size_t)(BK * 2);
    const size_t hstepA = (size_t)HALF * g.lda * 2, hstepB = (size_t)HALF * g.ldb * 2;
    const unsigned ldsw = (unsigned)wid * 1024u;
    const int aoff = lds_byte(wr * 64 + fr, fq * 8), boff = lds_byte(wc * 32 + fr, fq * 8);
#define PG8_SA(b, h) (((b) * 2 + (h)) * HTB)
#define PG8_SB(b, h) ((4 + (b) * 2 + (h)) * HTB)
#define PG8_STAGE(bufoff, gbase, voff) do { _Pragma("unroll") for (int _i = 0; _i < 2; ++_i) \
        __builtin_amdgcn_global_load_lds((const unsigned*)((const char*)(gbase) + (voff)[_i]), (PG8_LAS unsigned*)(lds + (bufoff) + ldsw + _i * 8192), 16, 0, 0); } while (0)
#define PG8_LDA(dst, b, h) do { _Pragma("unroll") for (int m = 0; m < 4; ++m) _Pragma("unroll") for (int k = 0; k < 2; ++k) dst[m][k] = *(const PG8_LAS bf16x8*)(lds + PG8_SA(b, h) + aoff + m * 2048 + k * 1024); } while (0)
#define PG8_LDB(dst, b, h) do { _Pragma("unroll") for (int n = 0; n < 2; ++n) _Pragma("unroll") for (int k = 0; k < 2; ++k) dst[n][k] = *(const PG8_LAS bf16x8*)(lds + PG8_SB(b, h) + boff + n * 2048 + k * 1024); } while (0)
#define PG8_MMA(ai, bj, At, Bt) do { __builtin_amdgcn_s_setprio(1); _Pragma("unroll") for (int m = 0; m < 4; ++m) _Pragma("unroll") for (int n = 0; n < 2; ++n) _Pragma("unroll") for (int k = 0; k < 2; ++k) \
        acc[ai][bj][m][n] = __builtin_amdgcn_mfma_f32_16x16x32_bf16(Bt[n][k], At[m][k], acc[ai][bj][m][n], 0, 0, 0); __builtin_amdgcn_s_setprio(0); } while (0)
#define PG8_WAIT_V(n) asm volatile("s_waitcnt vmcnt(" #n ")" ::: "memory")
#define PG8_WAIT_L(n) asm volatile("s_waitcnt lgkmcnt(" #n ")" ::: "memory")
#define PG8_BAR __builtin_amdgcn_s_barrier()
#define PG8_SCHED __builtin_amdgcn_sched_barrier(0)
    Unit cur, nxt; int ui = 0;
    if (!S.next(0, cur)) return;
    f32x4 acc[2][2][4][2];
#pragma unroll
    for (int a = 0; a < 2; ++a)
#pragma unroll
        for (int b = 0; b < 2; ++b)
#pragma unroll
            for (int m = 0; m < 4; ++m)
#pragma unroll
                for (int n = 0; n < 2; ++n) acc[a][b][m][n] = (f32x4){0.f, 0.f, 0.f, 0.f};
    bf16x8 At[4][2], B0[2][2], B1[2][2];
    const char* cA = S.a_base(cur); const char* cB = S.b_base(cur);
    S.a_ready(cur);
    if constexpr (SP2) {
        PG8_STAGE(PG8_SB(0, 0), cB, voffB); PG8_STAGE(PG8_SB(0, 1), cB + hstepB, voffB); PG8_STAGE(PG8_SA(0, 0), cA, voffA); PG8_STAGE(PG8_SA(0, 1), cA + hstepA, voffA);
        if (wr == 1) PG8_BAR;
        PG8_WAIT_V(2); PG8_BAR;
        PG8_STAGE(PG8_SB(1, 0), cB + kstep, voffB); PG8_STAGE(PG8_SA(1, 0), cA + kstep, voffA); PG8_STAGE(PG8_SB(1, 1), cB + hstepB + kstep, voffB);
        PG8_WAIT_V(6); PG8_BAR;
    } else {
        PG8_STAGE(PG8_SB(0, 0), cB, voffB); PG8_STAGE(PG8_SA(0, 0), cA, voffA); PG8_STAGE(PG8_SB(0, 1), cB + hstepB, voffB); PG8_STAGE(PG8_SA(0, 1), cA + hstepA, voffA);
        if (wr == 1) PG8_BAR;
        PG8_WAIT_V(4); PG8_BAR;
        PG8_STAGE(PG8_SB(1, 0), cB + kstep, voffB); PG8_STAGE(PG8_SA(1, 0), cA + kstep, voffA); PG8_STAGE(PG8_SB(1, 1), cB + hstepB + kstep, voffB);
        PG8_WAIT_V(6); PG8_BAR;
    }
    for (;;) {
        const bool has_next = S.next(ui + 1, nxt);
        const char* nA = has_next ? S.a_base(nxt) : cA; const char* nB = has_next ? S.b_base(nxt) : cB;
#pragma unroll 1
        for (int t = 0; t < nt; t += 2) {
            if constexpr (Epi::KHOOK) { if (t != 0 && (t & 7) == 0) E.khook(acc, cur, t >> 3, wr, fr); }
            const bool last = (t == nt - 2);
            const char* a1 = cA + (size_t)(t + 1) * kstep;
            const char* a2 = last ? nA : cA + (size_t)(t + 2) * kstep; const char* b2 = last ? nB : cB + (size_t)(t + 2) * kstep;
            const char* a3 = a2 + kstep; const char* b3 = b2 + kstep;
            if (last && has_next) S.a_ready(nxt);
            if constexpr (SP2) {
            PG8_LDB(B0, 0, 0); PG8_LDB(B1, 0, 1); PG8_SCHED; PG8_LDA(At, 0, 0); PG8_STAGE(PG8_SA(1, 1), a1 + hstepA, voffA);
            PG8_WAIT_V(8); PG8_WAIT_L(0); PG8_BAR; PG8_MMA(0, 0, At, B0); PG8_MMA(0, 1, At, B1); PG8_BAR; PG8_SCHED;
            PG8_LDA(At, 0, 1); PG8_STAGE(PG8_SB(0, 0), b2, voffB); PG8_STAGE(PG8_SB(0, 1), b2 + hstepB, voffB); PG8_STAGE(PG8_SA(0, 0), a2, voffA);
            PG8_WAIT_V(8); PG8_WAIT_L(0); PG8_BAR; PG8_MMA(1, 0, At, B0); PG8_MMA(1, 1, At, B1); PG8_BAR; PG8_SCHED;
            PG8_LDB(B0, 1, 0); PG8_LDB(B1, 1, 1); PG8_SCHED; PG8_LDA(At, 1, 0); PG8_STAGE(PG8_SA(0, 1), a2 + hstepA, voffA);
            PG8_WAIT_V(8); PG8_WAIT_L(0); PG8_BAR; PG8_MMA(0, 0, At, B0); PG8_MMA(0, 1, At, B1); PG8_BAR; PG8_SCHED;
            PG8_LDA(At, 1, 1); PG8_STAGE(PG8_SB(1, 0), b3, voffB); PG8_STAGE(PG8_SB(1, 1), b3 + hstepB, voffB); PG8_STAGE(PG8_SA(1, 0), a3, voffA);
            PG8_WAIT_V(8); PG8_WAIT_L(0); PG8_BAR; PG8_MMA(1, 0, At, B0); PG8_MMA(1, 1, At, B1); PG8_BAR; PG8_SCHED;
            } else {
            PG8_LDB(B0, 0, 0); PG8_SCHED; PG8_LDA(At, 0, 0); PG8_STAGE(PG8_SA(1, 1), a1 + hstepA, voffA);
            PG8_WAIT_L(8); PG8_BAR; PG8_WAIT_L(0); PG8_MMA(0, 0, At, B0); PG8_BAR; PG8_SCHED;
            PG8_LDB(B1, 0, 1); PG8_STAGE(PG8_SB(0, 0), b2, voffB);
            PG8_BAR; PG8_WAIT_L(0); PG8_MMA(0, 1, At, B1); PG8_BAR;
            PG8_LDA(At, 0, 1); PG8_STAGE(PG8_SA(0, 0), a2, voffA);
            PG8_BAR; PG8_WAIT_L(0); PG8_MMA(1, 0, At, B0); PG8_BAR; PG8_SCHED;
            PG8_STAGE(PG8_SB(0, 1), b2 + hstepB, voffB);
            PG8_WAIT_V(6); PG8_BAR; PG8_MMA(1, 1, At, B1); PG8_BAR;
            PG8_LDB(B0, 1, 0); PG8_SCHED; PG8_LDA(At, 1, 0); PG8_STAGE(PG8_SA(0, 1), a2 + hstepA, voffA);
            PG8_WAIT_L(8); PG8_BAR; PG8_WAIT_L(0); PG8_MMA(0, 0, At, B0); PG8_BAR; PG8_SCHED;
            PG8_LDB(B1, 1, 1); PG8_STAGE(PG8_SB(1, 0), b3, voffB);
            PG8_BAR; PG8_WAIT_L(0); PG8_MMA(0, 1, At, B1); PG8_BAR;
            PG8_LDA(At, 1, 1); PG8_STAGE(PG8_SA(1, 0), a3, voffA);
            PG8_BAR; PG8_WAIT_L(0); PG8_MMA(1, 0, At, B0); PG8_BAR; PG8_SCHED;
            PG8_STAGE(PG8_SB(1, 1), b3 + hstepB, voffB);
            PG8_WAIT_V(6); PG8_BAR; PG8_MMA(1, 1, At, B1); PG8_BAR;
            }
        }
        if constexpr (ALIGN_EPI) { if (wr == 0) PG8_BAR; }
        if constexpr (!Epi::AFTER_DRAIN) { E(acc, cur, wr, wc, fr, fq); S.done(cur); }
        if (!has_next) break;
#pragma unroll
        for (int a = 0; a < 2; ++a)
#pragma unroll
            for (int b = 0; b < 2; ++b)
#pragma unroll
                for (int m = 0; m < 4; ++m)
#pragma unroll
                    for (int n = 0; n < 2; ++n) acc[a][b][m][n] = (f32x4){0.f, 0.f, 0.f, 0.f};
        cur = nxt; cA = nA; cB = nB; ++ui;
        if constexpr (ALIGN_EPI) { if (wr == 1) PG8_BAR; }
    }
    PG8_WAIT_V(0);
    if constexpr (!ALIGN_EPI) { if (wr == 0) PG8_BAR; }
    PG8_BAR;
    if constexpr (Epi::AFTER_DRAIN) { E.fused(acc, cur, wr, wc, fr, fq, lds, wid, lane); S.done(cur); }
#undef PG8_SA
#undef PG8_SB
#undef PG8_STAGE
#undef PG8_LDA
#undef PG8_LDB
#undef PG8_MMA
#undef PG8_WAIT_V
#undef PG8_WAIT_L
#undef PG8_BAR
#undef PG8_SCHED
}
__device__ __forceinline__ float silu_f(float x) { return x * __builtin_amdgcn_rcpf(1.f + __builtin_amdgcn_exp2f(-1.4426950408889634f * x)); }
__device__ __forceinline__ float sigm_f(float x) { return __builtin_amdgcn_rcpf(1.f + __builtin_amdgcn_exp2f(-1.4426950408889634f * x)); }
__device__ __forceinline__ u32x4 pack8(const f32x4 a, const f32x4 b) { u32x4 w; w.x = cvt_pk_bf16(a[0], a[1]); w.y = cvt_pk_bf16(a[2], a[3]); w.z = cvt_pk_bf16(b[0], b[1]); w.w = cvt_pk_bf16(b[2], b[3]); return w; }
__device__ __forceinline__ unsigned short bf1(float f) { return (unsigned short)(cvt_pk_bf16(f, 0.f) & 0xffffu); }

struct EpiEven {
    static constexpr bool PERM = true, AFTER_DRAIN = false, KHOOK = false;
    bf16_t *QA, *KA, *VAT, *GA, *QB, *KB, *VB, *GB; float* LOGF; float* out;
    const float *qg, *kg, *hlb; float qscale; int MTOT, MPR; size_t okp, oks, ovp, ovs;
    __device__ __forceinline__ void operator()(const f32x4 (&acc)[2][2][4][2], const Unit& u, int wr, int wc, int fr, int fq) const {
        const int typ = u.pn >> 1;
        int rb = u.pm * BM + wr * 64 + fr; asm volatile("" : "+v"(rb));
        const int c0 = (u.pn & 1) * 256 + wc * 64 + fq * 8;
        const int d0 = fq * 8;
#pragma unroll
        for (int ai = 0; ai < 2; ++ai)
#pragma unroll
            for (int m = 0; m < 4; ++m) {
                const int row = rb + ai * HALF + m * 16;
                f32x4 v[2][2];
#pragma unroll
                for (int bj = 0; bj < 2; ++bj)
#pragma unroll
                    for (int n = 0; n < 2; ++n) v[bj][n] = acc[ai][bj][m][n];
                if (typ <= 1) {
                    float ss = 0.f;
#pragma unroll
                    for (int bj = 0; bj < 2; ++bj)
#pragma unroll
                        for (int n = 0; n < 2; ++n) ss += (v[bj][n][0] * v[bj][n][0] + v[bj][n][1] * v[bj][n][1]) + (v[bj][n][2] * v[bj][n][2] + v[bj][n][3] * v[bj][n][3]);
                    ss += __shfl_xor(ss, 16); ss += __shfl_xor(ss, 32);
                    const float rstd = __builtin_amdgcn_rsqf(ss * (1.f / 64.f) + 1e-6f) * (typ == 0 ? qscale : 1.f);
                    const float* g = (typ == 0) ? qg : kg;
#pragma unroll
                    for (int bj = 0; bj < 2; ++bj) {
#pragma unroll
                        for (int n = 0; n < 2; ++n) { const f32x4 gv = *(const f32x4*)(g + d0 + 32 * bj + 4 * n); v[bj][n] = v[bj][n] * gv * rstd; }
                        const int c = c0 + 32 * bj;
                        if (typ == 0) *(u32x4*)(QA + (size_t)row * 512 + c) = pack8(v[bj][0], v[bj][1]);
                        else {
                            *(u32x4*)(KA + (size_t)row * 512 + c) = pack8(v[bj][0], v[bj][1]);
                            float* ko = out + (row < MPR ? okp + (size_t)row * 512 : oks + (size_t)(row - MPR) * 512) + c;
                            *(f32x4*)ko = v[bj][0]; *(f32x4*)(ko + 4) = v[bj][1];
                        }
                    }
                } else if (typ == 2) {
#pragma unroll
                    for (int bj = 0; bj < 2; ++bj) {
                        const int c = c0 + 32 * bj;
                        float* vo = out + (row < MPR ? ovp + (size_t)row * 512 : ovs + (size_t)(row - MPR) * 512) + c;
                        *(f32x4*)vo = v[bj][0]; *(f32x4*)(vo + 4) = v[bj][1];
                        *(u32x4*)(VAT + (size_t)row * 512 + c) = pack8(v[bj][0], v[bj][1]);
                    }
                } else if (typ == 5) {
#pragma unroll
                    for (int bj = 0; bj < 2; ++bj) {
                        const int c = c0 + 32 * bj;
                        f32x4 lf[2], kk[2];
#pragma unroll
                        for (int n = 0; n < 2; ++n)
#pragma unroll
                            for (int e = 0; e < 4; ++e) {
                                const int cc = c + 4 * n + e;
                                const float lb = __builtin_amdgcn_rcpf(1.f + __expf(hlb[512 + cc] - hlb[cc]));
                                const float sg = sigm_f(v[bj][n][e]);
                                lf[n][e] = __logf(lb + (1.f - lb) * sg);
                                kk[n][e] = (1.f - lb) * (1.f - sg);
                            }
                        *(f32x4*)(LOGF + (size_t)row * 512 + c) = lf[0]; *(f32x4*)(LOGF + (size_t)row * 512 + c + 4) = lf[1];
                        *(u32x4*)(KB + (size_t)row * 512 + c) = pack8(kk[0], kk[1]);
                    }
                } else {
                    bf16_t* dst = (typ == 3) ? GA : (typ == 4) ? QB : (typ == 6) ? VB : GB;
#pragma unroll
                    for (int bj = 0; bj < 2; ++bj) {
                        if (typ != 6) {
#pragma unroll
                            for (int n = 0; n < 2; ++n)
#pragma unroll
                                for (int e = 0; e < 4; ++e) v[bj][n][e] = silu_f(v[bj][n][e]);
                        }
                        *(u32x4*)(dst + (size_t)row * 512 + c0 + 32 * bj) = pack8(v[bj][0], v[bj][1]);
                    }
                }
            }
    }
};


struct EpiY1 {
    static constexpr bool PERM = false, AFTER_DRAIN = false, KHOOK = false;
    const float* x; bf16_t* Y1; float* SS1;
    __device__ __forceinline__ void operator()(const f32x4 (&acc)[2][2][4][2], const Unit& u, int wr, int wc, int fr, int fq) const {
        int row0 = u.pm * BM + wr * 64 + fr; asm volatile("" : "+v"(row0));
        const int col0 = u.pn * BM + wc * 32 + 4 * fq;
#pragma unroll
        for (int ai = 0; ai < 2; ++ai)
#pragma unroll
            for (int m = 0; m < 4; ++m) {
                const int row = row0 + ai * HALF + m * 16; float ss = 0.f;
#pragma unroll
                for (int bj = 0; bj < 2; ++bj)
#pragma unroll
                    for (int n = 0; n < 2; ++n) { const int c = col0 + bj * HALF + n * 16;
                        const f32x4 y = acc[ai][bj][m][n] + *(const f32x4*)(x + (size_t)row * 1024 + c);
                        *(unsigned long long*)(Y1 + (size_t)row * 1024 + c) = (unsigned long long)cvt_pk_bf16(y[0], y[1]) | ((unsigned long long)cvt_pk_bf16(y[2], y[3]) << 32);
                        ss += (y[0] * y[0] + y[1] * y[1]) + (y[2] * y[2] + y[3] * y[3]); }
                ss += __shfl_xor(ss, 16); ss += __shfl_xor(ss, 32);
                if (fq == 0) atomicAdd(SS1 + row, ss);
            }
    }
};


__device__ __forceinline__ float lg2gamma(int h) { return __builtin_amdgcn_logf(1.f - __builtin_amdgcn_exp2f(-5.f - (float)h)); }

template <int KIND> struct EpiOdd3 {
    static constexpr bool PERM = true, AFTER_DRAIN = false, KHOOK = false;
    bf16_t *AQ, *KCH, *KCT, *BV, *GC, *QC, *KC, *VC; const float *rcos, *rsin, *rcosT, *rsinT; int MPR; const float* SS1;
    __device__ __forceinline__ void operator()(const f32x4 (&acc)[2][2][4][2], const Unit& u, int wr, int wc, int fr, int fq) const {

        if (KIND == 0) {
            const int j0 = wc * 32 + fq * 8;
            int rb = u.pm * BM + wr * 64 + fr; asm volatile("" : "+v"(rb));
#pragma unroll
            for (int ai = 0; ai < 2; ++ai)
#pragma unroll
                for (int m = 0; m < 4; ++m) {
                    const int row = rb + ai * HALF + m * 16;
                    const float rs = __builtin_amdgcn_rsqf(SS1[row] * (1.f / 1024.f) + 1e-6f);
                    if (u.pn < 8) {
                        const int pos = row & (TP - 1), h = u.pn & 3, tl = row & 255;
                        const float sc = rs * ((u.pn < 4) ? __builtin_amdgcn_exp2f((float)tl * lg2gamma(h)) : 0.0625f * __builtin_amdgcn_exp2f(-(float)tl * lg2gamma(h)));
                        f32x4 o1[2], o2[2];
#pragma unroll
                        for (int n = 0; n < 2; ++n) {
                            const f32x4 c = *(const f32x4*)(rcos + (size_t)pos * 128 + j0 + 4 * n), s = *(const f32x4*)(rsin + (size_t)pos * 128 + j0 + 4 * n);
                            const f32x4 x1 = acc[ai][0][m][n], x2 = acc[ai][1][m][n];
                            o1[n] = (x1 * c - x2 * s) * sc; o2[n] = (x2 * c + x1 * s) * sc;
                        }
                        bf16_t* dst = (u.pn < 4) ? AQ + (size_t)row * 2048 + h * 512 + 256 + j0 : KCH + (size_t)row * 1024 + h * 256 + j0;
                        *(u32x4*)dst = pack8(o1[0], o1[1]); *(u32x4*)(dst + 128) = pack8(o2[0], o2[1]);
                        if (u.pn >= 4) {
                            bf16_t* kt = KCT + ((size_t)(((row >> 13) * 4 + h) * 32 + ((row >> 8) & 31)) * 256 + j0) * 256 + tl;
#pragma unroll
                            for (int n = 0; n < 2; ++n)
#pragma unroll
                                for (int e = 0; e < 4; ++e) { kt[(size_t)(4 * n + e) * 256] = bf1(o1[n][e]); kt[(size_t)(128 + 4 * n + e) * 256] = bf1(o2[n][e]); }
                        }
                        asm volatile("" ::: "memory");
                    } else {
                        bf16_t* dst = GC + (size_t)row * 2048 + (u.pn - 8) * 256 + j0;
#pragma unroll
                        for (int bj = 0; bj < 2; ++bj) {
                            f32x4 a = acc[ai][bj][m][0] * rs, b = acc[ai][bj][m][1] * rs;
#pragma unroll
                            for (int e = 0; e < 4; ++e) { a[e] = silu_f(a[e]); b[e] = silu_f(b[e]); }
                            *(u32x4*)(dst + 128 * bj) = pack8(a, b);
                        }
                    }
                }
            return;
        }
        int fro = fr; asm volatile("" : "+v"(fro));
        {
            f32x4 rr[2][2];
#pragma unroll
            for (int bj = 0; bj < 2; ++bj) { const int tok0 = u.pn * BM + bj * HALF + wc * 32 + fq * 8;
                rr[bj][0] = *(const f32x4*)(SS1 + tok0); rr[bj][1] = *(const f32x4*)(SS1 + tok0 + 4); }
#pragma unroll
            for (int bj = 0; bj < 2; ++bj)
#pragma unroll
                for (int n = 0; n < 2; ++n)
#pragma unroll
                    for (int e = 0; e < 4; ++e) rr[bj][n][e] = __builtin_amdgcn_rsqf(rr[bj][n][e] * (1.f / 1024.f) + 1e-6f);
#pragma unroll
            for (int ai = 0; ai < 2; ++ai)
#pragma unroll
                for (int m = 0; m < 4; ++m) {
                    const int vf = (u.pm - 4) * BM + ai * HALF + wr * 64 + m * 16 + fro, h = vf >> 9, dv = vf & 511;
#pragma unroll
                    for (int bj = 0; bj < 2; ++bj) {
                        const int tok0 = u.pn * BM + bj * HALF + wc * 32 + fq * 8, b = tok0 >> 13, c = (tok0 >> 8) & 31, sl = tok0 & 255;
                        *(u32x4*)(BV + ((size_t)((b * 4 + h) * 32 + c) * 512 + dv) * 512 + sl) = pack8(acc[ai][bj][m][0] * rr[bj][0], acc[ai][bj][m][1] * rr[bj][1]);
                    }
                }
        }
    }
};
template <int KIND> struct Sched3 {
    StaticOrder so; const char *H, *W3T; int G, c;
    __device__ __forceinline__ void init(const void* H_, const void* W3T_, int G_, int c_) { H = (const char*)H_; W3T = (const char*)W3T_; G = G_; c = c_; so.init(16384, 4096, G_, c_); }
    __device__ __forceinline__ bool next(int i, Unit& u) const {
        const int L = i * G + c; u.aux = 0; u.kind = KIND;
        if (KIND == 0) return so.next(i, u);
        if (KIND == 1) { if (L >= 512) return false; u.pm = 4 + (L & 7); u.pn = L >> 3; return true; }
        if (L >= 24) return false; u.pm = 64; u.pn = L; return true;
    }
    __device__ __forceinline__ const char* a_base(const Unit& u) const { return (KIND == 1) ? W3T + (size_t)(1024 + 256 * u.pm) * 2048 : H + (size_t)u.pm * 256 * 2048; }
    __device__ __forceinline__ const char* b_base(const Unit& u) const {
        if (KIND == 1) return H + (size_t)u.pn * 256 * 2048;
        const int r0 = (KIND == 0 && u.pn >= 8) ? 4096 + 256 * (u.pn - 8) : 256 * u.pn;
        return W3T + (size_t)r0 * 2048; }
    __device__ __forceinline__ void a_ready(const Unit&) const {}
    __device__ __forceinline__ void done(const Unit&) const {}
};
struct SchedPlain {
    StaticOrder so; const char *A, *Bt; size_t ta, tb;
    __device__ __forceinline__ void init(const void* A_, const void* Bt_, int M, int N, int K, int G, int c) { A = (const char*)A_; Bt = (const char*)Bt_; ta = (size_t)256 * K * 2; tb = ta; so.init(M, N, G, c); }
    __device__ __forceinline__ bool next(int i, Unit& u) const { u.kind = 0; u.aux = 0; return so.next(i, u); }
    __device__ __forceinline__ const char* a_base(const Unit& u) const { return A + (size_t)u.pm * ta; }
    __device__ __forceinline__ const char* b_base(const Unit& u) const { return Bt + (size_t)u.pn * tb; }
    __device__ __forceinline__ void a_ready(const Unit&) const {}
    __device__ __forceinline__ void done(const Unit&) const {}
};
struct SchedRet {
    const char *Ab, *Bb; int G, c, mode;
    __device__ __forceinline__ bool next(int i, Unit& u) const {
        const int L = i * G + c, n = (mode == 1) ? 256 : 512; if (L >= n) return false;
        int bc, half; if (mode == 1) { bc = L; half = 0; } else { bc = L >> 1; half = L & 1; }
        u.pm = bc; u.pn = half; u.kind = 0; u.aux = (bc >> 7) * TP + (bc & 31) * 256; return true;
    }
    __device__ __forceinline__ const char* a_base(const Unit& u) const {
        if (mode == 0) return Ab + ((size_t)u.pm * 512 + u.pn * 256) * 512 * 2;
        const int h = (u.pm >> 5) & 3;
        return Ab + ((size_t)u.aux * 2048 + h * 512 + (mode == 1 ? 256 : 0)) * 2; }
    __device__ __forceinline__ const char* b_base(const Unit& u) const {
        const int h = (u.pm >> 5) & 3;
        if (mode == 0) return Bb + (size_t)u.pm * 256 * 256 * 2;
        if (mode == 1) return Bb + ((size_t)u.aux * 1024 + h * 256) * 2;
        return Bb + ((size_t)u.pm * 512 + u.pn * 256) * 512 * 2; }
    __device__ __forceinline__ void a_ready(const Unit&) const {}
    __device__ __forceinline__ void done(const Unit&) const {}
};
struct EpiRetA {
    static constexpr bool PERM = true, AFTER_DRAIN = false, KHOOK = false;
    bf16_t* DST;
    __device__ __forceinline__ void operator()(const f32x4 (&acc)[2][2][4][2], const Unit& u, int wr, int wc, int fr, int fq) const {
        bf16_t* base = DST + ((size_t)u.pm * 512 + u.pn * 256) * 256;
        int rb = wr * 64 + fr; asm volatile("" : "+v"(rb));
#pragma unroll
        for (int ai = 0; ai < 2; ++ai)
#pragma unroll
            for (int m = 0; m < 4; ++m) { bf16_t* rp = base + (size_t)(ai * HALF + m * 16 + rb) * 256 + wc * 32 + 8 * fq;
#pragma unroll
                for (int bj = 0; bj < 2; ++bj) *(u32x4*)(rp + bj * HALF) = pack8(acc[ai][bj][m][0], acc[ai][bj][m][1]); }
    }
};
struct EpiRetP {
    static constexpr bool PERM = true, AFTER_DRAIN = false, KHOOK = false;
    bf16_t* AQ;
    __device__ __forceinline__ void operator()(const f32x4 (&acc)[2][2][4][2], const Unit& u, int wr, int wc, int fr, int fq) const {
        const int h = (u.pm >> 5) & 3;
        int rb = wr * 64 + fr; asm volatile("" : "+v"(rb));
#pragma unroll
        for (int ai = 0; ai < 2; ++ai)
#pragma unroll
            for (int m = 0; m < 4; ++m) { const int t = ai * HALF + m * 16 + rb;
#pragma unroll
                for (int bj = 0; bj < 2; ++bj) { const int s0 = bj * HALF + wc * 32 + fq * 8; f32x4 a = acc[ai][bj][m][0], b = acc[ai][bj][m][1];
#pragma unroll
                    for (int e = 0; e < 4; ++e) { if (s0 + e > t) a[e] = 0.f; if (s0 + 4 + e > t) b[e] = 0.f; }
                    *(u32x4*)(AQ + (size_t)(u.aux + t) * 2048 + h * 512 + s0) = pack8(a, b); } }
    }
};
struct EpiRetO {
    static constexpr bool PERM = true, AFTER_DRAIN = false, KHOOK = false;
    const bf16_t* GC; bf16_t* MIX2; float* SS;
    __device__ __forceinline__ void operator()(const f32x4 (&acc)[2][2][4][2], const Unit& u, int wr, int wc, int fr, int fq) const {
        const int h = (u.pm >> 5) & 3;
        int rb = u.aux + wr * 64 + fr; asm volatile("" : "+v"(rb));
#pragma unroll
        for (int ai = 0; ai < 2; ++ai)
#pragma unroll
            for (int m = 0; m < 4; ++m) { const size_t row = (size_t)(rb + ai * HALF + m * 16); float ss = 0.f;
#pragma unroll
                for (int bj = 0; bj < 2; ++bj) { const int col = h * 512 + u.pn * 256 + bj * HALF + wc * 32 + fq * 8; f32x4 a = acc[ai][bj][m][0], b = acc[ai][bj][m][1];
                    ss += (a[0] * a[0] + a[1] * a[1]) + (a[2] * a[2] + a[3] * a[3]) + (b[0] * b[0] + b[1] * b[1]) + (b[2] * b[2] + b[3] * b[3]);
                    const u32x4 g = *(const u32x4*)(GC + row * 2048 + col);
                    a[0] *= __builtin_bit_cast(float, g.x << 16); a[1] *= __builtin_bit_cast(float, g.x & 0xffff0000u); a[2] *= __builtin_bit_cast(float, g.y << 16); a[3] *= __builtin_bit_cast(float, g.y & 0xffff0000u);
                    b[0] *= __builtin_bit_cast(float, g.z << 16); b[1] *= __builtin_bit_cast(float, g.z & 0xffff0000u); b[2] *= __builtin_bit_cast(float, g.w << 16); b[3] *= __builtin_bit_cast(float, g.w & 0xffff0000u);
                    *(u32x4*)(MIX2 + row * 2048 + col) = pack8(a, b); }
                ss += __shfl_xor(ss, 16); ss += __shfl_xor(ss, 32);
                if (fq == 0) atomicAdd(SS + row * 4 + h, ss); }
    }
};

struct SchedSplit {
    const char *A, *Bt; int nN, nP, G, c; size_t lda2, ldb2;
    __device__ __forceinline__ bool next(int i, Unit& u) const { const int L = i * G + c; if (L >= nN * nP) return false; u.pn = L / nP; u.aux = L % nP; u.pm = 0; u.kind = 0; return true; }
    __device__ __forceinline__ const char* a_base(const Unit& u) const { return A + (size_t)u.aux * 512; }
    __device__ __forceinline__ const char* b_base(const Unit& u) const { return Bt + (size_t)u.pn * 256 * ldb2 + (size_t)u.aux * 512; }
    __device__ __forceinline__ void a_ready(const Unit&) const {}
    __device__ __forceinline__ void done(const Unit&) const {}
};
struct EpiSlab {
    static constexpr bool PERM = true, AFTER_DRAIN = false, KHOOK = false;
    bf16_t* slab; int ncols;
    __device__ __forceinline__ void operator()(const f32x4 (&acc)[2][2][4][2], const Unit& u, int wr, int wc, int fr, int fq) const {
        int rb = wr * 64 + fr; asm volatile("" : "+v"(rb));
        bf16_t* base = slab + (size_t)u.aux * 256 * ncols + u.pn * BM + wc * 32 + 8 * fq;
#pragma unroll
        for (int ai = 0; ai < 2; ++ai)
#pragma unroll
            for (int m = 0; m < 4; ++m) { bf16_t* rp = base + (size_t)(rb + ai * HALF + m * 16) * ncols;
#pragma unroll
                for (int bj = 0; bj < 2; ++bj) *(u32x4*)(rp + bj * HALF) = pack8(acc[ai][bj][m][0], acc[ai][bj][m][1]); }
    }
};
struct EpiOut {
    static constexpr bool PERM = false, AFTER_DRAIN = false, KHOOK = true;
    const bf16_t* Y1; float* out; const float* SS;
    __device__ __forceinline__ float rstd(int row, int h) const { return __builtin_amdgcn_rsqf(SS[(size_t)row * 4 + h] * (1.f / 512.f) + 1e-6f); }
    __device__ __forceinline__ void khook(f32x4 (&acc)[2][2][4][2], const Unit& u, int hb, int wr, int fr) const {
        int rb = u.pm * BM + wr * 64 + fr; asm volatile("" : "+v"(rb));
#pragma unroll
        for (int ai = 0; ai < 2; ++ai)
#pragma unroll
            for (int m = 0; m < 4; ++m) { const int row = rb + ai * HALF + m * 16; const float ratio = rstd(row, hb - 1) * __builtin_amdgcn_rcpf(rstd(row, hb));
#pragma unroll
                for (int bj = 0; bj < 2; ++bj)
#pragma unroll
                    for (int n = 0; n < 2; ++n) acc[ai][bj][m][n] = acc[ai][bj][m][n] * ratio; }
    }
    __device__ __forceinline__ void operator()(const f32x4 (&acc)[2][2][4][2], const Unit& u, int wr, int wc, int fr, int fq) const {
        int row0 = u.pm * BM + wr * 64 + fr; asm volatile("" : "+v"(row0));
        const int col0 = u.pn * BM + wc * 32 + 4 * fq;
#pragma unroll
        for (int ai = 0; ai < 2; ++ai)
#pragma unroll
            for (int m = 0; m < 4; ++m) { const int row = row0 + ai * HALF + m * 16; const float r3 = rstd(row, 3);
#pragma unroll
                for (int bj = 0; bj < 2; ++bj)
#pragma unroll
                    for (int n = 0; n < 2; ++n) { const int c = col0 + bj * HALF + n * 16; const unsigned long long yq = *(const unsigned long long*)(Y1 + (size_t)row * 1024 + c);
                        const f32x4 yv = {__builtin_bit_cast(float, (unsigned)yq << 16), __builtin_bit_cast(float, (unsigned)yq & 0xffff0000u), __builtin_bit_cast(float, (unsigned)(yq >> 32) << 16), __builtin_bit_cast(float, (unsigned)(yq >> 32) & 0xffff0000u)};
                        *(f32x4*)(out + (size_t)row * 1024 + c) = acc[ai][bj][m][n] * r3 + yv; } }
    }
};
}
#define GAS __attribute__((address_space(1)))
#define LAS __attribute__((address_space(3)))
typedef unsigned short bf16;
typedef unsigned v4u __attribute__((ext_vector_type(4)));
typedef float f32x4 __attribute__((ext_vector_type(4)));
typedef short bf16x8 __attribute__((ext_vector_type(8)));
typedef GAS unsigned gu32;
typedef GAS unsigned long long gu64;
#define RLX_AGENT __ATOMIC_RELAXED, __HIP_MEMORY_SCOPE_AGENT
#define LDS_WAIT() asm volatile("s_waitcnt lgkmcnt(0)" ::: "memory")
#define VM_WAIT() asm volatile("s_waitcnt vmcnt(0)" ::: "memory")
__device__ __forceinline__ unsigned long long rt() { return __builtin_amdgcn_s_memrealtime(); }
__device__ __forceinline__ unsigned f2bf(float f) { unsigned u = __builtin_bit_cast(unsigned, f); return (u + 0x7fffu + ((u >> 16) & 1u)) >> 16; }
__device__ __forceinline__ unsigned pk2(float lo, float hi) { return f2bf(lo) | (f2bf(hi) << 16); }
#define XB_TMO      128
#define XB_XCNT(j)  (256  + 64 * (j))
#define XB_XSUB(j)  (1280 + 64 * (j))
#define XB_XGEN(j)  (2304 + 64 * (j))
#define XB_TOP      3328
#define XB_TOPGEN   3392
#define XCD_BAR_WORDS 3456
#define XB_SPIN_CAP (1u << 18)

__device__ __forceinline__ unsigned xb_ld(unsigned* p)              { return __hip_atomic_load(p, __ATOMIC_RELAXED, __HIP_MEMORY_SCOPE_AGENT); }
__device__ __forceinline__ unsigned xb_add(unsigned* p, unsigned v) { return __hip_atomic_fetch_add(p, v, __ATOMIC_RELAXED, __HIP_MEMORY_SCOPE_AGENT); }
__device__ __forceinline__ unsigned xb_xcc_id() { return (unsigned)__builtin_amdgcn_s_getreg((3 << 11) | 20) & 0xFu; }
#define XB_SPIN(cond, bar) do { unsigned _sp = 0; while (cond) { __builtin_amdgcn_s_sleep(1); \
    if ((++_sp & 255u) == 0u) { if (xb_ld(&(bar)[XB_TMO])) break; if (_sp > XB_SPIN_CAP) { atomicAdd(&(bar)[XB_TMO], 1u); break; } } } } while (0)

struct XcdBarrier {
    unsigned* bar; unsigned x;
    volatile LAS unsigned* st;
};

__device__ __forceinline__ XcdBarrier xcd_barrier_post(unsigned* bar, volatile LAS unsigned* st) {
    XcdBarrier b; b.bar = bar; b.x = xb_xcc_id(); b.st = st;
    if (threadIdx.x == 0) (void)xb_add(&bar[XB_XCNT(b.x)], 1u);
    return b;
}
__device__ __forceinline__ void xcd_barrier_complete(unsigned* bar, unsigned x, unsigned& nloc, unsigned& nx) {
    const unsigned G = gridDim.x * gridDim.y * gridDim.z;
    unsigned sum, cnt, mine, sp = 0u;
    for (;;) {
        sum = 0u; cnt = 0u; mine = 0u;
#pragma unroll
        for (unsigned j = 0; j < 16; ++j) { const unsigned c = xb_ld(&bar[XB_XCNT(j)]); sum += c; cnt += (c > 0u) ? 1u : 0u; mine = (j == x) ? c : mine; }
        if (sum == G) break;
        __builtin_amdgcn_s_sleep(1);
        if ((++sp & 255u) == 0u) { if (xb_ld(&bar[XB_TMO])) break; if (sp > XB_SPIN_CAP) { atomicAdd(&bar[XB_TMO], 1u); break; } }
    }
    nloc = mine > 0u ? mine : 1u; nx = cnt > 0u ? cnt : 1u;
}

__device__ __forceinline__ void xcd_barrier(const XcdBarrier& b) {
    asm volatile("s_waitcnt vmcnt(0)" ::: "memory");
    __syncthreads();
    if (threadIdx.x == 0) {
        unsigned* bar = b.bar;
        __builtin_amdgcn_s_waitcnt(0);
        unsigned nloc = b.st[0], nx = b.st[1];
        if (nloc == 0u) { xcd_barrier_complete(bar, b.x, nloc, nx); b.st[0] = nloc; b.st[1] = nx; }
        const unsigned old = xb_add(&bar[XB_XSUB(b.x)], 1u);
        const unsigned gen = old / nloc;
        if (old + 1u == (gen + 1u) * nloc) {
            __builtin_amdgcn_fence(__ATOMIC_RELEASE, "agent");
            asm volatile("s_waitcnt vmcnt(0)" ::: "memory");
            const unsigned og = xb_add(&bar[XB_TOP], 1u);
            const unsigned tg = og / nx;
            if (og + 1u == (tg + 1u) * nx) xb_add(&bar[XB_TOPGEN], 1u);
            else XB_SPIN(xb_ld(&bar[XB_TOPGEN]) == tg, bar);
            __builtin_amdgcn_fence(__ATOMIC_ACQUIRE, "agent");
            xb_add(&bar[XB_XGEN(b.x)], 1u);
            asm volatile("s_waitcnt vmcnt(0)" ::: "memory");
        } else {
            XB_SPIN(xb_ld(&bar[XB_XGEN(b.x)]) == gen, bar);
            __builtin_amdgcn_fence(__ATOMIC_ACQUIRE, "agent");
            asm volatile("s_waitcnt vmcnt(0)" ::: "memory");
        }
    }
    __syncthreads();
}
constexpr size_t MiB = 1u << 20;
constexpr size_t WS_CTL = 0, CTL_ZERO_BYTES = 1 * MiB;
constexpr size_t WS_W1T = 2 * MiB;
constexpr size_t WS_W2T = 10 * MiB;
constexpr size_t WS_W3T = 12 * MiB;
constexpr size_t WS_W4T = 24 * MiB;
constexpr size_t WS_RCOS = 28 * MiB, WS_RSIN = 33 * MiB;
constexpr size_t SZ_H = (size_t)MT * 1024 * 2;
constexpr size_t SZ_S = (size_t)MT * 512 * 2;
constexpr size_t WS_H = 40 * MiB;
constexpr size_t WS_QA = WS_H + 33 * MiB, WS_KA = WS_QA + 17 * MiB, WS_VAT = WS_KA + 17 * MiB, WS_GA = WS_VAT + 17 * MiB;
constexpr size_t WS_QB = WS_GA + 17 * MiB, WS_KB = WS_QB + 17 * MiB, WS_VB = WS_KB + 17 * MiB, WS_GB = WS_VB + 17 * MiB;
constexpr size_t WS_LOGF = WS_GB + 17 * MiB;
constexpr size_t WS_OB = WS_LOGF + 33 * MiB;
constexpr size_t WS_MIX = WS_OB + 33 * MiB;
constexpr size_t WS_Y1 = WS_MIX + 33 * MiB;
constexpr size_t WS_QC = WS_Y1 + 65 * MiB, WS_KC = WS_QC + 33 * MiB;
constexpr size_t WS_VC = WS_KC + 33 * MiB, WS_GC = WS_VC + 65 * MiB;
constexpr size_t WS_OC = WS_GC + 65 * MiB;
constexpr size_t WS_MIX2 = WS_OC + 130 * MiB;
constexpr size_t WS_AQ = WS_MIX2 + 65 * MiB;
constexpr size_t WS_KCH = WS_AQ + 64 * MiB;
constexpr size_t WS_KCT = WS_KCH + 32 * MiB;
constexpr size_t WS_BV = WS_KCT + 32 * MiB;
constexpr size_t WS_DST = WS_BV + 128 * MiB;
constexpr size_t WS_RCOST = WS_DST + 128 * MiB, WS_RSINT = WS_RCOST + 5 * MiB;
constexpr size_t WS_DSH = WS_RSINT + 5 * MiB;
constexpr size_t WS_SST = WS_DSH + 16 * MiB;
constexpr size_t WS_DD = WS_SST + 16 * MiB;
constexpr size_t WS_SLAB = WS_DD + 1 * MiB;
constexpr size_t WS_SLAB4 = WS_SLAB + 24 * MiB;
constexpr size_t WS_END = WS_SLAB4 + 8 * MiB;
constexpr size_t CTL_SS = 65536;
constexpr size_t CTL_SS1 = CTL_SS + (size_t)MP * 16;
constexpr size_t CTL_SSS = CTL_SS1 + (size_t)MT * 4;
static_assert(CTL_SSS + 4096 <= CTL_ZERO_BYTES, "SS / SS1 / SSS inside the zeroed region");
static_assert(SZ_H <= 33 * MiB && SZ_S <= 17 * MiB && (size_t)MT * 2048 * 4 <= 130 * MiB, "ws map");

constexpr int CW_TMO = 0, CW_CODE = 1, CW_BAR = 4096;

constexpr int RING_OFF = 0, RING_BYTES = 131072;
constexpr int LDSCTL_OFF = RING_BYTES, MISC_OFF = LDSCTL_OFF + 320;
constexpr int LDS_BYTES = 147456;
constexpr int NWAVES = 8;

typedef float f32x16 __attribute__((ext_vector_type(16)));
__device__ __forceinline__ float bf2f(bf16 b) { return __builtin_bit_cast(float, (unsigned)b << 16); }
__device__ __forceinline__ float bflo(unsigned w) { return __builtin_bit_cast(float, w << 16); }
__device__ __forceinline__ float bfhi(unsigned w) { return __builtin_bit_cast(float, w & 0xffff0000u); }
__device__ __forceinline__ int crow(int r, int hi) { return (r & 3) + 8 * (r >> 2) + 4 * hi; }
__device__ __forceinline__ float wave_sum(float v) {
#pragma unroll
    for (int o = 1; o < 64; o <<= 1) v += __shfl_xor(v, o);
    return v;
}

struct Frame {
    LAS unsigned char* lds;
    volatile LAS unsigned* MISC;
    gu32* ctl;
    int tid, lane, wave, G, bid;
    const float *xp, *xs, *ck, *cv, *st_h, *st_r, *ng, *w1, *w2, *qg, *kg, *sbb, *hlb, *og, *w3, *w4; const int* pt;
    float* out;
    unsigned char* ws;
    __device__ __forceinline__ float* SSS() const { return (float*)(ws + WS_CTL + CTL_SSS); }
    __device__ __forceinline__ float* SS1() const { return (float*)(ws + WS_CTL + CTL_SS1); }
    __device__ __forceinline__ bf16* SLAB() const { return (bf16*)(ws + WS_SLAB); }
    __device__ __forceinline__ bf16* Y1B() const { return (bf16*)(ws + WS_OB); }
    __device__ __forceinline__ bf16* SLAB4() const { return (bf16*)(ws + WS_SLAB4); }
    __device__ __forceinline__ bf16* W1T() const { return (bf16*)(ws + WS_W1T); }
    __device__ __forceinline__ bf16* W2T() const { return (bf16*)(ws + WS_W2T); }
    __device__ __forceinline__ bf16* W3T() const { return (bf16*)(ws + WS_W3T); }
    __device__ __forceinline__ bf16* W4T() const { return (bf16*)(ws + WS_W4T); }
    __device__ __forceinline__ bf16* H() const { return (bf16*)(ws + WS_H); }
    __device__ __forceinline__ bf16* QA() const { return (bf16*)(ws + WS_QA); }
    __device__ __forceinline__ bf16* KA() const { return (bf16*)(ws + WS_KA); }
    __device__ __forceinline__ bf16* VAT() const { return (bf16*)(ws + WS_VAT); }
    __device__ __forceinline__ bf16* VA() const { return (bf16*)(ws + WS_VAT); }
    __device__ __forceinline__ bf16* GA() const { return (bf16*)(ws + WS_GA); }
    __device__ __forceinline__ bf16* QB() const { return (bf16*)(ws + WS_QB); }
    __device__ __forceinline__ bf16* KB() const { return (bf16*)(ws + WS_KB); }
    __device__ __forceinline__ bf16* VB() const { return (bf16*)(ws + WS_VB); }
    __device__ __forceinline__ bf16* GB() const { return (bf16*)(ws + WS_GB); }
    __device__ __forceinline__ bf16* MIX() const { return (bf16*)(ws + WS_MIX); }
    __device__ __forceinline__ bf16* QC() const { return (bf16*)(ws + WS_QC); }
    __device__ __forceinline__ bf16* KC() const { return (bf16*)(ws + WS_KC); }
    __device__ __forceinline__ bf16* VC() const { return (bf16*)(ws + WS_VC); }
    __device__ __forceinline__ bf16* GC() const { return (bf16*)(ws + WS_GC); }
    __device__ __forceinline__ bf16* MIX2() const { return (bf16*)(ws + WS_MIX2); }
    __device__ __forceinline__ float* RCOS() const { return (float*)(ws + WS_RCOS); }
    __device__ __forceinline__ float* RSIN() const { return (float*)(ws + WS_RSIN); }
    __device__ __forceinline__ float* LOGF() const { return (float*)(ws + WS_LOGF); }
    __device__ __forceinline__ float* OB() const { return (float*)(ws + WS_OB); }
    __device__ __forceinline__ float* Y1() const { return (float*)(ws + WS_Y1); }
    __device__ __forceinline__ float* OC() const { return (float*)(ws + WS_OC); }
    __device__ __forceinline__ bf16* AQ() const { return (bf16*)(ws + WS_AQ); }
    __device__ __forceinline__ bf16* KCH() const { return (bf16*)(ws + WS_KCH); }
    __device__ __forceinline__ bf16* KCT() const { return (bf16*)(ws + WS_KCT); }
    __device__ __forceinline__ bf16* BV() const { return (bf16*)(ws + WS_BV); }
    __device__ __forceinline__ float* DST() const { return (float*)(ws + WS_DST); }
    __device__ __forceinline__ float* RCOST() const { return (float*)(ws + WS_RCOST); }
    __device__ __forceinline__ float* RSINT() const { return (float*)(ws + WS_RSINT); }
    __device__ __forceinline__ float* SS() const { return (float*)(ws + WS_CTL + CTL_SS); }
    __device__ __forceinline__ float* DSH() const { return (float*)(ws + WS_DSH); }
    __device__ __forceinline__ float* SST() const { return (float*)(ws + WS_SST); }
    __device__ __forceinline__ float* DD() const { return (float*)(ws + WS_DD); }
};

template <bool HP>
__device__ __forceinline__ void p0_transpose_item(const float* W, int K, int N, bf16* WT, LAS float* scr, int item, int lane, const float* gk = nullptr) {
    const int nblk = N / 32, kb = item / nblk, nb = item % nblk, k0 = 64 * kb, n0 = 32 * nb;
#pragma unroll 8
    for (int i = 0; i < 32; ++i) { const int kk = 2 * i + (lane >> 5); float w = W[(size_t)(k0 + kk) * N + n0 + (lane & 31)]; if (gk) w *= gk[k0 + kk]; scr[kk * 33 + (lane & 31)] = w; }
    LDS_WAIT(); asm volatile("" ::: "memory");
    const int c = lane & 7;
#pragma unroll
    for (int j = 0; j < 4; ++j) { const int n = (lane >> 3) + 8 * j; const LAS float* s = scr + (8 * c) * 33 + n;
        v4u o; o.x = pk2(s[0 * 33], s[1 * 33]); o.y = pk2(s[2 * 33], s[3 * 33]); o.z = pk2(s[4 * 33], s[5 * 33]); o.w = pk2(s[6 * 33], s[7 * 33]);
        int ca = n0 + n;
        if (HP) ca = (ca & ~255) | (((ca >> 5) & 1) << 7) | (((ca >> 6) & 3) << 5) | (ca & 31);
        *(GAS v4u*)(WT + (size_t)ca * K + k0 + 8 * c) = o; }
    LDS_WAIT(); asm volatile("" ::: "memory");
}
__device__ __forceinline__ void rms_row_to_bf16(int lane, const float* xrow, const float* g, bf16* orow) {
    const GAS f32x4* xr = (const GAS f32x4*)xrow + lane;
    f32x4 v[4]; float s2 = 0.f;
#pragma unroll
    for (int j = 0; j < 4; ++j) { v[j] = xr[64 * j]; s2 += (v[j].x * v[j].x + v[j].y * v[j].y) + (v[j].z * v[j].z + v[j].w * v[j].w); }
    const float rstd = 1.f / sqrtf(wave_sum(s2) * (1.f / 1024.f) + EPS);
    GAS unsigned long long* o8 = (GAS unsigned long long*)orow + lane;
#pragma unroll
    for (int j = 0; j < 4; ++j) { const f32x4 gv = *((const GAS f32x4*)g + lane + 64 * j);
        o8[64 * j] = (unsigned long long)pk2(v[j].x * rstd * gv.x, v[j].y * rstd * gv.y) | ((unsigned long long)pk2(v[j].z * rstd * gv.z, v[j].w * rstd * gv.w) << 32); }
}
__device__ __forceinline__ void sincos_acc(float a, float& s, float& c) {
    const double x = (double)a;
    const double kd = __builtin_rint(x * 0.63661977236758134308);
    const double r = (x - kd * 1.57079632673412561417e+00) - kd * 6.07710050650619224932e-11;
    const double r2 = r * r;
    const double sp = r * (1.0 + r2 * (-1.66666666666666324348e-01 + r2 * (8.33333333332248946124e-03 + r2 * (-1.98412698298579493134e-04 + r2 * (2.75573137070700676789e-06 + r2 * (-2.50507602534068634195e-08 + r2 * 1.58969099521155010221e-10))))));
    const double cp = 1.0 + r2 * (-0.5 + r2 * (4.16666666666666019037e-02 + r2 * (-1.38888888888741095749e-03 + r2 * (2.48015872894767294178e-05 + r2 * (-2.75573143513906633035e-07 + r2 * (2.08757232129817482790e-09 + r2 * -1.13596475577881948265e-11))))));
    const int q = (int)((long long)kd & 3);
    const double sv = (q & 1) ? cp : sp, cv = (q & 1) ? sp : cp;
    s = (float)((q & 2) ? -sv : sv);
    c = (float)(((q + 1) & 2) ? -cv : cv);
}
__device__ __forceinline__ void p0_prologue(Frame& F) {
    LAS float* scr = (LAS float*)(F.lds + RING_OFF + F.wave * 16384);
    const int gw = F.bid * NWAVES + F.wave, NGW = F.G * NWAVES;
    constexpr int I1 = (1024 / 64) * (N1 / 32), I2 = (1024 / 64) * (1024 / 32), I3 = (1024 / 64) * (N3 / 32), I4 = (2048 / 64) * (1024 / 32);
    for (int it = gw; it < I1 + I2 + I3 + I4; it += NGW) {
        int r = it;
        if (r < I1) { p0_transpose_item<true>(F.w1, 1024, N1, F.W1T(), scr, r, F.lane); continue; } r -= I1;
        if (r < I2) { p0_transpose_item<false>(F.w2, 1024, 1024, F.W2T(), scr, r, F.lane); continue; } r -= I2;
        if (r < I3) { p0_transpose_item<false>(F.w3, 1024, N3, F.W3T(), scr, r, F.lane, F.ng + 1024); continue; } r -= I3;
        p0_transpose_item<false>(F.w4, 2048, 1024, F.W4T(), scr, r, F.lane);
    }
    {
        f32x4 gv[4], cur[4];
#pragma unroll
        for (int j = 0; j < 4; ++j) gv[j] = *((const GAS f32x4*)F.ng + F.lane + 64 * j);
        int m = gw;
        if (m < MT) { const float* xr = (m < MP) ? F.xp + (size_t)m * DM : F.xs + (size_t)(m - MP) * DM;
#pragma unroll
            for (int j = 0; j < 4; ++j) cur[j] = *((const GAS f32x4*)xr + F.lane + 64 * j); }
        while (m < MT) {
            const int mn = m + NGW; f32x4 nxt[4];
            if (mn < MT) { const float* xr = (mn < MP) ? F.xp + (size_t)mn * DM : F.xs + (size_t)(mn - MP) * DM;
#pragma unroll
                for (int j = 0; j < 4; ++j) nxt[j] = *((const GAS f32x4*)xr + F.lane + 64 * j); }
            float s2 = 0.f;
#pragma unroll
            for (int j = 0; j < 4; ++j) s2 += (cur[j].x * cur[j].x + cur[j].y * cur[j].y) + (cur[j].z * cur[j].z + cur[j].w * cur[j].w);
            const float rstd = 1.f / sqrtf(wave_sum(s2) * (1.f / 1024.f) + EPS);
            GAS unsigned long long* o8 = (GAS unsigned long long*)(F.H() + (size_t)m * DM) + F.lane;
#pragma unroll
            for (int j = 0; j < 4; ++j)
                o8[64 * j] = (unsigned long long)pk2(cur[j].x * rstd * gv[j].x, cur[j].y * rstd * gv[j].y) | ((unsigned long long)pk2(cur[j].z * rstd * gv[j].z, cur[j].w * rstd * gv[j].w) << 32);
#pragma unroll
            for (int j = 0; j < 4; ++j) cur[j] = nxt[j];
            m = mn;
        }
    }
    const int ri = F.tid & 127;
    const float rinv = (float)(1.0 / exp2((double)((float)ri / 127.0f) * 13.287712379549449));
    for (int e = F.bid * (NWAVES * 64) + F.tid; e < (PAST + TSQ) * 128; e += F.G * NWAVES * 64) {
        const int pos = e >> 7, i = ri;
        const float inv = rinv;
        const float ang = (float)pos * inv;
        float s, c; sincos_acc(ang, s, c);
        F.RCOS()[e] = c; F.RSIN()[e] = s;
    }
}

__device__ __forceinline__ void sb_tile(f32x16& p0, f32x16& p1, float& carry, int hi, int kb0, int qpos, bool need_mask, v4u (&pw)[4]) {
#pragma unroll
    for (int r = 0; r < 16; ++r) {
        float b0 = __builtin_amdgcn_rcpf(1.f + __builtin_amdgcn_exp2f(p0[r]));
        float b1 = __builtin_amdgcn_rcpf(1.f + __builtin_amdgcn_exp2f(p1[r]));
        if (need_mask) { if (kb0 + r >= qpos) b0 = 0.f; if (kb0 + 32 + r >= qpos) b1 = 0.f; }
        p0[r] = b0; p1[r] = b1;
    }
    float s0 = 1.f, s1 = 1.f;
#pragma unroll
    for (int r = 15; r >= 0; --r) {
        const float b0 = p0[r], b1 = p1[r];
        p0[r] = b0 * s0; p1[r] = b1 * s1;
        s0 = __builtin_fmaf(-s0, b0, s0); s1 = __builtin_fmaf(-s1, b1, s1);
    }
    float t0, t1;
    {
      auto a = __builtin_amdgcn_permlane32_swap(__float_as_uint(s0), __float_as_uint(s0), false, false);
      auto b = __builtin_amdgcn_permlane32_swap(__float_as_uint(s1), __float_as_uint(s1), false, false);
      t0 = hi ? __uint_as_float(a[0]) : __uint_as_float(a[1]); t1 = hi ? __uint_as_float(b[0]) : __uint_as_float(b[1]); }
    const float pre1 = hi ? carry : carry * t1;
    const float pre0 = hi ? carry * s1 * t1 : carry * t1 * s1 * t0;
    carry = carry * ((s0 * s1) * (t0 * t1));
#pragma unroll
    for (int r = 0; r < 16; ++r) { p0[r] *= pre0; p1[r] *= pre1; }
    pw[0] = (v4u){pg8::cvt_pk_bf16(p0[0], p0[1]), pg8::cvt_pk_bf16(p0[2], p0[3]), pg8::cvt_pk_bf16(p0[4], p0[5]), pg8::cvt_pk_bf16(p0[6], p0[7])};
    pw[1] = (v4u){pg8::cvt_pk_bf16(p0[8], p0[9]), pg8::cvt_pk_bf16(p0[10], p0[11]), pg8::cvt_pk_bf16(p0[12], p0[13]), pg8::cvt_pk_bf16(p0[14], p0[15])};
    pw[2] = (v4u){pg8::cvt_pk_bf16(p1[0], p1[1]), pg8::cvt_pk_bf16(p1[2], p1[3]), pg8::cvt_pk_bf16(p1[4], p1[5]), pg8::cvt_pk_bf16(p1[6], p1[7])};
    pw[3] = (v4u){pg8::cvt_pk_bf16(p1[8], p1[9]), pg8::cvt_pk_bf16(p1[10], p1[11]), pg8::cvt_pk_bf16(p1[12], p1[13]), pg8::cvt_pk_bf16(p1[14], p1[15])};
}
typedef float f32x2v __attribute__((ext_vector_type(2)));
__device__ __forceinline__ void sb_tile2(f32x16& p0, f32x16& p1, float& carry, int hi, int kb0, int qpos, bool need_mask, v4u (&pw)[4]) {
#pragma unroll
    for (int r = 0; r < 16; ++r) { p0[r] = __builtin_amdgcn_exp2f(p0[r]); p1[r] = __builtin_amdgcn_exp2f(p1[r]); }
#define SB_INV4(P, j0) do { const f32x2v ea_ = {P[2 * (j0)], P[2 * (j0) + 1]}, eb_ = {P[2 * (j0) + 2], P[2 * (j0) + 3]}, ec_ = {P[2 * (j0) + 4], P[2 * (j0) + 5]}, ed_ = {P[2 * (j0) + 6], P[2 * (j0) + 7]}; \
        const f32x2v b_ = eb_ + (f32x2v){1.f, 1.f}; const f32x2v ab_ = ea_ * b_ + b_, abc_ = ab_ * ec_ + ab_, abcd_ = abc_ * ed_ + abc_; \
        f32x2v R_ = {__builtin_amdgcn_rcpf(abcd_.x), __builtin_amdgcn_rcpf(abcd_.y)}; \
        const f32x2v id_ = R_ * abc_; R_ = R_ * ed_ + R_; const f32x2v ic_ = R_ * ab_; R_ = R_ * ec_ + R_; const f32x2v ib_ = R_ * ea_ + R_, ia_ = R_ * b_; \
        P[2 * (j0)] = ia_.x; P[2 * (j0) + 1] = ia_.y; P[2 * (j0) + 2] = ib_.x; P[2 * (j0) + 3] = ib_.y; P[2 * (j0) + 4] = ic_.x; P[2 * (j0) + 5] = ic_.y; P[2 * (j0) + 6] = id_.x; P[2 * (j0) + 7] = id_.y; } while (0)
    SB_INV4(p0, 0); SB_INV4(p1, 0); SB_INV4(p0, 4); SB_INV4(p1, 4);
#undef SB_INV4
    if (need_mask) {
        asm volatile("" ::: "memory");
#pragma unroll
        for (int r = 0; r < 16; ++r) { const int kk = kb0 + 8 * (1 - (r & 1)) + (r >> 1); if (kk >= qpos) p0[r] = 0.f; if (kk + 32 >= qpos) p1[r] = 0.f; }
    }
    f32x2v s0 = {1.f, 1.f}, s1 = {1.f, 1.f};
#pragma unroll
    for (int k = 7; k >= 0; --k) {
        const f32x2v b0 = {p0[2 * k], p0[2 * k + 1]}, b1 = {p1[2 * k], p1[2 * k + 1]};
        const f32x2v w0 = b0 * s0, w1 = b1 * s1;
        s0 = s0 - s0 * b0; s1 = s1 - s1 * b1;
        p0[2 * k] = w0.x; p0[2 * k + 1] = w0.y; p1[2 * k] = w1.x; p1[2 * k + 1] = w1.y;
    }
    const float a0 = s0.x * s0.y, a1 = s1.x * s1.y;
    float t0, t1;
    { auto a = __builtin_amdgcn_permlane32_swap(__float_as_uint(a0), __float_as_uint(a0), false, false);
      auto b = __builtin_amdgcn_permlane32_swap(__float_as_uint(a1), __float_as_uint(a1), false, false);
      t0 = hi ? __uint_as_float(a[0]) : __uint_as_float(a[1]); t1 = hi ? __uint_as_float(b[0]) : __uint_as_float(b[1]); }
    const float pre1 = hi ? carry : carry * t1;
    const float pre0 = hi ? carry * a1 * t1 : carry * t1 * a1 * t0;
    carry = carry * ((a0 * a1) * (t0 * t1));
    const f32x2v q0 = {pre0, pre0 * s0.x}, q1 = {pre1, pre1 * s1.x};
#pragma unroll
    for (int k = 0; k < 8; ++k) { const f32x2v w0 = (f32x2v){p0[2 * k], p0[2 * k + 1]} * q0, w1 = (f32x2v){p1[2 * k], p1[2 * k + 1]} * q1;
        p0[2 * k] = w0.x; p0[2 * k + 1] = w0.y; p1[2 * k] = w1.x; p1[2 * k + 1] = w1.y; }
    pw[0] = (v4u){pg8::cvt_pk_bf16(p0[1], p0[3]), pg8::cvt_pk_bf16(p0[5], p0[7]), pg8::cvt_pk_bf16(p0[9], p0[11]), pg8::cvt_pk_bf16(p0[13], p0[15])};
    pw[1] = (v4u){pg8::cvt_pk_bf16(p0[0], p0[2]), pg8::cvt_pk_bf16(p0[4], p0[6]), pg8::cvt_pk_bf16(p0[8], p0[10]), pg8::cvt_pk_bf16(p0[12], p0[14])};
    pw[2] = (v4u){pg8::cvt_pk_bf16(p1[1], p1[3]), pg8::cvt_pk_bf16(p1[5], p1[7]), pg8::cvt_pk_bf16(p1[9], p1[11]), pg8::cvt_pk_bf16(p1[13], p1[15])};
    pw[3] = (v4u){pg8::cvt_pk_bf16(p1[0], p1[2]), pg8::cvt_pk_bf16(p1[4], p1[6]), pg8::cvt_pk_bf16(p1[8], p1[10]), pg8::cvt_pk_bf16(p1[12], p1[14])};
}
#define MFMA32(a, b, c) __builtin_amdgcn_mfma_f32_32x32x16_bf16((a), (b), (c), 0, 0, 0)
__device__ __forceinline__ f32x16 splat16(float v) { f32x16 r;
#pragma unroll
    for (int i = 0; i < 16; ++i) r[i] = v; return r; }

__device__ __forceinline__ bf16x8 cvt8(const f32x4 a, const f32x4 b) { return __builtin_bit_cast(bf16x8, pg8::pack8(a, b)); }

__device__ __forceinline__ void ret_passB(Frame& F) {
    for (int e = F.bid * (NWAVES * 64) + F.tid; e < 8 * 512 * 32; e += F.G * NWAVES * 64) {
        const int bh = e >> 14, dv = (e >> 5) & 511, dk8 = (e & 31) * 8, h = bh & 3;
        const float lg = pg8::lg2gamma(h), g1 = 1.f - __builtin_amdgcn_exp2f(-5.f - (float)h), g255 = __builtin_amdgcn_exp2f(255.f * lg), g256 = __builtin_amdgcn_exp2f(256.f * lg);
        f32x4 S0 = {0.f, 0.f, 0.f, 0.f}, S1 = {0.f, 0.f, 0.f, 0.f};
        for (int c0 = 0; c0 < 32; c0 += 16) {
            v4u dq[16];
#pragma unroll
            for (int j = 0; j < 16; ++j) dq[j] = *(const v4u*)((const bf16*)F.DST() + ((size_t)(bh * 32 + c0 + j) * 512 + dv) * 256 + dk8);
#pragma unroll
            for (int j = 0; j < 16; ++j) { const size_t ro = (size_t)(bh * 32 + c0 + j) * 512 + dv;
                const f32x4 d0 = {bflo(dq[j][0]), bfhi(dq[j][0]), bflo(dq[j][1]), bfhi(dq[j][1])}, d1 = {bflo(dq[j][2]), bfhi(dq[j][2]), bflo(dq[j][3]), bfhi(dq[j][3])};
                *(pg8::u32x4*)(F.BV() + ro * 512 + 256 + dk8) = pg8::pack8(S0 * g1, S1 * g1);
                S0 = S0 * g256 + d0 * g255; S1 = S1 * g256 + d1 * g255; }
        }
        float* so = F.out + ORT_P + ((size_t)bh * 256 + dk8) * 512 + dv;
#pragma unroll
        for (int i = 0; i < 4; ++i) { so[(size_t)i * 512] = S0[i]; so[(size_t)(i + 4) * 512] = S1[i]; }
    }
}

typedef unsigned u32x2 __attribute__((ext_vector_type(2)));
constexpr int HQ_STR = 136, HT_STR = 72;
constexpr int H_QT = 0, H_KH = 17408, H_KHT = 34816, H_VT = 53248, H_PP = 71680, H_CS = 80896, H_RR = 82944, H_A63 = 83456, H_C63 = 83968, H_SSQ = 84480;
#define MFMA16(a, b, c) __builtin_amdgcn_mfma_f32_16x16x32_bf16((a), (b), (c), 0, 0, 0)
__device__ __forceinline__ void hgrn_passB(Frame& F) {
    const int vb = (F.bid + F.G / 2) % F.G;
    for (int e = vb * (NWAVES * 64) + F.tid; e < 8 * 128 * 32; e += F.G * NWAVES * 64) {
        const int bh = e >> 12, dk = (e >> 5) & 127, dv4 = (e & 31) * 4;
        f32x4 S = {0.f, 0.f, 0.f, 0.f};
        for (int s0 = 0; s0 < 32; s0 += 16) {
            f32x4 dv[16]; float dd[16];
#pragma unroll
            for (int j = 0; j < 16; ++j) { dv[j] = *(const f32x4*)(F.DSH() + ((size_t)(bh * 32 + s0 + j) * 128 + dk) * 128 + dv4); dd[j] = F.DD()[(size_t)(bh * 32 + s0 + j) * 128 + dk]; }
#pragma unroll
            for (int j = 0; j < 16; ++j) { *(f32x4*)(F.SST() + ((size_t)(bh * 32 + s0 + j) * 128 + dk) * 128 + dv4) = S; S = S * __expf(dd[j]) + dv[j]; }
        }
        *(f32x4*)(F.out + OHG_P + ((size_t)bh * 128 + dk) * 128 + dv4) = S;
    }
}

__device__ __forceinline__ void ret_sample_unit(Frame& F, int s, int h, int vhalf) {
    const int tid = F.tid, v = tid & 255, kh = tid >> 8, col = vhalf * 256 + v;
    LAS float* QL = (LAS float*)(F.lds + RING_OFF);
    LAS float* KL = QL + 8 * 256;
    LAS float* OP = KL + 8 * 256;
    const size_t row0 = (size_t)MP + s * 8;
    for (int e = tid; e < 8 * 256; e += NWAVES * 64) { const int t = e >> 8, kk = e & 255;
        QL[e] = bf2f(F.QC()[(row0 + t) * 1024 + h * 256 + kk]); KL[e] = bf2f(F.KC()[(row0 + t) * 1024 + h * 256 + kk]); }
    float vt[8];
#pragma unroll
    for (int t = 0; t < 8; ++t) vt[t] = bf2f(F.VC()[(row0 + t) * 2048 + h * 512 + col]);
    const float gamma = 1.f - __builtin_amdgcn_exp2f(-5.f - (float)h);
    float S[128];
    const float* s0 = F.st_r + (((size_t)s * HC + h) * DKC + kh * 128) * DVC + col;
#pragma unroll
    for (int i = 0; i < 128; ++i) S[i] = s0[(size_t)i * DVC];
    __syncthreads();
    float o[8];
#pragma unroll
    for (int t = 0; t < 8; ++t) {
        float acc = 0.f;
#pragma unroll
        for (int i4 = 0; i4 < 32; ++i4) {
            const f32x4 kq = *(const LAS f32x4*)(KL + t * 256 + kh * 128 + 4 * i4), qq = *(const LAS f32x4*)(QL + t * 256 + kh * 128 + 4 * i4);
#pragma unroll
            for (int j = 0; j < 4; ++j) { S[4 * i4 + j] = gamma * S[4 * i4 + j] + kq[j] * vt[t]; acc += qq[j] * S[4 * i4 + j]; }
        }
        o[t] = acc;
    }
#pragma unroll
    for (int t = 0; t < 8; ++t) OP[(kh * 8 + t) * 256 + v] = o[t];
    float* so = F.out + ORT_S + (((size_t)s * HC + h) * DKC + kh * 128) * DVC + col;
#pragma unroll
    for (int i = 0; i < 128; ++i) so[(size_t)i * DVC] = S[i];
    __syncthreads();
    for (int e = tid; e < 8 * 256; e += NWAVES * 64) {
        const int t = e >> 8, vv = e & 255; const float ov = OP[e] + OP[8 * 256 + e];
        const size_t gi = (row0 + t) * 2048 + h * 512 + vhalf * 256 + vv;
        F.MIX2()[gi] = pg8::bf1(ov * bf2f(F.GC()[gi]));
        const float sq = wave_sum(ov * ov);
        if (F.lane == 0) atomicAdd(F.SSS() + (s * 8 + t) * 4 + h, sq);
    }
    __syncthreads();
}
__device__ __forceinline__ void hgrn_sample_unit(Frame& F, int s, int h) {
    const int tid = F.tid, v = tid & 127, kq = tid >> 7;
    LAS float* FL = (LAS float*)(F.lds + RING_OFF);
    LAS float* KL = FL + 8 * 128; LAS float* QL = KL + 8 * 128; LAS float* OP = QL + 8 * 128;
    const size_t row0 = (size_t)MP + s * 8;
    for (int e = tid; e < 8 * 128; e += NWAVES * 64) { const int t = e >> 7, kk = e & 127; const size_t gi = (row0 + t) * 512 + h * 128 + kk;
        FL[e] = __expf(F.LOGF()[gi]); KL[e] = bf2f(F.KB()[gi]); QL[e] = bf2f(F.QB()[gi]); }
    float vt[8];
#pragma unroll
    for (int t = 0; t < 8; ++t) vt[t] = bf2f(F.VB()[(row0 + t) * 512 + h * 128 + v]);
    float S[32];
    const float* s0 = F.st_h + (((size_t)s * HB + h) * DKB + kq * 32) * DVB + v;
#pragma unroll
    for (int i = 0; i < 32; ++i) S[i] = s0[(size_t)i * DVB];
    __syncthreads();
#pragma unroll
    for (int t = 0; t < 8; ++t) {
        float acc = 0.f;
#pragma unroll
        for (int i4 = 0; i4 < 8; ++i4) {
            const f32x4 ff = *(const LAS f32x4*)(FL + t * 128 + kq * 32 + 4 * i4), kk = *(const LAS f32x4*)(KL + t * 128 + kq * 32 + 4 * i4), qq = *(const LAS f32x4*)(QL + t * 128 + kq * 32 + 4 * i4);
#pragma unroll
            for (int j = 0; j < 4; ++j) { S[4 * i4 + j] = ff[j] * S[4 * i4 + j] + kk[j] * vt[t]; acc += qq[j] * S[4 * i4 + j]; }
        }
        OP[(kq * 8 + t) * 128 + v] = acc;
    }
    float* so = F.out + OHG_S + (((size_t)s * HB + h) * DKB + kq * 32) * DVB + v;
#pragma unroll
    for (int i = 0; i < 32; ++i) so[(size_t)i * DVB] = S[i];
    __syncthreads();
    {
        const int t = F.wave, c0 = 2 * F.lane;
        float a = 0.f, b = 0.f;
#pragma unroll
        for (int q4 = 0; q4 < 4; ++q4) { a += OP[(q4 * 8 + t) * 128 + c0]; b += OP[(q4 * 8 + t) * 128 + c0 + 1]; }
        const float rstd = 1.f / sqrtf(wave_sum(a * a + b * b) * (1.f / 128.f) + EPS);
        const size_t row = row0 + t;
        const unsigned gt = *(const unsigned*)(F.GB() + row * 512 + h * 128 + c0);
        *(unsigned*)(F.MIX() + row * 1024 + 512 + h * 128 + c0) = pg8::cvt_pk_bf16(a * rstd * F.og[c0] * bflo(gt), b * rstd * F.og[c0 + 1] * bfhi(gt));
    }
    __syncthreads();
}

constexpr int AT_K = 0, AT_V = 24576, AT_O = 49152, AT_SLOT = 8192;
__device__ __forceinline__ void glds16(const void* gsrc, unsigned lds_dst) { unsigned keep;
    asm volatile("s_mov_b32 %0, m0\n\ts_mov_b32 m0, %2\n\ts_nop 0\n\tglobal_load_lds_dwordx4 %1, off\n\ts_mov_b32 m0, %0" : "=&s"(keep) : "v"(gsrc), "s"(lds_dst) : "memory"); }
typedef short v4i16_t __attribute__((ext_vector_type(4)));
__device__ __forceinline__ v4i16_t vtr(const LAS unsigned char* p) { return __builtin_amdgcn_ds_read_tr16_b64_v4i16((LAS v4i16_t*)p); }

__device__ __forceinline__ void bf8_add(const bf16* p, f32x4& a, f32x4& b) { const v4u w = *(const v4u*)p; a[0] += bflo(w[0]); a[1] += bfhi(w[0]); a[2] += bflo(w[1]); a[3] += bfhi(w[1]); b[0] += bflo(w[2]); b[1] += bfhi(w[2]); b[2] += bflo(w[3]); b[3] += bfhi(w[3]); }
__device__ __forceinline__ void slab_sum8(const bf16* slab, int nparts, size_t pstride, size_t off, f32x4& a, f32x4& b) {
    a = (f32x4){0.f, 0.f, 0.f, 0.f}; b = a;
    for (int p = 0; p < nparts; ++p) bf8_add(slab + p * pstride + off, a, b);
}
__device__ __forceinline__ void pp1_item(Frame& F, int item) {
    const int r = item >> 3, gi = item & 7, lane = F.lane, c = lane * 8, a0 = gi * 512 + c;
    const int g0 = (a0 & ~255) | (((a0 >> 5) & 1) << 7) | (((a0 >> 6) & 3) << 5) | (a0 & 31);
    f32x4 x, y; slab_sum8(F.SLAB(), 4, (size_t)256 * N1, (size_t)r * N1 + g0, x, y);
    const size_t row = (size_t)MP + r;
    if (gi <= 1) {
        float ss = (x[0] * x[0] + x[1] * x[1]) + (x[2] * x[2] + x[3] * x[3]) + (y[0] * y[0] + y[1] * y[1]) + (y[2] * y[2] + y[3] * y[3]);
        ss += __shfl_xor(ss, 1); ss += __shfl_xor(ss, 2); ss += __shfl_xor(ss, 4);
        const float rstd = __builtin_amdgcn_rsqf(ss * (1.f / 64.f) + EPS) * (gi == 0 ? -0.125f * LOG2E : 1.f);
        const float* g = (gi == 0 ? F.qg : F.kg) + (c & 63);
        x = x * *(const f32x4*)g * rstd; y = y * *(const f32x4*)(g + 4) * rstd;
        if (gi == 0) *(pg8::u32x4*)(F.QA() + row * 512 + c) = pg8::pack8(x, y);
        else { *(pg8::u32x4*)(F.KA() + row * 512 + c) = pg8::pack8(x, y); float* ko = F.out + OK_S + (size_t)r * 512 + c; *(f32x4*)ko = x; *(f32x4*)(ko + 4) = y; }
    } else if (gi == 2) {
        *(pg8::u32x4*)(F.VA() + row * 512 + c) = pg8::pack8(x, y); float* vo = F.out + OV_S + (size_t)r * 512 + c; *(f32x4*)vo = x; *(f32x4*)(vo + 4) = y;
    } else if (gi == 5) {
        f32x4 lf0, lf1, k0, k1;
#pragma unroll
        for (int e = 0; e < 8; ++e) { const int cc = c + e; const float lb = __builtin_amdgcn_rcpf(1.f + __expf(F.hlb[512 + cc] - F.hlb[cc])); const float v = e < 4 ? x[e & 3] : y[e & 3];
            const float sg = pg8::sigm_f(v); const float lf = __logf(lb + (1.f - lb) * sg), kk = (1.f - lb) * (1.f - sg);
            if (e < 4) { lf0[e & 3] = lf; k0[e & 3] = kk; } else { lf1[e & 3] = lf; k1[e & 3] = kk; } }
        *(f32x4*)(F.LOGF() + row * 512 + c) = lf0; *(f32x4*)(F.LOGF() + row * 512 + c + 4) = lf1;
        *(pg8::u32x4*)(F.KB() + row * 512 + c) = pg8::pack8(k0, k1);
    } else {
        bf16* dst = (gi == 3) ? F.GA() : (gi == 4) ? F.QB() : (gi == 6) ? F.VB() : F.GB();
        if (gi != 6) {
#pragma unroll
            for (int e = 0; e < 4; ++e) { x[e] = pg8::silu_f(x[e]); y[e] = pg8::silu_f(y[e]); } }
        *(pg8::u32x4*)(dst + row * 512 + c) = pg8::pack8(x, y);
    }
}
__device__ __forceinline__ void pp2_row(Frame& F, int r) {
    const int lane = F.lane; f32x4 v[4]; float s2 = 0.f;
#pragma unroll
    for (int j = 0; j < 2; ++j) { const int c = 8 * lane + 512 * j; f32x4 a, b2; slab_sum8(F.SLAB(), 4, (size_t)256 * 1024, (size_t)r * 1024 + c, a, b2);
        a += *(const f32x4*)(F.xs + (size_t)r * DM + c); b2 += *(const f32x4*)(F.xs + (size_t)r * DM + c + 4);
        *(f32x4*)(F.Y1() + ((size_t)MP + r) * DM + c) = a; *(f32x4*)(F.Y1() + ((size_t)MP + r) * DM + c + 4) = b2;
        s2 += (a[0] * a[0] + a[1] * a[1]) + (a[2] * a[2] + a[3] * a[3]) + (b2[0] * b2[0] + b2[1] * b2[1]) + (b2[2] * b2[2] + b2[3] * b2[3]);
        v[2 * j] = a; v[2 * j + 1] = b2; }
    s2 = wave_sum(s2); if (lane == 0) F.SS1()[MP + r] = s2;
#pragma unroll
    for (int j = 0; j < 2; ++j) { const int c = 8 * lane + 512 * j;
        *(pg8::u32x4*)(F.H() + ((size_t)MP + r) * DM + c) = pg8::pack8(v[2 * j], v[2 * j + 1]); }
}
__device__ __forceinline__ void pp3_item(Frame& F, int item) {
    const int r = item / 24, pn = item % 24, lane = F.lane; const size_t row = (size_t)MP + r;
    if (lane >= 32) return;
    const size_t off = (size_t)r * N3 + pn * 256, ps = (size_t)256 * N3;
    const float rs = __builtin_amdgcn_rsqf(F.SS1()[MP + r] * (1.f / 1024.f) + EPS);
    if (pn < 8) {
        const int j = 8 * (lane & 15), up = lane >> 4;
        f32x4 x1a, x1b, x2a, x2b; slab_sum8(F.SLAB(), 4, ps, off + j, x1a, x1b); slab_sum8(F.SLAB(), 4, ps, off + 128 + j, x2a, x2b);
        const int pos = PAST + (r & 7);
        const f32x4 ca = *(const f32x4*)(F.RCOS() + (size_t)pos * 128 + j), cb = *(const f32x4*)(F.RCOS() + (size_t)pos * 128 + j + 4), sa = *(const f32x4*)(F.RSIN() + (size_t)pos * 128 + j), sb = *(const f32x4*)(F.RSIN() + (size_t)pos * 128 + j + 4);
        const float sc = rs * (pn < 4 ? 1.f : 0.0625f);
        const f32x4 oa = (up ? (x2a * ca + x1a * sa) : (x1a * ca - x2a * sa)) * sc, ob = (up ? (x2b * cb + x1b * sb) : (x1b * cb - x2b * sb)) * sc;
        *(pg8::u32x4*)((pn < 4 ? F.QC() : F.KC()) + row * 1024 + (pn & 3) * 256 + up * 128 + j) = pg8::pack8(oa, ob);
    } else {
        const int j = 8 * lane; f32x4 xa, xb; slab_sum8(F.SLAB(), 4, ps, off + j, xa, xb);
        xa = xa * rs; xb = xb * rs;
        const bool isg = pn >= 16;
        if (isg) {
#pragma unroll
            for (int e = 0; e < 4; ++e) { xa[e] = pg8::silu_f(xa[e]); xb[e] = pg8::silu_f(xb[e]); } }
        *(pg8::u32x4*)((isg ? F.GC() : F.VC()) + row * 2048 + ((pn - 8) & 7) * 256 + j) = pg8::pack8(xa, xb);
    }
}
__device__ __forceinline__ void pp4_row(Frame& F, int r) {
    float rs[4];
#pragma unroll
    for (int hh = 0; hh < 4; ++hh) rs[hh] = __builtin_amdgcn_rsqf(F.SSS()[r * 4 + hh] * (1.f / 512.f) + EPS);
#pragma unroll
    for (int j = 0; j < 2; ++j) { const int c = 8 * F.lane + 512 * j;
        f32x4 a = *(const f32x4*)(F.Y1() + ((size_t)MP + r) * DM + c), b2 = *(const f32x4*)(F.Y1() + ((size_t)MP + r) * DM + c + 4);
#pragma unroll
        for (int p = 0; p < 8; ++p) { f32x4 pa = {0.f, 0.f, 0.f, 0.f}, pb = pa; bf8_add(F.SLAB4() + ((size_t)p * 256 + r) * 1024 + c, pa, pb); a += pa * rs[p >> 1]; b2 += pb * rs[p >> 1]; }
        *(f32x4*)(F.out + OY_S + (size_t)r * DM + c) = a; *(f32x4*)(F.out + OY_S + (size_t)r * DM + c + 4) = b2; }
}

constexpr int G_QT = 0, G_KH = 17408, G_VV = 34816, G_PP = 52224, G_CS = 61440, G_RR = 69632, G_A63 = 70144, G_C63 = 70656, G_OST = 73728, OST_STR = 132;
__device__ __forceinline__ bf16x8 tr8(const LAS unsigned char* p, int rowbytes4) { const v4i16_t a = vtr(p), b = vtr(p + rowbytes4); return (bf16x8){a[0], a[1], a[2], a[3], b[0], b[1], b[2], b[3]}; }
#define LDS_BAR() asm volatile("s_waitcnt lgkmcnt(0)\n\ts_barrier" ::: "memory")
template <bool OUT>
__device__ __forceinline__ void hgrn_chunk_unit2(Frame& F, int bh, int sc) {
    const int tid = F.tid, lane = F.lane, w = F.wave, l15 = lane & 15, g = lane >> 4;
    const int b = bh >> 2, h = bh & 3, cg = tid & 31, tq = tid >> 5;
    LAS unsigned char* L = F.lds + RING_OFF;
    LAS bf16* QT = (LAS bf16*)(L + G_QT); LAS bf16* KH = (LAS bf16*)(L + G_KH); LAS bf16* VV = (LAS bf16*)(L + G_VV); LAS bf16* PP = (LAS bf16*)(L + G_PP);
    LAS float* CS = (LAS float*)(L + G_CS); LAS float* RR = (LAS float*)(L + G_RR); LAS float* A63 = (LAS float*)(L + G_A63); LAS float* C63 = (LAS float*)(L + G_C63); LAS float* OST = (LAS float*)(L + G_OST);
    f32x4 S[8];
    unsigned sbase = (unsigned)(((bh * 32 + sc) * 128 + 4 * g) * 128 + 16 * w + l15);
    asm volatile("" : "+v"(sbase));
#pragma unroll
    for (int i = 0; i < 8; ++i)
#pragma unroll
        for (int r = 0; r < 4; ++r) S[i][r] = OUT ? F.SST()[sbase + (unsigned)(16 * i + r) * 128u] : 0.f;
    f32x4 dsum = {0.f, 0.f, 0.f, 0.f};
    f32x4 lf[4]; u32x2 kq[4], qq[4], vq[4];
    unsigned e0 = (unsigned)((b * TP + sc * 256 + 4 * tq) * 512 + h * 128 + 4 * cg);
#define HG_LOAD(ch_) do { unsigned ee = e0 + (unsigned)(ch_) * 64u * 512u; asm volatile("" : "+v"(ee)); \
        _Pragma("unroll") for (int i = 0; i < 4; ++i) { lf[i] = *(const f32x4*)(F.LOGF() + ee + (unsigned)i * 512u); kq[i] = *(const u32x2*)(F.KB() + ee + (unsigned)i * 512u); \
            vq[i] = *(const u32x2*)(F.VB() + ee + (unsigned)i * 512u); if (OUT) qq[i] = *(const u32x2*)(F.QB() + ee + (unsigned)i * 512u); } } while (0)
    HG_LOAD(0);
    const LAS unsigned char* trK = (const LAS unsigned char*)KH + ((8 * g + (l15 >> 2)) * HQ_STR + (l15 & 3) * 4) * 2;
    const LAS unsigned char* trV = (const LAS unsigned char*)VV + ((8 * g + (l15 >> 2)) * HQ_STR + 16 * w + (l15 & 3) * 4) * 2;
    for (int ch = 0; ch < 4; ++ch) {
        f32x4 c[4]; c[0] = lf[0]; c[1] = c[0] + lf[1]; c[2] = c[1] + lf[2]; c[3] = c[2] + lf[3];
        *(LAS f32x4*)(CS + tq * 128 + 4 * cg) = c[3];
        LDS_BAR();
        f32x4 off = {0.f, 0.f, 0.f, 0.f}, run = {0.f, 0.f, 0.f, 0.f}, r = {0.f, 0.f, 0.f, 0.f};
#pragma unroll
        for (int q = 0; q < 16; ++q) { const f32x4 v = *(const LAS f32x4*)(CS + q * 128 + 4 * cg); if (q == 8) r = run; if (q < tq) off += v; run += v; }
        const f32x4 b63 = run;
#pragma unroll
        for (int i = 0; i < 4; ++i) {
            const int t = 4 * tq + i; const f32x4 bt = off + c[i];
            f32x4 kf = {bflo(kq[i].x), bfhi(kq[i].x), bflo(kq[i].y), bfhi(kq[i].y)};
#pragma unroll
            for (int e = 0; e < 4; ++e) kf[e] *= __expf(r[e] - bt[e]);
            *(LAS u32x2*)(KH + t * HQ_STR + 4 * cg) = (u32x2){pg8::cvt_pk_bf16(kf[0], kf[1]), pg8::cvt_pk_bf16(kf[2], kf[3])};
            *(LAS u32x2*)(VV + t * HQ_STR + 4 * cg) = vq[i];
            if (OUT) { f32x4 qf = {bflo(qq[i].x), bfhi(qq[i].x), bflo(qq[i].y), bfhi(qq[i].y)};
#pragma unroll
                for (int e = 0; e < 4; ++e) qf[e] *= __expf(bt[e] - r[e]);
                *(LAS u32x2*)(QT + t * HQ_STR + 4 * cg) = (u32x2){pg8::cvt_pk_bf16(qf[0], qf[1]), pg8::cvt_pk_bf16(qf[2], qf[3])}; }
        }
        if (tq == 0) { f32x4 er, ea, ec;
#pragma unroll
            for (int e = 0; e < 4; ++e) { er[e] = __expf(r[e]); ea[e] = __expf(b63[e]); ec[e] = __expf(b63[e] - r[e]); }
            *(LAS f32x4*)(RR + 4 * cg) = er; *(LAS f32x4*)(A63 + 4 * cg) = ea; *(LAS f32x4*)(C63 + 4 * cg) = ec; dsum += b63; }
        if (ch < 3) HG_LOAD(ch + 1);
        v4u gq0, gq1; unsigned rowe = 0;
        if (OUT) { rowe = (unsigned)(b * TP + sc * 256 + ch * 64 + (tid >> 3)); asm volatile("" : "+v"(rowe));
            gq0 = *(const v4u*)(F.GB() + rowe * 512u + h * 128 + (tid & 7) * 16); gq1 = *(const v4u*)(F.GB() + rowe * 512u + h * 128 + (tid & 7) * 16 + 8); }
        LDS_BAR();
        f32x4 o[4];
        bf16x8 vf[2];
#pragma unroll
        for (int kk = 0; kk < 2; ++kk) vf[kk] = tr8(trV + (32 * kk) * HQ_STR * 2, 4 * HQ_STR * 2);
        if (OUT) {
#pragma unroll
            for (int tt = 0; tt < 2; ++tt) {
                const int tile = 2 * w + tt, ti = tile >> 2, si = tile & 3;
                f32x4 p = {0.f, 0.f, 0.f, 0.f};
#pragma unroll
                for (int kk = 0; kk < 4; ++kk) {
                    const bf16x8 a = *(const LAS bf16x8*)(QT + (16 * ti + l15) * HQ_STR + 32 * kk + 8 * g), bb = *(const LAS bf16x8*)(KH + (16 * si + l15) * HQ_STR + 32 * kk + 8 * g);
                    p = MFMA16(a, bb, p);
                }
#pragma unroll
                for (int rr = 0; rr < 4; ++rr) { const int tl = 16 * ti + 4 * g + rr, sl = 16 * si + l15; PP[tl * HT_STR + sl] = pg8::bf1(sl <= tl ? p[rr] : 0.f); }
            }
            LDS_BAR();
#pragma unroll
            for (int ti = 0; ti < 4; ++ti) { o[ti] = (f32x4){0.f, 0.f, 0.f, 0.f};
#pragma unroll
                for (int kk = 0; kk < 2; ++kk) { const bf16x8 a = *(const LAS bf16x8*)(PP + (16 * ti + l15) * HT_STR + 32 * kk + 8 * g); o[ti] = MFMA16(a, vf[kk], o[ti]); } }
#pragma unroll
            for (int kk = 0; kk < 4; ++kk) {
                const f32x4 r0 = *(const LAS f32x4*)(RR + 32 * kk + 4 * g), r1 = *(const LAS f32x4*)(RR + 32 * kk + 16 + 4 * g);
                const bf16x8 sb = __builtin_bit_cast(bf16x8, pg8::pack8(S[2 * kk] * r0, S[2 * kk + 1] * r1));
#pragma unroll
                for (int ti = 0; ti < 4; ++ti) {
                    const u32x2 a0 = *(const LAS u32x2*)(QT + (16 * ti + l15) * HQ_STR + 32 * kk + 4 * g), a1 = *(const LAS u32x2*)(QT + (16 * ti + l15) * HQ_STR + 32 * kk + 16 + 4 * g);
                    const v4u av = {a0.x, a0.y, a1.x, a1.y};
                    o[ti] = MFMA16(__builtin_bit_cast(bf16x8, av), sb, o[ti]);
                }
            }
        }
#pragma unroll
        for (int i = 0; i < 8; ++i) {
            f32x4 U = {0.f, 0.f, 0.f, 0.f};
#pragma unroll
            for (int kk = 0; kk < 2; ++kk) { const bf16x8 a = tr8(trK + ((32 * kk) * HQ_STR + 16 * i) * 2, 4 * HQ_STR * 2); U = MFMA16(a, vf[kk], U); }
            const f32x4 a63 = *(const LAS f32x4*)(A63 + 16 * i + 4 * g), c63 = *(const LAS f32x4*)(C63 + 16 * i + 4 * g);
            S[i] = a63 * S[i] + c63 * U;
        }
        if (OUT) {
#pragma unroll
            for (int ti = 0; ti < 4; ++ti)
#pragma unroll
                for (int rr = 0; rr < 4; ++rr) OST[(16 * ti + 4 * g + rr) * OST_STR + 16 * w + l15] = o[ti][rr];
            LDS_BAR();
            const int t = tid >> 3, c16 = (tid & 7) * 16;
            f32x4 x[4]; float sq = 0.f;
#pragma unroll
            for (int j = 0; j < 4; ++j) { x[j] = *(const LAS f32x4*)(OST + t * OST_STR + c16 + 4 * j); sq += (x[j][0] * x[j][0] + x[j][1] * x[j][1]) + (x[j][2] * x[j][2] + x[j][3] * x[j][3]); }
            sq += __shfl_xor(sq, 1); sq += __shfl_xor(sq, 2); sq += __shfl_xor(sq, 4);
            const float rstd = __builtin_amdgcn_rsqf(sq * (1.f / 128.f) + EPS);
            const v4u g0 = gq0, g1 = gq1;
#pragma unroll
            for (int j = 0; j < 4; ++j) { const f32x4 gn = *(const f32x4*)(F.og + c16 + 4 * j); x[j] = x[j] * gn * rstd; }
            x[0][0] *= bflo(g0[0]); x[0][1] *= bfhi(g0[0]); x[0][2] *= bflo(g0[1]); x[0][3] *= bfhi(g0[1]); x[1][0] *= bflo(g0[2]); x[1][1] *= bfhi(g0[2]); x[1][2] *= bflo(g0[3]); x[1][3] *= bfhi(g0[3]);
            x[2][0] *= bflo(g1[0]); x[2][1] *= bfhi(g1[0]); x[2][2] *= bflo(g1[1]); x[2][3] *= bfhi(g1[1]); x[3][0] *= bflo(g1[2]); x[3][1] *= bfhi(g1[2]); x[3][2] *= bflo(g1[3]); x[3][3] *= bfhi(g1[3]);
            *(pg8::u32x4*)(F.MIX() + rowe * 1024u + 512u + h * 128 + c16) = pg8::pack8(x[0], x[1]);
            *(pg8::u32x4*)(F.MIX() + rowe * 1024u + 512u + h * 128 + c16 + 8) = pg8::pack8(x[2], x[3]);
        }
    }
#undef HG_LOAD
    if (!OUT) {
#pragma unroll
        for (int i = 0; i < 8; ++i)
#pragma unroll
            for (int r = 0; r < 4; ++r) F.DSH()[sbase + (unsigned)(16 * i + r) * 128u] = S[i][r];
        if (tq == 0) *(f32x4*)(F.DD() + (size_t)(bh * 32 + sc) * 128 + 4 * cg) = dsum;
    }
    __syncthreads();
}

typedef short s16x4 __attribute__((ext_vector_type(4)));

struct DecStage2 { f32x4 k[4]; f32x4 v[4]; };
constexpr int DW_T = 107008;
struct DecW { DecStage2 S; f32x4 o[4]; float carry; bf16x8 qb[2]; int i, last, w, s, h, pagev; LAS unsigned char* tb; u32x2 wpk; bool pend; };
__device__ __forceinline__ void decw_load(Frame& F, DecW& D, int l15, int g) {
    const int kb = 1024 * D.w + 1024 - 16 * D.i;
    const int page = __builtin_amdgcn_readlane(D.pagev, (kb >> 7) & 7);
    const unsigned sbase = (unsigned)__builtin_amdgcn_readfirstlane((int)((((unsigned)page * PAGE + (unsigned)(kb & 127)) * 512u + (unsigned)(D.h * 64)) * 4u));
    const __amdgpu_buffer_rsrc_t rk = __builtin_amdgcn_make_buffer_rsrc((void*)F.ck, 0, 0x7fffffff, 0x00020000), rv = __builtin_amdgcn_make_buffer_rsrc((void*)F.cv, 0, 0x7fffffff, 0x00020000);
    int vk = l15 * 2048 + 32 * g; asm volatile("" : "+v"(vk)); const int vv = vk - 16 * g;
#pragma unroll
    for (int ks = 0; ks < 2; ++ks) { D.S.k[2 * ks] = __builtin_bit_cast(f32x4, __builtin_amdgcn_raw_buffer_load_b128(rk, vk + 128 * ks, sbase, 0)); D.S.k[2 * ks + 1] = __builtin_bit_cast(f32x4, __builtin_amdgcn_raw_buffer_load_b128(rk, vk + 128 * ks + 16, sbase, 0)); }
#pragma unroll
    for (int j = 0; j < 4; ++j) D.S.v[j] = __builtin_bit_cast(f32x4, __builtin_amdgcn_raw_buffer_load_b128(rv, vv + 64 * j, sbase, 0));
}
__device__ __forceinline__ void decw_procA(DecW& D, bool newk, float cinit, int l15, int g) {
    f32x4 p = {cinit, cinit, cinit, cinit};
    p = MFMA16(cvt8(D.S.k[0], D.S.k[1]), D.qb[0], p); p = MFMA16(cvt8(D.S.k[2], D.S.k[3]), D.qb[1], p);
    float bt[4];
#pragma unroll
    for (int r = 0; r < 4; ++r) { bt[r] = __builtin_amdgcn_rcpf(1.f + __builtin_amdgcn_exp2f(p[r])); if (newk && (4 * g + r >= l15 || 4 * g + r >= 8)) bt[r] = 0.f; }
    float suf = 1.f, wl[4];
#pragma unroll
    for (int r = 3; r >= 0; --r) { wl[r] = bt[r] * suf; suf = __builtin_fmaf(-suf, bt[r], suf); }
    float t1, po;
    { auto a = __builtin_amdgcn_permlane16_swap(__float_as_uint(suf), __float_as_uint(suf), false, false); t1 = (g & 1) ? __uint_as_float(a[0]) : __uint_as_float(a[1]); }
    const float pp = suf * t1;
    { auto b = __builtin_amdgcn_permlane32_swap(__float_as_uint(pp), __float_as_uint(pp), false, false); po = (g & 2) ? __uint_as_float(b[0]) : __uint_as_float(b[1]); }
    const float pre = D.carry * ((g & 2) ? 1.f : po) * ((g & 1) ? 1.f : t1);
    D.carry = D.carry * pp * po;
    D.wpk = (u32x2){pg8::cvt_pk_bf16(wl[0] * pre, wl[1] * pre), pg8::cvt_pk_bf16(wl[2] * pre, wl[3] * pre)};
#pragma unroll
    for (int j = 0; j < 4; ++j) *(LAS u32x2*)(D.tb + j * 512 + l15 * 32 + g * 8) = (u32x2){pg8::cvt_pk_bf16(D.S.v[j][0], D.S.v[j][1]), pg8::cvt_pk_bf16(D.S.v[j][2], D.S.v[j][3])};
}
__device__ __forceinline__ void decw_procB(DecW& D, int l15, int g) {
    asm volatile("s_waitcnt lgkmcnt(0)" ::: "memory");
#pragma unroll
    for (int dt = 0; dt < 4; ++dt) { const v4i16_t vb = vtr(D.tb + dt * 512 + (4 * g + (l15 >> 2)) * 32 + (l15 & 3) * 8);
        D.o[dt] = __builtin_amdgcn_mfma_f32_16x16x16bf16_1k(__builtin_bit_cast(s16x4, D.wpk), vb, D.o[dt], 0, 0, 0); }
}
__device__ __forceinline__ void decw_proc(DecW& D, bool newk, float cinit, int l15, int g) { decw_procA(D, newk, cinit, l15, g); decw_procB(D, l15, g); }
__device__ __forceinline__ void attn_unit_dec(Frame& F, int b, int h, int qb, DecW& D) {
    const int lane = F.lane, r32 = lane & 31, hi = lane >> 5, wid = F.wave, l15 = lane & 15, g4 = lane >> 4;
    const int rowbase = b * TP, q0 = qb * 256 + 32 * wid, qpos = q0 + r32;
    const float cinit = -F.sbb[h] * LOG2E, dcinit = -F.sbb[D.h] * LOG2E;
    LAS unsigned char* L = F.lds + RING_OFF;
    const unsigned lds0 = (unsigned)(uintptr_t)L;
    bf16x8 qr[4];
#pragma unroll
    for (int d0 = 0; d0 < 4; ++d0) qr[d0] = *(const bf16x8*)(F.QA() + (size_t)(rowbase + qpos) * 512 + h * 64 + d0 * 16 + hi * 8);
    asm volatile("" :: "v"(qr[0]), "v"(qr[1]), "v"(qr[2]), "v"(qr[3]));
    const int NT = 4 * (qb + 1);
    const int rr_ = (lane & 3) + 4 * ((lane & 31) >> 3), pil = 16 * ((lane >> 2) & 1) + 8 * (1 - (rr_ & 1)) + (rr_ >> 1) + (lane & 32);
    const bf16* ksrc = F.KA() + (size_t)(rowbase + pil) * 512 + h * 64 + wid * 8;
    const bf16* vsrc = F.VA() + (size_t)(rowbase + 16 * (wid & 3) + (lane >> 2)) * 512 + h * 64 + (wid >> 2) * 32 + (lane & 3) * 8;
    const unsigned kdst = lds0 + AT_K + wid * 1024, vdst = lds0 + AT_V + wid * 1024;
#define AT_DMA(t, slot) do { glds16(ksrc + (size_t)(t) * 64 * 512, (unsigned)__builtin_amdgcn_readfirstlane(kdst + (slot))); glds16(vsrc + (size_t)(t) * 64 * 512, (unsigned)__builtin_amdgcn_readfirstlane(vdst + (slot))); } while (0)
    const LAS unsigned char* kfb = L + AT_K + hi * 1024 + r32 * 16;
    const LAS unsigned char* vfb = L + AT_V + ((lane >> 4) & 1) * 32 + (lane & 3) * 8 + ((lane & 15) >> 2) * 64 + hi * 1024;
    f32x16 o0 = splat16(0.f), o1 = splat16(0.f); float carry = 1.f;
    int s_cur = 0, s_nxt = AT_SLOT, s_fre = 2 * AT_SLOT;
    bool l1 = false, l2 = false;
    AT_DMA(NT - 1, 0); AT_DMA(NT - 2, AT_SLOT);
    if (wid >= 4) __builtin_amdgcn_s_setprio(1);
    for (int t = NT - 1; t >= 0; --t) {
        if (t == 0) asm volatile("s_waitcnt vmcnt(0) lgkmcnt(0)\n\ts_barrier" ::: "memory");
        else if (l1 || l2) asm volatile("s_waitcnt vmcnt(10) lgkmcnt(0)\n\ts_barrier" ::: "memory");
        else asm volatile("s_waitcnt vmcnt(2) lgkmcnt(0)\n\ts_barrier" ::: "memory");
        const bool dstep = ((t & 1) == (wid >> 2)) && (D.i <= D.last) && !D.pend;
        if (dstep) decw_procA(D, false, dcinit, l15, g4);
        else if (D.pend) { decw_procB(D, l15, g4); D.pend = false; }
        if (t >= 2) AT_DMA(t - 2, s_fre);
        l2 = l1; l1 = false;
        const int kbase = 64 * t;
        if (kbase <= q0 + 30) {
            f32x16 p0 = splat16(cinit), p1 = splat16(cinit);
#pragma unroll
            for (int d0 = 0; d0 < 4; ++d0) {
                const bf16x8 k0 = *(const LAS bf16x8*)(kfb + s_cur + d0 * 2048), k1 = *(const LAS bf16x8*)(kfb + s_cur + d0 * 2048 + 512);
                p0 = MFMA32(k0, qr[d0], p0); p1 = MFMA32(k1, qr[d0], p1);
            }
            v4u pw[4];
            sb_tile2(p0, p1, carry, hi, kbase + 16 * hi, qpos, kbase + 63 >= q0, pw);
#pragma unroll
            for (int ks = 0; ks < 4; ++ks) {
                const LAS unsigned char* vp = vfb + s_cur + (ks >> 1) * 2048 + (ks & 1) * 512;
                const v4i16_t a0 = vtr(vp), a1 = vtr(vp + 256), b0 = vtr(vp + 4096), b1 = vtr(vp + 4096 + 256);
                const bf16x8 v0 = {a0[0], a0[1], a0[2], a0[3], a1[0], a1[1], a1[2], a1[3]}, v1 = {b0[0], b0[1], b0[2], b0[3], b1[0], b1[1], b1[2], b1[3]};
                o0 = MFMA32(__builtin_bit_cast(bf16x8, pw[ks]), v0, o0); o1 = MFMA32(__builtin_bit_cast(bf16x8, pw[ks]), v1, o1);
            }
        }
        if (dstep) { D.pend = true; ++D.i; if (D.i <= D.last) { decw_load(F, D, l15, g4); l1 = true; } }
        const int tmp = s_fre; s_fre = s_cur; s_cur = s_nxt; s_nxt = tmp;
    }
    __builtin_amdgcn_s_setprio(0);
    LAS bf16* stg = (LAS bf16*)(L + AT_O) + wid * 2048;
#pragma unroll
    for (int r = 0; r < 16; ++r) { const int orow = crow(r, hi); stg[orow * 64 + r32] = pg8::bf1(o0[r]); stg[orow * 64 + 32 + r32] = pg8::bf1(o1[r]); }
    asm volatile("s_waitcnt lgkmcnt(0)" ::: "memory");
#pragma unroll
    for (int i = 0; i < 4; ++i) {
        const int row = i * 8 + (lane >> 3), ch = lane & 7; const size_t grow = (size_t)rowbase + q0 + row;
        const v4u ov = *(const LAS v4u*)(stg + row * 64 + ch * 8), gv = *(const v4u*)(F.GA() + grow * 512 + h * 64 + ch * 8);
        f32x4 x, y;
        x[0] = bflo(ov[0]) * bflo(gv[0]); x[1] = bfhi(ov[0]) * bfhi(gv[0]); x[2] = bflo(ov[1]) * bflo(gv[1]); x[3] = bfhi(ov[1]) * bfhi(gv[1]);
        y[0] = bflo(ov[2]) * bflo(gv[2]); y[1] = bfhi(ov[2]) * bfhi(gv[2]); y[2] = bflo(ov[3]) * bflo(gv[3]); y[3] = bfhi(ov[3]) * bfhi(gv[3]);
        *(pg8::u32x4*)(F.MIX() + grow * 1024 + h * 64 + ch * 8) = pg8::pack8(x, y);
    }
    asm volatile("s_waitcnt lgkmcnt(0)\n\ts_barrier" ::: "memory");
#undef AT_DMA
}
constexpr int DW_OB = 90112, DW_CB = 106496;
__device__ __forceinline__ void attn_pair_dec(Frame& F, int it) {
    const int lane = F.lane, l15 = lane & 15, g4 = lane >> 4, wid = F.wave;
    const int bh = it >> 4, x = it & 15;
    DecW D; D.s = it >> 3; D.h = it & 7; D.w = wid; D.carry = 1.f; D.i = 1; D.last = 64; D.pend = false;
    D.pagev = F.pt[D.s * NPG + 8 * wid + (lane & 7)];
    D.tb = F.lds + RING_OFF + DW_T + wid * 2048;
#pragma unroll
    for (int dt = 0; dt < 4; ++dt) D.o[dt] = (f32x4){0.f, 0.f, 0.f, 0.f};
#pragma unroll
    for (int ks = 0; ks < 2; ++ks) D.qb[ks] = *(const bf16x8*)(F.QA() + ((size_t)MP + D.s * 8 + (l15 & 7)) * 512 + D.h * 64 + 32 * ks + 8 * g4);
    const float dcinit = -F.sbb[D.h] * LOG2E;
    if (wid == 7) {
        const size_t row = (size_t)MP + D.s * 8;
        const bf16* kp = F.KA() + (row + (l15 & 7)) * 512 + D.h * 64 + 8 * g4;
#pragma unroll
        for (int ks = 0; ks < 2; ++ks) { const v4u w = *(const v4u*)(kp + 32 * ks);
            D.S.k[2 * ks] = (f32x4){bflo(w[0]), bfhi(w[0]), bflo(w[1]), bfhi(w[1])}; D.S.k[2 * ks + 1] = (f32x4){bflo(w[2]), bfhi(w[2]), bflo(w[3]), bfhi(w[3])}; }
        const bf16* vp = F.VA() + (row + (l15 & 7)) * 512 + D.h * 64 + 4 * g4;
#pragma unroll
        for (int j = 0; j < 4; ++j) { const u32x2 w = *(const u32x2*)(vp + 16 * j); D.S.v[j] = (f32x4){bflo(w.x), bfhi(w.x), bflo(w.y), bfhi(w.y)}; }
        decw_proc(D, true, dcinit, l15, g4);
    }
    decw_load(F, D, l15, g4);
    asm volatile("s_waitcnt vmcnt(0)" ::: "memory");
    attn_unit_dec(F, bh >> 3, bh & 7, 31 - x, D);
    attn_unit_dec(F, bh >> 3, bh & 7, x, D);
    if (D.pend) { decw_procB(D, l15, g4); D.pend = false; }
    while (D.i <= D.last) { decw_proc(D, false, dcinit, l15, g4); ++D.i; if (D.i <= D.last) decw_load(F, D, l15, g4); }
    LAS float* ob = (LAS float*)(F.lds + RING_OFF + DW_OB); LAS float* cb = (LAS float*)(F.lds + RING_OFF + DW_CB);
    if (g4 < 2) {
#pragma unroll
        for (int dt = 0; dt < 4; ++dt)
#pragma unroll
            for (int r = 0; r < 4; ++r) ob[(wid * 8 + 4 * g4 + r) * 64 + 16 * dt + l15] = D.o[dt][r];
        if (g4 == 0 && l15 < 8) cb[wid * 8 + l15] = D.carry;
    }
    __syncthreads();
    {
        const int q = F.tid >> 6, d = F.tid & 63; float acc = 0.f, pref = 1.f;
#pragma unroll
        for (int w = 7; w >= 0; --w) { acc += pref * ob[(w * 8 + q) * 64 + d]; pref *= cb[w * 8 + q]; }
        const size_t row = (size_t)MP + D.s * 8 + q;
        F.MIX()[row * 1024 + D.h * 64 + d] = pg8::bf1(acc * bf2f(F.GA()[row * 512 + D.h * 64 + d]));
    }
    __syncthreads();
}

#ifndef MK_N_LAUNCHES
#define MK_N_LAUNCHES 1
#endif
constexpr int NPH = 15;
constexpr int N_LAUNCHES = MK_N_LAUNCHES;
struct Args { const void* in[17]; float* out; unsigned char* ws; int ph_lo, ph_hi, li, pad; };
__global__ void __launch_bounds__(NWAVES * 64, 2) mk_fwd(Args args) {
    extern __shared__ __attribute__((aligned(16))) unsigned char lds[];
    Frame F;
    F.lds = (LAS unsigned char*)lds;
    F.MISC = (volatile LAS unsigned*)(F.lds + MISC_OFF);
    F.tid = threadIdx.x; F.lane = F.tid & 63; F.wave = __builtin_amdgcn_readfirstlane(F.tid >> 6);
    F.G = gridDim.x; F.bid = blockIdx.x;
    unsigned char* ws = args.ws;
    F.ctl = (gu32*)(ws + WS_CTL);
    F.xp = (const float*)args.in[0]; F.xs = (const float*)args.in[1]; F.ck = (const float*)args.in[2]; F.cv = (const float*)args.in[3]; F.pt = (const int*)args.in[4];
    F.st_h = (const float*)args.in[5]; F.st_r = (const float*)args.in[6]; F.ng = (const float*)args.in[7]; F.w1 = (const float*)args.in[8]; F.w2 = (const float*)args.in[9];
    F.qg = (const float*)args.in[10]; F.kg = (const float*)args.in[11]; F.sbb = (const float*)args.in[12]; F.hlb = (const float*)args.in[13]; F.og = (const float*)args.in[14];
    F.w3 = (const float*)args.in[15]; F.w4 = (const float*)args.in[16]; F.out = args.out;
    F.ws = ws;
    for (int u = F.tid; u < (LDS_BYTES - LDSCTL_OFF) / 4; u += NWAVES * 64) ((LAS unsigned*)(F.lds + LDSCTL_OFF))[u] = 0u;
    __syncthreads();
    XcdBarrier bar; bar.bar = (unsigned*)(F.ctl + CW_BAR); bar.x = 0; bar.st = nullptr;
    if (N_LAUNCHES == 1) bar = xcd_barrier_post((unsigned*)(F.ctl + CW_BAR), F.MISC + 8);
#define GRID_BAR() do { if (N_LAUNCHES == 1) xcd_barrier(bar); } while (0)
    const int lo = args.ph_lo, hi = args.ph_hi;
#define IN(k) (lo <= (k) && (k) < hi)
    const int gw = F.bid * NWAVES + F.wave, NGW = F.G * NWAVES;
    const int vcu_ = (F.G % 8 == 0) ? (F.bid % 8) * (F.G / 8) + F.bid / 8 : F.bid;

    if (IN(0)) { p0_prologue(F); GRID_BAR(); }
    if (IN(1)) {
        pg8::Gemm g{1024, 1024, 1024}; pg8::SchedPlain S; S.init(F.H(), F.W1T(), MP, N1, 1024, F.G, F.bid);
        pg8::EpiEven E{F.QA(), F.KA(), F.VAT(), F.GA(), F.QB(), F.KB(), F.VB(), F.GB(), F.LOGF(), F.out, F.qg, F.kg, F.hlb, -0.125f * LOG2E, MT, MP, OK_P, OK_S, OV_P, OV_S};
        pg8::gemm_phase<pg8::EpiEven, pg8::SchedPlain, true, true>(F.lds + RING_OFF, g, S, E);
        { pg8::Gemm gs{256, 1024, 1024}; pg8::SchedSplit Ss{(const char*)(F.H() + (size_t)MP * 1024), (const char*)F.W1T(), N1 / 256, 4, F.G, F.bid, 2048, 2048};
          pg8::EpiSlab Es{F.SLAB(), N1}; pg8::gemm_phase<pg8::EpiSlab, pg8::SchedSplit, true, true>(F.lds + RING_OFF, gs, Ss, Es); }
        GRID_BAR();
    }
    if (IN(2)) {
        for (int it = gw; it < MSM * 8; it += NGW) pp1_item(F, it);
        for (int u = F.bid; u < 8 * 32; u += F.G) hgrn_chunk_unit2<false>(F, u >> 5, u & 31);
        GRID_BAR();
    }
    if (IN(3)) {
        hgrn_passB(F);
        for (int u = F.bid; u < NSQ * HB; u += F.G) hgrn_sample_unit(F, u >> 2, u & 3);
        { const int vcu = (F.G % 8 == 0) ? (F.bid % 8) * (F.G / 8) + F.bid / 8 : F.bid;
          for (int it = vcu; it < 256; it += F.G) attn_pair_dec(F, it); }
        GRID_BAR();
    }
    if (IN(4)) {
        for (int u = F.bid; u < 8 * 32; u += F.G) hgrn_chunk_unit2<true>(F, u >> 5, u & 31);
        { pg8::Gemm gs{256, 1024, 1024}; pg8::SchedSplit Ss{(const char*)(F.MIX() + (size_t)MP * 1024), (const char*)F.W2T(), 4, 4, F.G, F.bid, 2048, 2048};
          pg8::EpiSlab Es{F.SLAB(), 1024}; pg8::gemm_phase<pg8::EpiSlab, pg8::SchedSplit, true, true>(F.lds + RING_OFF, gs, Ss, Es); }
        GRID_BAR();
    }
    if (IN(6)) {
        pg8::Gemm g{1024, 1024, 1024}; pg8::SchedPlain S; S.init(F.MIX(), F.W2T(), MP, 1024, 1024, F.G, F.bid);
        pg8::EpiY1 E{F.xp, F.Y1B(), F.SS1()};
        pg8::gemm_phase<pg8::EpiY1, pg8::SchedPlain, true, true>(F.lds + RING_OFF, g, S, E);
        for (int r = gw; r < MSM; r += NGW) pp2_row(F, r);
        GRID_BAR();
    }
    if (IN(8)) {
        pg8::Gemm g{1024, 1024, 1024};
        { pg8::Sched3<0> S; S.init(F.Y1B(), F.W3T(), F.G, F.bid); pg8::EpiOdd3<0> E{F.AQ(), F.KCH(), F.KCT(), F.BV(), F.GC(), F.QC(), F.KC(), F.VC(), F.RCOS(), F.RSIN(), F.RCOST(), F.RSINT(), MP, F.SS1()};
          pg8::gemm_phase<pg8::EpiOdd3<0>, pg8::Sched3<0>, true, true>(F.lds + RING_OFF, g, S, E); }
        { pg8::Sched3<1> S; S.init(F.Y1B(), F.W3T(), F.G, F.bid); pg8::EpiOdd3<1> E{F.AQ(), F.KCH(), F.KCT(), F.BV(), F.GC(), F.QC(), F.KC(), F.VC(), F.RCOS(), F.RSIN(), F.RCOST(), F.RSINT(), MP, F.SS1()};
          pg8::gemm_phase<pg8::EpiOdd3<1>, pg8::Sched3<1>, true, true>(F.lds + RING_OFF, g, S, E); }
        { pg8::Gemm gs{256, 1024, 1024}; pg8::SchedSplit Ss{(const char*)(F.H() + (size_t)MP * 1024), (const char*)F.W3T(), N3 / 256, 4, F.G, F.bid, 2048, 2048};
          pg8::EpiSlab Es{F.SLAB(), N3}; pg8::gemm_phase<pg8::EpiSlab, pg8::SchedSplit, true, true>(F.lds + RING_OFF, gs, Ss, Es); }
        GRID_BAR();
    }
    if (IN(9)) {
        { pg8::Gemm g{256, 512, 256}; pg8::SchedRet S{(const char*)F.BV(), (const char*)F.KCT(), F.G, vcu_, 0};
          pg8::EpiRetA E{(pg8::bf16_t*)F.DST()};
          pg8::gemm_phase<pg8::EpiRetA, pg8::SchedRet, true, true>(F.lds + RING_OFF, g, S, E); }
        { pg8::Gemm g{256, 2048, 1024}; pg8::SchedRet S{(const char*)F.AQ(), (const char*)F.KCH(), F.G, vcu_, 1};
          pg8::EpiRetP E{F.AQ()};
          pg8::gemm_phase<pg8::EpiRetP, pg8::SchedRet, true, true>(F.lds + RING_OFF, g, S, E); }
        for (int it = gw; it < MSM * 24; it += NGW) pp3_item(F, it);
        GRID_BAR();
    }
    if (IN(10)) {
        ret_passB(F);
        for (int u = F.bid; u < NSQ * HC * 2; u += F.G) ret_sample_unit(F, u >> 3, (u >> 1) & 3, u & 1);
        GRID_BAR();
    }
    if (IN(12)) {
        pg8::Gemm g{512, 2048, 512}; pg8::SchedRet S{(const char*)F.AQ(), (const char*)F.BV(), F.G, vcu_, 2};
        pg8::EpiRetO E{F.GC(), F.MIX2(), F.SS()};
        pg8::gemm_phase<pg8::EpiRetO, pg8::SchedRet, true, true>(F.lds + RING_OFF, g, S, E);
        { pg8::Gemm gs{256, 2048, 2048}; pg8::SchedSplit Ss{(const char*)(F.MIX2() + (size_t)MP * 2048), (const char*)F.W4T(), 4, 8, F.G, F.bid, 4096, 4096};
          pg8::EpiSlab Es{F.SLAB4(), 1024}; pg8::gemm_phase<pg8::EpiSlab, pg8::SchedSplit, true, true>(F.lds + RING_OFF, gs, Ss, Es); }
        GRID_BAR();
    }
    if (IN(14)) {
        pg8::Gemm g{2048, 2048, 2048}; pg8::SchedPlain S; S.init(F.MIX2(), F.W4T(), MP, 1024, 2048, F.G, F.bid);
        pg8::EpiOut E{F.Y1B(), F.out + OY_P, F.SS()};
        pg8::gemm_phase<pg8::EpiOut, pg8::SchedPlain, true, true>(F.lds + RING_OFF, g, S, E);
        for (int r = gw; r < MSM; r += NGW) pp4_row(F, r);
    }
#undef IN
}

extern "C" void kernel_launch(void* const* d_in, const int* in_sizes, int n_in, void* d_out, int out_size, void* d_ws, size_t ws_size, hipStream_t stream) {
    static int grid = 0;
    if (grid == 0) {
        if (n_in != 17 || (size_t)out_size != OUT_TOTAL || ws_size < WS_END) { fprintf(stderr, "kernel_launch: unexpected shapes: n_in %d out %d ws %zu (need %zu)\n", n_in, out_size, ws_size, (size_t)WS_END); grid = -1; return; }
        int dev = 0, cus = 0, per_cu = 0;
        if (hipGetDevice(&dev) != hipSuccess || hipDeviceGetAttribute(&cus, hipDeviceAttributeMultiprocessorCount, dev) != hipSuccess) { grid = -1; return; }
        if (hipFuncSetAttribute((const void*)mk_fwd, hipFuncAttributeMaxDynamicSharedMemorySize, LDS_BYTES) != hipSuccess) { fprintf(stderr, "kernel_launch: hipFuncSetAttribute failed\n"); grid = -1; return; }
        if (hipOccupancyMaxActiveBlocksPerMultiprocessor(&per_cu, (const void*)mk_fwd, NWAVES * 64, LDS_BYTES) != hipSuccess || per_cu < 1) { fprintf(stderr, "kernel_launch: occupancy query says %d\n", per_cu); }
        (void)hipGetLastError();
        grid = cus;
    }
    if (grid < 0) return;
    if (hipMemsetAsync((char*)d_ws + WS_CTL, 0, CTL_ZERO_BYTES, stream) != hipSuccess) return;
    Args a{};
    for (int i = 0; i < 17; ++i) a.in[i] = d_in[i];
    a.out = (float*)d_out; a.ws = (unsigned char*)d_ws;
    for (int li = 0; li < N_LAUNCHES; ++li) {
        a.ph_lo = (N_LAUNCHES == 1) ? 0 : li; a.ph_hi = (N_LAUNCHES == 1) ? NPH : li + 1; a.li = li;
        hipLaunchKernelGGL(mk_fwd, dim3(grid), dim3(NWAVES * 64), LDS_BYTES, stream, a);
        if (hipPeekAtLastError() != hipSuccess) break;
    }
}
```

```cpp
#include <hip/hip_runtime.h>
#include <cstdio>
#include <cstdint>

constexpr int DM = 1024, TP = 8192, NBP = 2, MP = NBP * TP;
constexpr int NSQ = 32, TSQ = 8, MSM = NSQ * TSQ;
constexpr int MT = MP + MSM;
constexpr int PAST = 8192, PAGE = 128, NPG = PAST / PAGE;
constexpr int HA = 8, HDA = 64, WA = 512, HB = 4, DKB = 128, DVB = 128, HC = 4, DKC = 256, DVC = 512, WC = 2048;
constexpr int N1 = 4096, N3 = 6144;
constexpr float EPS = 1e-6f;
constexpr float LOG2E = 1.4426950408889634f;
constexpr size_t OY_P = 0, OY_S = 16777216, OK_P = 17039360, OV_P = 25427968, OK_S = 33816576, OV_S = 33947648,
                 OHG_P = 34078720, OHG_S = 34209792, ORT_P = 36306944, ORT_S = 37355520, OUT_TOTAL = 54132736;
#define MK_N_LAUNCHES 1
namespace pg8 {
#define PG8_LAS __attribute__((address_space(3)))
typedef unsigned short bf16_t;
typedef short bf16x8 __attribute__((ext_vector_type(8)));
typedef float f32x4 __attribute__((ext_vector_type(4)));
typedef unsigned u32x4 __attribute__((ext_vector_type(4)));
constexpr int BM = 256, BK = 64, HALF = 128, HTB = HALF * BK * 2  , STAGE_BYTES = 8 * HTB, NXCD = 8, WGM = 8;

__host__ __device__ __forceinline__ int lds_byte(int r, int c) { const int st = (r >> 4) * 2 + (c >> 5), rr = r & 15, cc = c & 31, ob = rr * 64 + cc * 2; return st * 1024 + (ob ^ (((ob >> 9) & 1) << 5)); }
__host__ __device__ __forceinline__ void stage_rc(int b, int& R, int& C) { const int st = b / 1024, sb = b % 1024, swz = sb ^ (((sb >> 9) & 1) << 5); R = (st >> 1) * 16 + swz / 64; C = (st & 1) * 32 + (swz % 64) / 2; }
__host__ __device__ __forceinline__ int perm32(int rho) { const int n = rho >> 4, i = rho & 15; return 8 * (i >> 2) + 4 * n + (i & 3); }

struct Unit { int pm, pn, kind, aux; };
struct Gemm { int K, lda, ldb; };

struct StaticOrder {
    int nM, nN, nwg, G, c;
    __host__ __device__ void init(int M, int N, int G_, int c_) { nM = M / BM; nN = N / BM; nwg = nM * nN; G = G_; c = c_; }
    __host__ __device__ bool next(int i, Unit& u) const {
        const long L = (long)i * G + c; if (L >= nwg) return false;
        int wgid = (int)L; { const int q = nwg / NXCD, r = nwg % NXCD, xcd = wgid % NXCD, off = wgid / NXCD; wgid = (xcd < r ? xcd * (q + 1) : r * (q + 1) + (xcd - r) * q) + off; }
        const int nig = WGM * nN, gid = wgid / nig, fm = gid * WGM, gsz = (nM - fm) < WGM ? (nM - fm) : WGM;
        u.pm = fm + ((wgid % nig) % gsz); u.pn = (wgid % nig) / gsz; return true;
    }
    __device__ __forceinline__ void a_ready(const Unit&) const {}
    __device__ __forceinline__ void done(const Unit&) const {}
};
typedef float f32x2_t __attribute__((ext_vector_type(2))); typedef __bf16 bf16x2_t __attribute__((ext_vector_type(2)));
__device__ __forceinline__ unsigned cvt_pk_bf16(float lo, float hi) { f32x2_t v = {lo, hi}; bf16x2_t b = __builtin_convertvector(v, bf16x2_t); return __builtin_bit_cast(unsigned, b); }
typedef float f32x2 __attribute__((ext_vector_type(2)));
template <class Epi, class Sched, bool ALIGN_EPI = false, bool SP2 = false>
__device__ __forceinline__ void gemm_phase(PG8_LAS unsigned char* lds, const Gemm g, const Sched& S, const Epi& E) {
    const int tid = threadIdx.x, wid = __builtin_amdgcn_readfirstlane(tid >> 6), lane = tid & 63, wr = wid >> 2, wc = wid & 3, fr = lane & 15, fq = lane >> 4;
    const int K = g.K, nt = K / BK;
    unsigned voffA[2], voffB[2];
#pragma unroll
    for (int i = 0; i < 2; ++i) { int R, C; stage_rc(tid * 16 + i * 8192, R, C); const int Rb = Epi::PERM ? ((R & ~31) + perm32(R & 31)) : R;
        voffA[i] = (unsigned)(R * g.lda + C) * 2u; voffB[i] = (unsigned)(Rb * g.ldb + C) * 2u; }
    const size_t kstep = (size_t)(BK * 2);
    const size_t hstepA = (size_t)HALF * g.lda * 2, hstepB = (size_t)HALF * g.ldb * 2;
    const unsigned ldsw = (unsigned)wid * 1024u;
    const int aoff = lds_byte(wr * 64 + fr, fq * 8), boff = lds_byte(wc * 32 + fr, fq * 8);
#define PG8_SA(b, h) (((b) * 2 + (h)) * HTB)
#define PG8_SB(b, h) ((4 + (b) * 2 + (h)) * HTB)
#define PG8_STAGE(bufoff, gbase, voff) do { _Pragma("unroll") for (int _i = 0; _i < 2; ++_i) \
        __builtin_amdgcn_global_load_lds((const unsigned*)((const char*)(gbase) + (voff)[_i]), (PG8_LAS unsigned*)(lds + (bufoff) + ldsw + _i * 8192), 16, 0, 0); } while (0)
#define PG8_LDA(dst, b, h) do { _Pragma("unroll") for (int m = 0; m < 4; ++m) _Pragma("unroll") for (int k = 0; k < 2; ++k) dst[m][k] = *(const PG8_LAS bf16x8*)(lds + PG8_SA(b, h) + aoff + m * 2048 + k * 1024); } while (0)
#define PG8_LDB(dst, b, h) do { _Pragma("unroll") for (int n = 0; n < 2; ++n) _Pragma("unroll") for (int k = 0; k < 2; ++k) dst[n][k] = *(const PG8_LAS bf16x8*)(lds + PG8_SB(b, h) + boff + n * 2048 + k * 1024); } while (0)
#define PG8_MMA(ai, bj, At, Bt) do { __builtin_amdgcn_s_setprio(1); _Pragma("unroll") for (int m = 0; m < 4; ++m) _Pragma("unroll") for (int n = 0; n < 2; ++n) _Pragma("unroll") for (int k = 0; k < 2; ++k) \
        acc[ai][bj][m][n] = __builtin_amdgcn_mfma_f32_16x16x32_bf16(Bt[n][k], At[m][k], acc[ai][bj][m][n], 0, 0, 0); __builtin_amdgcn_s_setprio(0); } while (0)
#define PG8_WAIT_V(n) asm volatile("s_waitcnt vmcnt(" #n ")" ::: "memory")
#define PG8_WAIT_L(n) asm volatile("s_waitcnt lgkmcnt(" #n ")" ::: "memory")
#define PG8_BAR __builtin_amdgcn_s_barrier()
#define PG8_SCHED __builtin_amdgcn_sched_barrier(0)
    Unit cur, nxt; int ui = 0;
    if (!S.next(0, cur)) return;
    f32x4 acc[2][2][4][2];
#pragma unroll
    for (int a = 0; a < 2; ++a)
#pragma unroll
        for (int b = 0; b < 2; ++b)
#pragma unroll
            for (int m = 0; m < 4; ++m)
#pragma unroll
                for (int n = 0; n < 2; ++n) acc[a][b][m][n] = (f32x4){0.f, 0.f, 0.f, 0.f};
    bf16x8 At[4][2], B0[2][2], B1[2][2];
    const char* cA = S.a_base(cur); const char* cB = S.b_base(cur);
    S.a_ready(cur);
    if constexpr (SP2) {
        PG8_STAGE(PG8_SB(0, 0), cB, voffB); PG8_STAGE(PG8_SB(0, 1), cB + hstepB, voffB); PG8_STAGE(PG8_SA(0, 0), cA, voffA); PG8_STAGE(PG8_SA(0, 1), cA + hstepA, voffA);
        if (wr == 1) PG8_BAR;
        PG8_WAIT_V(2); PG8_BAR;
        PG8_STAGE(PG8_SB(1, 0), cB + kstep, voffB); PG8_STAGE(PG8_SA(1, 0), cA + kstep, voffA); PG8_STAGE(PG8_SB(1, 1), cB + hstepB + kstep, voffB);
        PG8_WAIT_V(6); PG8_BAR;
    } else {
        PG8_STAGE(PG8_SB(0, 0), cB, voffB); PG8_STAGE(PG8_SA(0, 0), cA, voffA); PG8_STAGE(PG8_SB(0, 1), cB + hstepB, voffB); PG8_STAGE(PG8_SA(0, 1), cA + hstepA, voffA);
        if (wr == 1) PG8_BAR;
        PG8_WAIT_V(4); PG8_BAR;
        PG8_STAGE(PG8_SB(1, 0), cB + kstep, voffB); PG8_STAGE(PG8_SA(1, 0), cA + kstep, voffA); PG8_STAGE(PG8_SB(1, 1), cB + hstepB + kstep, voffB);
        PG8_WAIT_V(6); PG8_BAR;
    }
    for (;;) {
        const bool has_next = S.next(ui + 1, nxt);
        const char* nA = has_next ? S.a_base(nxt) : cA; const char* nB = has_next ? S.b_base(nxt) : cB;
#pragma unroll 1
        for (int t = 0; t < nt; t += 2) {
            if constexpr (Epi::KHOOK) { if (t != 0 && (t & 7) == 0) E.khook(acc, cur, t >> 3, wr, fr); }
            const bool last = (t == nt - 2);
            const char* a1 = cA + (size_t)(t + 1) * kstep;
            const char* a2 = last ? nA : cA + (size_t)(t + 2) * kstep; const char* b2 = last ? nB : cB + (size_t)(t + 2) * kstep;
            const char* a3 = a2 + kstep; const char* b3 = b2 + kstep;
            if (last && has_next) S.a_ready(nxt);
            if constexpr (SP2) {
            PG8_LDB(B0, 0, 0); PG8_LDB(B1, 0, 1); PG8_SCHED; PG8_LDA(At, 0, 0); PG8_STAGE(PG8_SA(1, 1), a1 + hstepA, voffA);
            PG8_WAIT_V(8); PG8_WAIT_L(0); PG8_BAR; PG8_MMA(0, 0, At, B0); PG8_MMA(0, 1, At, B1); PG8_BAR; PG8_SCHED;
            PG8_LDA(At, 0, 1); PG8_STAGE(PG8_SB(0, 0), b2, voffB); PG8_STAGE(PG8_SB(0, 1), b2 + hstepB, voffB); PG8_STAGE(PG8_SA(0, 0), a2, voffA);
            PG8_WAIT_V(8); PG8_WAIT_L(0); PG8_BAR; PG8_MMA(1, 0, At, B0); PG8_MMA(1, 1, At, B1); PG8_BAR; PG8_SCHED;
            PG8_LDB(B0, 1, 0); PG8_LDB(B1, 1, 1); PG8_SCHED; PG8_LDA(At, 1, 0); PG8_STAGE(PG8_SA(0, 1), a2 + hstepA, voffA);
            PG8_WAIT_V(8); PG8_WAIT_L(0); PG8_BAR; PG8_MMA(0, 0, At, B0); PG8_MMA(0, 1, At, B1); PG8_BAR; PG8_SCHED;
            PG8_LDA(At, 1, 1); PG8_STAGE(PG8_SB(1, 0), b3, voffB); PG8_STAGE(PG8_SB(1, 1), b3 + hstepB, voffB); PG8_STAGE(PG8_SA(1, 0), a3, voffA);
            PG8_WAIT_V(8); PG8_WAIT_L(0); PG8_BAR; PG8_MMA(1, 0, At, B0); PG8_MMA(1, 1, At, B1); PG8_BAR; PG8_SCHED;
            } else {
            PG8_LDB(B0, 0, 0); PG8_SCHED; PG8_LDA(At, 0, 0); PG8_STAGE(PG8_SA(1, 1), a1 + hstepA, voffA);
            PG8_WAIT_L(8); PG8_BAR; PG8_WAIT_L(0); PG8_MMA(0, 0, At, B0); PG8_BAR; PG8_SCHED;
            PG8_LDB(B1, 0, 1); PG8_STAGE(PG8_SB(0, 0), b2, voffB);
            PG8_BAR; PG8_WAIT_L(0); PG8_MMA(0, 1, At, B1); PG8_BAR;
            PG8_LDA(At, 0, 1); PG8_STAGE(PG8_SA(0, 0), a2, voffA);
            PG8_BAR; PG8_WAIT_L(0); PG8_MMA(1, 0, At, B0); PG8_BAR; PG8_SCHED;
            PG8_STAGE(PG8_SB(0, 1), b2 + hstepB, voffB);
            PG8_WAIT_V(6); PG8_BAR; PG8_MMA(1, 1, At, B1); PG8_BAR;
            PG8_LDB(B0, 1, 0); PG8_SCHED; PG8_LDA(At, 1, 0); PG8_STAGE(PG8_SA(0, 1), a2 + hstepA, voffA);
            PG8_WAIT_L(8); PG8_BAR; PG8_WAIT_L(0); PG8_MMA(0, 0, At, B0); PG8_BAR; PG8_SCHED;
            PG8_LDB(B1, 1, 1); PG8_STAGE(PG8_SB(1, 0), b3, voffB);
            PG8_BAR; PG8_WAIT_L(0); PG8_MMA(0, 1, At, B1); PG8_BAR;
            PG8_LDA(At, 1, 1); PG8_STAGE(PG8_SA(1, 0), a3, voffA);
            PG8_BAR; PG8_WAIT_L(0); PG8_MMA(1, 0, At, B0); PG8_BAR; PG8_SCHED;
            PG8_STAGE(PG8_SB(1, 1), b3 + hstepB, voffB);
            PG8_WAIT_V(6); PG8_BAR; PG8_MMA(1, 1, At, B1); PG8_BAR;
            }
        }
        if constexpr (ALIGN_EPI) { if (wr == 0) PG8_BAR; }
        if constexpr (!Epi::AFTER_DRAIN) { E(acc, cur, wr, wc, fr, fq); S.done(cur); }
        if (!has_next) break;
#pragma unroll
        for (int a = 0; a < 2; ++a)
#pragma unroll
            for (int b = 0; b < 2; ++b)
#pragma unroll
                for (int m = 0; m < 4; ++m)
#pragma unroll
                    for (int n = 0; n < 2; ++n) acc[a][b][m][n] = (f32x4){0.f, 0.f, 0.f, 0.f};
        cur = nxt; cA = nA; cB = nB; ++ui;
        if constexpr (ALIGN_EPI) { if (wr == 1) PG8_BAR; }
    }
    PG8_WAIT_V(0);
    if constexpr (!ALIGN_EPI) { if (wr == 0) PG8_BAR; }
    PG8_BAR;
    if constexpr (Epi::AFTER_DRAIN) { E.fused(acc, cur, wr, wc, fr, fq, lds, wid, lane); S.done(cur); }
#undef PG8_SA
#undef PG8_SB
#undef PG8_STAGE
#undef PG8_LDA
#undef PG8_LDB
#undef PG8_MMA
#undef PG8_WAIT_V
#undef PG8_WAIT_L
#undef PG8_BAR
#undef PG8_SCHED
}
__device__ __forceinline__ float silu_f(float x) { return x * __builtin_amdgcn_rcpf(1.f + __builtin_amdgcn_exp2f(-1.4426950408889634f * x)); }
__device__ __forceinline__ float sigm_f(float x) { return __builtin_amdgcn_rcpf(1.f + __builtin_amdgcn_exp2f(-1.4426950408889634f * x)); }
__device__ __forceinline__ u32x4 pack8(const f32x4 a, const f32x4 b) { u32x4 w; w.x = cvt_pk_bf16(a[0], a[1]); w.y = cvt_pk_bf16(a[2], a[3]); w.z = cvt_pk_bf16(b[0], b[1]); w.w = cvt_pk_bf16(b[2], b[3]); return w; }
__device__ __forceinline__ unsigned short bf1(float f) { return (unsigned short)(cvt_pk_bf16(f, 0.f) & 0xffffu); }

struct EpiEven {
    static constexpr bool PERM = true, AFTER_DRAIN = false, KHOOK = false;
    bf16_t *QA, *KA, *VAT, *GA, *QB, *KB, *VB, *GB; float* LOGF; float* out;
    const float *qg, *kg, *hlb; float qscale; int MTOT, MPR; size_t okp, oks, ovp, ovs;
    __device__ __forceinline__ void operator()(const f32x4 (&acc)[2][2][4][2], const Unit& u, int wr, int wc, int fr, int fq) const {
        const int typ = u.pn >> 1;
        int rb = u.pm * BM + wr * 64 + fr; asm volatile("" : "+v"(rb));
        const int c0 = (u.pn & 1) * 256 + wc * 64 + fq * 8;
        const int d0 = fq * 8;
#pragma unroll
        for (int ai = 0; ai < 2; ++ai)
#pragma unroll
            for (int m = 0; m < 4; ++m) {
                const int row = rb + ai * HALF + m * 16;
                f32x4 v[2][2];
#pragma unroll
                for (int bj = 0; bj < 2; ++bj)
#pragma unroll
                    for (int n = 0; n < 2; ++n) v[bj][n] = acc[ai][bj][m][n];
                if (typ <= 1) {
                    float ss = 0.f;
#pragma unroll
                    for (int bj = 0; bj < 2; ++bj)
#pragma unroll
                        for (int n = 0; n < 2; ++n) ss += (v[bj][n][0] * v[bj][n][0] + v[bj][n][1] * v[bj][n][1]) + (v[bj][n][2] * v[bj][n][2] + v[bj][n][3] * v[bj][n][3]);
                    ss += __shfl_xor(ss, 16); ss += __shfl_xor(ss, 32);
                    const float rstd = __builtin_amdgcn_rsqf(ss * (1.f / 64.f) + 1e-6f) * (typ == 0 ? qscale : 1.f);
                    const float* g = (typ == 0) ? qg : kg;
#pragma unroll
                    for (int bj = 0; bj < 2; ++bj) {
#pragma unroll
                        for (int n = 0; n < 2; ++n) { const f32x4 gv = *(const f32x4*)(g + d0 + 32 * bj + 4 * n); v[bj][n] = v[bj][n] * gv * rstd; }
                        const int c = c0 + 32 * bj;
                        if (typ == 0) *(u32x4*)(QA + (size_t)row * 512 + c) = pack8(v[bj][0], v[bj][1]);
                        else {
                            *(u32x4*)(KA + (size_t)row * 512 + c) = pack8(v[bj][0], v[bj][1]);
                            float* ko = out + (row < MPR ? okp + (size_t)row * 512 : oks + (size_t)(row - MPR) * 512) + c;
                            *(f32x4*)ko = v[bj][0]; *(f32x4*)(ko + 4) = v[bj][1];
                        }
                    }
                } else if (typ == 2) {
#pragma unroll
                    for (int bj = 0; bj < 2; ++bj) {
                        const int c = c0 + 32 * bj;
                        float* vo = out + (row < MPR ? ovp + (size_t)row * 512 : ovs + (size_t)(row - MPR) * 512) + c;
                        *(f32x4*)vo = v[bj][0]; *(f32x4*)(vo + 4) = v[bj][1];
                        *(u32x4*)(VAT + (size_t)row * 512 + c) = pack8(v[bj][0], v[bj][1]);
                    }
                } else if (typ == 5) {
#pragma unroll
                    for (int bj = 0; bj < 2; ++bj) {
                        const int c = c0 + 32 * bj;
                        f32x4 lf[2], kk[2];
#pragma unroll
                        for (int n = 0; n < 2; ++n)
#pragma unroll
                            for (int e = 0; e < 4; ++e) {
                                const int cc = c + 4 * n + e;
                                const float lb = __builtin_amdgcn_rcpf(1.f + __expf(hlb[512 + cc] - hlb[cc]));
                                const float sg = sigm_f(v[bj][n][e]);
                                lf[n][e] = __logf(lb + (1.f - lb) * sg);
                                kk[n][e] = (1.f - lb) * (1.f - sg);
                            }
                        *(f32x4*)(LOGF + (size_t)row * 512 + c) = lf[0]; *(f32x4*)(LOGF + (size_t)row * 512 + c + 4) = lf[1];
                        *(u32x4*)(KB + (size_t)row * 512 + c) = pack8(kk[0], kk[1]);
                    }
                } else {
                    bf16_t* dst = (typ == 3) ? GA : (typ == 4) ? QB : (typ == 6) ? VB : GB;
#pragma unroll
                    for (int bj = 0; bj < 2; ++bj) {
                        if (typ != 6) {
#pragma unroll
                            for (int n = 0; n < 2; ++n)
#pragma unroll
                                for (int e = 0; e < 4; ++e) v[bj][n][e] = silu_f(v[bj][n][e]);
                        }
                        *(u32x4*)(dst + (size_t)row * 512 + c0 + 32 * bj) = pack8(v[bj][0], v[bj][1]);
                    }
                }
            }
    }
};


struct EpiY1 {
    static constexpr bool PERM = false, AFTER_DRAIN = false, KHOOK = false;
    const float* x; bf16_t* Y1; float* SS1;
    __device__ __forceinline__ void operator()(const f32x4 (&acc)[2][2][4][2], const Unit& u, int wr, int wc, int fr, int fq) const {
        int row0 = u.pm * BM + wr * 64 + fr; asm volatile("" : "+v"(row0));
        const int col0 = u.pn * BM + wc * 32 + 4 * fq;
#pragma unroll
        for (int ai = 0; ai < 2; ++ai)
#pragma unroll
            for (int m = 0; m < 4; ++m) {
                const int row = row0 + ai * HALF + m * 16; float ss = 0.f;
#pragma unroll
                for (int bj = 0; bj < 2; ++bj)
#pragma unroll
                    for (int n = 0; n < 2; ++n) { const int c = col0 + bj * HALF + n * 16;
                        const f32x4 y = acc[ai][bj][m][n] + *(const f32x4*)(x + (size_t)row * 1024 + c);
                        *(unsigned long long*)(Y1 + (size_t)row * 1024 + c) = (unsigned long long)cvt_pk_bf16(y[0], y[1]) | ((unsigned long long)cvt_pk_bf16(y[2], y[3]) << 32);
                        ss += (y[0] * y[0] + y[1] * y[1]) + (y[2] * y[2] + y[3] * y[3]); }
                ss += __shfl_xor(ss, 16); ss += __shfl_xor(ss, 32);
                if (fq == 0) atomicAdd(SS1 + row, ss);
            }
    }
};


__device__ __forceinline__ float lg2gamma(int h) { return __builtin_amdgcn_logf(1.f - __builtin_amdgcn_exp2f(-5.f - (float)h)); }

template <int KIND> struct EpiOdd3 {
    static constexpr bool PERM = true, AFTER_DRAIN = false, KHOOK = false;
    bf16_t *AQ, *KCH, *KCT, *BV, *GC, *QC, *KC, *VC; const float *rcos, *rsin, *rcosT, *rsinT; int MPR; const float* SS1;
    __device__ __forceinline__ void operator()(const f32x4 (&acc)[2][2][4][2], const Unit& u, int wr, int wc, int fr, int fq) const {

        if (KIND == 0) {
            const int j0 = wc * 32 + fq * 8;
            int rb = u.pm * BM + wr * 64 + fr; asm volatile("" : "+v"(rb));
#pragma unroll
            for (int ai = 0; ai < 2; ++ai)
#pragma unroll
                for (int m = 0; m < 4; ++m) {
                    const int row = rb + ai * HALF + m * 16;
                    const float rs = __builtin_amdgcn_rsqf(SS1[row] * (1.f / 1024.f) + 1e-6f);
                    if (u.pn < 8) {
                        const int pos = row & (TP - 1), h = u.pn & 3, tl = row & 255;
                        const float sc = rs * ((u.pn < 4) ? __builtin_amdgcn_exp2f((float)tl * lg2gamma(h)) : 0.0625f * __builtin_amdgcn_exp2f(-(float)tl * lg2gamma(h)));
                        f32x4 o1[2], o2[2];
#pragma unroll
                        for (int n = 0; n < 2; ++n) {
                            const f32x4 c = *(const f32x4*)(rcos + (size_t)pos * 128 + j0 + 4 * n), s = *(const f32x4*)(rsin + (size_t)pos * 128 + j0 + 4 * n);
                            const f32x4 x1 = acc[ai][0][m][n], x2 = acc[ai][1][m][n];
                            o1[n] = (x1 * c - x2 * s) * sc; o2[n] = (x2 * c + x1 * s) * sc;
                        }
                        bf16_t* dst = (u.pn < 4) ? AQ + (size_t)row * 2048 + h * 512 + 256 + j0 : KCH + (size_t)row * 1024 + h * 256 + j0;
                        *(u32x4*)dst = pack8(o1[0], o1[1]); *(u32x4*)(dst + 128) = pack8(o2[0], o2[1]);
                        if (u.pn >= 4) {
                            bf16_t* kt = KCT + ((size_t)(((row >> 13) * 4 + h) * 32 + ((row >> 8) & 31)) * 256 + j0) * 256 + tl;
#pragma unroll
                            for (int n = 0; n < 2; ++n)
#pragma unroll
                                for (int e = 0; e < 4; ++e) { kt[(size_t)(4 * n + e) * 256] = bf1(o1[n][e]); kt[(size_t)(128 + 4 * n + e) * 256] = bf1(o2[n][e]); }
                        }
                        asm volatile("" ::: "memory");
                    } else {
                        bf16_t* dst = GC + (size_t)row * 2048 + (u.pn - 8) * 256 + j0;
#pragma unroll
                        for (int bj = 0; bj < 2; ++bj) {
                            f32x4 a = acc[ai][bj][m][0] * rs, b = acc[ai][bj][m][1] * rs;
#pragma unroll
                            for (int e = 0; e < 4; ++e) { a[e] = silu_f(a[e]); b[e] = silu_f(b[e]); }
                            *(u32x4*)(dst + 128 * bj) = pack8(a, b);
                        }
                    }
                }
            return;
        }
        int fro = fr; asm volatile("" : "+v"(fro));
        {
            f32x4 rr[2][2];
#pragma unroll
            for (int bj = 0; bj < 2; ++bj) { const int tok0 = u.pn * BM + bj * HALF + wc * 32 + fq * 8;
                rr[bj][0] = *(const f32x4*)(SS1 + tok0); rr[bj][1] = *(const f32x4*)(SS1 + tok0 + 4); }
#pragma unroll
            for (int bj = 0; bj < 2; ++bj)
#pragma unroll
                for (int n = 0; n < 2; ++n)
#pragma unroll
                    for (int e = 0; e < 4; ++e) rr[bj][n][e] = __builtin_amdgcn_rsqf(rr[bj][n][e] * (1.f / 1024.f) + 1e-6f);
#pragma unroll
            for (int ai = 0; ai < 2; ++ai)
#pragma unroll
                for (int m = 0; m < 4; ++m) {
                    const int vf = (u.pm - 4) * BM + ai * HALF + wr * 64 + m * 16 + fro, h = vf >> 9, dv = vf & 511;
#pragma unroll
                    for (int bj = 0; bj < 2; ++bj) {
                        const int tok0 = u.pn * BM + bj * HALF + wc * 32 + fq * 8, b = tok0 >> 13, c = (tok0 >> 8) & 31, sl = tok0 & 255;
                        *(u32x4*)(BV + ((size_t)((b * 4 + h) * 32 + c) * 512 + dv) * 512 + sl) = pack8(acc[ai][bj][m][0] * rr[bj][0], acc[ai][bj][m][1] * rr[bj][1]);
                    }
                }
        }
    }
};
template <int KIND> struct Sched3 {
    StaticOrder so; const char *H, *W3T; int G, c;
    __device__ __forceinline__ void init(const void* H_, const void* W3T_, int G_, int c_) { H = (const char*)H_; W3T = (const char*)W3T_; G = G_; c = c_; so.init(16384, 4096, G_, c_); }
    __device__ __forceinline__ bool next(int i, Unit& u) const {
        const int L = i * G + c; u.aux = 0; u.kind = KIND;
        if (KIND == 0) return so.next(i, u);
        if (KIND == 1) { if (L >= 512) return false; u.pm = 4 + (L & 7); u.pn = L >> 3; return true; }
        if (L >= 24) return false; u.pm = 64; u.pn = L; return true;
    }
    __device__ __forceinline__ const char* a_base(const Unit& u) const { return (KIND == 1) ? W3T + (size_t)(1024 + 256 * u.pm) * 2048 : H + (size_t)u.pm * 256 * 2048; }
    __device__ __forceinline__ const char* b_base(const Unit& u) const {
        if (KIND == 1) return H + (size_t)u.pn * 256 * 2048;
        const int r0 = (KIND == 0 && u.pn >= 8) ? 4096 + 256 * (u.pn - 8) : 256 * u.pn;
        return W3T + (size_t)r0 * 2048; }
    __device__ __forceinline__ void a_ready(const Unit&) const {}
    __device__ __forceinline__ void done(const Unit&) const {}
};
struct SchedPlain {
    StaticOrder so; const char *A, *Bt; size_t ta, tb;
    __device__ __forceinline__ void init(const void* A_, const void* Bt_, int M, int N, int K, int G, int c) { A = (const char*)A_; Bt = (const char*)Bt_; ta = (size_t)256 * K * 2; tb = ta; so.init(M, N, G, c); }
    __device__ __forceinline__ bool next(int i, Unit& u) const { u.kind = 0; u.aux = 0; return so.next(i, u); }
    __device__ __forceinline__ const char* a_base(const Unit& u) const { return A + (size_t)u.pm * ta; }
    __device__ __forceinline__ const char* b_base(const Unit& u) const { return Bt + (size_t)u.pn * tb; }
    __device__ __forceinline__ void a_ready(const Unit&) const {}
    __device__ __forceinline__ void done(const Unit&) const {}
};
struct SchedRet {
    const char *Ab, *Bb; int G, c, mode;
    __device__ __forceinline__ bool next(int i, Unit& u) const {
        const int L = i * G + c, n = (mode == 1) ? 256 : 512; if (L >= n) return false;
        int bc, half; if (mode == 1) { bc = L; half = 0; } else { bc = L >> 1; half = L & 1; }
        u.pm = bc; u.pn = half; u.kind = 0; u.aux = (bc >> 7) * TP + (bc & 31) * 256; return true;
    }
    __device__ __forceinline__ const char* a_base(const Unit& u) const {
        if (mode == 0) return Ab + ((size_t)u.pm * 512 + u.pn * 256) * 512 * 2;
        const int h = (u.pm >> 5) & 3;
        return Ab + ((size_t)u.aux * 2048 + h * 512 + (mode == 1 ? 256 : 0)) * 2; }
    __device__ __forceinline__ const char* b_base(const Unit& u) const {
        const int h = (u.pm >> 5) & 3;
        if (mode == 0) return Bb + (size_t)u.pm * 256 * 256 * 2;
        if (mode == 1) return Bb + ((size_t)u.aux * 1024 + h * 256) * 2;
        return Bb + ((size_t)u.pm * 512 + u.pn * 256) * 512 * 2; }
    __device__ __forceinline__ void a_ready(const Unit&) const {}
    __device__ __forceinline__ void done(const Unit&) const {}
};
struct EpiRetA {
    static constexpr bool PERM = true, AFTER_DRAIN = false, KHOOK = false;
    bf16_t* DST;
    __device__ __forceinline__ void operator()(const f32x4 (&acc)[2][2][4][2], const Unit& u, int wr, int wc, int fr, int fq) const {
        bf16_t* base = DST + ((size_t)u.pm * 512 + u.pn * 256) * 256;
        int rb = wr * 64 + fr; asm volatile("" : "+v"(rb));
#pragma unroll
        for (int ai = 0; ai < 2; ++ai)
#pragma unroll
            for (int m = 0; m < 4; ++m) { bf16_t* rp = base + (size_t)(ai * HALF + m * 16 + rb) * 256 + wc * 32 + 8 * fq;
#pragma unroll
                for (int bj = 0; bj < 2; ++bj) *(u32x4*)(rp + bj * HALF) = pack8(acc[ai][bj][m][0], acc[ai][bj][m][1]); }
    }
};
struct EpiRetP {
    static constexpr bool PERM = true, AFTER_DRAIN = false, KHOOK = false;
    bf16_t* AQ;
    __device__ __forceinline__ void operator()(const f32x4 (&acc)[2][2][4][2], const Unit& u, int wr, int wc, int fr, int fq) const {
        const int h = (u.pm >> 5) & 3;
        int rb = wr * 64 + fr; asm volatile("" : "+v"(rb));
#pragma unroll
        for (int ai = 0; ai < 2; ++ai)
#pragma unroll
            for (int m = 0; m < 4; ++m) { const int t = ai * HALF + m * 16 + rb;
#pragma unroll
                for (int bj = 0; bj < 2; ++bj) { const int s0 = bj * HALF + wc * 32 + fq * 8; f32x4 a = acc[ai][bj][m][0], b = acc[ai][bj][m][1];
#pragma unroll
                    for (int e = 0; e < 4; ++e) { if (s0 + e > t) a[e] = 0.f; if (s0 + 4 + e > t) b[e] = 0.f; }
                    *(u32x4*)(AQ + (size_t)(u.aux + t) * 2048 + h * 512 + s0) = pack8(a, b); } }
    }
};
struct EpiRetO {
    static constexpr bool PERM = true, AFTER_DRAIN = false, KHOOK = false;
    const bf16_t* GC; bf16_t* MIX2; float* SS;
    __device__ __forceinline__ void operator()(const f32x4 (&acc)[2][2][4][2], const Unit& u, int wr, int wc, int fr, int fq) const {
        const int h = (u.pm >> 5) & 3;
        int rb = u.aux + wr * 64 + fr; asm volatile("" : "+v"(rb));
#pragma unroll
        for (int ai = 0; ai < 2; ++ai)
#pragma unroll
            for (int m = 0; m < 4; ++m) { const size_t row = (size_t)(rb + ai * HALF + m * 16); float ss = 0.f;
#pragma unroll
                for (int bj = 0; bj < 2; ++bj) { const int col = h * 512 + u.pn * 256 + bj * HALF + wc * 32 + fq * 8; f32x4 a = acc[ai][bj][m][0], b = acc[ai][bj][m][1];
                    ss += (a[0] * a[0] + a[1] * a[1]) + (a[2] * a[2] + a[3] * a[3]) + (b[0] * b[0] + b[1] * b[1]) + (b[2] * b[2] + b[3] * b[3]);
                    const u32x4 g = *(const u32x4*)(GC + row * 2048 + col);
                    a[0] *= __builtin_bit_cast(float, g.x << 16); a[1] *= __builtin_bit_cast(float, g.x & 0xffff0000u); a[2] *= __builtin_bit_cast(float, g.y << 16); a[3] *= __builtin_bit_cast(float, g.y & 0xffff0000u);
                    b[0] *= __builtin_bit_cast(float, g.z << 16); b[1] *= __builtin_bit_cast(float, g.z & 0xffff0000u); b[2] *= __builtin_bit_cast(float, g.w << 16); b[3] *= __builtin_bit_cast(float, g.w & 0xffff0000u);
                    *(u32x4*)(MIX2 + row * 2048 + col) = pack8(a, b); }
                ss += __shfl_xor(ss, 16); ss += __shfl_xor(ss, 32);
                if (fq == 0) atomicAdd(SS + row * 4 + h, ss); }
    }
};

struct SchedSplit {
    const char *A, *Bt; int nN, nP, G, c; size_t lda2, ldb2;
    __device__ __forceinline__ bool next(int i, Unit& u) const { const int L = i * G + c; if (L >= nN * nP) return false; u.pn = L / nP; u.aux = L % nP; u.pm = 0; u.kind = 0; return true; }
    __device__ __forceinline__ const char* a_base(const Unit& u) const { return A + (size_t)u.aux * 512; }
    __device__ __forceinline__ const char* b_base(const Unit& u) const { return Bt + (size_t)u.pn * 256 * ldb2 + (size_t)u.aux * 512; }
    __device__ __forceinline__ void a_ready(const Unit&) const {}
    __device__ __forceinline__ void done(const Unit&) const {}
};
struct EpiSlab {
    static constexpr bool PERM = true, AFTER_DRAIN = false, KHOOK = false;
    bf16_t* slab; int ncols;
    __device__ __forceinline__ void operator()(const f32x4 (&acc)[2][2][4][2], const Unit& u, int wr, int wc, int fr, int fq) const {
        int rb = wr * 64 + fr; asm volatile("" : "+v"(rb));
        bf16_t* base = slab + (size_t)u.aux * 256 * ncols + u.pn * BM + wc * 32 + 8 * fq;
#pragma unroll
        for (int ai = 0; ai < 2; ++ai)
#pragma unroll
            for (int m = 0; m < 4; ++m) { bf16_t* rp = base + (size_t)(rb + ai * HALF + m * 16) * ncols;
#pragma unroll
                for (int bj = 0; bj < 2; ++bj) *(u32x4*)(rp + bj * HALF) = pack8(acc[ai][bj][m][0], acc[ai][bj][m][1]); }
    }
};
struct EpiOut {
    static constexpr bool PERM = false, AFTER_DRAIN = false, KHOOK = true;
    const bf16_t* Y1; float* out; const float* SS;
    __device__ __forceinline__ float rstd(int row, int h) const { return __builtin_amdgcn_rsqf(SS[(size_t)row * 4 + h] * (1.f / 512.f) + 1e-6f); }
    __device__ __forceinline__ void khook(f32x4 (&acc)[2][2][4][2], const Unit& u, int hb, int wr, int fr) const {
        int rb = u.pm * BM + wr * 64 + fr; asm volatile("" : "+v"(rb));
#pragma unroll
        for (int ai = 0; ai < 2; ++ai)
#pragma unroll
            for (int m = 0; m < 4; ++m) { const int row = rb + ai * HALF + m * 16; const float ratio = rstd(row, hb - 1) * __builtin_amdgcn_rcpf(rstd(row, hb));
#pragma unroll
                for (int bj = 0; bj < 2; ++bj)
#pragma unroll
                    for (int n = 0; n < 2; ++n) acc[ai][bj][m][n] = acc[ai][bj][m][n] * ratio; }
    }
    __device__ __forceinline__ void operator()(const f32x4 (&acc)[2][2][4][2], const Unit& u, int wr, int wc, int fr, int fq) const {
        int row0 = u.pm * BM + wr * 64 + fr; asm volatile("" : "+v"(row0));
        const int col0 = u.pn * BM + wc * 32 + 4 * fq;
#pragma unroll
        for (int ai = 0; ai < 2; ++ai)
#pragma unroll
            for (int m = 0; m < 4; ++m) { const int row = row0 + ai * HALF + m * 16; const float r3 = rstd(row, 3);
#pragma unroll
                for (int bj = 0; bj < 2; ++bj)
#pragma unroll
                    for (int n = 0; n < 2; ++n) { const int c = col0 + bj * HALF + n * 16; const unsigned long long yq = *(const unsigned long long*)(Y1 + (size_t)row * 1024 + c);
                        const f32x4 yv = {__builtin_bit_cast(float, (unsigned)yq << 16), __builtin_bit_cast(float, (unsigned)yq & 0xffff0000u), __builtin_bit_cast(float, (unsigned)(yq >> 32) << 16), __builtin_bit_cast(float, (unsigned)(yq >> 32) & 0xffff0000u)};
                        *(f32x4*)(out + (size_t)row * 1024 + c) = acc[ai][bj][m][n] * r3 + yv; } }
    }
};
}
#define GAS __attribute__((address_space(1)))
#define LAS __attribute__((address_space(3)))
typedef unsigned short bf16;
typedef unsigned v4u __attribute__((ext_vector_type(4)));
typedef float f32x4 __attribute__((ext_vector_type(4)));
typedef short bf16x8 __attribute__((ext_vector_type(8)));
typedef GAS unsigned gu32;
typedef GAS unsigned long long gu64;
#define RLX_AGENT __ATOMIC_RELAXED, __HIP_MEMORY_SCOPE_AGENT
#define LDS_WAIT() asm volatile("s_waitcnt lgkmcnt(0)" ::: "memory")
#define VM_WAIT() asm volatile("s_waitcnt vmcnt(0)" ::: "memory")
__device__ __forceinline__ unsigned long long rt() { return __builtin_amdgcn_s_memrealtime(); }
__device__ __forceinline__ unsigned f2bf(float f) { unsigned u = __builtin_bit_cast(unsigned, f); return (u + 0x7fffu + ((u >> 16) & 1u)) >> 16; }
__device__ __forceinline__ unsigned pk2(float lo, float hi) { return f2bf(lo) | (f2bf(hi) << 16); }
#define XB_TMO      128
#define XB_XCNT(j)  (256  + 64 * (j))
#define XB_XSUB(j)  (1280 + 64 * (j))
#define XB_XGEN(j)  (2304 + 64 * (j))
#define XB_TOP      3328
#define XB_TOPGEN   3392
#define XCD_BAR_WORDS 3456
#define XB_SPIN_CAP (1u << 18)

__device__ __forceinline__ unsigned xb_ld(unsigned* p)              { return __hip_atomic_load(p, __ATOMIC_RELAXED, __HIP_MEMORY_SCOPE_AGENT); }
__device__ __forceinline__ unsigned xb_add(unsigned* p, unsigned v) { return __hip_atomic_fetch_add(p, v, __ATOMIC_RELAXED, __HIP_MEMORY_SCOPE_AGENT); }
__device__ __forceinline__ unsigned xb_xcc_id() { return (unsigned)__builtin_amdgcn_s_getreg((3 << 11) | 20) & 0xFu; }
#define XB_SPIN(cond, bar) do { unsigned _sp = 0; while (cond) { __builtin_amdgcn_s_sleep(1); \
    if ((++_sp & 255u) == 0u) { if (xb_ld(&(bar)[XB_TMO])) break; if (_sp > XB_SPIN_CAP) { atomicAdd(&(bar)[XB_TMO], 1u); break; } } } } while (0)

struct XcdBarrier {
    unsigned* bar; unsigned x;
    volatile LAS unsigned* st;
};

__device__ __forceinline__ XcdBarrier xcd_barrier_post(unsigned* bar, volatile LAS unsigned* st) {
    XcdBarrier b; b.bar = bar; b.x = xb_xcc_id(); b.st = st;
    if (threadIdx.x == 0) (void)xb_add(&bar[XB_XCNT(b.x)], 1u);
    return b;
}
__device__ __forceinline__ void xcd_barrier_complete(unsigned* bar, unsigned x, unsigned& nloc, unsigned& nx) {
    const unsigned G = gridDim.x * gridDim.y * gridDim.z;
    unsigned sum, cnt, mine, sp = 0u;
    for (;;) {
        sum = 0u; cnt = 0u; mine = 0u;
#pragma unroll
        for (unsigned j = 0; j < 16; ++j) { const unsigned c = xb_ld(&bar[XB_XCNT(j)]); sum += c; cnt += (c > 0u) ? 1u : 0u; mine = (j == x) ? c : mine; }
        if (sum == G) break;
        __builtin_amdgcn_s_sleep(1);
        if ((++sp & 255u) == 0u) { if (xb_ld(&bar[XB_TMO])) break; if (sp > XB_SPIN_CAP) { atomicAdd(&bar[XB_TMO], 1u); break; } }
    }
    nloc = mine > 0u ? mine : 1u; nx = cnt > 0u ? cnt : 1u;
}

__device__ __forceinline__ void xcd_barrier(const XcdBarrier& b) {
    asm volatile("s_waitcnt vmcnt(0)" ::: "memory");
    __syncthreads();
    if (threadIdx.x == 0) {
        unsigned* bar = b.bar;
        __builtin_amdgcn_s_waitcnt(0);
        unsigned nloc = b.st[0], nx = b.st[1];
        if (nloc == 0u) { xcd_barrier_complete(bar, b.x, nloc, nx); b.st[0] = nloc; b.st[1] = nx; }
        const unsigned old = xb_add(&bar[XB_XSUB(b.x)], 1u);
        const unsigned gen = old / nloc;
        if (old + 1u == (gen + 1u) * nloc) {
            __builtin_amdgcn_fence(__ATOMIC_RELEASE, "agent");
            asm volatile("s_waitcnt vmcnt(0)" ::: "memory");
            const unsigned og = xb_add(&bar[XB_TOP], 1u);
            const unsigned tg = og / nx;
            if (og + 1u == (tg + 1u) * nx) xb_add(&bar[XB_TOPGEN], 1u);
            else XB_SPIN(xb_ld(&bar[XB_TOPGEN]) == tg, bar);
            __builtin_amdgcn_fence(__ATOMIC_ACQUIRE, "agent");
            xb_add(&bar[XB_XGEN(b.x)], 1u);
            asm volatile("s_waitcnt vmcnt(0)" ::: "memory");
        } else {
            XB_SPIN(xb_ld(&bar[XB_XGEN(b.x)]) == gen, bar);
            __builtin_amdgcn_fence(__ATOMIC_ACQUIRE, "agent");
            asm volatile("s_waitcnt vmcnt(0)" ::: "memory");
        }
    }
    __syncthreads();
}
constexpr size_t MiB = 1u << 20;
constexpr size_t WS_CTL = 0, CTL_ZERO_BYTES = 1 * MiB;
constexpr size_t WS_W1T = 2 * MiB;
constexpr size_t WS_W2T = 10 * MiB;
constexpr size_t WS_W3T = 12 * MiB;
constexpr size_t WS_W4T = 24 * MiB;
constexpr size_t WS_RCOS = 28 * MiB, WS_RSIN = 33 * MiB;
constexpr size_t SZ_H = (size_t)MT * 1024 * 2;
constexpr size_t SZ_S = (size_t)MT * 512 * 2;
constexpr size_t WS_H = 40 * MiB;
constexpr size_t WS_QA = WS_H + 33 * MiB, WS_KA = WS_QA + 17 * MiB, WS_VAT = WS_KA + 17 * MiB, WS_GA = WS_VAT + 17 * MiB;
constexpr size_t WS_QB = WS_GA + 17 * MiB, WS_KB = WS_QB + 17 * MiB, WS_VB = WS_KB + 17 * MiB, WS_GB = WS_VB + 17 * MiB;
constexpr size_t WS_LOGF = WS_GB + 17 * MiB;
constexpr size_t WS_OB = WS_LOGF + 33 * MiB;
constexpr size_t WS_MIX = WS_OB + 33 * MiB;
constexpr size_t WS_Y1 = WS_MIX + 33 * MiB;
constexpr size_t WS_QC = WS_Y1 + 65 * MiB, WS_KC = WS_QC + 33 * MiB;
constexpr size_t WS_VC = WS_KC + 33 * MiB, WS_GC = WS_VC + 65 * MiB;
constexpr size_t WS_OC = WS_GC + 65 * MiB;
constexpr size_t WS_MIX2 = WS_OC + 130 * MiB;
constexpr size_t WS_AQ = WS_MIX2 + 65 * MiB;
constexpr size_t WS_KCH = WS_AQ + 64 * MiB;
constexpr size_t WS_KCT = WS_KCH + 32 * MiB;
constexpr size_t WS_BV = WS_KCT + 32 * MiB;
constexpr size_t WS_DST = WS_BV + 128 * MiB;
constexpr size_t WS_RCOST = WS_DST + 128 * MiB, WS_RSINT = WS_RCOST + 5 * MiB;
constexpr size_t WS_DSH = WS_RSINT + 5 * MiB;
constexpr size_t WS_SST = WS_DSH + 16 * MiB;
constexpr size_t WS_DD = WS_SST + 16 * MiB;
constexpr size_t WS_SLAB = WS_DD + 1 * MiB;
constexpr size_t WS_SLAB4 = WS_SLAB + 24 * MiB;
constexpr size_t WS_END = WS_SLAB4 + 8 * MiB;
constexpr size_t CTL_SS = 65536;
constexpr size_t CTL_SS1 = CTL_SS + (size_t)MP * 16;
constexpr size_t CTL_SSS = CTL_SS1 + (size_t)MT * 4;
static_assert(CTL_SSS + 4096 <= CTL_ZERO_BYTES, "SS / SS1 / SSS inside the zeroed region");
static_assert(SZ_H <= 33 * MiB && SZ_S <= 17 * MiB && (size_t)MT * 2048 * 4 <= 130 * MiB, "ws map");

constexpr int CW_TMO = 0, CW_CODE = 1, CW_BAR = 4096;

constexpr int RING_OFF = 0, RING_BYTES = 131072;
constexpr int LDSCTL_OFF = RING_BYTES, MISC_OFF = LDSCTL_OFF + 320;
constexpr int LDS_BYTES = 147456;
constexpr int NWAVES = 8;

typedef float f32x16 __attribute__((ext_vector_type(16)));
__device__ __forceinline__ float bf2f(bf16 b) { return __builtin_bit_cast(float, (unsigned)b << 16); }
__device__ __forceinline__ float bflo(unsigned w) { return __builtin_bit_cast(float, w << 16); }
__device__ __forceinline__ float bfhi(unsigned w) { return __builtin_bit_cast(float, w & 0xffff0000u); }
__device__ __forceinline__ int crow(int r, int hi) { return (r & 3) + 8 * (r >> 2) + 4 * hi; }
__device__ __forceinline__ float wave_sum(float v) {
#pragma unroll
    for (int o = 1; o < 64; o <<= 1) v += __shfl_xor(v, o);
    return v;
}

struct Frame {
    LAS unsigned char* lds;
    volatile LAS unsigned* MISC;
    gu32* ctl;
    int tid, lane, wave, G, bid;
    const float *xp, *xs, *ck, *cv, *st_h, *st_r, *ng, *w1, *w2, *qg, *kg, *sbb, *hlb, *og, *w3, *w4; const int* pt;
    float* out;
    unsigned char* ws;
    __device__ __forceinline__ float* SSS() const { return (float*)(ws + WS_CTL + CTL_SSS); }
    __device__ __forceinline__ float* SS1() const { return (float*)(ws + WS_CTL + CTL_SS1); }
    __device__ __forceinline__ bf16* SLAB() const { return (bf16*)(ws + WS_SLAB); }
    __device__ __forceinline__ bf16* Y1B() const { return (bf16*)(ws + WS_OB); }
    __device__ __forceinline__ bf16* SLAB4() const { return (bf16*)(ws + WS_SLAB4); }
    __device__ __forceinline__ bf16* W1T() const { return (bf16*)(ws + WS_W1T); }
    __device__ __forceinline__ bf16* W2T() const { return (bf16*)(ws + WS_W2T); }
    __device__ __forceinline__ bf16* W3T() const { return (bf16*)(ws + WS_W3T); }
    __device__ __forceinline__ bf16* W4T() const { return (bf16*)(ws + WS_W4T); }
    __device__ __forceinline__ bf16* H() const { return (bf16*)(ws + WS_H); }
    __device__ __forceinline__ bf16* QA() const { return (bf16*)(ws + WS_QA); }
    __device__ __forceinline__ bf16* KA() const { return (bf16*)(ws + WS_KA); }
    __device__ __forceinline__ bf16* VAT() const { return (bf16*)(ws + WS_VAT); }
    __device__ __forceinline__ bf16* VA() const { return (bf16*)(ws + WS_VAT); }
    __device__ __forceinline__ bf16* GA() const { return (bf16*)(ws + WS_GA); }
    __device__ __forceinline__ bf16* QB() const { return (bf16*)(ws + WS_QB); }
    __device__ __forceinline__ bf16* KB() const { return (bf16*)(ws + WS_KB); }
    __device__ __forceinline__ bf16* VB() const { return (bf16*)(ws + WS_VB); }
    __device__ __forceinline__ bf16* GB() const { return (bf16*)(ws + WS_GB); }
    __device__ __forceinline__ bf16* MIX() const { return (bf16*)(ws + WS_MIX); }
    __device__ __forceinline__ bf16* QC() const { return (bf16*)(ws + WS_QC); }
    __device__ __forceinline__ bf16* KC() const { return (bf16*)(ws + WS_KC); }
    __device__ __forceinline__ bf16* VC() const { return (bf16*)(ws + WS_VC); }
    __device__ __forceinline__ bf16* GC() const { return (bf16*)(ws + WS_GC); }
    __device__ __forceinline__ bf16* MIX2() const { return (bf16*)(ws + WS_MIX2); }
    __device__ __forceinline__ float* RCOS() const { return (float*)(ws + WS_RCOS); }
    __device__ __forceinline__ float* RSIN() const { return (float*)(ws + WS_RSIN); }
    __device__ __forceinline__ float* LOGF() const { return (float*)(ws + WS_LOGF); }
    __device__ __forceinline__ float* OB() const { return (float*)(ws + WS_OB); }
    __device__ __forceinline__ float* Y1() const { return (float*)(ws + WS_Y1); }
    __device__ __forceinline__ float* OC() const { return (float*)(ws + WS_OC); }
    __device__ __forceinline__ bf16* AQ() const { return (bf16*)(ws + WS_AQ); }
    __device__ __forceinline__ bf16* KCH() const { return (bf16*)(ws + WS_KCH); }
    __device__ __forceinline__ bf16* KCT() const { return (bf16*)(ws + WS_KCT); }
    __device__ __forceinline__ bf16* BV() const { return (bf16*)(ws + WS_BV); }
    __device__ __forceinline__ float* DST() const { return (float*)(ws + WS_DST); }
    __device__ __forceinline__ float* RCOST() const { return (float*)(ws + WS_RCOST); }
    __device__ __forceinline__ float* RSINT() const { return (float*)(ws + WS_RSINT); }
    __device__ __forceinline__ float* SS() const { return (float*)(ws + WS_CTL + CTL_SS); }
    __device__ __forceinline__ float* DSH() const { return (float*)(ws + WS_DSH); }
    __device__ __forceinline__ float* SST() const { return (float*)(ws + WS_SST); }
    __device__ __forceinline__ float* DD() const { return (float*)(ws + WS_DD); }
};

template <bool HP>
__device__ __forceinline__ void p0_transpose_item(const float* W, int K, int N, bf16* WT, LAS float* scr, int item, int lane, const float* gk = nullptr) {
    const int nblk = N / 32, kb = item / nblk, nb = item % nblk, k0 = 64 * kb, n0 = 32 * nb;
#pragma unroll 8
    for (int i = 0; i < 32; ++i) { const int kk = 2 * i + (lane >> 5); float w = W[(size_t)(k0 + kk) * N + n0 + (lane & 31)]; if (gk) w *= gk[k0 + kk]; scr[kk * 33 + (lane & 31)] = w; }
    LDS_WAIT(); asm volatile("" ::: "memory");
    const int c = lane & 7;
#pragma unroll
    for (int j = 0; j < 4; ++j) { const int n = (lane >> 3) + 8 * j; const LAS float* s = scr + (8 * c) * 33 + n;
        v4u o; o.x = pk2(s[0 * 33], s[1 * 33]); o.y = pk2(s[2 * 33], s[3 * 33]); o.z = pk2(s[4 * 33], s[5 * 33]); o.w = pk2(s[6 * 33], s[7 * 33]);
        int ca = n0 + n;
        if (HP) ca = (ca & ~255) | (((ca >> 5) & 1) << 7) | (((ca >> 6) & 3) << 5) | (ca & 31);
        *(GAS v4u*)(WT + (size_t)ca * K + k0 + 8 * c) = o; }
    LDS_WAIT(); asm volatile("" ::: "memory");
}
__device__ __forceinline__ void rms_row_to_bf16(int lane, const float* xrow, const float* g, bf16* orow) {
    const GAS f32x4* xr = (const GAS f32x4*)xrow + lane;
    f32x4 v[4]; float s2 = 0.f;
#pragma unroll
    for (int j = 0; j < 4; ++j) { v[j] = xr[64 * j]; s2 += (v[j].x * v[j].x + v[j].y * v[j].y) + (v[j].z * v[j].z + v[j].w * v[j].w); }
    const float rstd = 1.f / sqrtf(wave_sum(s2) * (1.f / 1024.f) + EPS);
    GAS unsigned long long* o8 = (GAS unsigned long long*)orow + lane;
#pragma unroll
    for (int j = 0; j < 4; ++j) { const f32x4 gv = *((const GAS f32x4*)g + lane + 64 * j);
        o8[64 * j] = (unsigned long long)pk2(v[j].x * rstd * gv.x, v[j].y * rstd * gv.y) | ((unsigned long long)pk2(v[j].z * rstd * gv.z, v[j].w * rstd * gv.w) << 32); }
}
__device__ __forceinline__ void sincos_acc(float a, float& s, float& c) {
    const double x = (double)a;
    const double kd = __builtin_rint(x * 0.63661977236758134308);
    const double r = (x - kd * 1.57079632673412561417e+00) - kd * 6.07710050650619224932e-11;
    const double r2 = r * r;
    const double sp = r * (1.0 + r2 * (-1.66666666666666324348e-01 + r2 * (8.33333333332248946124e-03 + r2 * (-1.98412698298579493134e-04 + r2 * (2.75573137070700676789e-06 + r2 * (-2.50507602534068634195e-08 + r2 * 1.58969099521155010221e-10))))));
    const double cp = 1.0 + r2 * (-0.5 + r2 * (4.16666666666666019037e-02 + r2 * (-1.38888888888741095749e-03 + r2 * (2.48015872894767294178e-05 + r2 * (-2.75573143513906633035e-07 + r2 * (2.08757232129817482790e-09 + r2 * -1.13596475577881948265e-11))))));
    const int q = (int)((long long)kd & 3);
    const double sv = (q & 1) ? cp : sp, cv = (q & 1) ? sp : cp;
    s = (float)((q & 2) ? -sv : sv);
    c = (float)(((q + 1) & 2) ? -cv : cv);
}
__device__ __forceinline__ void p0_prologue(Frame& F) {
    LAS float* scr = (LAS float*)(F.lds + RING_OFF + F.wave * 16384);
    const int gw = F.bid * NWAVES + F.wave, NGW = F.G * NWAVES;
    constexpr int I1 = (1024 / 64) * (N1 / 32), I2 = (1024 / 64) * (1024 / 32), I3 = (1024 / 64) * (N3 / 32), I4 = (2048 / 64) * (1024 / 32);
    for (int it = gw; it < I1 + I2 + I3 + I4; it += NGW) {
        int r = it;
        if (r < I1) { p0_transpose_item<true>(F.w1, 1024, N1, F.W1T(), scr, r, F.lane); continue; } r -= I1;
        if (r < I2) { p0_transpose_item<false>(F.w2, 1024, 1024, F.W2T(), scr, r, F.lane); continue; } r -= I2;
        if (r < I3) { p0_transpose_item<false>(F.w3, 1024, N3, F.W3T(), scr, r, F.lane, F.ng + 1024); continue; } r -= I3;
        p0_transpose_item<false>(F.w4, 2048, 1024, F.W4T(), scr, r, F.lane);
    }
    {
        f32x4 gv[4], cur[4];
#pragma unroll
        for (int j = 0; j < 4; ++j) gv[j] = *((const GAS f32x4*)F.ng + F.lane + 64 * j);
        int m = gw;
        if (m < MT) { const float* xr = (m < MP) ? F.xp + (size_t)m * DM : F.xs + (size_t)(m - MP) * DM;
#pragma unroll
            for (int j = 0; j < 4; ++j) cur[j] = *((const GAS f32x4*)xr + F.lane + 64 * j); }
        while (m < MT) {
            const int mn = m + NGW; f32x4 nxt[4];
            if (mn < MT) { const float* xr = (mn < MP) ? F.xp + (size_t)mn * DM : F.xs + (size_t)(mn - MP) * DM;
#pragma unroll
                for (int j = 0; j < 4; ++j) nxt[j] = *((const GAS f32x4*)xr + F.lane + 64 * j); }
            float s2 = 0.f;
#pragma unroll
            for (int j = 0; j < 4; ++j) s2 += (cur[j].x * cur[j].x + cur[j].y * cur[j].y) + (cur[j].z * cur[j].z + cur[j].w * cur[j].w);
            const float rstd = 1.f / sqrtf(wave_sum(s2) * (1.f / 1024.f) + EPS);
            GAS unsigned long long* o8 = (GAS unsigned long long*)(F.H() + (size_t)m * DM) + F.lane;
#pragma unroll
            for (int j = 0; j < 4; ++j)
                o8[64 * j] = (unsigned long long)pk2(cur[j].x * rstd * gv[j].x, cur[j].y * rstd * gv[j].y) | ((unsigned long long)pk2(cur[j].z * rstd * gv[j].z, cur[j].w * rstd * gv[j].w) << 32);
#pragma unroll
            for (int j = 0; j < 4; ++j) cur[j] = nxt[j];
            m = mn;
        }
    }
    const int ri = F.tid & 127;
    const float rinv = (float)(1.0 / exp2((double)((float)ri / 127.0f) * 13.287712379549449));
    for (int e = F.bid * (NWAVES * 64) + F.tid; e < (PAST + TSQ) * 128; e += F.G * NWAVES * 64) {
        const int pos = e >> 7, i = ri;
        const float inv = rinv;
        const float ang = (float)pos * inv;
        float s, c; sincos_acc(ang, s, c);
        F.RCOS()[e] = c; F.RSIN()[e] = s;
    }
}

__device__ __forceinline__ void sb_tile(f32x16& p0, f32x16& p1, float& carry, int hi, int kb0, int qpos, bool need_mask, v4u (&pw)[4]) {
#pragma unroll
    for (int r = 0; r < 16; ++r) {
        float b0 = __builtin_amdgcn_rcpf(1.f + __builtin_amdgcn_exp2f(p0[r]));
        float b1 = __builtin_amdgcn_rcpf(1.f + __builtin_amdgcn_exp2f(p1[r]));
        if (need_mask) { if (kb0 + r >= qpos) b0 = 0.f; if (kb0 + 32 + r >= qpos) b1 = 0.f; }
        p0[r] = b0; p1[r] = b1;
    }
    float s0 = 1.f, s1 = 1.f;
#pragma unroll
    for (int r = 15; r >= 0; --r) {
        const float b0 = p0[r], b1 = p1[r];
        p0[r] = b0 * s0; p1[r] = b1 * s1;
        s0 = __builtin_fmaf(-s0, b0, s0); s1 = __builtin_fmaf(-s1, b1, s1);
    }
    float t0, t1;
    {
      auto a = __builtin_amdgcn_permlane32_swap(__float_as_uint(s0), __float_as_uint(s0), false, false);
      auto b = __builtin_amdgcn_permlane32_swap(__float_as_uint(s1), __float_as_uint(s1), false, false);
      t0 = hi ? __uint_as_float(a[0]) : __uint_as_float(a[1]); t1 = hi ? __uint_as_float(b[0]) : __uint_as_float(b[1]); }
    const float pre1 = hi ? carry : carry * t1;
    const float pre0 = hi ? carry * s1 * t1 : carry * t1 * s1 * t0;
    carry = carry * ((s0 * s1) * (t0 * t1));
#pragma unroll
    for (int r = 0; r < 16; ++r) { p0[r] *= pre0; p1[r] *= pre1; }
    pw[0] = (v4u){pg8::cvt_pk_bf16(p0[0], p0[1]), pg8::cvt_pk_bf16(p0[2], p0[3]), pg8::cvt_pk_bf16(p0[4], p0[5]), pg8::cvt_pk_bf16(p0[6], p0[7])};
    pw[1] = (v4u){pg8::cvt_pk_bf16(p0[8], p0[9]), pg8::cvt_pk_bf16(p0[10], p0[11]), pg8::cvt_pk_bf16(p0[12], p0[13]), pg8::cvt_pk_bf16(p0[14], p0[15])};
    pw[2] = (v4u){pg8::cvt_pk_bf16(p1[0], p1[1]), pg8::cvt_pk_bf16(p1[2], p1[3]), pg8::cvt_pk_bf16(p1[4], p1[5]), pg8::cvt_pk_bf16(p1[6], p1[7])};
    pw[3] = (v4u){pg8::cvt_pk_bf16(p1[8], p1[9]), pg8::cvt_pk_bf16(p1[10], p1[11]), pg8::cvt_pk_bf16(p1[12], p1[13]), pg8::cvt_pk_bf16(p1[14], p1[15])};
}
typedef float f32x2v __attribute__((ext_vector_type(2)));
__device__ __forceinline__ void sb_tile2(f32x16& p0, f32x16& p1, float& carry, int hi, int kb0, int qpos, bool need_mask, v4u (&pw)[4]) {
#pragma unroll
    for (int r = 0; r < 16; ++r) { p0[r] = __builtin_amdgcn_exp2f(p0[r]); p1[r] = __builtin_amdgcn_exp2f(p1[r]); }
#define SB_INV4(P, j0) do { const f32x2v ea_ = {P[2 * (j0)], P[2 * (j0) + 1]}, eb_ = {P[2 * (j0) + 2], P[2 * (j0) + 3]}, ec_ = {P[2 * (j0) + 4], P[2 * (j0) + 5]}, ed_ = {P[2 * (j0) + 6], P[2 * (j0) + 7]}; \
        const f32x2v b_ = eb_ + (f32x2v){1.f, 1.f}; const f32x2v ab_ = ea_ * b_ + b_, abc_ = ab_ * ec_ + ab_, abcd_ = abc_ * ed_ + abc_; \
        f32x2v R_ = {__builtin_amdgcn_rcpf(abcd_.x), __builtin_amdgcn_rcpf(abcd_.y)}; \
        const f32x2v id_ = R_ * abc_; R_ = R_ * ed_ + R_; const f32x2v ic_ = R_ * ab_; R_ = R_ * ec_ + R_; const f32x2v ib_ = R_ * ea_ + R_, ia_ = R_ * b_; \
        P[2 * (j0)] = ia_.x; P[2 * (j0) + 1] = ia_.y; P[2 * (j0) + 2] = ib_.x; P[2 * (j0) + 3] = ib_.y; P[2 * (j0) + 4] = ic_.x; P[2 * (j0) + 5] = ic_.y; P[2 * (j0) + 6] = id_.x; P[2 * (j0) + 7] = id_.y; } while (0)
    SB_INV4(p0, 0); SB_INV4(p1, 0); SB_INV4(p0, 4); SB_INV4(p1, 4);
#undef SB_INV4
    if (need_mask) {
        asm volatile("" ::: "memory");
#pragma unroll
        for (int r = 0; r < 16; ++r) { const int kk = kb0 + 8 * (1 - (r & 1)) + (r >> 1); if (kk >= qpos) p0[r] = 0.f; if (kk + 32 >= qpos) p1[r] = 0.f; }
    }
    f32x2v s0 = {1.f, 1.f}, s1 = {1.f, 1.f};
#pragma unroll
    for (int k = 7; k >= 0; --k) {
        const f32x2v b0 = {p0[2 * k], p0[2 * k + 1]}, b1 = {p1[2 * k], p1[2 * k + 1]};
        const f32x2v w0 = b0 * s0, w1 = b1 * s1;
        s0 = s0 - s0 * b0; s1 = s1 - s1 * b1;
        p0[2 * k] = w0.x; p0[2 * k + 1] = w0.y; p1[2 * k] = w1.x; p1[2 * k + 1] = w1.y;
    }
    const float a0 = s0.x * s0.y, a1 = s1.x * s1.y;
    float t0, t1;
    { auto a = __builtin_amdgcn_permlane32_swap(__float_as_uint(a0), __float_as_uint(a0), false, false);
      auto b = __builtin_amdgcn_permlane32_swap(__float_as_uint(a1), __float_as_uint(a1), false, false);
      t0 = hi ? __uint_as_float(a[0]) : __uint_as_float(a[1]); t1 = hi ? __uint_as_float(b[0]) : __uint_as_float(b[1]); }
    const float pre1 = hi ? carry : carry * t1;
    const float pre0 = hi ? carry * a1 * t1 : carry * t1 * a1 * t0;
    carry = carry * ((a0 * a1) * (t0 * t1));
    const f32x2v q0 = {pre0, pre0 * s0.x}, q1 = {pre1, pre1 * s1.x};
#pragma unroll
    for (int k = 0; k < 8; ++k) { const f32x2v w0 = (f32x2v){p0[2 * k], p0[2 * k + 1]} * q0, w1 = (f32x2v){p1[2 * k], p1[2 * k + 1]} * q1;
        p0[2 * k] = w0.x; p0[2 * k + 1] = w0.y; p1[2 * k] = w1.x; p1[2 * k + 1] = w1.y; }
    pw[0] = (v4u){pg8::cvt_pk_bf16(p0[1], p0[3]), pg8::cvt_pk_bf16(p0[5], p0[7]), pg8::cvt_pk_bf16(p0[9], p0[11]), pg8::cvt_pk_bf16(p0[13], p0[15])};
    pw[1] = (v4u){pg8::cvt_pk_bf16(p0[0], p0[2]), pg8::cvt_pk_bf16(p0[4], p0[6]), pg8::cvt_pk_bf16(p0[8], p0[10]), pg8::cvt_pk_bf16(p0[12], p0[14])};
    pw[2] = (v4u){pg8::cvt_pk_bf16(p1[1], p1[3]), pg8::cvt_pk_bf16(p1[5], p1[7]), pg8::cvt_pk_bf16(p1[9], p1[11]), pg8::cvt_pk_bf16(p1[13], p1[15])};
    pw[3] = (v4u){pg8::cvt_pk_bf16(p1[0], p1[2]), pg8::cvt_pk_bf16(p1[4], p1[6]), pg8::cvt_pk_bf16(p1[8], p1[10]), pg8::cvt_pk_bf16(p1[12], p1[14])};
}
#define MFMA32(a, b, c) __builtin_amdgcn_mfma_f32_32x32x16_bf16((a), (b), (c), 0, 0, 0)
__device__ __forceinline__ f32x16 splat16(float v) { f32x16 r;
#pragma unroll
    for (int i = 0; i < 16; ++i) r[i] = v; return r; }

__device__ __forceinline__ bf16x8 cvt8(const f32x4 a, const f32x4 b) { return __builtin_bit_cast(bf16x8, pg8::pack8(a, b)); }

__device__ __forceinline__ void ret_passB(Frame& F) {
    for (int e = F.bid * (NWAVES * 64) + F.tid; e < 8 * 512 * 32; e += F.G * NWAVES * 64) {
        const int bh = e >> 14, dv = (e >> 5) & 511, dk8 = (e & 31) * 8, h = bh & 3;
        const float lg = pg8::lg2gamma(h), g1 = 1.f - __builtin_amdgcn_exp2f(-5.f - (float)h), g255 = __builtin_amdgcn_exp2f(255.f * lg), g256 = __builtin_amdgcn_exp2f(256.f * lg);
        f32x4 S0 = {0.f, 0.f, 0.f, 0.f}, S1 = {0.f, 0.f, 0.f, 0.f};
        for (int c0 = 0; c0 < 32; c0 += 16) {
            v4u dq[16];
#pragma unroll
            for (int j = 0; j < 16; ++j) dq[j] = *(const v4u*)((const bf16*)F.DST() + ((size_t)(bh * 32 + c0 + j) * 512 + dv) * 256 + dk8);
#pragma unroll
            for (int j = 0; j < 16; ++j) { const size_t ro = (size_t)(bh * 32 + c0 + j) * 512 + dv;
                const f32x4 d0 = {bflo(dq[j][0]), bfhi(dq[j][0]), bflo(dq[j][1]), bfhi(dq[j][1])}, d1 = {bflo(dq[j][2]), bfhi(dq[j][2]), bflo(dq[j][3]), bfhi(dq[j][3])};
                *(pg8::u32x4*)(F.BV() + ro * 512 + 256 + dk8) = pg8::pack8(S0 * g1, S1 * g1);
                S0 = S0 * g256 + d0 * g255; S1 = S1 * g256 + d1 * g255; }
        }
        float* so = F.out + ORT_P + ((size_t)bh * 256 + dk8) * 512 + dv;
#pragma unroll
        for (int i = 0; i < 4; ++i) { so[(size_t)i * 512] = S0[i]; so[(size_t)(i + 4) * 512] = S1[i]; }
    }
}

typedef unsigned u32x2 __attribute__((ext_vector_type(2)));
constexpr int HQ_STR = 136, HT_STR = 72;
constexpr int H_QT = 0, H_KH = 17408, H_KHT = 34816, H_VT = 53248, H_PP = 71680, H_CS = 80896, H_RR = 82944, H_A63 = 83456, H_C63 = 83968, H_SSQ = 84480;
#define MFMA16(a, b, c) __builtin_amdgcn_mfma_f32_16x16x32_bf16((a), (b), (c), 0, 0, 0)
__device__ __forceinline__ void hgrn_passB(Frame& F) {
    const int vb = (F.bid + F.G / 2) % F.G;
    for (int e = vb * (NWAVES * 64) + F.tid; e < 8 * 128 * 32; e += F.G * NWAVES * 64) {
        const int bh = e >> 12, dk = (e >> 5) & 127, dv4 = (e & 31) * 4;
        f32x4 S = {0.f, 0.f, 0.f, 0.f};
        for (int s0 = 0; s0 < 32; s0 += 16) {
            f32x4 dv[16]; float dd[16];
#pragma unroll
            for (int j = 0; j < 16; ++j) { dv[j] = *(const f32x4*)(F.DSH() + ((size_t)(bh * 32 + s0 + j) * 128 + dk) * 128 + dv4); dd[j] = F.DD()[(size_t)(bh * 32 + s0 + j) * 128 + dk]; }
#pragma unroll
            for (int j = 0; j < 16; ++j) { *(f32x4*)(F.SST() + ((size_t)(bh * 32 + s0 + j) * 128 + dk) * 128 + dv4) = S; S = S * __expf(dd[j]) + dv[j]; }
        }
        *(f32x4*)(F.out + OHG_P + ((size_t)bh * 128 + dk) * 128 + dv4) = S;
    }
}

__device__ __forceinline__ void ret_sample_unit(Frame& F, int s, int h, int vhalf) {
    const int tid = F.tid, v = tid & 255, kh = tid >> 8, col = vhalf * 256 + v;
    LAS float* QL = (LAS float*)(F.lds + RING_OFF);
    LAS float* KL = QL + 8 * 256;
    LAS float* OP = KL + 8 * 256;
    const size_t row0 = (size_t)MP + s * 8;
    for (int e = tid; e < 8 * 256; e += NWAVES * 64) { const int t = e >> 8, kk = e & 255;
        QL[e] = bf2f(F.QC()[(row0 + t) * 1024 + h * 256 + kk]); KL[e] = bf2f(F.KC()[(row0 + t) * 1024 + h * 256 + kk]); }
    float vt[8];
#pragma unroll
    for (int t = 0; t < 8; ++t) vt[t] = bf2f(F.VC()[(row0 + t) * 2048 + h * 512 + col]);
    const float gamma = 1.f - __builtin_amdgcn_exp2f(-5.f - (float)h);
    float S[128];
    const float* s0 = F.st_r + (((size_t)s * HC + h) * DKC + kh * 128) * DVC + col;
#pragma unroll
    for (int i = 0; i < 128; ++i) S[i] = s0[(size_t)i * DVC];
    __syncthreads();
    float o[8];
#pragma unroll
    for (int t = 0; t < 8; ++t) {
        float acc = 0.f;
#pragma unroll
        for (int i4 = 0; i4 < 32; ++i4) {
            const f32x4 kq = *(const LAS f32x4*)(KL + t * 256 + kh * 128 + 4 * i4), qq = *(const LAS f32x4*)(QL + t * 256 + kh * 128 + 4 * i4);
#pragma unroll
            for (int j = 0; j < 4; ++j) { S[4 * i4 + j] = gamma * S[4 * i4 + j] + kq[j] * vt[t]; acc += qq[j] * S[4 * i4 + j]; }
        }
        o[t] = acc;
    }
#pragma unroll
    for (int t = 0; t < 8; ++t) OP[(kh * 8 + t) * 256 + v] = o[t];
    float* so = F.out + ORT_S + (((size_t)s * HC + h) * DKC + kh * 128) * DVC + col;
#pragma unroll
    for (int i = 0; i < 128; ++i) so[(size_t)i * DVC] = S[i];
    __syncthreads();
    for (int e = tid; e < 8 * 256; e += NWAVES * 64) {
        const int t = e >> 8, vv = e & 255; const float ov = OP[e] + OP[8 * 256 + e];
        const size_t gi = (row0 + t) * 2048 + h * 512 + vhalf * 256 + vv;
        F.MIX2()[gi] = pg8::bf1(ov * bf2f(F.GC()[gi]));
        const float sq = wave_sum(ov * ov);
        if (F.lane == 0) atomicAdd(F.SSS() + (s * 8 + t) * 4 + h, sq);
    }
    __syncthreads();
}
__device__ __forceinline__ void hgrn_sample_unit(Frame& F, int s, int h) {
    const int tid = F.tid, v = tid & 127, kq = tid >> 7;
    LAS float* FL = (LAS float*)(F.lds + RING_OFF);
    LAS float* KL = FL + 8 * 128; LAS float* QL = KL + 8 * 128; LAS float* OP = QL + 8 * 128;
    const size_t row0 = (size_t)MP + s * 8;
    for (int e = tid; e < 8 * 128; e += NWAVES * 64) { const int t = e >> 7, kk = e & 127; const size_t gi = (row0 + t) * 512 + h * 128 + kk;
        FL[e] = __expf(F.LOGF()[gi]); KL[e] = bf2f(F.KB()[gi]); QL[e] = bf2f(F.QB()[gi]); }
    float vt[8];
#pragma unroll
    for (int t = 0; t < 8; ++t) vt[t] = bf2f(F.VB()[(row0 + t) * 512 + h * 128 + v]);
    float S[32];
    const float* s0 = F.st_h + (((size_t)s * HB + h) * DKB + kq * 32) * DVB + v;
#pragma unroll
    for (int i = 0; i < 32; ++i) S[i] = s0[(size_t)i * DVB];
    __syncthreads();
#pragma unroll
    for (int t = 0; t < 8; ++t) {
        float acc = 0.f;
#pragma unroll
        for (int i4 = 0; i4 < 8; ++i4) {
            const f32x4 ff = *(const LAS f32x4*)(FL + t * 128 + kq * 32 + 4 * i4), kk = *(const LAS f32x4*)(KL + t * 128 + kq * 32 + 4 * i4), qq = *(const LAS f32x4*)(QL + t * 128 + kq * 32 + 4 * i4);
#pragma unroll
            for (int j = 0; j < 4; ++j) { S[4 * i4 + j] = ff[j] * S[4 * i4 + j] + kk[j] * vt[t]; acc += qq[j] * S[4 * i4 + j]; }
        }
        OP[(kq * 8 + t) * 128 + v] = acc;
    }
    float* so = F.out + OHG_S + (((size_t)s * HB + h) * DKB + kq * 32) * DVB + v;
#pragma unroll
    for (int i = 0; i < 32; ++i) so[(size_t)i * DVB] = S[i];
    __syncthreads();
    {
        const int t = F.wave, c0 = 2 * F.lane;
        float a = 0.f, b = 0.f;
#pragma unroll
        for (int q4 = 0; q4 < 4; ++q4) { a += OP[(q4 * 8 + t) * 128 + c0]; b += OP[(q4 * 8 + t) * 128 + c0 + 1]; }
        const float rstd = 1.f / sqrtf(wave_sum(a * a + b * b) * (1.f / 128.f) + EPS);
        const size_t row = row0 + t;
        const unsigned gt = *(const unsigned*)(F.GB() + row * 512 + h * 128 + c0);
        *(unsigned*)(F.MIX() + row * 1024 + 512 + h * 128 + c0) = pg8::cvt_pk_bf16(a * rstd * F.og[c0] * bflo(gt), b * rstd * F.og[c0 + 1] * bfhi(gt));
    }
    __syncthreads();
}

constexpr int AT_K = 0, AT_V = 24576, AT_O = 49152, AT_SLOT = 8192;
__device__ __forceinline__ void glds16(const void* gsrc, unsigned lds_dst) { unsigned keep;
    asm volatile("s_mov_b32 %0, m0\n\ts_mov_b32 m0, %2\n\ts_nop 0\n\tglobal_load_lds_dwordx4 %1, off\n\ts_mov_b32 m0, %0" : "=&s"(keep) : "v"(gsrc), "s"(lds_dst) : "memory"); }
typedef short v4i16_t __attribute__((ext_vector_type(4)));
__device__ __forceinline__ v4i16_t vtr(const LAS unsigned char* p) { return __builtin_amdgcn_ds_read_tr16_b64_v4i16((LAS v4i16_t*)p); }

__device__ __forceinline__ void bf8_add(const bf16* p, f32x4& a, f32x4& b) { const v4u w = *(const v4u*)p; a[0] += bflo(w[0]); a[1] += bfhi(w[0]); a[2] += bflo(w[1]); a[3] += bfhi(w[1]); b[0] += bflo(w[2]); b[1] += bfhi(w[2]); b[2] += bflo(w[3]); b[3] += bfhi(w[3]); }
__device__ __forceinline__ void slab_sum8(const bf16* slab, int nparts, size_t pstride, size_t off, f32x4& a, f32x4& b) {
    a = (f32x4){0.f, 0.f, 0.f, 0.f}; b = a;
    for (int p = 0; p < nparts; ++p) bf8_add(slab + p * pstride + off, a, b);
}
__device__ __forceinline__ void pp1_item(Frame& F, int item) {
    const int r = item >> 3, gi = item & 7, lane = F.lane, c = lane * 8, a0 = gi * 512 + c;
    const int g0 = (a0 & ~255) | (((a0 >> 5) & 1) << 7) | (((a0 >> 6) & 3) << 5) | (a0 & 31);
    f32x4 x, y; slab_sum8(F.SLAB(), 4, (size_t)256 * N1, (size_t)r * N1 + g0, x, y);
    const size_t row = (size_t)MP + r;
    if (gi <= 1) {
        float ss = (x[0] * x[0] + x[1] * x[1]) + (x[2] * x[2] + x[3] * x[3]) + (y[0] * y[0] + y[1] * y[1]) + (y[2] * y[2] + y[3] * y[3]);
        ss += __shfl_xor(ss, 1); ss += __shfl_xor(ss, 2); ss += __shfl_xor(ss, 4);
        const float rstd = __builtin_amdgcn_rsqf(ss * (1.f / 64.f) + EPS) * (gi == 0 ? -0.125f * LOG2E : 1.f);
        const float* g = (gi == 0 ? F.qg : F.kg) + (c & 63);
        x = x * *(const f32x4*)g * rstd; y = y * *(const f32x4*)(g + 4) * rstd;
        if (gi == 0) *(pg8::u32x4*)(F.QA() + row * 512 + c) = pg8::pack8(x, y);
        else { *(pg8::u32x4*)(F.KA() + row * 512 + c) = pg8::pack8(x, y); float* ko = F.out + OK_S + (size_t)r * 512 + c; *(f32x4*)ko = x; *(f32x4*)(ko + 4) = y; }
    } else if (gi == 2) {
        *(pg8::u32x4*)(F.VA() + row * 512 + c) = pg8::pack8(x, y); float* vo = F.out + OV_S + (size_t)r * 512 + c; *(f32x4*)vo = x; *(f32x4*)(vo + 4) = y;
    } else if (gi == 5) {
        f32x4 lf0, lf1, k0, k1;
#pragma unroll
        for (int e = 0; e < 8; ++e) { const int cc = c + e; const float lb = __builtin_amdgcn_rcpf(1.f + __expf(F.hlb[512 + cc] - F.hlb[cc])); const float v = e < 4 ? x[e & 3] : y[e & 3];
            const float sg = pg8::sigm_f(v); const float lf = __logf(lb + (1.f - lb) * sg), kk = (1.f - lb) * (1.f - sg);
            if (e < 4) { lf0[e & 3] = lf; k0[e & 3] = kk; } else { lf1[e & 3] = lf; k1[e & 3] = kk; } }
        *(f32x4*)(F.LOGF() + row * 512 + c) = lf0; *(f32x4*)(F.LOGF() + row * 512 + c + 4) = lf1;
        *(pg8::u32x4*)(F.KB() + row * 512 + c) = pg8::pack8(k0, k1);
    } else {
        bf16* dst = (gi == 3) ? F.GA() : (gi == 4) ? F.QB() : (gi == 6) ? F.VB() : F.GB();
        if (gi != 6) {
#pragma unroll
            for (int e = 0; e < 4; ++e) { x[e] = pg8::silu_f(x[e]); y[e] = pg8::silu_f(y[e]); } }
        *(pg8::u32x4*)(dst + row * 512 + c) = pg8::pack8(x, y);
    }
}
__device__ __forceinline__ void pp2_row(Frame& F, int r) {
    const int lane = F.lane; f32x4 v[4]; float s2 = 0.f;
#pragma unroll
    for (int j = 0; j < 2; ++j) { const int c = 8 * lane + 512 * j; f32x4 a, b2; slab_sum8(F.SLAB(), 4, (size_t)256 * 1024, (size_t)r * 1024 + c, a, b2);
        a += *(const f32x4*)(F.xs + (size_t)r * DM + c); b2 += *(const f32x4*)(F.xs + (size_t)r * DM + c + 4);
        *(f32x4*)(F.Y1() + ((size_t)MP + r) * DM + c) = a; *(f32x4*)(F.Y1() + ((size_t)MP + r) * DM + c + 4) = b2;
        s2 += (a[0] * a[0] + a[1] * a[1]) + (a[2] * a[2] + a[3] * a[3]) + (b2[0] * b2[0] + b2[1] * b2[1]) + (b2[2] * b2[2] + b2[3] * b2[3]);
        v[2 * j] = a; v[2 * j + 1] = b2; }
    s2 = wave_sum(s2); if (lane == 0) F.SS1()[MP + r] = s2;
#pragma unroll
    for (int j = 0; j < 2; ++j) { const int c = 8 * lane + 512 * j;
        *(pg8::u32x4*)(F.H() + ((size_t)MP + r) * DM + c) = pg8::pack8(v[2 * j], v[2 * j + 1]); }
}
__device__ __forceinline__ void pp3_item(Frame& F, int item) {
    const int r = item / 24, pn = item % 24, lane = F.lane; const size_t row = (size_t)MP + r;
    if (lane >= 32) return;
    const size_t off = (size_t)r * N3 + pn * 256, ps = (size_t)256 * N3;
    const float rs = __builtin_amdgcn_rsqf(F.SS1()[MP + r] * (1.f / 1024.f) + EPS);
    if (pn < 8) {
        const int j = 8 * (lane & 15), up = lane >> 4;
        f32x4 x1a, x1b, x2a, x2b; slab_sum8(F.SLAB(), 4, ps, off + j, x1a, x1b); slab_sum8(F.SLAB(), 4, ps, off + 128 + j, x2a, x2b);
        const int pos = PAST + (r & 7);
        const f32x4 ca = *(const f32x4*)(F.RCOS() + (size_t)pos * 128 + j), cb = *(const f32x4*)(F.RCOS() + (size_t)pos * 128 + j + 4), sa = *(const f32x4*)(F.RSIN() + (size_t)pos * 128 + j), sb = *(const f32x4*)(F.RSIN() + (size_t)pos * 128 + j + 4);
        const float sc = rs * (pn < 4 ? 1.f : 0.0625f);
        const f32x4 oa = (up ? (x2a * ca + x1a * sa) : (x1a * ca - x2a * sa)) * sc, ob = (up ? (x2b * cb + x1b * sb) : (x1b * cb - x2b * sb)) * sc;
        *(pg8::u32x4*)((pn < 4 ? F.QC() : F.KC()) + row * 1024 + (pn & 3) * 256 + up * 128 + j) = pg8::pack8(oa, ob);
    } else {
        const int j = 8 * lane; f32x4 xa, xb; slab_sum8(F.SLAB(), 4, ps, off + j, xa, xb);
        xa = xa * rs; xb = xb * rs;
        const bool isg = pn >= 16;
        if (isg) {
#pragma unroll
            for (int e = 0; e < 4; ++e) { xa[e] = pg8::silu_f(xa[e]); xb[e] = pg8::silu_f(xb[e]); } }
        *(pg8::u32x4*)((isg ? F.GC() : F.VC()) + row * 2048 + ((pn - 8) & 7) * 256 + j) = pg8::pack8(xa, xb);
    }
}
__device__ __forceinline__ void pp4_row(Frame& F, int r) {
    float rs[4];
#pragma unroll
    for (int hh = 0; hh < 4; ++hh) rs[hh] = __builtin_amdgcn_rsqf(F.SSS()[r * 4 + hh] * (1.f / 512.f) + EPS);
#pragma unroll
    for (int j = 0; j < 2; ++j) { const int c = 8 * F.lane + 512 * j;
        f32x4 a = *(const f32x4*)(F.Y1() + ((size_t)MP + r) * DM + c), b2 = *(const f32x4*)(F.Y1() + ((size_t)MP + r) * DM + c + 4);
#pragma unroll
        for (int p = 0; p < 8; ++p) { f32x4 pa = {0.f, 0.f, 0.f, 0.f}, pb = pa; bf8_add(F.SLAB4() + ((size_t)p * 256 + r) * 1024 + c, pa, pb); a += pa * rs[p >> 1]; b2 += pb * rs[p >> 1]; }
        *(f32x4*)(F.out + OY_S + (size_t)r * DM + c) = a; *(f32x4*)(F.out + OY_S + (size_t)r * DM + c + 4) = b2; }
}

constexpr int G_QT = 0, G_KH = 17408, G_VV = 34816, G_PP = 52224, G_CS = 61440, G_RR = 69632, G_A63 = 70144, G_C63 = 70656, G_OST = 73728, OST_STR = 132;
__device__ __forceinline__ bf16x8 tr8(const LAS unsigned char* p, int rowbytes4) { const v4i16_t a = vtr(p), b = vtr(p + rowbytes4); return (bf16x8){a[0], a[1], a[2], a[3], b[0], b[1], b[2], b[3]}; }
#define LDS_BAR() asm volatile("s_waitcnt lgkmcnt(0)\n\ts_barrier" ::: "memory")
template <bool OUT>
__device__ __forceinline__ void hgrn_chunk_unit2(Frame& F, int bh, int sc) {
    const int tid = F.tid, lane = F.lane, w = F.wave, l15 = lane & 15, g = lane >> 4;
    const int b = bh >> 2, h = bh & 3, cg = tid & 31, tq = tid >> 5;
    LAS unsigned char* L = F.lds + RING_OFF;
    LAS bf16* QT = (LAS bf16*)(L + G_QT); LAS bf16* KH = (LAS bf16*)(L + G_KH); LAS bf16* VV = (LAS bf16*)(L + G_VV); LAS bf16* PP = (LAS bf16*)(L + G_PP);
    LAS float* CS = (LAS float*)(L + G_CS); LAS float* RR = (LAS float*)(L + G_RR); LAS float* A63 = (LAS float*)(L + G_A63); LAS float* C63 = (LAS float*)(L + G_C63); LAS float* OST = (LAS float*)(L + G_OST);
    f32x4 S[8];
    unsigned sbase = (unsigned)(((bh * 32 + sc) * 128 + 4 * g) * 128 + 16 * w + l15);
    asm volatile("" : "+v"(sbase));
#pragma unroll
    for (int i = 0; i < 8; ++i)
#pragma unroll
        for (int r = 0; r < 4; ++r) S[i][r] = OUT ? F.SST()[sbase + (unsigned)(16 * i + r) * 128u] : 0.f;
    f32x4 dsum = {0.f, 0.f, 0.f, 0.f};
    f32x4 lf[4]; u32x2 kq[4], qq[4], vq[4];
    unsigned e0 = (unsigned)((b * TP + sc * 256 + 4 * tq) * 512 + h * 128 + 4 * cg);
#define HG_LOAD(ch_) do { unsigned ee = e0 + (unsigned)(ch_) * 64u * 512u; asm volatile("" : "+v"(ee)); \
        _Pragma("unroll") for (int i = 0; i < 4; ++i) { lf[i] = *(const f32x4*)(F.LOGF() + ee + (unsigned)i * 512u); kq[i] = *(const u32x2*)(F.KB() + ee + (unsigned)i * 512u); \
            vq[i] = *(const u32x2*)(F.VB() + ee + (unsigned)i * 512u); if (OUT) qq[i] = *(const u32x2*)(F.QB() + ee + (unsigned)i * 512u); } } while (0)
    HG_LOAD(0);
    const LAS unsigned char* trK = (const LAS unsigned char*)KH + ((8 * g + (l15 >> 2)) * HQ_STR + (l15 & 3) * 4) * 2;
    const LAS unsigned char* trV = (const LAS unsigned char*)VV + ((8 * g + (l15 >> 2)) * HQ_STR + 16 * w + (l15 & 3) * 4) * 2;
    for (int ch = 0; ch < 4; ++ch) {
        f32x4 c[4]; c[0] = lf[0]; c[1] = c[0] + lf[1]; c[2] = c[1] + lf[2]; c[3] = c[2] + lf[3];
        *(LAS f32x4*)(CS + tq * 128 + 4 * cg) = c[3];
        LDS_BAR();
        f32x4 off = {0.f, 0.f, 0.f, 0.f}, run = {0.f, 0.f, 0.f, 0.f}, r = {0.f, 0.f, 0.f, 0.f};
#pragma unroll
        for (int q = 0; q < 16; ++q) { const f32x4 v = *(const LAS f32x4*)(CS + q * 128 + 4 * cg); if (q == 8) r = run; if (q < tq) off += v; run += v; }
        const f32x4 b63 = run;
#pragma unroll
        for (int i = 0; i < 4; ++i) {
            const int t = 4 * tq + i; const f32x4 bt = off + c[i];
            f32x4 kf = {bflo(kq[i].x), bfhi(kq[i].x), bflo(kq[i].y), bfhi(kq[i].y)};
#pragma unroll
            for (int e = 0; e < 4; ++e) kf[e] *= __expf(r[e] - bt[e]);
            *(LAS u32x2*)(KH + t * HQ_STR + 4 * cg) = (u32x2){pg8::cvt_pk_bf16(kf[0], kf[1]), pg8::cvt_pk_bf16(kf[2], kf[3])};
            *(LAS u32x2*)(VV + t * HQ_STR + 4 * cg) = vq[i];
            if (OUT) { f32x4 qf = {bflo(qq[i].x), bfhi(qq[i].x), bflo(qq[i].y), bfhi(qq[i].y)};
#pragma unroll
                for (int e = 0; e < 4; ++e) qf[e] *= __expf(bt[e] - r[e]);
                *(LAS u32x2*)(QT + t * HQ_STR + 4 * cg) = (u32x2){pg8::cvt_pk_bf16(qf[0], qf[1]), pg8::cvt_pk_bf16(qf[2], qf[3])}; }
        }
        if (tq == 0) { f32x4 er, ea, ec;
#pragma unroll
            for (int e = 0; e < 4; ++e) { er[e] = __expf(r[e]); ea[e] = __expf(b63[e]); ec[e] = __expf(b63[e] - r[e]); }
            *(LAS f32x4*)(RR + 4 * cg) = er; *(LAS f32x4*)(A63 + 4 * cg) = ea; *(LAS f32x4*)(C63 + 4 * cg) = ec; dsum += b63; }
        if (ch < 3) HG_LOAD(ch + 1);
        v4u gq0, gq1; unsigned rowe = 0;
        if (OUT) { rowe = (unsigned)(b * TP + sc * 256 + ch * 64 + (tid >> 3)); asm volatile("" : "+v"(rowe));
            gq0 = *(const v4u*)(F.GB() + rowe * 512u + h * 128 + (tid & 7) * 16); gq1 = *(const v4u*)(F.GB() + rowe * 512u + h * 128 + (tid & 7) * 16 + 8); }
        LDS_BAR();
        f32x4 o[4];
        bf16x8 vf[2];
#pragma unroll
        for (int kk = 0; kk < 2; ++kk) vf[kk] = tr8(trV + (32 * kk) * HQ_STR * 2, 4 * HQ_STR * 2);
        if (OUT) {
#pragma unroll
            for (int tt = 0; tt < 2; ++tt) {
                const int tile = 2 * w + tt, ti = tile >> 2, si = tile & 3;
                f32x4 p = {0.f, 0.f, 0.f, 0.f};
#pragma unroll
                for (int kk = 0; kk < 4; ++kk) {
                    const bf16x8 a = *(const LAS bf16x8*)(QT + (16 * ti + l15) * HQ_STR + 32 * kk + 8 * g), bb = *(const LAS bf16x8*)(KH + (16 * si + l15) * HQ_STR + 32 * kk + 8 * g);
                    p = MFMA16(a, bb, p);
                }
#pragma unroll
                for (int rr = 0; rr < 4; ++rr) { const int tl = 16 * ti + 4 * g + rr, sl = 16 * si + l15; PP[tl * HT_STR + sl] = pg8::bf1(sl <= tl ? p[rr] : 0.f); }
            }
            LDS_BAR();
#pragma unroll
            for (int ti = 0; ti < 4; ++ti) { o[ti] = (f32x4){0.f, 0.f, 0.f, 0.f};
#pragma unroll
                for (int kk = 0; kk < 2; ++kk) { const bf16x8 a = *(const LAS bf16x8*)(PP + (16 * ti + l15) * HT_STR + 32 * kk + 8 * g); o[ti] = MFMA16(a, vf[kk], o[ti]); } }
#pragma unroll
            for (int kk = 0; kk < 4; ++kk) {
                const f32x4 r0 = *(const LAS f32x4*)(RR + 32 * kk + 4 * g), r1 = *(const LAS f32x4*)(RR + 32 * kk + 16 + 4 * g);
                const bf16x8 sb = __builtin_bit_cast(bf16x8, pg8::pack8(S[2 * kk] * r0, S[2 * kk + 1] * r1));
#pragma unroll
                for (int ti = 0; ti < 4; ++ti) {
                    const u32x2 a0 = *(const LAS u32x2*)(QT + (16 * ti + l15) * HQ_STR + 32 * kk + 4 * g), a1 = *(const LAS u32x2*)(QT + (16 * ti + l15) * HQ_STR + 32 * kk + 16 + 4 * g);
                    const v4u av = {a0.x, a0.y, a1.x, a1.y};
                    o[ti] = MFMA16(__builtin_bit_cast(bf16x8, av), sb, o[ti]);
                }
            }
        }
#pragma unroll
        for (int i = 0; i < 8; ++i) {
            f32x4 U = {0.f, 0.f, 0.f, 0.f};
#pragma unroll
            for (int kk = 0; kk < 2; ++kk) { const bf16x8 a = tr8(trK + ((32 * kk) * HQ_STR + 16 * i) * 2, 4 * HQ_STR * 2); U = MFMA16(a, vf[kk], U); }
            const f32x4 a63 = *(const LAS f32x4*)(A63 + 16 * i + 4 * g), c63 = *(const LAS f32x4*)(C63 + 16 * i + 4 * g);
            S[i] = a63 * S[i] + c63 * U;
        }
        if (OUT) {
#pragma unroll
            for (int ti = 0; ti < 4; ++ti)
#pragma unroll
                for (int rr = 0; rr < 4; ++rr) OST[(16 * ti + 4 * g + rr) * OST_STR + 16 * w + l15] = o[ti][rr];
            LDS_BAR();
            const int t = tid >> 3, c16 = (tid & 7) * 16;
            f32x4 x[4]; float sq = 0.f;
#pragma unroll
            for (int j = 0; j < 4; ++j) { x[j] = *(const LAS f32x4*)(OST + t * OST_STR + c16 + 4 * j); sq += (x[j][0] * x[j][0] + x[j][1] * x[j][1]) + (x[j][2] * x[j][2] + x[j][3] * x[j][3]); }
            sq += __shfl_xor(sq, 1); sq += __shfl_xor(sq, 2); sq += __shfl_xor(sq, 4);
            const float rstd = __builtin_amdgcn_rsqf(sq * (1.f / 128.f) + EPS);
            const v4u g0 = gq0, g1 = gq1;
#pragma unroll
            for (int j = 0; j < 4; ++j) { const f32x4 gn = *(const f32x4*)(F.og + c16 + 4 * j); x[j] = x[j] * gn * rstd; }
            x[0][0] *= bflo(g0[0]); x[0][1] *= bfhi(g0[0]); x[0][2] *= bflo(g0[1]); x[0][3] *= bfhi(g0[1]); x[1][0] *= bflo(g0[2]); x[1][1] *= bfhi(g0[2]); x[1][2] *= bflo(g0[3]); x[1][3] *= bfhi(g0[3]);
            x[2][0] *= bflo(g1[0]); x[2][1] *= bfhi(g1[0]); x[2][2] *= bflo(g1[1]); x[2][3] *= bfhi(g1[1]); x[3][0] *= bflo(g1[2]); x[3][1] *= bfhi(g1[2]); x[3][2] *= bflo(g1[3]); x[3][3] *= bfhi(g1[3]);
            *(pg8::u32x4*)(F.MIX() + rowe * 1024u + 512u + h * 128 + c16) = pg8::pack8(x[0], x[1]);
            *(pg8::u32x4*)(F.MIX() + rowe * 1024u + 512u + h * 128 + c16 + 8) = pg8::pack8(x[2], x[3]);
        }
    }
#undef HG_LOAD
    if (!OUT) {
#pragma unroll
        for (int i = 0; i < 8; ++i)
#pragma unroll
            for (int r = 0; r < 4; ++r) F.DSH()[sbase + (unsigned)(16 * i + r) * 128u] = S[i][r];
        if (tq == 0) *(f32x4*)(F.DD() + (size_t)(bh * 32 + sc) * 128 + 4 * cg) = dsum;
    }
    __syncthreads();
}

typedef short s16x4 __attribute__((ext_vector_type(4)));

struct DecStage2 { f32x4 k[4]; f32x4 v[4]; };
constexpr int DW_T = 107008;
struct DecW { DecStage2 S; f32x4 o[4]; float carry; bf16x8 qb[2]; int i, last, w, s, h, pagev; LAS unsigned char* tb; u32x2 wpk; bool pend; };
__device__ __forceinline__ void decw_load(Frame& F, DecW& D, int l15, int g) {
    const int kb = 1024 * D.w + 1024 - 16 * D.i;
    const int page = __builtin_amdgcn_readlane(D.pagev, (kb >> 7) & 7);
    const unsigned sbase = (unsigned)__builtin_amdgcn_readfirstlane((int)((((unsigned)page * PAGE + (unsigned)(kb & 127)) * 512u + (unsigned)(D.h * 64)) * 4u));
    const __amdgpu_buffer_rsrc_t rk = __builtin_amdgcn_make_buffer_rsrc((void*)F.ck, 0, 0x7fffffff, 0x00020000), rv = __builtin_amdgcn_make_buffer_rsrc((void*)F.cv, 0, 0x7fffffff, 0x00020000);
    int vk = l15 * 2048 + 32 * g; asm volatile("" : "+v"(vk)); const int vv = vk - 16 * g;
#pragma unroll
    for (int ks = 0; ks < 2; ++ks) { D.S.k[2 * ks] = __builtin_bit_cast(f32x4, __builtin_amdgcn_raw_buffer_load_b128(rk, vk + 128 * ks, sbase, 0)); D.S.k[2 * ks + 1] = __builtin_bit_cast(f32x4, __builtin_amdgcn_raw_buffer_load_b128(rk, vk + 128 * ks + 16, sbase, 0)); }
#pragma unroll
    for (int j = 0; j < 4; ++j) D.S.v[j] = __builtin_bit_cast(f32x4, __builtin_amdgcn_raw_buffer_load_b128(rv, vv + 64 * j, sbase, 0));
}
__device__ __forceinline__ void decw_procA(DecW& D, bool newk, float cinit, int l15, int g) {
    f32x4 p = {cinit, cinit, cinit, cinit};
    p = MFMA16(cvt8(D.S.k[0], D.S.k[1]), D.qb[0], p); p = MFMA16(cvt8(D.S.k[2], D.S.k[3]), D.qb[1], p);
    float bt[4];
#pragma unroll
    for (int r = 0; r < 4; ++r) { bt[r] = __builtin_amdgcn_rcpf(1.f + __builtin_amdgcn_exp2f(p[r])); if (newk && (4 * g + r >= l15 || 4 * g + r >= 8)) bt[r] = 0.f; }
    float suf = 1.f, wl[4];
#pragma unroll
    for (int r = 3; r >= 0; --r) { wl[r] = bt[r] * suf; suf = __builtin_fmaf(-suf, bt[r], suf); }
    float t1, po;
    { auto a = __builtin_amdgcn_permlane16_swap(__float_as_uint(suf), __float_as_uint(suf), false, false); t1 = (g & 1) ? __uint_as_float(a[0]) : __uint_as_float(a[1]); }
    const float pp = suf * t1;
    { auto b = __builtin_amdgcn_permlane32_swap(__float_as_uint(pp), __float_as_uint(pp), false, false); po = (g & 2) ? __uint_as_float(b[0]) : __uint_as_float(b[1]); }
    const float pre = D.carry * ((g & 2) ? 1.f : po) * ((g & 1) ? 1.f : t1);
    D.carry = D.carry * pp * po;
    D.wpk = (u32x2){pg8::cvt_pk_bf16(wl[0] * pre, wl[1] * pre), pg8::cvt_pk_bf16(wl[2] * pre, wl[3] * pre)};
#pragma unroll
    for (int j = 0; j < 4; ++j) *(LAS u32x2*)(D.tb + j * 512 + l15 * 32 + g * 8) = (u32x2){pg8::cvt_pk_bf16(D.S.v[j][0], D.S.v[j][1]), pg8::cvt_pk_bf16(D.S.v[j][2], D.S.v[j][3])};
}
__device__ __forceinline__ void decw_procB(DecW& D, int l15, int g) {
    asm volatile("s_waitcnt lgkmcnt(0)" ::: "memory");
#pragma unroll
    for (int dt = 0; dt < 4; ++dt) { const v4i16_t vb = vtr(D.tb + dt * 512 + (4 * g + (l15 >> 2)) * 32 + (l15 & 3) * 8);
        D.o[dt] = __builtin_amdgcn_mfma_f32_16x16x16bf16_1k(__builtin_bit_cast(s16x4, D.wpk), vb, D.o[dt], 0, 0, 0); }
}
__device__ __forceinline__ void decw_proc(DecW& D, bool newk, float cinit, int l15, int g) { decw_procA(D, newk, cinit, l15, g); decw_procB(D, l15, g); }
__device__ __forceinline__ void attn_unit_dec(Frame& F, int b, int h, int qb, DecW& D) {
    const int lane = F.lane, r32 = lane & 31, hi = lane >> 5, wid = F.wave, l15 = lane & 15, g4 = lane >> 4;
    const int rowbase = b * TP, q0 = qb * 256 + 32 * wid, qpos = q0 + r32;
    const float cinit = -F.sbb[h] * LOG2E, dcinit = -F.sbb[D.h] * LOG2E;
    LAS unsigned char* L = F.lds + RING_OFF;
    const unsigned lds0 = (unsigned)(uintptr_t)L;
    bf16x8 qr[4];
#pragma unroll
    for (int d0 = 0; d0 < 4; ++d0) qr[d0] = *(const bf16x8*)(F.QA() + (size_t)(rowbase + qpos) * 512 + h * 64 + d0 * 16 + hi * 8);
    asm volatile("" :: "v"(qr[0]), "v"(qr[1]), "v"(qr[2]), "v"(qr[3]));
    const int NT = 4 * (qb + 1);
    const int rr_ = (lane & 3) + 4 * ((lane & 31) >> 3), pil = 16 * ((lane >> 2) & 1) + 8 * (1 - (rr_ & 1)) + (rr_ >> 1) + (lane & 32);
    const bf16* ksrc = F.KA() + (size_t)(rowbase + pil) * 512 + h * 64 + wid * 8;
    const bf16* vsrc = F.VA() + (size_t)(rowbase + 16 * (wid & 3) + (lane >> 2)) * 512 + h * 64 + (wid >> 2) * 32 + (lane & 3) * 8;
    const unsigned kdst = lds0 + AT_K + wid * 1024, vdst = lds0 + AT_V + wid * 1024;
#define AT_DMA(t, slot) do { glds16(ksrc + (size_t)(t) * 64 * 512, (unsigned)__builtin_amdgcn_readfirstlane(kdst + (slot))); glds16(vsrc + (size_t)(t) * 64 * 512, (unsigned)__builtin_amdgcn_readfirstlane(vdst + (slot))); } while (0)
    const LAS unsigned char* kfb = L + AT_K + hi * 1024 + r32 * 16;
    const LAS unsigned char* vfb = L + AT_V + ((lane >> 4) & 1) * 32 + (lane & 3) * 8 + ((lane & 15) >> 2) * 64 + hi * 1024;
    f32x16 o0 = splat16(0.f), o1 = splat16(0.f); float carry = 1.f;
    int s_cur = 0, s_nxt = AT_SLOT, s_fre = 2 * AT_SLOT;
    bool l1 = false, l2 = false;
    AT_DMA(NT - 1, 0); AT_DMA(NT - 2, AT_SLOT);
    if (wid >= 4) __builtin_amdgcn_s_setprio(1);
    for (int t = NT - 1; t >= 0; --t) {
        if (t == 0) asm volatile("s_waitcnt vmcnt(0) lgkmcnt(0)\n\ts_barrier" ::: "memory");
        else if (l1 || l2) asm volatile("s_waitcnt vmcnt(10) lgkmcnt(0)\n\ts_barrier" ::: "memory");
        else asm volatile("s_waitcnt vmcnt(2) lgkmcnt(0)\n\ts_barrier" ::: "memory");
        const bool dstep = ((t & 1) == (wid >> 2)) && (D.i <= D.last) && !D.pend;
        if (dstep) decw_procA(D, false, dcinit, l15, g4);
        else if (D.pend) { decw_procB(D, l15, g4); D.pend = false; }
        if (t >= 2) AT_DMA(t - 2, s_fre);
        l2 = l1; l1 = false;
        const int kbase = 64 * t;
        if (kbase <= q0 + 30) {
            f32x16 p0 = splat16(cinit), p1 = splat16(cinit);
#pragma unroll
            for (int d0 = 0; d0 < 4; ++d0) {
                const bf16x8 k0 = *(const LAS bf16x8*)(kfb + s_cur + d0 * 2048), k1 = *(const LAS bf16x8*)(kfb + s_cur + d0 * 2048 + 512);
                p0 = MFMA32(k0, qr[d0], p0); p1 = MFMA32(k1, qr[d0], p1);
            }
            v4u pw[4];
            sb_tile2(p0, p1, carry, hi, kbase + 16 * hi, qpos, kbase + 63 >= q0, pw);
#pragma unroll
            for (int ks = 0; ks < 4; ++ks) {
                const LAS unsigned char* vp = vfb + s_cur + (ks >> 1) * 2048 + (ks & 1) * 512;
                const v4i16_t a0 = vtr(vp), a1 = vtr(vp + 256), b0 = vtr(vp + 4096), b1 = vtr(vp + 4096 + 256);
                const bf16x8 v0 = {a0[0], a0[1], a0[2], a0[3], a1[0], a1[1], a1[2], a1[3]}, v1 = {b0[0], b0[1], b0[2], b0[3], b1[0], b1[1], b1[2], b1[3]};
                o0 = MFMA32(__builtin_bit_cast(bf16x8, pw[ks]), v0, o0); o1 = MFMA32(__builtin_bit_cast(bf16x8, pw[ks]), v1, o1);
            }
        }
        if (dstep) { D.pend = true; ++D.i; if (D.i <= D.last) { decw_load(F, D, l15, g4); l1 = true; } }
        const int tmp = s_fre; s_fre = s_cur; s_cur = s_nxt; s_nxt = tmp;
    }
    __builtin_amdgcn_s_setprio(0);
    LAS bf16* stg = (LAS bf16*)(L + AT_O) + wid * 2048;
#pragma unroll
    for (int r = 0; r < 16; ++r) { const int orow = crow(r, hi); stg[orow * 64 + r32] = pg8::bf1(o0[r]); stg[orow * 64 + 32 + r32] = pg8::bf1(o1[r]); }
    asm volatile("s_waitcnt lgkmcnt(0)" ::: "memory");
#pragma unroll
    for (int i = 0; i < 4; ++i) {
        const int row = i * 8 + (lane >> 3), ch = lane & 7; const size_t grow = (size_t)rowbase + q0 + row;
        const v4u ov = *(const LAS v4u*)(stg + row * 64 + ch * 8), gv = *(const v4u*)(F.GA() + grow * 512 + h * 64 + ch * 8);
        f32x4 x, y;
        x[0] = bflo(ov[0]) * bflo(gv[0]); x[1] = bfhi(ov[0]) * bfhi(gv[0]); x[2] = bflo(ov[1]) * bflo(gv[1]); x[3] = bfhi(ov[1]) * bfhi(gv[1]);
        y[0] = bflo(ov[2]) * bflo(gv[2]); y[1] = bfhi(ov[2]) * bfhi(gv[2]); y[2] = bflo(ov[3]) * bflo(gv[3]); y[3] = bfhi(ov[3]) * bfhi(gv[3]);
        *(pg8::u32x4*)(F.MIX() + grow * 1024 + h * 64 + ch * 8) = pg8::pack8(x, y);
    }
    asm volatile("s_waitcnt lgkmcnt(0)\n\ts_barrier" ::: "memory");
#undef AT_DMA
}
constexpr int DW_OB = 90112, DW_CB = 106496;
__device__ __forceinline__ void attn_pair_dec(Frame& F, int it) {
    const int lane = F.lane, l15 = lane & 15, g4 = lane >> 4, wid = F.wave;
    const int bh = it >> 4, x = it & 15;
    DecW D; D.s = it >> 3; D.h = it & 7; D.w = wid; D.carry = 1.f; D.i = 1; D.last = 64; D.pend = false;
    D.pagev = F.pt[D.s * NPG + 8 * wid + (lane & 7)];
    D.tb = F.lds + RING_OFF + DW_T + wid * 2048;
#pragma unroll
    for (int dt = 0; dt < 4; ++dt) D.o[dt] = (f32x4){0.f, 0.f, 0.f, 0.f};
#pragma unroll
    for (int ks = 0; ks < 2; ++ks) D.qb[ks] = *(const bf16x8*)(F.QA() + ((size_t)MP + D.s * 8 + (l15 & 7)) * 512 + D.h * 64 + 32 * ks + 8 * g4);
    const float dcinit = -F.sbb[D.h] * LOG2E;
    if (wid == 7) {
        const size_t row = (size_t)MP + D.s * 8;
        const bf16* kp = F.KA() + (row + (l15 & 7)) * 512 + D.h * 64 + 8 * g4;
#pragma unroll
        for (int ks = 0; ks < 2; ++ks) { const v4u w = *(const v4u*)(kp + 32 * ks);
            D.S.k[2 * ks] = (f32x4){bflo(w[0]), bfhi(w[0]), bflo(w[1]), bfhi(w[1])}; D.S.k[2 * ks + 1] = (f32x4){bflo(w[2]), bfhi(w[2]), bflo(w[3]), bfhi(w[3])}; }
        const bf16* vp = F.VA() + (row + (l15 & 7)) * 512 + D.h * 64 + 4 * g4;
#pragma unroll
        for (int j = 0; j < 4; ++j) { const u32x2 w = *(const u32x2*)(vp + 16 * j); D.S.v[j] = (f32x4){bflo(w.x), bfhi(w.x), bflo(w.y), bfhi(w.y)}; }
        decw_proc(D, true, dcinit, l15, g4);
    }
    decw_load(F, D, l15, g4);
    asm volatile("s_waitcnt vmcnt(0)" ::: "memory");
    attn_unit_dec(F, bh >> 3, bh & 7, 31 - x, D);
    attn_unit_dec(F, bh >> 3, bh & 7, x, D);
    if (D.pend) { decw_procB(D, l15, g4); D.pend = false; }
    while (D.i <= D.last) { decw_proc(D, false, dcinit, l15, g4); ++D.i; if (D.i <= D.last) decw_load(F, D, l15, g4); }
    LAS float* ob = (LAS float*)(F.lds + RING_OFF + DW_OB); LAS float* cb = (LAS float*)(F.lds + RING_OFF + DW_CB);
    if (g4 < 2) {
#pragma unroll
        for (int dt = 0; dt < 4; ++dt)
#pragma unroll
            for (int r = 0; r < 4; ++r) ob[(wid * 8 + 4 * g4 + r) * 64 + 16 * dt + l15] = D.o[dt][r];
        if (g4 == 0 && l15 < 8) cb[wid * 8 + l15] = D.carry;
    }
    __syncthreads();
    {
        const int q = F.tid >> 6, d = F.tid & 63; float acc = 0.f, pref = 1.f;
#pragma unroll
        for (int w = 7; w >= 0; --w) { acc += pref * ob[(w * 8 + q) * 64 + d]; pref *= cb[w * 8 + q]; }
        const size_t row = (size_t)MP + D.s * 8 + q;
        F.MIX()[row * 1024 + D.h * 64 + d] = pg8::bf1(acc * bf2f(F.GA()[row * 512 + D.h * 64 + d]));
    }
    __syncthreads();
}

#ifndef MK_N_LAUNCHES
#define MK_N_LAUNCHES 1
#endif
constexpr int NPH = 15;
constexpr int N_LAUNCHES = MK_N_LAUNCHES;
struct Args { const void* in[17]; float* out; unsigned char* ws; int ph_lo, ph_hi, li, pad; };
__global__ void __launch_bounds__(NWAVES * 64, 2) mk_fwd(Args args) {
    extern __shared__ __attribute__((aligned(16))) unsigned char lds[];
    Frame F;
    F.lds = (LAS unsigned char*)lds;
    F.MISC = (volatile LAS unsigned*)(F.lds + MISC_OFF);
    F.tid = threadIdx.x; F.lane = F.tid & 63; F.wave = __builtin_amdgcn_readfirstlane(F.tid >> 6);
    F.G = gridDim.x; F.bid = blockIdx.x;
    unsigned char* ws = args.ws;
    F.ctl = (gu32*)(ws + WS_CTL);
    F.xp = (const float*)args.in[0]; F.xs = (const float*)args.in[1]; F.ck = (const float*)args.in[2]; F.cv = (const float*)args.in[3]; F.pt = (const int*)args.in[4];
    F.st_h = (const float*)args.in[5]; F.st_r = (const float*)args.in[6]; F.ng = (const float*)args.in[7]; F.w1 = (const float*)args.in[8]; F.w2 = (const float*)args.in[9];
    F.qg = (const float*)args.in[10]; F.kg = (const float*)args.in[11]; F.sbb = (const float*)args.in[12]; F.hlb = (const float*)args.in[13]; F.og = (const float*)args.in[14];
    F.w3 = (const float*)args.in[15]; F.w4 = (const float*)args.in[16]; F.out = args.out;
    F.ws = ws;
    for (int u = F.tid; u < (LDS_BYTES - LDSCTL_OFF) / 4; u += NWAVES * 64) ((LAS unsigned*)(F.lds + LDSCTL_OFF))[u] = 0u;
    __syncthreads();
    XcdBarrier bar; bar.bar = (unsigned*)(F.ctl + CW_BAR); bar.x = 0; bar.st = nullptr;
    if (N_LAUNCHES == 1) bar = xcd_barrier_post((unsigned*)(F.ctl + CW_BAR), F.MISC + 8);
#define GRID_BAR() do { if (N_LAUNCHES == 1) xcd_barrier(bar); } while (0)
    const int lo = args.ph_lo, hi = args.ph_hi;
#define IN(k) (lo <= (k) && (k) < hi)
    const int gw = F.bid * NWAVES + F.wave, NGW = F.G * NWAVES;
    const int vcu_ = (F.G % 8 == 0) ? (F.bid % 8) * (F.G / 8) + F.bid / 8 : F.bid;

    if (IN(0)) { p0_prologue(F); GRID_BAR(); }
    if (IN(1)) {
        pg8::Gemm g{1024, 1024, 1024}; pg8::SchedPlain S; S.init(F.H(), F.W1T(), MP, N1, 1024, F.G, F.bid);
        pg8::EpiEven E{F.QA(), F.KA(), F.VAT(), F.GA(), F.QB(), F.KB(), F.VB(), F.GB(), F.LOGF(), F.out, F.qg, F.kg, F.hlb, -0.125f * LOG2E, MT, MP, OK_P, OK_S, OV_P, OV_S};
        pg8::gemm_phase<pg8::EpiEven, pg8::SchedPlain, true, true>(F.lds + RING_OFF, g, S, E);
        { pg8::Gemm gs{256, 1024, 1024}; pg8::SchedSplit Ss{(const char*)(F.H() + (size_t)MP * 1024), (const char*)F.W1T(), N1 / 256, 4, F.G, F.bid, 2048, 2048};
          pg8::EpiSlab Es{F.SLAB(), N1}; pg8::gemm_phase<pg8::EpiSlab, pg8::SchedSplit, true, true>(F.lds + RING_OFF, gs, Ss, Es); }
        GRID_BAR();
    }
    if (IN(2)) {
        for (int it = gw; it < MSM * 8; it += NGW) pp1_item(F, it);
        for (int u = F.bid; u < 8 * 32; u += F.G) hgrn_chunk_unit2<false>(F, u >> 5, u & 31);
        GRID_BAR();
    }
    if (IN(3)) {
        hgrn_passB(F);
        for (int u = F.bid; u < NSQ * HB; u += F.G) hgrn_sample_unit(F, u >> 2, u & 3);
        { const int vcu = (F.G % 8 == 0) ? (F.bid % 8) * (F.G / 8) + F.bid / 8 : F.bid;
          for (int it = vcu; it < 256; it += F.G) attn_pair_dec(F, it); }
        GRID_BAR();
    }
    if (IN(4)) {
        for (int u = F.bid; u < 8 * 32; u += F.G) hgrn_chunk_unit2<true>(F, u >> 5, u & 31);
        { pg8::Gemm gs{256, 1024, 1024}; pg8::SchedSplit Ss{(const char*)(F.MIX() + (size_t)MP * 1024), (const char*)F.W2T(), 4, 4, F.G, F.bid, 2048, 2048};
          pg8::EpiSlab Es{F.SLAB(), 1024}; pg8::gemm_phase<pg8::EpiSlab, pg8::SchedSplit, true, true>(F.lds + RING_OFF, gs, Ss, Es); }
        GRID_BAR();
    }
    if (IN(6)) {
        pg8::Gemm g{1024, 1024, 1024}; pg8::SchedPlain S; S.init(F.MIX(), F.W2T(), MP, 1024, 1024, F.G, F.bid);
        pg8::EpiY1 E{F.xp, F.Y1B(), F.SS1()};
        pg8::gemm_phase<pg8::EpiY1, pg8::SchedPlain, true, true>(F.lds + RING_OFF, g, S, E);
        for (int r = gw; r < MSM; r += NGW) pp2_row(F, r);
        GRID_BAR();
    }
    if (IN(8)) {
        pg8::Gemm g{1024, 1024, 1024};
        { pg8::Sched3<0> S; S.init(F.Y1B(), F.W3T(), F.G, F.bid); pg8::EpiOdd3<0> E{F.AQ(), F.KCH(), F.KCT(), F.BV(), F.GC(), F.QC(), F.KC(), F.VC(), F.RCOS(), F.RSIN(), F.RCOST(), F.RSINT(), MP, F.SS1()};
          pg8::gemm_phase<pg8::EpiOdd3<0>, pg8::Sched3<0>, true, true>(F.lds + RING_OFF, g, S, E); }
        { pg8::Sched3<1> S; S.init(F.Y1B(), F.W3T(), F.G, F.bid); pg8::EpiOdd3<1> E{F.AQ(), F.KCH(), F.KCT(), F.BV(), F.GC(), F.QC(), F.KC(), F.VC(), F.RCOS(), F.RSIN(), F.RCOST(), F.RSINT(), MP, F.SS1()};
          pg8::gemm_phase<pg8::EpiOdd3<1>, pg8::Sched3<1>, true, true>(F.lds + RING_OFF, g, S, E); }
        { pg8::Gemm gs{256, 1024, 1024}; pg8::SchedSplit Ss{(const char*)(F.H() + (size_t)MP * 1024), (const char*)F.W3T(), N3 / 256, 4, F.G, F.bid, 2048, 2048};
          pg8::EpiSlab Es{F.SLAB(), N3}; pg8::gemm_phase<pg8::EpiSlab, pg8::SchedSplit, true, true>(F.lds + RING_OFF, gs, Ss, Es); }
        GRID_BAR();
    }
    if (IN(9)) {
        { pg8::Gemm g{256, 512, 256}; pg8::SchedRet S{(const char*)F.BV(), (const char*)F.KCT(), F.G, vcu_, 0};
          pg8::EpiRetA E{(pg8::bf16_t*)F.DST()};
          pg8::gemm_phase<pg8::EpiRetA, pg8::SchedRet, true, true>(F.lds + RING_OFF, g, S, E); }
        { pg8::Gemm g{256, 2048, 1024}; pg8::SchedRet S{(const char*)F.AQ(), (const char*)F.KCH(), F.G, vcu_, 1};
          pg8::EpiRetP E{F.AQ()};
          pg8::gemm_phase<pg8::EpiRetP, pg8::SchedRet, true, true>(F.lds + RING_OFF, g, S, E); }
        for (int it = gw; it < MSM * 24; it += NGW) pp3_item(F, it);
        GRID_BAR();
    }
    if (IN(10)) {
        ret_passB(F);
        for (int u = F.bid; u < NSQ * HC * 2; u += F.G) ret_sample_unit(F, u >> 3, (u >> 1) & 3, u & 1);
        GRID_BAR();
    }
    if (IN(12)) {
        pg8::Gemm g{512, 2048, 512}; pg8::SchedRet S{(const char*)F.AQ(), (const char*)F.BV(), F.G, vcu_, 2};
        pg8::EpiRetO E{F.GC(), F.MIX2(), F.SS()};
        pg8::gemm_phase<pg8::EpiRetO, pg8::SchedRet, true, true>(F.lds + RING_OFF, g, S, E);
        { pg8::Gemm gs{256, 2048, 2048}; pg8::SchedSplit Ss{(const char*)(F.MIX2() + (size_t)MP * 2048), (const char*)F.W4T(), 4, 8, F.G, F.bid, 4096, 4096};
          pg8::EpiSlab Es{F.SLAB4(), 1024}; pg8::gemm_phase<pg8::EpiSlab, pg8::SchedSplit, true, true>(F.lds + RING_OFF, gs, Ss, Es); }
        GRID_BAR();
    }
    if (IN(14)) {
        pg8::Gemm g{2048, 2048, 2048}; pg8::SchedPlain S; S.init(F.MIX2(), F.W4T(), MP, 1024, 2048, F.G, F.bid);
        pg8::EpiOut E{F.Y1B(), F.out + OY_P, F.SS()};
        pg8::gemm_phase<pg8::EpiOut, pg8::SchedPlain, true, true>(F.lds + RING_OFF, g, S, E);
        for (int r = gw; r < MSM; r += NGW) pp4_row(F, r);
    }
#undef IN
}

extern "C" void kernel_launch(void* const* d_in, const int* in_sizes, int n_in, void* d_out, int out_size, void* d_ws, size_t ws_size, hipStream_t stream) {
    static int grid = 0;
    if (grid == 0) {
        if (n_in != 17 || (size_t)out_size != OUT_TOTAL || ws_size < WS_END) { fprintf(stderr, "kernel_launch: unexpected shapes: n_in %d out %d ws %zu (need %zu)\n", n_in, out_size, ws_size, (size_t)WS_END); grid = -1; return; }
        int dev = 0, cus = 0, per_cu = 0;
        if (hipGetDevice(&dev) != hipSuccess || hipDeviceGetAttribute(&cus, hipDeviceAttributeMultiprocessorCount, dev) != hipSuccess) { grid = -1; return; }
        if (hipFuncSetAttribute((const void*)mk_fwd, hipFuncAttributeMaxDynamicSharedMemorySize, LDS_BYTES) != hipSuccess) { fprintf(stderr, "kernel_launch: hipFuncSetAttribute failed\n"); grid = -1; return; }
        if (hipOccupancyMaxActiveBlocksPerMultiprocessor(&per_cu, (const void*)mk_fwd, NWAVES * 64, LDS_BYTES) != hipSuccess || per_cu < 1) { fprintf(stderr, "kernel_launch: occupancy query says %d\n", per_cu); }
        (void)hipGetLastError();
        grid = cus;
    }
    if (grid < 0) return;
    if (hipMemsetAsync((char*)d_ws + WS_CTL, 0, (size_t)409600  , stream) != hipSuccess) return;
    Args a{};
    for (int i = 0; i < 17; ++i) a.in[i] = d_in[i];
    a.out = (float*)d_out; a.ws = (unsigned char*)d_ws;
    for (int li = 0; li < N_LAUNCHES; ++li) {
        a.ph_lo = (N_LAUNCHES == 1) ? 0 : li; a.ph_hi = (N_LAUNCHES == 1) ? NPH : li + 1; a.li = li;
        hipLaunchKernelGGL(mk_fwd, dim3(grid), dim3(NWAVES * 64), LDS_BYTES, stream, a);
        if (hipPeekAtLastError() != hipSuccess) break;
    }
}
```
